# Optimizing an MI355X kernel written in HIP

```python
import math
import jax, jax.numpy as jnp
from jax import lax
import numpy as np

D_MODEL = 2048
BATCH = 4
SEQ = 2048
DEPTH = 1
DEC_BATCH = 128
DEC_SEQ = 1
PAST_LEN = 16384
PAGE_SIZE = 128

D_S5 = D_MODEL // 2
S5_GROUP = 16
S5_GROUPS = D_S5 // S5_GROUP
S5_STATE = 64
D_LRU = D_MODEL // 2
LRU_HEADS = 16
LRU_HEAD_DIM = D_LRU // LRU_HEADS
CONV_W = 4
LRU_C = 8.0
D_IN = D_S5 + 2 * D_LRU
D_MIX = D_S5 + D_LRU
D_FF = 11 * D_MODEL // 4
EPS = 1e-6

kernel_name = "hymba_s5_rglru_macaron_step"


def _rmsnorm(x, g):
    xf = x.astype(jnp.float32)
    y = xf * lax.rsqrt(jnp.mean(xf * xf, axis=-1, keepdims=True) + EPS)
    return (y * g.astype(jnp.float32)).astype(x.dtype)


def _swiglu(x, w1, w3, w2):
    return (jax.nn.silu(x @ w1) * (x @ w3)) @ w2


def _linear_scan(a, b):
    def comb(e1, e2):
        a1, b1 = e1
        a2, b2 = e2
        return a2 * a1, a2 * b1 + b2
    return lax.associative_scan(comb, (a, b), axis=0)


def _s5(u, h0, lam_re, lam_im, log_dt, b_re, b_im, c_re, c_im, d_skip, w_glu, b_glu):
    f32 = jnp.float32
    bsz, L, _ = u.shape
    uf = u.astype(f32)
    lam = lax.complex(lam_re.astype(f32), lam_im.astype(f32))
    dt = jnp.exp(log_dt.astype(f32))[:, None]
    lam_bar = jnp.exp(lam * dt)
    b_mat = lax.complex(b_re.astype(f32), b_im.astype(f32))
    b_bar = ((lam_bar - 1.0) / lam)[..., None] * b_mat
    ug = uf.reshape(bsz, L, S5_GROUPS, S5_GROUP).transpose(1, 0, 2, 3)
    bu = jnp.einsum('lbgc,gpc->lbgp', ug.astype(jnp.complex64), b_bar)
    a = jnp.broadcast_to(lam_bar, (L, 1) + lam_bar.shape)
    a_cum, h = _linear_scan(a, bu)
    h = h + a_cum * h0[None]
    c_mat = lax.complex(c_re.astype(f32), c_im.astype(f32))
    y = jnp.real(jnp.einsum('lbgp,gcp->lbgc', h, c_mat))
    y = y.transpose(1, 0, 2, 3).reshape(bsz, L, D_S5) + d_skip.astype(f32) * uf
    g = jax.nn.gelu(y).astype(u.dtype)
    out = g * jax.nn.sigmoid(g @ w_glu + b_glu)
    return out, h[-1]


def _rglru(x, gate, conv_buf, h0, conv_w, conv_b, w_a, b_a, w_x, b_x, lam_l):
    f32 = jnp.float32
    bsz, L, _ = x.shape
    xp = jnp.concatenate([conv_buf.astype(x.dtype), x], axis=1)
    xc = conv_b + sum(xp[:, k:k + L] * conv_w[k] for k in range(CONV_W))
    new_buf = xp[:, L:]
    xh = xc.reshape(bsz, L, LRU_HEADS, LRU_HEAD_DIM)
    r = jax.nn.sigmoid(jnp.einsum('blhi,hij->blhj', xh, w_a).reshape(bsz, L, D_LRU) + b_a)
    i = jax.nn.sigmoid(jnp.einsum('blhi,hij->blhj', xh, w_x).reshape(bsz, L, D_LRU) + b_x)
    log_a = -LRU_C * r.astype(f32) * jax.nn.softplus(-lam_l.astype(f32))
    a = jnp.exp(log_a)
    bx = jnp.sqrt(-jnp.expm1(2.0 * log_a)) * (i.astype(f32) * xc.astype(f32))
    a_cum, h = _linear_scan(a.transpose(1, 0, 2), bx.transpose(1, 0, 2))
    h = h + a_cum * h0.astype(f32)[None]
    y = h.transpose(1, 0, 2).astype(x.dtype) * jax.nn.gelu(gate)
    return y, h[-1], new_buf


def _layer(x, s5_h0, lru_h0, conv_buf,
           g_ffn1, w1_a, w3_a, w2_a, g_mix, w_in,
           lam_re, lam_im, log_dt, b_re, b_im, c_re, c_im, d_skip, w_glu, b_glu,
           conv_w, conv_b, w_a, b_a, w_x, b_x, lam_l,
           g_out_s5, g_out_lru, w_out, g_ffn2, w1_b, w3_b, w2_b):
    x = x + 0.5 * _swiglu(_rmsnorm(x, g_ffn1), w1_a, w3_a, w2_a)
    xn = _rmsnorm(x, g_mix)
    proj = xn @ w_in
    u_s5 = proj[..., :D_S5]
    x_lru = proj[..., D_S5:D_S5 + D_LRU]
    gate = proj[..., D_S5 + D_LRU:]
    s5_out, s5_h = _s5(u_s5, s5_h0, lam_re, lam_im, log_dt, b_re, b_im, c_re, c_im, d_skip, w_glu, b_glu)
    lru_out, lru_h, new_buf = _rglru(x_lru, gate, conv_buf, lru_h0, conv_w, conv_b, w_a, b_a, w_x, b_x, lam_l)
    merged = jnp.concatenate([_rmsnorm(s5_out, g_out_s5), _rmsnorm(lru_out, g_out_lru)], axis=-1)
    x = x + merged @ w_out
    x = x + 0.5 * _swiglu(_rmsnorm(x, g_ffn2), w1_b, w3_b, w2_b)
    return x, s5_h, lru_h, new_buf


def setup_inputs(seed: int = 0) -> dict:
    key = jax.random.key(seed)
    ks = jax.random.split(key, 40)
    f32 = jnp.float32
    nrm = lambda k, shape, s: jax.random.normal(k, shape, f32) * s
    gain = lambda k, shape: 1.0 + 0.01 * jax.random.normal(k, shape, f32)
    n = jnp.arange(S5_STATE, dtype=f32)
    a0 = jax.random.uniform(ks[30], (DEPTH, D_LRU), f32, 0.9, 0.999)
    sig = a0 ** (1.0 / LRU_C)
    return {
        "x_prompt": nrm(ks[0], (BATCH, SEQ, D_MODEL), 1.0),
        "x_sample": nrm(ks[1], (DEC_BATCH, DEC_SEQ, D_MODEL), 1.0),
        "state_s5_re": nrm(ks[2], (DEPTH, DEC_BATCH, S5_GROUPS, S5_STATE), 0.1),
        "state_s5_im": nrm(ks[3], (DEPTH, DEC_BATCH, S5_GROUPS, S5_STATE), 0.1),
        "state_lru_h": nrm(ks[4], (DEPTH, DEC_BATCH, D_LRU), 0.5),
        "state_lru_conv": nrm(ks[5], (DEPTH, DEC_BATCH, CONV_W - 1, D_LRU), 1.0),
        "g_ffn1": gain(ks[6], (DEPTH, D_MODEL)),
        "w1_a": nrm(ks[7], (DEPTH, D_MODEL, D_FF), D_MODEL ** -0.5),
        "w3_a": nrm(ks[8], (DEPTH, D_MODEL, D_FF), D_MODEL ** -0.5),
        "w2_a": nrm(ks[9], (DEPTH, D_FF, D_MODEL), D_FF ** -0.5),
        "g_mix": gain(ks[10], (DEPTH, D_MODEL)),
        "w_in": nrm(ks[11], (DEPTH, D_MODEL, D_IN), D_MODEL ** -0.5),
        "lam_re": -0.5 + nrm(ks[12], (DEPTH, S5_GROUPS, S5_STATE), 0.01),
        "lam_im": math.pi * n + nrm(ks[13], (DEPTH, S5_GROUPS, S5_STATE), 0.01),
        "log_dt": jax.random.uniform(ks[14], (DEPTH, S5_GROUPS), f32, math.log(1e-3), math.log(1e-1)),
        "b_re": nrm(ks[15], (DEPTH, S5_GROUPS, S5_STATE, S5_GROUP), (2 * S5_GROUP) ** -0.5),
        "b_im": nrm(ks[16], (DEPTH, S5_GROUPS, S5_STATE, S5_GROUP), (2 * S5_GROUP) ** -0.5),
        "c_re": nrm(ks[17], (DEPTH, S5_GROUPS, S5_GROUP, S5_STATE), (2 * S5_STATE) ** -0.5),
        "c_im": nrm(ks[18], (DEPTH, S5_GROUPS, S5_GROUP, S5_STATE), (2 * S5_STATE) ** -0.5),
        "d_skip": nrm(ks[19], (DEPTH, D_S5), 1.0),
        "w_glu": nrm(ks[20], (DEPTH, D_S5, D_S5), D_S5 ** -0.5),
        "b_glu": nrm(ks[21], (DEPTH, D_S5), 0.01),
        "conv_w": nrm(ks[22], (DEPTH, CONV_W, D_LRU), CONV_W ** -0.5),
        "conv_b": nrm(ks[23], (DEPTH, D_LRU), 0.01),
        "w_a": nrm(ks[24], (DEPTH, LRU_HEADS, LRU_HEAD_DIM, LRU_HEAD_DIM), LRU_HEAD_DIM ** -0.5),
        "b_a": nrm(ks[25], (DEPTH, D_LRU), 0.01),
        "w_x": nrm(ks[26], (DEPTH, LRU_HEADS, LRU_HEAD_DIM, LRU_HEAD_DIM), LRU_HEAD_DIM ** -0.5),
        "b_x": nrm(ks[27], (DEPTH, D_LRU), 0.01),
        "lam_l": jnp.log(sig) - jnp.log1p(-sig),
        "g_out_s5": gain(ks[28], (DEPTH, D_S5)),
        "g_out_lru": gain(ks[29], (DEPTH, D_LRU)),
        "w_out": nrm(ks[31], (DEPTH, D_MIX, D_MODEL), D_MIX ** -0.5),
        "g_ffn2": gain(ks[32], (DEPTH, D_MODEL)),
        "w1_b": nrm(ks[33], (DEPTH, D_MODEL, D_FF), D_MODEL ** -0.5),
        "w3_b": nrm(ks[34], (DEPTH, D_MODEL, D_FF), D_MODEL ** -0.5),
        "w2_b": nrm(ks[35], (DEPTH, D_FF, D_MODEL), D_FF ** -0.5),
        "g_final": gain(ks[36], (D_MODEL,)),
    }


def reference(x_prompt, x_sample, state_s5_re, state_s5_im, state_lru_h, state_lru_conv,
              g_ffn1, w1_a, w3_a, w2_a, g_mix, w_in,
              lam_re, lam_im, log_dt, b_re, b_im, c_re, c_im, d_skip, w_glu, b_glu,
              conv_w, conv_b, w_a, b_a, w_x, b_x, lam_l,
              g_out_s5, g_out_lru, w_out, g_ffn2, w1_b, w3_b, w2_b, g_final):
    f32 = jnp.float32

    def run(x, s5_re0, s5_im0, lru0, conv0):
        s5_re_new, s5_im_new, lru_new, conv_new = [], [], [], []
        for l in range(DEPTH):
            h0 = lax.complex(s5_re0[l].astype(f32), s5_im0[l].astype(f32))
            x, s5_h, lru_h, buf = _layer(
                x, h0, lru0[l], conv0[l],
                g_ffn1[l], w1_a[l], w3_a[l], w2_a[l], g_mix[l], w_in[l],
                lam_re[l], lam_im[l], log_dt[l], b_re[l], b_im[l], c_re[l], c_im[l], d_skip[l], w_glu[l], b_glu[l],
                conv_w[l], conv_b[l], w_a[l], b_a[l], w_x[l], b_x[l], lam_l[l],
                g_out_s5[l], g_out_lru[l], w_out[l], g_ffn2[l], w1_b[l], w3_b[l], w2_b[l])
            s5_re_new.append(jnp.real(s5_h).astype(s5_re0.dtype))
            s5_im_new.append(jnp.imag(s5_h).astype(s5_im0.dtype))
            lru_new.append(lru_h.astype(lru0.dtype))
            conv_new.append(buf.astype(conv0.dtype))
        y = _rmsnorm(x, g_final)
        return y, jnp.stack(s5_re_new), jnp.stack(s5_im_new), jnp.stack(lru_new), jnp.stack(conv_new)

    bp = x_prompt.shape[0]
    dt_p = x_prompt.dtype
    zeros_s5 = jnp.zeros((DEPTH, bp, S5_GROUPS, S5_STATE), dt_p)
    zeros_lru = jnp.zeros((DEPTH, bp, D_LRU), dt_p)
    zeros_conv = jnp.zeros((DEPTH, bp, CONV_W - 1, D_LRU), dt_p)
    y_prompt, p_s5_re, p_s5_im, p_lru_h, p_lru_conv = run(x_prompt, zeros_s5, zeros_s5, zeros_lru, zeros_conv)
    y_sample, s_s5_re, s_s5_im, s_lru_h, s_lru_conv = run(x_sample, state_s5_re, state_s5_im, state_lru_h, state_lru_conv)
    return (y_prompt, y_sample, p_s5_re, p_s5_im, p_lru_h, p_lru_conv, s_s5_re, s_s5_im, s_lru_h, s_lru_conv)
```

```cpp
#include <hip/hip_runtime.h>
#include <cstdio>
#include <cstdint>

#define LAS __attribute__((address_space(3)))
#define GAS __attribute__((address_space(1)))
typedef unsigned short bf16_t;
typedef short bf16x8 __attribute__((ext_vector_type(8)));
typedef float f32x4 __attribute__((ext_vector_type(4)));
typedef float f32x16 __attribute__((ext_vector_type(16)));
typedef unsigned u32x4 __attribute__((ext_vector_type(4)));
typedef unsigned u32x2 __attribute__((ext_vector_type(2)));

#ifndef MK_N_LAUNCHES
#define MK_N_LAUNCHES 1
#endif

constexpr int D = 2048, FF = 5632, DIN = 3072, DH = 1024;
constexpr int MP = 8192, MS = 128, M = MP + MS, MPAD = 8448;
constexpr int SEQ = 2048, NB = 4, NG = 64, NP = 64, GS = 16;
constexpr float EPS = 1e-6f;
constexpr int NPHASE = 10;
constexpr int NWAVES = 8;

constexpr size_t MiB = 1u << 20;
constexpr size_t WS_CTL = 0, CTL_ZERO_BYTES = 1 * MiB;
constexpr size_t WS_W13A = 1 * MiB, WS_W2A = 45 * MiB, WS_WIN = 67 * MiB, WS_WGLU = 79 * MiB, WS_WOUT = 81 * MiB, WS_W13B = 89 * MiB, WS_W2B = 133 * MiB;
constexpr size_t WS_S5M = 155 * MiB, WS_S5AUX = 171 * MiB;
constexpr size_t WS_XB = 172 * MiB;
constexpr size_t WS_X1 = 205 * MiB;
constexpr size_t WS_H = 271 * MiB;
constexpr size_t WS_U = 271 * MiB, WS_XLRU = WS_U + (size_t)MPAD * DH * 2, WS_GG = WS_XLRU + (size_t)MPAD * DH * 4, WS_MRG = WS_GG + (size_t)MPAD * DH * 2;
constexpr size_t WS_END = 370 * MiB;
static_assert(WS_MRG + (size_t)MPAD * D * 2 <= WS_END && WS_H + (size_t)MPAD * FF * 2 <= WS_END, "ws map");
constexpr int S5M_GROUP_BYTES = 256 * 1024;
constexpr int S5AUX_GROUP_FLOATS = 2304;
constexpr int CW_BAR = 4096;
constexpr size_t CTL_SSQ_BYTE = 262144;

constexpr int RING_BYTES = 131072;
constexpr int LDSCTL_OFF = RING_BYTES, MISC_OFF = LDSCTL_OFF + 320;
constexpr int LDS_BYTES = 147456;

__device__ __forceinline__ unsigned cvt_pk_bf16(float lo, float hi) { unsigned r; asm volatile("v_cvt_pk_bf16_f32 %0, %1, %2" : "=v"(r) : "v"(lo), "v"(hi)); return r; }
__device__ __forceinline__ float bf_lo(unsigned w) { return __uint_as_float(w << 16); }
__device__ __forceinline__ float bf_hi(unsigned w) { return __uint_as_float(w & 0xffff0000u); }
__device__ __forceinline__ float fexp(float x) { return __builtin_amdgcn_exp2f(x * 1.44269504089f); }
__device__ __forceinline__ float fsigmoid(float x) { return __builtin_amdgcn_rcpf(1.0f + fexp(-x)); }
__device__ __forceinline__ float fsilu(float x) { return x * fsigmoid(x); }
__device__ __forceinline__ float fgelu(float x) { return x * fsigmoid(1.5957691216057308f * (x + 0.044715f * x * x * x)); }
__device__ __forceinline__ u32x4 pack8(const f32x4 a, const f32x4 b) { u32x4 w; w.x = cvt_pk_bf16(a[0], a[1]); w.y = cvt_pk_bf16(a[2], a[3]); w.z = cvt_pk_bf16(b[0], b[1]); w.w = cvt_pk_bf16(b[2], b[3]); return w; }
__device__ __forceinline__ float dot4(const f32x4 a) { return (a[0] * a[0] + a[1] * a[1]) + (a[2] * a[2] + a[3] * a[3]); }
__device__ __forceinline__ float wave_sum(float v) {
#pragma unroll
    for (int o = 1; o < 64; o <<= 1) v += __shfl_xor(v, o);
    return v;
}
#define LDS_WAIT() asm volatile("s_waitcnt lgkmcnt(0)" ::: "memory")
#define VM_WAIT() asm volatile("s_waitcnt vmcnt(0)" ::: "memory")

namespace pg8 {
constexpr int BM = 256, BK = 64, HALF = 128, HTB = HALF * BK * 2, STAGE_BYTES = 8 * HTB, NXCD = 8, WGM = 8;
__host__ __device__ __forceinline__ int lds_byte(int r, int c) { const int st = (r >> 4) * 2 + (c >> 5), rr = r & 15, cc = c & 31, ob = rr * 64 + cc * 2; return st * 1024 + (ob ^ (((ob >> 9) & 1) << 5)); }
__host__ __device__ __forceinline__ void stage_rc(int b, int& R, int& C) { const int st = b / 1024, sb = b % 1024, swz = sb ^ (((sb >> 9) & 1) << 5); R = (st >> 1) * 16 + swz / 64; C = (st & 1) * 32 + (swz % 64) / 2; }
__host__ __device__ __forceinline__ int perm32(int rho) { const int n = rho >> 4, i = rho & 15; return 8 * (i >> 2) + 4 * n + (i & 3); }

struct Unit { int pm, pn, kt0, nkt; };
struct Gemm { const bf16_t* A; const bf16_t* Bt; int lda, ldb; };

struct StaticOrder {
    int nM, nN, nwg, G, c, nkt;
    __device__ void init(int nM_, int nN_, int nkt_, int G_, int c_) { nM = nM_; nN = nN_; nwg = nM * nN; G = G_; c = c_; nkt = nkt_; }
    __device__ bool next(int i, Unit& u) const {
        const long L = (long)i * G + c; if (L >= nwg) return false;
        int wgid = (int)L; { const int q = nwg / NXCD, r = nwg % NXCD, xcd = wgid % NXCD, off = wgid / NXCD; wgid = (xcd < r ? xcd * (q + 1) : r * (q + 1) + (xcd - r) * q) + off; }
        const int nig = WGM * nN, gid = wgid / nig, fm = gid * WGM, gsz = (nM - fm) < WGM ? (nM - fm) : WGM;
        u.pm = fm + ((wgid % nig) % gsz); u.pn = (wgid % nig) / gsz; u.kt0 = 0; u.nkt = nkt; return true;
    }
};

template <class Epi, class Sched>
__device__ __forceinline__ void gemm_phase(LAS unsigned char* lds, const Gemm g, const Sched& S, const Epi& E) {
    const int tid = threadIdx.x, wid = __builtin_amdgcn_readfirstlane(tid >> 6), lane = tid & 63, wr = wid >> 2, wc = wid & 3, fr = lane & 15, fq = lane >> 4;
    unsigned voffA[2], voffB[2];
#pragma unroll
    for (int i = 0; i < 2; ++i) { int R, C; stage_rc(tid * 16 + i * 8192, R, C); const int Rb = Epi::PERM ? ((R & ~31) + perm32(R & 31)) : R;
        voffA[i] = (unsigned)(R * g.lda + C) * 2u; voffB[i] = (unsigned)(Rb * g.ldb + C) * 2u; }
    const size_t kstep = (size_t)(BK * 2);
    const size_t hstepA = (size_t)HALF * g.lda * 2, hstepB = (size_t)HALF * g.ldb * 2;
    const size_t tstepA = 2 * hstepA, tstepB = 2 * hstepB;
    const unsigned ldsw = (unsigned)wid * 1024u;
    const int aoff = lds_byte(wr * 64 + fr, fq * 8), boff = lds_byte(wc * 32 + fr, fq * 8);
#define PG8_SA(b, h) (((b) * 2 + (h)) * HTB)
#define PG8_SB(b, h) ((4 + (b) * 2 + (h)) * HTB)
#define PG8_STAGE(bufoff, gbase, voff) do { _Pragma("unroll") for (int _i = 0; _i < 2; ++_i) \
        __builtin_amdgcn_global_load_lds((const unsigned*)((const char*)(gbase) + (voff)[_i]), (LAS unsigned*)(lds + (bufoff) + ldsw + _i * 8192), 16, 0, 0); } while (0)
#define PG8_LDA(dst, b, h) do { _Pragma("unroll") for (int m = 0; m < 4; ++m) _Pragma("unroll") for (int k = 0; k < 2; ++k) dst[m][k] = *(const LAS bf16x8*)(lds + PG8_SA(b, h) + aoff + m * 2048 + k * 1024); } while (0)
#define PG8_LDB(dst, b, h) do { _Pragma("unroll") for (int n = 0; n < 2; ++n) _Pragma("unroll") for (int k = 0; k < 2; ++k) dst[n][k] = *(const LAS bf16x8*)(lds + PG8_SB(b, h) + boff + n * 2048 + k * 1024); } while (0)
#define PG8_MMA(ai, bj, At, Bt) do { __builtin_amdgcn_s_setprio(1); _Pragma("unroll") for (int m = 0; m < 4; ++m) _Pragma("unroll") for (int n = 0; n < 2; ++n) _Pragma("unroll") for (int k = 0; k < 2; ++k) \
        acc[ai][bj][m][n] = __builtin_amdgcn_mfma_f32_16x16x32_bf16(Bt[n][k], At[m][k], acc[ai][bj][m][n], 0, 0, 0); __builtin_amdgcn_s_setprio(0); } while (0)
#define PG8_WAIT_V(n) asm volatile("s_waitcnt vmcnt(" #n ")" ::: "memory")
#define PG8_WAIT_L(n) asm volatile("s_waitcnt lgkmcnt(" #n ")" ::: "memory")
#define PG8_BAR __builtin_amdgcn_s_barrier()
#define PG8_SCHED __builtin_amdgcn_sched_barrier(0)
    Unit cur, nxt; int ui = 0;
    if (!S.next(0, cur)) return;
    f32x4 acc[2][2][4][2];
#pragma unroll
    for (int a = 0; a < 2; ++a)
#pragma unroll
        for (int b = 0; b < 2; ++b)
#pragma unroll
            for (int m = 0; m < 4; ++m)
#pragma unroll
                for (int n = 0; n < 2; ++n) acc[a][b][m][n] = (f32x4){0.f, 0.f, 0.f, 0.f};
    bf16x8 At[4][2], B0[2][2], B1[2][2];
    const char* cA = (const char*)g.A + (size_t)cur.pm * tstepA + (size_t)cur.kt0 * kstep;
    const char* cB = (const char*)g.Bt + (size_t)cur.pn * tstepB + (size_t)cur.kt0 * kstep;
    PG8_STAGE(PG8_SB(0, 0), cB, voffB); PG8_STAGE(PG8_SB(0, 1), cB + hstepB, voffB); PG8_STAGE(PG8_SA(0, 0), cA, voffA); PG8_STAGE(PG8_SA(0, 1), cA + hstepA, voffA);
    if (wr == 1) PG8_BAR;
    PG8_WAIT_V(2); PG8_BAR;
    PG8_STAGE(PG8_SB(1, 0), cB + kstep, voffB); PG8_STAGE(PG8_SA(1, 0), cA + kstep, voffA); PG8_STAGE(PG8_SB(1, 1), cB + hstepB + kstep, voffB);
    PG8_WAIT_V(6); PG8_BAR;
    for (;;) {
        const bool has_next = S.next(ui + 1, nxt);
        const char* nA = has_next ? (const char*)g.A + (size_t)nxt.pm * tstepA + (size_t)nxt.kt0 * kstep : cA;
        const char* nB = has_next ? (const char*)g.Bt + (size_t)nxt.pn * tstepB + (size_t)nxt.kt0 * kstep : cB;
        const int nt = cur.nkt;
        for (int t = 0; t < nt; t += 2) {
            const bool last = (t == nt - 2);
            const char* a1 = cA + (size_t)(t + 1) * kstep;
            const char* a2 = last ? nA : cA + (size_t)(t + 2) * kstep; const char* b2 = last ? nB : cB + (size_t)(t + 2) * kstep;
            const char* a3 = a2 + kstep; const char* b3 = b2 + kstep;
            if constexpr (Epi::HAS_MID) { if (t == Epi::MID_T) E.mid(acc, cur, wr, wc, fr, fq); }
            PG8_LDB(B0, 0, 0); PG8_LDB(B1, 0, 1); PG8_SCHED; PG8_LDA(At, 0, 0); PG8_STAGE(PG8_SA(1, 1), a1 + hstepA, voffA);
            PG8_WAIT_V(8); PG8_WAIT_L(0); PG8_BAR; PG8_MMA(0, 0, At, B0); PG8_MMA(0, 1, At, B1); PG8_BAR; PG8_SCHED;
            PG8_LDA(At, 0, 1); PG8_STAGE(PG8_SB(0, 0), b2, voffB); PG8_STAGE(PG8_SB(0, 1), b2 + hstepB, voffB); PG8_STAGE(PG8_SA(0, 0), a2, voffA);
            PG8_WAIT_V(8); PG8_WAIT_L(0); PG8_BAR; PG8_MMA(1, 0, At, B0); PG8_MMA(1, 1, At, B1); PG8_BAR; PG8_SCHED;
            PG8_LDB(B0, 1, 0); PG8_LDB(B1, 1, 1); PG8_SCHED; PG8_LDA(At, 1, 0); PG8_STAGE(PG8_SA(0, 1), a2 + hstepA, voffA);
            PG8_WAIT_V(8); PG8_WAIT_L(0); PG8_BAR; PG8_MMA(0, 0, At, B0); PG8_MMA(0, 1, At, B1); PG8_BAR; PG8_SCHED;
            PG8_LDA(At, 1, 1); PG8_STAGE(PG8_SB(1, 0), b3, voffB); PG8_STAGE(PG8_SB(1, 1), b3 + hstepB, voffB); PG8_STAGE(PG8_SA(1, 0), a3, voffA);
            PG8_WAIT_V(8); PG8_WAIT_L(0); PG8_BAR; PG8_MMA(1, 0, At, B0); PG8_MMA(1, 1, At, B1); PG8_BAR; PG8_SCHED;
        }
        if (wr == 0) PG8_BAR;
        E(acc, cur, wr, wc, fr, fq);
        if (!has_next) break;
#pragma unroll
        for (int a = 0; a < 2; ++a)
#pragma unroll
            for (int b = 0; b < 2; ++b)
#pragma unroll
                for (int m = 0; m < 4; ++m)
#pragma unroll
                    for (int n = 0; n < 2; ++n) acc[a][b][m][n] = (f32x4){0.f, 0.f, 0.f, 0.f};
        cur = nxt; cA = nA; cB = nB; ++ui;
        if (wr == 1) PG8_BAR;
    }
    PG8_WAIT_V(0);
    PG8_BAR;
#undef PG8_SA
#undef PG8_SB
#undef PG8_STAGE
#undef PG8_LDA
#undef PG8_LDB
#undef PG8_MMA
#undef PG8_WAIT_V
#undef PG8_WAIT_L
#undef PG8_BAR
#undef PG8_SCHED
}

typedef f32x4 Acc[2][2][4][2];

struct EpiSwiGLU {
    static constexpr bool PERM = true, HAS_MID = false; static constexpr int MID_T = -1;
    bf16_t* O; const float* ssq;
    __device__ __forceinline__ void mid(Acc&, const Unit&, int, int, int, int) const {}
    __device__ __forceinline__ void operator()(const Acc& acc, const Unit& u, int wr, int wc, int fr, int fq) const {
        int row0 = u.pm * BM + wr * 64 + fr, colh = u.pn * 128 + wc * 32 + 8 * fq; asm volatile("" : "+v"(row0), "+v"(colh));
#pragma unroll
        for (int ai = 0; ai < 2; ++ai)
#pragma unroll
            for (int m = 0; m < 4; ++m) {
                const int row = row0 + ai * HALF + m * 16;
                const float r = rsqrtf(ssq[row] * (1.0f / D) + EPS);
                f32x4 h0, h1;
#pragma unroll
                for (int j = 0; j < 4; ++j) { h0[j] = fsilu(acc[ai][0][m][0][j] * r) * (acc[ai][1][m][0][j] * r); h1[j] = fsilu(acc[ai][0][m][1][j] * r) * (acc[ai][1][m][1][j] * r); }
                *(u32x4*)(O + (size_t)row * FF + colh) = pack8(h0, h1);
            }
    }
};
struct EpiResid {
    static constexpr bool PERM = true, HAS_MID = false; static constexpr int MID_T = -1;
    const float* xp; const float* xs; float* X1; bf16_t* XB; float* ssq;
    __device__ __forceinline__ void mid(Acc&, const Unit&, int, int, int, int) const {}
    __device__ __forceinline__ void operator()(const Acc& acc, const Unit& u, int wr, int wc, int fr, int fq) const {
        int row0 = u.pm * BM + wr * 64 + fr, col0 = u.pn * BM + wc * 32 + 8 * fq; asm volatile("" : "+v"(row0), "+v"(col0));
#pragma unroll
        for (int ai = 0; ai < 2; ++ai)
#pragma unroll
            for (int m = 0; m < 4; ++m) {
                const int row = row0 + ai * HALF + m * 16;
                const float* xr = row < MP ? xp + (size_t)row * D : (row < M ? xs + (size_t)(row - MP) * D : nullptr);
                float s = 0.f;
#pragma unroll
                for (int bj = 0; bj < 2; ++bj) {
                    const int c = col0 + bj * HALF;
                    f32x4 r0 = (f32x4){0.f, 0.f, 0.f, 0.f}, r1 = r0;
                    if (xr) { r0 = *(const f32x4*)(xr + c); r1 = *(const f32x4*)(xr + c + 4); }
                    const f32x4 v0 = r0 + 0.5f * acc[ai][bj][m][0], v1 = r1 + 0.5f * acc[ai][bj][m][1];
                    *(f32x4*)(X1 + (size_t)row * D + c) = v0; *(f32x4*)(X1 + (size_t)row * D + c + 4) = v1;
                    *(u32x4*)(XB + (size_t)row * D + c) = pack8(v0, v1);
                    s += dot4(v0) + dot4(v1);
                }
                s += __shfl_xor(s, 16); s += __shfl_xor(s, 32);
                if (fq == 0) atomicAdd(ssq + row, s);
            }
    }
};
struct EpiProj {
    static constexpr bool PERM = true, HAS_MID = false; static constexpr int MID_T = -1;
    bf16_t* U; float* XL; bf16_t* GG; const float* ssq;
    __device__ __forceinline__ void mid(Acc&, const Unit&, int, int, int, int) const {}
    __device__ __forceinline__ void operator()(const Acc& acc, const Unit& u, int wr, int wc, int fr, int fq) const {
        int row0 = u.pm * BM + wr * 64 + fr, col0 = (u.pn & 3) * BM + wc * 32 + 8 * fq; const int seg = u.pn >> 2; asm volatile("" : "+v"(row0), "+v"(col0));
#pragma unroll
        for (int ai = 0; ai < 2; ++ai)
#pragma unroll
            for (int m = 0; m < 4; ++m) {
                const int row = row0 + ai * HALF + m * 16;
                const float r = rsqrtf(ssq[row] * (1.0f / D) + EPS);
#pragma unroll
                for (int bj = 0; bj < 2; ++bj) {
                    const size_t o = (size_t)row * DH + col0 + bj * HALF;
                    f32x4 v0 = acc[ai][bj][m][0] * r, v1 = acc[ai][bj][m][1] * r;
                    if (seg == 0) { *(u32x4*)(U + o) = pack8(v0, v1); }
                    else if (seg == 1) { *(f32x4*)(XL + o) = v0; *(f32x4*)(XL + o + 4) = v1; }
                    else {
#pragma unroll
                        for (int j = 0; j < 4; ++j) { v0[j] = fgelu(v0[j]); v1[j] = fgelu(v1[j]); }
                        *(u32x4*)(GG + o) = pack8(v0, v1);
                    }
                }
            }
    }
};
struct EpiGlu {
    static constexpr bool PERM = true, HAS_MID = false; static constexpr int MID_T = -1;
    const bf16_t* GS; const float* bias; bf16_t* MRG; float* ssq;
    __device__ __forceinline__ void mid(Acc&, const Unit&, int, int, int, int) const {}
    __device__ __forceinline__ void operator()(const Acc& acc, const Unit& u, int wr, int wc, int fr, int fq) const {
        int row0 = u.pm * BM + wr * 64 + fr, col0 = u.pn * BM + wc * 32 + 8 * fq; asm volatile("" : "+v"(row0), "+v"(col0));
#pragma unroll
        for (int ai = 0; ai < 2; ++ai)
#pragma unroll
            for (int m = 0; m < 4; ++m) {
                const int row = row0 + ai * HALF + m * 16;
                float s = 0.f;
#pragma unroll
                for (int bj = 0; bj < 2; ++bj) {
                    const int c = col0 + bj * HALF;
                    const u32x4 gw = *(const u32x4*)(GS + (size_t)row * DH + c);
                    const f32x4 b0 = *(const f32x4*)(bias + c), b1 = *(const f32x4*)(bias + c + 4);
                    const f32x4 g0 = (f32x4){bf_lo(gw.x), bf_hi(gw.x), bf_lo(gw.y), bf_hi(gw.y)}, g1 = (f32x4){bf_lo(gw.z), bf_hi(gw.z), bf_lo(gw.w), bf_hi(gw.w)};
                    f32x4 v0, v1;
#pragma unroll
                    for (int j = 0; j < 4; ++j) { v0[j] = g0[j] * fsigmoid(acc[ai][bj][m][0][j] + b0[j]); v1[j] = g1[j] * fsigmoid(acc[ai][bj][m][1][j] + b1[j]); }
                    *(u32x4*)(MRG + (size_t)row * D + c) = pack8(v0, v1);
                    s += dot4(v0) + dot4(v1);
                }
                s += __shfl_xor(s, 16); s += __shfl_xor(s, 32);
                if (fq == 0) atomicAdd(ssq + row, s);
            }
    }
};
struct EpiOut {
    static constexpr bool PERM = true, HAS_MID = true; static constexpr int MID_T = 16;
    const float* ssq_s5; const float* ssq_lru; float* X1; bf16_t* XB; float* ssq;
    __device__ __forceinline__ void mid(Acc& acc, const Unit& u, int wr, int wc, int fr, int fq) const {
        int row0 = u.pm * BM + wr * 64 + fr; asm volatile("" : "+v"(row0));
#pragma unroll
        for (int ai = 0; ai < 2; ++ai)
#pragma unroll
            for (int m = 0; m < 4; ++m) {
                const int row = row0 + ai * HALF + m * 16;
                const float f = rsqrtf(ssq_s5[row] * (1.0f / DH) + EPS) * sqrtf(ssq_lru[row] * (1.0f / DH) + EPS);
#pragma unroll
                for (int bj = 0; bj < 2; ++bj)
#pragma unroll
                    for (int n = 0; n < 2; ++n) acc[ai][bj][m][n] = acc[ai][bj][m][n] * f;
            }
    }
    __device__ __forceinline__ void operator()(const Acc& acc, const Unit& u, int wr, int wc, int fr, int fq) const {
        int row0 = u.pm * BM + wr * 64 + fr, col0 = u.pn * BM + wc * 32 + 8 * fq; asm volatile("" : "+v"(row0), "+v"(col0));
#pragma unroll
        for (int ai = 0; ai < 2; ++ai)
#pragma unroll
            for (int m = 0; m < 4; ++m) {
                const int row = row0 + ai * HALF + m * 16;
                const float r = rsqrtf(ssq_lru[row] * (1.0f / DH) + EPS);
                float s = 0.f;
#pragma unroll
                for (int bj = 0; bj < 2; ++bj) {
                    float* p = X1 + (size_t)row * D + col0 + bj * HALF;
                    const f32x4 v0 = *(const f32x4*)p + r * acc[ai][bj][m][0], v1 = *(const f32x4*)(p + 4) + r * acc[ai][bj][m][1];
                    *(f32x4*)p = v0; *(f32x4*)(p + 4) = v1;
                    *(u32x4*)(XB + (size_t)row * D + col0 + bj * HALF) = pack8(v0, v1);
                    s += dot4(v0) + dot4(v1);
                }
                s += __shfl_xor(s, 16); s += __shfl_xor(s, 32);
                if (fq == 0) atomicAdd(ssq + row, s);
            }
    }
};
struct EpiFinal {
    static constexpr bool PERM = true, HAS_MID = false; static constexpr int MID_T = -1;
    const float* X1; float* out; float* ssq;
    __device__ __forceinline__ void mid(Acc&, const Unit&, int, int, int, int) const {}
    __device__ __forceinline__ void operator()(const Acc& acc, const Unit& u, int wr, int wc, int fr, int fq) const {
        int row0 = u.pm * BM + wr * 64 + fr, col0 = u.pn * BM + wc * 32 + 8 * fq; asm volatile("" : "+v"(row0), "+v"(col0));
#pragma unroll
        for (int ai = 0; ai < 2; ++ai)
#pragma unroll
            for (int m = 0; m < 4; ++m) {
                const int row = row0 + ai * HALF + m * 16;
                float s = 0.f;
                if (row < M) {
#pragma unroll
                    for (int bj = 0; bj < 2; ++bj) {
                        const size_t o = (size_t)row * D + col0 + bj * HALF;
                        const f32x4 v0 = *(const f32x4*)(X1 + o) + 0.5f * acc[ai][bj][m][0], v1 = *(const f32x4*)(X1 + o + 4) + 0.5f * acc[ai][bj][m][1];
                        *(f32x4*)(out + o) = v0; *(f32x4*)(out + o + 4) = v1;
                        s += dot4(v0) + dot4(v1);
                    }
                }
                s += __shfl_xor(s, 16); s += __shfl_xor(s, 32);
                if (fq == 0 && row < M) atomicAdd(ssq + row, s);
            }
    }
};
}

#define XB_TMO      128
#define XB_XCNT(j)  (256  + 64 * (j))
#define XB_XSUB(j)  (1280 + 64 * (j))
#define XB_XGEN(j)  (2304 + 64 * (j))
#define XB_TOP      3328
#define XB_TOPGEN   3392
#define XCD_BAR_WORDS 3456
#define XB_SPIN_CAP (1u << 18)
__device__ __forceinline__ unsigned xb_ld(unsigned* p)              { return __hip_atomic_load(p, __ATOMIC_RELAXED, __HIP_MEMORY_SCOPE_AGENT); }
__device__ __forceinline__ unsigned xb_add(unsigned* p, unsigned v) { return __hip_atomic_fetch_add(p, v, __ATOMIC_RELAXED, __HIP_MEMORY_SCOPE_AGENT); }
__device__ __forceinline__ unsigned xb_xcc_id() { return (unsigned)__builtin_amdgcn_s_getreg((3 << 11) | 20) & 0xFu; }
#define XB_SPIN(cond, bar) do { unsigned _sp = 0; while (cond) { __builtin_amdgcn_s_sleep(1); \
    if ((++_sp & 255u) == 0u) { if (xb_ld(&(bar)[XB_TMO])) break; if (_sp > XB_SPIN_CAP) { atomicAdd(&(bar)[XB_TMO], 1u); break; } } } } while (0)
struct XcdBarrier { unsigned* bar; unsigned x; volatile LAS unsigned* st; };
__device__ __forceinline__ XcdBarrier xcd_barrier_post(unsigned* bar, volatile LAS unsigned* st) {
    XcdBarrier b; b.bar = bar; b.x = xb_xcc_id(); b.st = st;
    if (threadIdx.x == 0) (void)xb_add(&bar[XB_XCNT(b.x)], 1u);
    return b;
}
__device__ __forceinline__ void xcd_barrier_complete(unsigned* bar, unsigned x, unsigned& nloc, unsigned& nx) {
    const unsigned G = gridDim.x * gridDim.y * gridDim.z;
    unsigned sum, cnt, mine, sp = 0u;
    for (;;) {
        sum = 0u; cnt = 0u; mine = 0u;
#pragma unroll
        for (unsigned j = 0; j < 16; ++j) { const unsigned c = xb_ld(&bar[XB_XCNT(j)]); sum += c; cnt += (c > 0u) ? 1u : 0u; mine = (j == x) ? c : mine; }
        if (sum == G) break;
        __builtin_amdgcn_s_sleep(1);
        if ((++sp & 255u) == 0u) { if (xb_ld(&bar[XB_TMO])) break; if (sp > XB_SPIN_CAP) { atomicAdd(&bar[XB_TMO], 1u); break; } }
    }
    nloc = mine > 0u ? mine : 1u; nx = cnt > 0u ? cnt : 1u;
}
__device__ __forceinline__ void xcd_barrier(const XcdBarrier& b) {
    asm volatile("s_waitcnt vmcnt(0)" ::: "memory");
    __syncthreads();
    if (threadIdx.x == 0) {
        unsigned* bar = b.bar;
        __builtin_amdgcn_s_waitcnt(0);
        unsigned nloc = b.st[0], nx = b.st[1];
        if (nloc == 0u) { xcd_barrier_complete(bar, b.x, nloc, nx); b.st[0] = nloc; b.st[1] = nx; }
        const unsigned old = xb_add(&bar[XB_XSUB(b.x)], 1u);
        const unsigned gen = old / nloc;
        if (old + 1u == (gen + 1u) * nloc) {
            __builtin_amdgcn_fence(__ATOMIC_RELEASE, "agent");
            asm volatile("s_waitcnt vmcnt(0)" ::: "memory");
            const unsigned og = xb_add(&bar[XB_TOP], 1u);
            const unsigned tg = og / nx;
            if (og + 1u == (tg + 1u) * nx) xb_add(&bar[XB_TOPGEN], 1u);
            else XB_SPIN(xb_ld(&bar[XB_TOPGEN]) == tg, bar);
            __builtin_amdgcn_fence(__ATOMIC_ACQUIRE, "agent");
            xb_add(&bar[XB_XGEN(b.x)], 1u);
            asm volatile("s_waitcnt vmcnt(0)" ::: "memory");
        } else {
            XB_SPIN(xb_ld(&bar[XB_XGEN(b.x)]) == gen, bar);
            __builtin_amdgcn_fence(__ATOMIC_ACQUIRE, "agent");
            asm volatile("s_waitcnt vmcnt(0)" ::: "memory");
        }
    }
    __syncthreads();
}

enum { I_XP = 0, I_XS, I_S5RE, I_S5IM, I_LRUH, I_LRUCONV, I_GFFN1, I_W1A, I_W3A, I_W2A, I_GMIX, I_WIN, I_LAMRE, I_LAMIM, I_LOGDT, I_BRE, I_BIM, I_CRE, I_CIM,
       I_DSKIP, I_WGLU, I_BGLU, I_CONVW, I_CONVB, I_WA, I_BA, I_WX, I_BX, I_LAML, I_GS5, I_GLRU, I_WOUT, I_GFFN2, I_W1B, I_W3B, I_W2B, I_GFINAL, N_IN };
struct Args { const float* in[N_IN]; float* out; unsigned char* ws; int ph_lo, ph_hi; };
constexpr size_t O_Y = 0, O_PS5RE = (size_t)M * D, O_PS5IM = O_PS5RE + NB * NG * NP, O_PLRUH = O_PS5IM + NB * NG * NP, O_PLRUC = O_PLRUH + NB * DH,
                 O_SS5RE = O_PLRUC + NB * 3 * DH, O_SS5IM = O_SS5RE + (size_t)MS * NG * NP, O_SLRUH = O_SS5IM + (size_t)MS * NG * NP, O_SLRUC = O_SLRUH + (size_t)MS * DH,
                 O_END = O_SLRUC + (size_t)MS * 3 * DH;
static_assert(O_END == 18661376, "output size");

__device__ __forceinline__ void p0_transpose_item(const float* W, int N, const float* gk, bf16_t* WT, int ldt, int k0, int n0, int nd0, LAS float* scr, int lane) {
#pragma unroll 8
    for (int i = 0; i < 32; ++i) { const int kk = 2 * i + (lane >> 5); float v = W[(size_t)(k0 + kk) * N + n0 + (lane & 31)]; if (gk) v *= gk[k0 + kk]; scr[kk * 33 + (lane & 31)] = v; }
    LDS_WAIT(); asm volatile("" ::: "memory");
    const int c = lane & 7;
#pragma unroll
    for (int j = 0; j < 4; ++j) { const int n = (lane >> 3) + 8 * j; const LAS float* s = scr + (8 * c) * 33 + n;
        u32x4 o; o.x = cvt_pk_bf16(s[0 * 33], s[1 * 33]); o.y = cvt_pk_bf16(s[2 * 33], s[3 * 33]); o.z = cvt_pk_bf16(s[4 * 33], s[5 * 33]); o.w = cvt_pk_bf16(s[6 * 33], s[7 * 33]);
        *(u32x4*)(WT + (size_t)(nd0 + n) * ldt + k0 + 8 * c) = o; }
    LDS_WAIT(); asm volatile("" ::: "memory");
}
__device__ __forceinline__ void p0_weight(const float* W, int K, int N, const float* gk, bf16_t* WT, int dual, int off, LAS float* scr, int lane, int gw, int NGW) {
    const int nblk = N / 32, nitems = (K / 64) * nblk;
    for (int it = gw; it < nitems; it += NGW) {
        const int kb = it / nblk, nb = it % nblk, n0 = nb * 32;
        const int nd0 = dual ? ((n0 >> 7) * 256 + (n0 & 127) + off) : n0;
        p0_transpose_item(W, N, gk, WT, K, kb * 64, n0, nd0, scr, lane);
    }
}
__device__ __forceinline__ void sincos_d(double x, double& s, double& c) {
    const double k = rint(x * 0.63661977236758134308);
    double r = fma(-k, 1.57079632679489655800, x); r = fma(-k, 6.12323399573676603587e-17, r);
    const double r2 = r * r;
    double sp = -7.6471637318198164759e-13; sp = fma(sp, r2, 1.6059043836821614599e-10); sp = fma(sp, r2, -2.5052108385441718775e-8); sp = fma(sp, r2, 2.7557319223985890653e-6);
    sp = fma(sp, r2, -1.9841269841269841270e-4); sp = fma(sp, r2, 8.3333333333333333333e-3); sp = fma(sp, r2, -1.6666666666666666667e-1);
    const double sr = fma(sp * r2, r, r);
    double cp = 4.7794773323873852974e-14; cp = fma(cp, r2, -1.1470745597729724714e-11); cp = fma(cp, r2, 2.0876756987868098979e-9); cp = fma(cp, r2, -2.7557319223985890653e-7);
    cp = fma(cp, r2, 2.4801587301587301587e-5); cp = fma(cp, r2, -1.3888888888888888889e-3); cp = fma(cp, r2, 4.1666666666666666667e-2); cp = fma(cp, r2, -0.5);
    const double cr = fma(cp, r2, 1.0);
    const int q = ((int)k) & 3;
    s = (q == 0) ? sr : (q == 1) ? cr : (q == 2) ? -sr : -cr;
    c = (q == 0) ? cr : (q == 1) ? -sr : (q == 2) ? -cr : sr;
}
__device__ __forceinline__ void p0_s5_matrices(const Args& a, LAS unsigned char* lds, int vc, int tid) {
    const int g = vc >> 2, part = vc & 3;
    LAS float* LPre = (LAS float*)lds;
    LAS float* LPim = LPre + 17 * 64;
    LAS float* BBre = LPim + 17 * 64;
    LAS float* BBim = BBre + 1024;
    LAS float* CRe = BBim + 1024;
    LAS float* CIm = CRe + 1024;
    LAS float* Kt = CIm + 1024;
    const double dt = exp((double)a.in[I_LOGDT][g]);
    for (int idx = tid; idx < 17 * 64; idx += NWAVES * 64) {
        const int k = idx >> 6, p = idx & 63;
        const double lre = (double)a.in[I_LAMRE][g * 64 + p], lim = (double)a.in[I_LAMIM][g * 64 + p];
        const double mag = exp(lre * dt * (double)k); double s, c; sincos_d(lim * dt * (double)k, s, c);
        LPre[idx] = (float)(mag * c); LPim[idx] = (float)(mag * s);
    }
    for (int idx = tid; idx < 1024; idx += NWAVES * 64) {
        const int p = idx >> 4;
        const double lre = (double)a.in[I_LAMRE][g * 64 + p], lim = (double)a.in[I_LAMIM][g * 64 + p];
        const double mag = exp(lre * dt); double s, c; sincos_d(lim * dt, s, c);
        const double nr = mag * c - 1.0, ni = mag * s, den = lre * lre + lim * lim;
        const double qr = (nr * lre + ni * lim) / den, qi = (ni * lre - nr * lim) / den;
        const double br = (double)a.in[I_BRE][(size_t)g * 1024 + idx], bi = (double)a.in[I_BIM][(size_t)g * 1024 + idx];
        BBre[idx] = (float)(qr * br - qi * bi); BBim[idx] = (float)(qr * bi + qi * br);
        CRe[idx] = a.in[I_CRE][(size_t)g * 1024 + idx]; CIm[idx] = a.in[I_CIM][(size_t)g * 1024 + idx];
    }
    __syncthreads();
    for (int idx = tid; idx < 4096; idx += NWAVES * 64) {
        const int k = idx >> 8, c = (idx >> 4) & 15, cp = idx & 15;
        float acc = 0.f;
        for (int p = 0; p < 64; ++p) {
            const float lr = LPre[k * 64 + p], li = LPim[k * 64 + p], br = BBre[p * 16 + cp], bi = BBim[p * 16 + cp];
            const float tr = lr * br - li * bi, ti = lr * bi + li * br;
            acc += CRe[c * 64 + p] * tr - CIm[c * 64 + p] * ti;
        }
        if (k == 0 && c == cp) acc += a.in[I_DSKIP][g * 16 + c];
        Kt[idx] = acc;
    }
    __syncthreads();
    bf16_t* Win = (bf16_t*)(a.ws + WS_S5M + (size_t)g * S5M_GROUP_BYTES);
    bf16_t* MW = Win + 128 * 256;
    for (int idx = tid; idx < 64 * 48; idx += NWAVES * 64) {
        const int rr = idx / 48, cg = idx % 48, s = 4 * part + (rr >> 4), c = rr & 15;
        float v[8];
        if (cg < 32) { const int sp = cg >> 1, c0 = (cg & 1) * 8;
#pragma unroll
            for (int i = 0; i < 8; ++i) v[i] = (sp <= s) ? Kt[((s - sp) * 16 + c) * 16 + c0 + i] : 0.f;
        } else { const int im = cg >= 40, p0 = (cg - (im ? 40 : 32)) * 8;
#pragma unroll
            for (int i = 0; i < 8; ++i) { const int p = p0 + i; const float cr = CRe[c * 64 + p], ci = CIm[c * 64 + p], lr = LPre[(s + 1) * 64 + p], li = LPim[(s + 1) * 64 + p];
                v[i] = im ? -(cr * li + ci * lr) : (cr * lr - ci * li); }
        }
        u32x4 o; o.x = cvt_pk_bf16(v[0], v[1]); o.y = cvt_pk_bf16(v[2], v[3]); o.z = cvt_pk_bf16(v[4], v[5]); o.w = cvt_pk_bf16(v[6], v[7]);
        *(u32x4*)(MW + (size_t)(s * 16 + c) * 384 + cg * 8) = o;
    }
    for (int idx = tid; idx < 32 * 32; idx += NWAVES * 64) {
        const int n = 32 * part + (idx >> 5), cg = idx & 31, p = n & 63, im = n >> 6, sp = cg >> 1, c0 = (cg & 1) * 8;
        const float lr = LPre[(15 - sp) * 64 + p], li = LPim[(15 - sp) * 64 + p];
        float v[8];
#pragma unroll
        for (int i = 0; i < 8; ++i) { const float br = BBre[p * 16 + c0 + i], bi = BBim[p * 16 + c0 + i]; v[i] = im ? (lr * bi + li * br) : (lr * br - li * bi); }
        u32x4 o; o.x = cvt_pk_bf16(v[0], v[1]); o.y = cvt_pk_bf16(v[2], v[3]); o.z = cvt_pk_bf16(v[4], v[5]); o.w = cvt_pk_bf16(v[6], v[7]);
        *(u32x4*)(Win + (size_t)n * 256 + cg * 8) = o;
    }
    if (part == 0) {
        float* aux = (float*)(a.ws + WS_S5AUX) + (size_t)g * S5AUX_GROUP_FLOATS;
        for (int idx = tid; idx < 64; idx += NWAVES * 64) { aux[idx] = LPre[64 + idx]; aux[64 + idx] = LPim[64 + idx]; aux[128 + idx] = LPre[16 * 64 + idx]; aux[192 + idx] = LPim[16 * 64 + idx]; }
        for (int idx = tid; idx < 1024; idx += NWAVES * 64) { aux[256 + idx] = BBre[idx]; aux[1280 + idx] = BBim[idx]; }
    }
    __syncthreads();
}
__device__ __forceinline__ void p0_prologue(const Args& a, LAS unsigned char* lds, int vcu, int G, int tid, int lane, int wave) {
    p0_s5_matrices(a, lds, vcu, tid);
    LAS float* scr = (LAS float*)(lds + wave * 16384);
    const int gw = vcu * NWAVES + wave, NGW = G * NWAVES;
    unsigned char* ws = a.ws;
    bf16_t* XB = (bf16_t*)(ws + WS_XB); float* ssq0 = (float*)(ws + WS_CTL + CTL_SSQ_BYTE);
    for (int m = gw; m < MPAD; m += NGW) {
        u32x2* o = (u32x2*)(XB + (size_t)m * D) + lane;
        if (m < M) {
            const float* xr = m < MP ? a.in[I_XP] + (size_t)m * D : a.in[I_XS] + (size_t)(m - MP) * D;
            const f32x4* x4 = (const f32x4*)xr + lane; f32x4 v[8]; float s = 0.f;
#pragma unroll
            for (int j = 0; j < 8; ++j) { v[j] = x4[64 * j]; s += dot4(v[j]); }
            s = wave_sum(s);
#pragma unroll
            for (int j = 0; j < 8; ++j) { u32x2 w; w.x = cvt_pk_bf16(v[j][0], v[j][1]); w.y = cvt_pk_bf16(v[j][2], v[j][3]); o[64 * j] = w; }
            if (lane == 0) ssq0[m] = s;
        } else {
#pragma unroll
            for (int j = 0; j < 8; ++j) o[64 * j] = (u32x2){0u, 0u};
        }
    }
    p0_weight(a.in[I_W1A], D, FF, a.in[I_GFFN1], (bf16_t*)(ws + WS_W13A), 1, 0, scr, lane, gw, NGW);
    p0_weight(a.in[I_W3A], D, FF, a.in[I_GFFN1], (bf16_t*)(ws + WS_W13A), 1, 128, scr, lane, gw, NGW);
    p0_weight(a.in[I_W2A], FF, D, nullptr, (bf16_t*)(ws + WS_W2A), 0, 0, scr, lane, gw, NGW);
    p0_weight(a.in[I_WIN], D, DIN, a.in[I_GMIX], (bf16_t*)(ws + WS_WIN), 0, 0, scr, lane, gw, NGW);
    p0_weight(a.in[I_WGLU], DH, DH, nullptr, (bf16_t*)(ws + WS_WGLU), 0, 0, scr, lane, gw, NGW);
    {
        const int nblk = D / 32, nitems = (D / 64) * nblk;
        for (int it = gw; it < nitems; it += NGW) {
            const int kb = it / nblk, nb = it % nblk, k0 = kb * 64;
            const float* gk = k0 < DH ? a.in[I_GS5] : a.in[I_GLRU] - DH;
            p0_transpose_item(a.in[I_WOUT], D, gk, (bf16_t*)(ws + WS_WOUT), D, k0, nb * 32, nb * 32, scr, lane);
        }
    }
    p0_weight(a.in[I_W1B], D, FF, a.in[I_GFFN2], (bf16_t*)(ws + WS_W13B), 1, 0, scr, lane, gw, NGW);
    p0_weight(a.in[I_W3B], D, FF, a.in[I_GFFN2], (bf16_t*)(ws + WS_W13B), 1, 128, scr, lane, gw, NGW);
    p0_weight(a.in[I_W2B], FF, D, nullptr, (bf16_t*)(ws + WS_W2B), 0, 0, scr, lane, gw, NGW);
}

#define MFMA32(a, b, c) __builtin_amdgcn_mfma_f32_32x32x16_bf16((a), (b), (c), 0, 0, 0)
constexpr int SP_PITCH = 272;
__device__ __forceinline__ void s5_prompt(const Args& a, LAS unsigned char* lds, int b, int g, int tid, int lane, int wave) {
    const bf16_t* U = (const bf16_t*)(a.ws + WS_U);
    const bf16_t* Win = (const bf16_t*)(a.ws + WS_S5M + (size_t)g * S5M_GROUP_BYTES);
    const bf16_t* MW = Win + 128 * 256;
    bf16_t* GS5 = (bf16_t*)(a.ws + WS_XB);
    LAS float* Z = (LAS float*)lds;
    LAS unsigned char* SP = lds + 65536;
    const int r32 = lane & 31, hh = lane >> 5;
    {
        const int mt = wave & 3, nt0 = (wave >> 2) * 2;
        f32x16 acc0, acc1;
#pragma unroll
        for (int i = 0; i < 16; ++i) { acc0[i] = 0.f; acc1[i] = 0.f; }
        const bf16_t* xa = U + ((size_t)(b * SEQ + 16 * (32 * mt + r32))) * DH + 16 * g + 8 * hh;
        const bf16_t* w0 = Win + (size_t)(32 * nt0 + r32) * 256 + 8 * hh;
        const bf16_t* w1 = w0 + 32 * 256;
#pragma unroll 4
        for (int ks = 0; ks < 16; ++ks) {
            const bf16x8 af = *(const bf16x8*)(xa + (size_t)ks * DH);
            const bf16x8 b0 = *(const bf16x8*)(w0 + 16 * ks), b1 = *(const bf16x8*)(w1 + 16 * ks);
            acc0 = MFMA32(af, b0, acc0); acc1 = MFMA32(af, b1, acc1);
        }
#pragma unroll
        for (int i = 0; i < 16; ++i) { const int j = 32 * mt + (i & 3) + 8 * (i >> 2) + 4 * hh;
            Z[j * 128 + 32 * nt0 + r32] = acc0[i]; Z[j * 128 + 32 * nt0 + 32 + r32] = acc1[i]; }
    }
    __syncthreads();
    if (wave == 0) {
        const float* aux = (const float*)(a.ws + WS_S5AUX) + (size_t)g * S5AUX_GROUP_FLOATS;
        const float l16r = aux[128 + lane], l16i = aux[192 + lane];
        float sr = 0.f, si = 0.f;
        for (int j = 0; j < 128; ++j) {
            const float zr = Z[j * 128 + lane], zi = Z[j * 128 + 64 + lane];
            const unsigned w = cvt_pk_bf16(sr, si);
            *(LAS unsigned short*)(SP + j * SP_PITCH + 2 * lane) = (unsigned short)(w & 0xffffu);
            *(LAS unsigned short*)(SP + j * SP_PITCH + 128 + 2 * lane) = (unsigned short)(w >> 16);
            const float nr = l16r * sr - l16i * si + zr, ni = l16r * si + l16i * sr + zi;
            sr = nr; si = ni;
        }
        a.out[O_PS5RE + (size_t)(b * NG + g) * NP + lane] = sr;
        a.out[O_PS5IM + (size_t)(b * NG + g) * NP + lane] = si;
    }
    __syncthreads();
    {
        f32x16 acc[4];
#pragma unroll
        for (int n = 0; n < 4; ++n)
#pragma unroll
            for (int i = 0; i < 16; ++i) acc[n][i] = 0.f;
        const bf16_t* mw = MW + (size_t)(32 * wave + r32) * 384 + 8 * hh;
        const bf16_t* xb = U + ((size_t)(b * SEQ + 16 * r32)) * DH + 16 * g + 8 * hh;
        const int nks = 2 * wave + 2;
        for (int ks = 0; ks < nks; ++ks) {
            const bf16x8 af = *(const bf16x8*)(mw + 16 * ks);
#pragma unroll
            for (int n = 0; n < 4; ++n) { const bf16x8 bf = *(const bf16x8*)(xb + (size_t)n * 512 * DH + (size_t)ks * DH); acc[n] = MFMA32(af, bf, acc[n]); }
        }
#pragma unroll
        for (int kq = 0; kq < 8; ++kq) {
            const bf16x8 af = *(const bf16x8*)(mw + 256 + 16 * kq);
#pragma unroll
            for (int n = 0; n < 4; ++n) { const bf16x8 bf = *(const LAS bf16x8*)(SP + (32 * n + r32) * SP_PITCH + 32 * kq + 16 * hh); acc[n] = MFMA32(af, bf, acc[n]); }
        }
#pragma unroll
        for (int n = 0; n < 4; ++n)
#pragma unroll
            for (int q = 0; q < 4; ++q) {
                const int s = 2 * wave + (q >> 1), c0 = 8 * (q & 1) + 4 * hh, t = 16 * (32 * n + r32) + s;
                u32x2 w; w.x = cvt_pk_bf16(fgelu(acc[n][4 * q]), fgelu(acc[n][4 * q + 1])); w.y = cvt_pk_bf16(fgelu(acc[n][4 * q + 2]), fgelu(acc[n][4 * q + 3]));
                *(u32x2*)(GS5 + (size_t)(b * SEQ + t) * DH + 16 * g + c0) = w;
            }
    }
    __syncthreads();
}
__device__ __forceinline__ void s5_sample(const Args& a, int bs, int g, int lane) {
    const bf16_t* U = (const bf16_t*)(a.ws + WS_U);
    bf16_t* GS5 = (bf16_t*)(a.ws + WS_XB);
    const float* aux = (const float*)(a.ws + WS_S5AUX) + (size_t)g * S5AUX_GROUP_FLOATS;
    const int row = MP + bs;
    float u[16];
    { const u32x4 w0 = *(const u32x4*)(U + (size_t)row * DH + 16 * g), w1 = *(const u32x4*)(U + (size_t)row * DH + 16 * g + 8);
      u[0] = bf_lo(w0.x); u[1] = bf_hi(w0.x); u[2] = bf_lo(w0.y); u[3] = bf_hi(w0.y); u[4] = bf_lo(w0.z); u[5] = bf_hi(w0.z); u[6] = bf_lo(w0.w); u[7] = bf_hi(w0.w);
      u[8] = bf_lo(w1.x); u[9] = bf_hi(w1.x); u[10] = bf_lo(w1.y); u[11] = bf_hi(w1.y); u[12] = bf_lo(w1.z); u[13] = bf_hi(w1.z); u[14] = bf_lo(w1.w); u[15] = bf_hi(w1.w); }
    const float lr = aux[lane], li = aux[64 + lane];
    const size_t so = (size_t)(bs * NG + g) * NP + lane;
    const float h0r = a.in[I_S5RE][so], h0i = a.in[I_S5IM][so];
    float hr = lr * h0r - li * h0i, hi = lr * h0i + li * h0r;
    const f32x4* bbr = (const f32x4*)(aux + 256 + lane * 16); const f32x4* bbi = (const f32x4*)(aux + 1280 + lane * 16);
#pragma unroll
    for (int q = 0; q < 4; ++q) { const f32x4 br = bbr[q], bi = bbi[q];
#pragma unroll
        for (int j = 0; j < 4; ++j) { hr += br[j] * u[4 * q + j]; hi += bi[j] * u[4 * q + j]; } }
    a.out[O_SS5RE + so] = hr; a.out[O_SS5IM + so] = hi;
    float ymine = 0.f;
#pragma unroll
    for (int c = 0; c < 16; ++c) {
        const float cr = a.in[I_CRE][(size_t)(g * 16 + c) * 64 + lane], ci = a.in[I_CIM][(size_t)(g * 16 + c) * 64 + lane];
        const float y = wave_sum(cr * hr - ci * hi);
        if (lane == c) ymine = y + a.in[I_DSKIP][g * 16 + c] * u[c];
    }
    float uc = 0.f;
    (void)uc;
    if (lane < 16) { const float gv = fgelu(ymine); const unsigned w = cvt_pk_bf16(gv, gv); GS5[(size_t)row * DH + 16 * g + lane] = (bf16_t)(w & 0xffffu); }
}

constexpr int XC_PITCH = 144;
__device__ __forceinline__ void lru_item(const Args& a, LAS unsigned char* lds, bool sample, int b, int head, int q, int tid, int lane, int wave) {
    const float* XL = (const float*)(a.ws + WS_XLRU);
    const bf16_t* GG = (const bf16_t*)(a.ws + WS_GG);
    bf16_t* MRG = (bf16_t*)(a.ws + WS_MRG);
    float* ssq_lru = (float*)(a.ws + WS_CTL + CTL_SSQ_BYTE) + 3 * MPAD;
    LAS unsigned char* XC = lds;
    LAS float* XCF = (LAS float*)(lds + 36864);
    LAS float* AA = XCF + 4096;
    LAS float* BX = AA + 4096;
    const int ch0 = 64 * head + 16 * q;
    const int fr = lane & 15, fq = lane >> 4;
    bf16x8 Bf[2][2];
#pragma unroll
    for (int mat = 0; mat < 2; ++mat)
#pragma unroll
        for (int ks = 0; ks < 2; ++ks) {
            const float* w = (mat ? a.in[I_WX] : a.in[I_WA]) + ((size_t)(head * 64 + 32 * ks + 8 * fq)) * 64 + 16 * q + fr;
            u32x4 p; p.x = cvt_pk_bf16(w[0], w[64]); p.y = cvt_pk_bf16(w[128], w[192]); p.z = cvt_pk_bf16(w[256], w[320]); p.w = cvt_pk_bf16(w[384], w[448]);
            Bf[mat][ks] = __builtin_bit_cast(bf16x8, p);
        }
    const int chn = ch0 + fr;
    const float ba = a.in[I_BA][chn], bx_ = a.in[I_BX][chn];
    const float spl = log1pf(expf(-a.in[I_LAML][chn]));
    const int ci = tid & 63, cch = 64 * head + ci;
    const float cw0 = a.in[I_CONVW][cch], cw1 = a.in[I_CONVW][DH + cch], cw2 = a.in[I_CONVW][2 * DH + cch], cw3 = a.in[I_CONVW][3 * DH + cch], cb = a.in[I_CONVB][cch];
    const int nchunk = sample ? 1 : 8, T = sample ? 128 : 256;
    float hcar = 0.f;
    for (int chk = 0; chk < nchunk; ++chk) {
        const int R0 = sample ? MP : b * SEQ + chk * 256;
        {
            const int RPT = T / 8, rg = tid >> 6, r0 = rg * RPT;
            if (!sample) {
                const int t0 = chk * 256 + r0;
                float xm3 = (t0 >= 3) ? XL[(size_t)(R0 + r0 - 3) * DH + cch] : 0.f;
                float xm2 = (t0 >= 2) ? XL[(size_t)(R0 + r0 - 2) * DH + cch] : 0.f;
                float xm1 = (t0 >= 1) ? XL[(size_t)(R0 + r0 - 1) * DH + cch] : 0.f;
#pragma unroll 8
                for (int rr = 0; rr < 32; ++rr) {
                    const float x0 = XL[(size_t)(R0 + r0 + rr) * DH + cch];
                    const float xc = cb + cw0 * xm3 + cw1 * xm2 + cw2 * xm1 + cw3 * x0;
                    xm3 = xm2; xm2 = xm1; xm1 = x0;
                    const unsigned w = cvt_pk_bf16(xc, xc);
                    *(LAS unsigned short*)(XC + (r0 + rr) * XC_PITCH + 2 * ci) = (unsigned short)(w & 0xffffu);
                    if ((ci >> 4) == q) XCF[(r0 + rr) * 16 + (ci & 15)] = xc;
                }
            } else {
                const float* cbuf = a.in[I_LRUCONV];
#pragma unroll 4
                for (int rr = 0; rr < 16; ++rr) {
                    const int bs = r0 + rr;
                    const float x0 = XL[(size_t)(R0 + bs) * DH + cch];
                    const float c0 = cbuf[((size_t)bs * 3 + 0) * DH + cch], c1 = cbuf[((size_t)bs * 3 + 1) * DH + cch], c2 = cbuf[((size_t)bs * 3 + 2) * DH + cch];
                    const float xc = cb + cw0 * c0 + cw1 * c1 + cw2 * c2 + cw3 * x0;
                    const unsigned w = cvt_pk_bf16(xc, xc);
                    *(LAS unsigned short*)(XC + bs * XC_PITCH + 2 * ci) = (unsigned short)(w & 0xffffu);
                    if ((ci >> 4) == q) {
                        XCF[bs * 16 + (ci & 15)] = xc;
                        float* oc = a.out + O_SLRUC + (size_t)bs * 3 * DH + cch;
                        oc[0] = c1; oc[DH] = c2; oc[2 * DH] = x0;
                    }
                }
            }
        }
        __syncthreads();
        {
            const int ntile = T / 16;
            for (int tile = wave; tile < ntile; tile += NWAVES) {
                f32x4 ar = (f32x4){0.f, 0.f, 0.f, 0.f}, ax = ar;
#pragma unroll
                for (int ks = 0; ks < 2; ++ks) {
                    const bf16x8 af = *(const LAS bf16x8*)(XC + (16 * tile + fr) * XC_PITCH + 64 * ks + 16 * fq);
                    ar = __builtin_amdgcn_mfma_f32_16x16x32_bf16(af, Bf[0][ks], ar, 0, 0, 0);
                    ax = __builtin_amdgcn_mfma_f32_16x16x32_bf16(af, Bf[1][ks], ax, 0, 0, 0);
                }
#pragma unroll
                for (int r4 = 0; r4 < 4; ++r4) {
                    const int rr = 16 * tile + 4 * fq + r4;
                    const float xcv = XCF[rr * 16 + fr];
                    const float rg_ = fsigmoid(ar[r4] + ba), ig = fsigmoid(ax[r4] + bx_);
                    const float la = -8.0f * rg_ * spl;
                    const float av = fexp(la);
                    const float bv = sqrtf(-expm1f(2.0f * la)) * (ig * xcv);
                    AA[rr * 16 + fr] = av; BX[rr * 16 + fr] = bv;
                }
            }
        }
        __syncthreads();
        if (!sample) {
            if (wave == 0 && lane < 16) {
                float h = hcar;
#pragma unroll 8
                for (int rr = 0; rr < 256; ++rr) { h = AA[rr * 16 + lane] * h + BX[rr * 16 + lane]; BX[rr * 16 + lane] = h; }
                hcar = h;
            }
        } else {
            for (int idx = tid; idx < 128 * 16; idx += NWAVES * 64) {
                const int bs = idx >> 4, n = idx & 15;
                const float h = AA[idx] * a.in[I_LRUH][(size_t)bs * DH + ch0 + n] + BX[idx];
                BX[idx] = h; a.out[O_SLRUH + (size_t)bs * DH + ch0 + n] = h;
            }
        }
        __syncthreads();
        {
            const int rr = tid >> 1, half = tid & 1;
            if (rr < T) {
                const size_t row = (size_t)R0 + rr;
                const f32x4 h0 = *(const LAS f32x4*)(BX + rr * 16 + 8 * half), h1 = *(const LAS f32x4*)(BX + rr * 16 + 8 * half + 4);
                const u32x4 gw = *(const u32x4*)(GG + row * DH + ch0 + 8 * half);
                const f32x4 y0 = (f32x4){h0[0] * bf_lo(gw.x), h0[1] * bf_hi(gw.x), h0[2] * bf_lo(gw.y), h0[3] * bf_hi(gw.y)};
                const f32x4 y1 = (f32x4){h1[0] * bf_lo(gw.z), h1[1] * bf_hi(gw.z), h1[2] * bf_lo(gw.w), h1[3] * bf_hi(gw.w)};
                *(u32x4*)(MRG + row * D + DH + ch0 + 8 * half) = pack8(y0, y1);
                float s = dot4(y0) + dot4(y1);
                s += __shfl_xor(s, 1);
                if (half == 0) atomicAdd(ssq_lru + row, s);
            }
        }
    }
    if (!sample) {
        if (wave == 0 && lane < 16) a.out[O_PLRUH + (size_t)b * DH + ch0 + lane] = hcar;
        if (wave == 1 && lane < 48) { const int k = lane >> 4, n = lane & 15;
            a.out[O_PLRUC + ((size_t)b * 3 + k) * DH + ch0 + n] = XL[(size_t)(b * SEQ + SEQ - 3 + k) * DH + ch0 + n]; }
    }
    __syncthreads();
}

__global__ void __launch_bounds__(NWAVES * 64, 2) hymba_fwd(Args args) {
    extern __shared__ __attribute__((aligned(16))) unsigned char lds_raw[];
    LAS unsigned char* lds = (LAS unsigned char*)lds_raw;
    volatile LAS unsigned* MISC = (volatile LAS unsigned*)(lds + MISC_OFF);
    const int tid = threadIdx.x, lane = tid & 63, wave = __builtin_amdgcn_readfirstlane(tid >> 6);
    const int G = gridDim.x, bx = blockIdx.x;
    const int vcu = (G % 8 == 0) ? (bx % 8) * (G / 8) + bx / 8 : bx;
    unsigned char* ws = args.ws;
    unsigned* ctl = (unsigned*)(ws + WS_CTL);
    for (int u = tid; u < (LDS_BYTES - LDSCTL_OFF) / 4; u += NWAVES * 64) ((LAS unsigned*)(lds + LDSCTL_OFF))[u] = 0u;
    __syncthreads();
    XcdBarrier bar; bar.bar = ctl + CW_BAR; bar.x = 0; bar.st = nullptr;
    if (MK_N_LAUNCHES == 1) bar = xcd_barrier_post(ctl + CW_BAR, MISC + 8);
#define GRID_BAR() do { if (MK_N_LAUNCHES == 1) xcd_barrier(bar); } while (0)
    const int lo = args.ph_lo, hi = args.ph_hi;
#define IN(k) (lo <= (k) && (k) < hi)
#define BOTH(k) (IN(k) && IN((k) + 1))
    float* ssq = (float*)(ws + WS_CTL + CTL_SSQ_BYTE);
    float *ssq0 = ssq, *ssq1 = ssq + MPAD, *ssq_s5 = ssq + 2 * MPAD, *ssq_lru = ssq + 3 * MPAD, *ssq2 = ssq + 4 * MPAD, *ssq3 = ssq + 5 * MPAD;
    bf16_t* XB = (bf16_t*)(ws + WS_XB); float* X1 = (float*)(ws + WS_X1); bf16_t* HID = (bf16_t*)(ws + WS_H);
    bf16_t* U = (bf16_t*)(ws + WS_U); float* XL = (float*)(ws + WS_XLRU); bf16_t* GG = (bf16_t*)(ws + WS_GG); bf16_t* MRG = (bf16_t*)(ws + WS_MRG);
    constexpr int NM = MPAD / 256;

    if (IN(0)) { p0_prologue(args, lds, vcu, G, tid, lane, wave); if (BOTH(0)) GRID_BAR(); }
    if (IN(1)) {
        pg8::Gemm g{XB, (const bf16_t*)(ws + WS_W13A), D, D}; pg8::StaticOrder S; S.init(NM, 2 * FF / 256, D / 64, G, bx);
        pg8::EpiSwiGLU E{HID, ssq0};
        pg8::gemm_phase(lds, g, S, E);
        if (BOTH(1)) GRID_BAR();
    }
    if (IN(2)) {
        pg8::Gemm g{HID, (const bf16_t*)(ws + WS_W2A), FF, FF}; pg8::StaticOrder S; S.init(NM, D / 256, FF / 64, G, bx);
        pg8::EpiResid E{args.in[I_XP], args.in[I_XS], X1, XB, ssq1};
        pg8::gemm_phase(lds, g, S, E);
        if (BOTH(2)) GRID_BAR();
    }
    if (IN(3)) {
        pg8::Gemm g{XB, (const bf16_t*)(ws + WS_WIN), D, D}; pg8::StaticOrder S; S.init(NM, DIN / 256, D / 64, G, bx);
        pg8::EpiProj E{U, XL, GG, ssq1};
        pg8::gemm_phase(lds, g, S, E);
        if (BOTH(3)) GRID_BAR();
    }
    if (IN(4)) {
        { bf16_t* GS5 = XB; const int gw = bx * NWAVES + wave, NGW = G * NWAVES;
          for (int m = M + gw; m < MPAD; m += NGW) {
              ((u32x4*)(GS5 + (size_t)m * DH))[lane] = (u32x4){0u, 0u, 0u, 0u}; ((u32x4*)(GS5 + (size_t)m * DH))[64 + lane] = (u32x4){0u, 0u, 0u, 0u};
              ((u32x4*)(MRG + (size_t)m * D + DH))[lane] = (u32x4){0u, 0u, 0u, 0u}; ((u32x4*)(MRG + (size_t)m * D + DH))[64 + lane] = (u32x4){0u, 0u, 0u, 0u}; } }
        for (int it = bx; it < NB * NG; it += G) { const int b = it >> 6, g = ((it & 7) << 3) | ((it >> 3) & 7); s5_prompt(args, lds, b, g, tid, lane, wave); }
        for (int it = bx * NWAVES + wave; it < MS * NG; it += G * NWAVES) s5_sample(args, it >> 6, it & 63, lane);
        __syncthreads();
        for (int it = bx; it < NB * 64; it += G) lru_item(args, lds, false, it >> 6, (it >> 2) & 15, it & 3, tid, lane, wave);
        for (int it = bx; it < 64; it += G) lru_item(args, lds, true, 0, it >> 2, it & 3, tid, lane, wave);
        if (BOTH(4)) GRID_BAR();
    }
    if (IN(5)) {
        pg8::Gemm g{XB, (const bf16_t*)(ws + WS_WGLU), DH, DH}; pg8::StaticOrder S; S.init(NM, DH / 256, DH / 64, G, bx);
        pg8::EpiGlu E{XB, args.in[I_BGLU], MRG, ssq_s5};
        pg8::gemm_phase(lds, g, S, E);
        if (BOTH(5)) GRID_BAR();
    }
    if (IN(6)) {
        pg8::Gemm g{MRG, (const bf16_t*)(ws + WS_WOUT), D, D}; pg8::StaticOrder S; S.init(NM, D / 256, D / 64, G, bx);
        pg8::EpiOut E{ssq_s5, ssq_lru, X1, XB, ssq2};
        pg8::gemm_phase(lds, g, S, E);
        if (BOTH(6)) GRID_BAR();
    }
    if (IN(7)) {
        pg8::Gemm g{XB, (const bf16_t*)(ws + WS_W13B), D, D}; pg8::StaticOrder S; S.init(NM, 2 * FF / 256, D / 64, G, bx);
        pg8::EpiSwiGLU E{HID, ssq2};
        pg8::gemm_phase(lds, g, S, E);
        if (BOTH(7)) GRID_BAR();
    }
    if (IN(8)) {
        pg8::Gemm g{HID, (const bf16_t*)(ws + WS_W2B), FF, FF}; pg8::StaticOrder S; S.init(NM, D / 256, FF / 64, G, bx);
        pg8::EpiFinal E{X1, args.out, ssq3};
        pg8::gemm_phase(lds, g, S, E);
        if (BOTH(8)) GRID_BAR();
    }
    if (IN(9)) {
        const int gw = bx * NWAVES + wave, NGW = G * NWAVES;
        const f32x4* gf = (const f32x4*)args.in[I_GFINAL] + lane;
        for (int m = gw; m < M; m += NGW) {
            const float r = rsqrtf(ssq3[m] * (1.0f / D) + EPS);
            f32x4* o = (f32x4*)(args.out + (size_t)m * D) + lane;
#pragma unroll
            for (int j = 0; j < 8; ++j) o[64 * j] = o[64 * j] * gf[64 * j] * r;
        }
    }
#undef IN
#undef BOTH
#undef GRID_BAR
}

extern "C" void kernel_launch(void* const* d_in, const int* in_sizes, int n_in, void* d_out, int out_size, void* d_ws, size_t ws_size, hipStream_t stream) {
    static int grid = 0;
    if (grid == 0) {
        if (n_in != N_IN || in_sizes[0] != MP * D || (size_t)out_size != O_END || ws_size < WS_END) {
            fprintf(stderr, "kernel_launch: unexpected problem: n_in %d in0 %d out %d ws %zu (need %zu)\n", n_in, n_in > 0 ? in_sizes[0] : -1, out_size, ws_size, (size_t)WS_END); grid = -1; return; }
        int dev = 0, cus = 0;
        if (hipGetDevice(&dev) != hipSuccess || hipDeviceGetAttribute(&cus, hipDeviceAttributeMultiprocessorCount, dev) != hipSuccess) { grid = -1; return; }
        if (hipFuncSetAttribute((const void*)hymba_fwd, hipFuncAttributeMaxDynamicSharedMemorySize, LDS_BYTES) != hipSuccess) { fprintf(stderr, "kernel_launch: hipFuncSetAttribute failed\n"); grid = -1; return; }
        int per_cu = 0;
        if (hipOccupancyMaxActiveBlocksPerMultiprocessor(&per_cu, (const void*)hymba_fwd, NWAVES * 64, LDS_BYTES) != hipSuccess || per_cu < 1)
            fprintf(stderr, "kernel_launch: note: occupancy query reports %d workgroups per CU\n", per_cu);
        (void)hipGetLastError();
        grid = cus;
    }
    if (grid < 0) return;
    if (hipMemsetAsync((char*)d_ws + WS_CTL, 0, CTL_ZERO_BYTES, stream) != hipSuccess) { fprintf(stderr, "kernel_launch: memset failed\n"); return; }
    Args a{};
    for (int i = 0; i < N_IN; ++i) a.in[i] = (const float*)d_in[i];
    a.out = (float*)d_out; a.ws = (unsigned char*)d_ws;
    if (MK_N_LAUNCHES == 1) {
        a.ph_lo = 0; a.ph_hi = NPHASE;
        hipLaunchKernelGGL(hymba_fwd, dim3(grid), dim3(NWAVES * 64), LDS_BYTES, stream, a);
    } else {
        for (int p = 0; p < NPHASE; ++p) { a.ph_lo = p; a.ph_hi = p + 1; hipLaunchKernelGGL(hymba_fwd, dim3(grid), dim3(NWAVES * 64), LDS_BYTES, stream, a); }
    }
}
```

```cpp
#include <hip/hip_runtime.h>
#include <cstdio>
#include <cstdint>

#define LAS __attribute__((address_space(3)))
#define GAS __attribute__((address_space(1)))
typedef unsigned short bf16_t;
typedef short bf16x8 __attribute__((ext_vector_type(8)));
typedef float f32x4 __attribute__((ext_vector_type(4)));
typedef float f32x16 __attribute__((ext_vector_type(16)));
typedef unsigned u32x4 __attribute__((ext_vector_type(4)));
typedef unsigned u32x2 __attribute__((ext_vector_type(2)));

#ifndef MK_N_LAUNCHES
#define MK_N_LAUNCHES 1
#endif

constexpr int D = 2048, FF = 5632, DIN = 3072, DH = 1024;
constexpr int MP = 8192, MS = 128, M = MP + MS, MPAD = 8448;
constexpr int SEQ = 2048, NB = 4, NG = 64, NP = 64, GS = 16;
constexpr float EPS = 1e-6f;
constexpr int NPHASE = 12;
constexpr int NMP = MP / 256;
constexpr int NWAVES = 8;

constexpr size_t MiB = 1u << 20;
constexpr size_t WS_CTL = 0, CTL_ZERO_BYTES = 1 * MiB;
constexpr size_t WS_W13A = 1 * MiB, WS_W2A = 45 * MiB, WS_WIN = 67 * MiB, WS_WGLU = 79 * MiB, WS_WOUT = 81 * MiB, WS_W13B = 89 * MiB, WS_W2B = 133 * MiB;
constexpr size_t WS_S5M = 155 * MiB, WS_S5AUX = 171 * MiB;
constexpr size_t WS_XB = 172 * MiB;
constexpr size_t WS_X1 = 205 * MiB;
constexpr size_t WS_H = 271 * MiB;
constexpr size_t WS_U = 271 * MiB, WS_XLRU = WS_U + (size_t)MPAD * DH * 2, WS_GG = WS_XLRU + (size_t)MPAD * DH * 4, WS_MRG = WS_GG + (size_t)MPAD * DH * 2;
constexpr size_t WS_SLAB = 362 * MiB;
constexpr size_t WS_END = 373 * MiB;
static_assert(WS_MRG + (size_t)MPAD * D * 2 <= WS_END && WS_H + (size_t)MPAD * FF * 2 <= WS_SLAB && WS_SLAB + (size_t)11 * MS * D * 4 <= WS_END, "ws map");
constexpr int S5M_GROUP_BYTES = 256 * 1024;
constexpr int S5AUX_GROUP_FLOATS = 2304;
constexpr int CW_BAR = 4096;
constexpr size_t CTL_SSQ_BYTE = 262144;

constexpr int RING_BYTES = 131072;
constexpr int LDSCTL_OFF = RING_BYTES, MISC_OFF = LDSCTL_OFF + 320;
constexpr int LDS_BYTES = 147456;

__device__ __forceinline__ unsigned cvt_pk_bf16(float lo, float hi) { unsigned r; asm volatile("v_cvt_pk_bf16_f32 %0, %1, %2" : "=v"(r) : "v"(lo), "v"(hi)); return r; }
__device__ __forceinline__ float bf_lo(unsigned w) { return __uint_as_float(w << 16); }
__device__ __forceinline__ float bf_hi(unsigned w) { return __uint_as_float(w & 0xffff0000u); }
__device__ __forceinline__ float fexp(float x) { return __builtin_amdgcn_exp2f(x * 1.44269504089f); }
__device__ __forceinline__ float fsigmoid(float x) { return __builtin_amdgcn_rcpf(1.0f + fexp(-x)); }
__device__ __forceinline__ float fsilu(float x) { return x * fsigmoid(x); }
__device__ __forceinline__ float fgelu(float x) { return x * fsigmoid(1.5957691216057308f * (x + 0.044715f * x * x * x)); }
__device__ __forceinline__ u32x4 pack8(const f32x4 a, const f32x4 b) { u32x4 w; w.x = cvt_pk_bf16(a[0], a[1]); w.y = cvt_pk_bf16(a[2], a[3]); w.z = cvt_pk_bf16(b[0], b[1]); w.w = cvt_pk_bf16(b[2], b[3]); return w; }
__device__ __forceinline__ float dot4(const f32x4 a) { return (a[0] * a[0] + a[1] * a[1]) + (a[2] * a[2] + a[3] * a[3]); }
__device__ __forceinline__ float wave_sum(float v) {
#pragma unroll
    for (int o = 1; o < 64; o <<= 1) v += __shfl_xor(v, o);
    return v;
}
#define LDS_WAIT() asm volatile("s_waitcnt lgkmcnt(0)" ::: "memory")
#define VM_WAIT() asm volatile("s_waitcnt vmcnt(0)" ::: "memory")

namespace pg8 {
constexpr int BM = 256, BK = 64, HALF = 128, HTB = HALF * BK * 2, STAGE_BYTES = 8 * HTB, NXCD = 8, WGM = 8;
__host__ __device__ __forceinline__ int lds_byte(int r, int c) { const int st = (r >> 4) * 2 + (c >> 5), rr = r & 15, cc = c & 31, ob = rr * 64 + cc * 2; return st * 1024 + (ob ^ (((ob >> 9) & 1) << 5)); }
__host__ __device__ __forceinline__ void stage_rc(int b, int& R, int& C) { const int st = b / 1024, sb = b % 1024, swz = sb ^ (((sb >> 9) & 1) << 5); R = (st >> 1) * 16 + swz / 64; C = (st & 1) * 32 + (swz % 64) / 2; }
__host__ __device__ __forceinline__ int perm32(int rho) { const int n = rho >> 4, i = rho & 15; return 8 * (i >> 2) + 4 * n + (i & 3); }

struct Unit { int pm, pn, kt0, nkt; };
struct Gemm { const bf16_t* A; const bf16_t* Bt; int lda, ldb; };

struct PanelOrder {
    int nN, nwgP, G, c, nktFull, sliceKt, nExtra;
    __device__ void init(int nN_, int nktFull_, int sliceKt_, int G_, int c_) { nN = nN_; nwgP = 32 * nN_; G = G_; c = c_; nktFull = nktFull_; sliceKt = sliceKt_; nExtra = nN_ * (nktFull_ / sliceKt_); }
    __device__ bool next(int i, Unit& u) const {
        const long L = (long)i * G + c;
        if (L < nwgP) {
            int wgid = (int)L; { const int q = nwgP / NXCD, r = nwgP % NXCD, xcd = wgid % NXCD, off = wgid / NXCD; wgid = (xcd < r ? xcd * (q + 1) : r * (q + 1) + (xcd - r) * q) + off; }
            const int nig = WGM * nN, gid = wgid / nig, fm = gid * WGM, gsz = (32 - fm) < WGM ? (32 - fm) : WGM;
            u.pm = fm + ((wgid % nig) % gsz); u.pn = (wgid % nig) / gsz; u.kt0 = 0; u.nkt = nktFull; return true;
        }
        const int e = (int)(L - nwgP); if (e >= nExtra) return false;
        u.pm = 32; u.pn = e % nN; u.kt0 = (e / nN) * sliceKt; u.nkt = sliceKt; return true;
    }
};

template <class Epi, class Sched>
__device__ __forceinline__ void gemm_phase(LAS unsigned char* lds, const Gemm g, const Sched& S, const Epi& E) {
    const int tid = threadIdx.x, wid = __builtin_amdgcn_readfirstlane(tid >> 6), lane = tid & 63, wr = wid >> 2, wc = wid & 3, fr = lane & 15, fq = lane >> 4;
    unsigned voffA[2], voffB[2];
#pragma unroll
    for (int i = 0; i < 2; ++i) { int R, C; stage_rc(tid * 16 + i * 8192, R, C); const int Rb = Epi::PERM ? ((R & ~31) + perm32(R & 31)) : R;
        voffA[i] = (unsigned)(R * g.lda + C) * 2u; voffB[i] = (unsigned)(Rb * g.ldb + C) * 2u; }
    const size_t kstep = (size_t)(BK * 2);
    const size_t hstepA = (size_t)HALF * g.lda * 2, hstepB = (size_t)HALF * g.ldb * 2;
    const size_t tstepA = 2 * hstepA, tstepB = 2 * hstepB;
    const unsigned ldsw = (unsigned)wid * 1024u;
    const int aoff = lds_byte(wr * 64 + fr, fq * 8), boff = lds_byte(wc * 32 + fr, fq * 8);
#define PG8_SA(b, h) (((b) * 2 + (h)) * HTB)
#define PG8_SB(b, h) ((4 + (b) * 2 + (h)) * HTB)
#define PG8_STAGE(bufoff, gbase, voff) do { _Pragma("unroll") for (int _i = 0; _i < 2; ++_i) \
        __builtin_amdgcn_global_load_lds((const unsigned*)((const char*)(gbase) + (voff)[_i]), (LAS unsigned*)(lds + (bufoff) + ldsw + _i * 8192), 16, 0, 0); } while (0)
#define PG8_LDA(dst, b, h) do { _Pragma("unroll") for (int m = 0; m < 4; ++m) _Pragma("unroll") for (int k = 0; k < 2; ++k) dst[m][k] = *(const LAS bf16x8*)(lds + PG8_SA(b, h) + aoff + m * 2048 + k * 1024); } while (0)
#define PG8_LDB(dst, b, h) do { _Pragma("unroll") for (int n = 0; n < 2; ++n) _Pragma("unroll") for (int k = 0; k < 2; ++k) dst[n][k] = *(const LAS bf16x8*)(lds + PG8_SB(b, h) + boff + n * 2048 + k * 1024); } while (0)
#define PG8_MMA(ai, bj, At, Bt) do { __builtin_amdgcn_s_setprio(1); _Pragma("unroll") for (int m = 0; m < 4; ++m) _Pragma("unroll") for (int n = 0; n < 2; ++n) _Pragma("unroll") for (int k = 0; k < 2; ++k) \
        acc[ai][bj][m][n] = __builtin_amdgcn_mfma_f32_16x16x32_bf16(Bt[n][k], At[m][k], acc[ai][bj][m][n], 0, 0, 0); __builtin_amdgcn_s_setprio(0); } while (0)
#define PG8_WAIT_V(n) asm volatile("s_waitcnt vmcnt(" #n ")" ::: "memory")
#define PG8_WAIT_L(n) asm volatile("s_waitcnt lgkmcnt(" #n ")" ::: "memory")
#define PG8_BAR __builtin_amdgcn_s_barrier()
#define PG8_SCHED __builtin_amdgcn_sched_barrier(0)
    Unit cur, nxt; int ui = 0;
    if (!S.next(0, cur)) return;
    f32x4 acc[2][2][4][2];
#pragma unroll
    for (int a = 0; a < 2; ++a)
#pragma unroll
        for (int b = 0; b < 2; ++b)
#pragma unroll
            for (int m = 0; m < 4; ++m)
#pragma unroll
                for (int n = 0; n < 2; ++n) acc[a][b][m][n] = (f32x4){0.f, 0.f, 0.f, 0.f};
    bf16x8 At[4][2], B0[2][2], B1[2][2];
    const char* cA = (const char*)g.A + (size_t)cur.pm * tstepA + (size_t)cur.kt0 * kstep;
    const char* cB = (const char*)g.Bt + (size_t)cur.pn * tstepB + (size_t)cur.kt0 * kstep;
    PG8_STAGE(PG8_SB(0, 0), cB, voffB); PG8_STAGE(PG8_SB(0, 1), cB + hstepB, voffB); PG8_STAGE(PG8_SA(0, 0), cA, voffA); PG8_STAGE(PG8_SA(0, 1), cA + hstepA, voffA);
    if (wr == 1) PG8_BAR;
    PG8_WAIT_V(2); PG8_BAR;
    PG8_STAGE(PG8_SB(1, 0), cB + kstep, voffB); PG8_STAGE(PG8_SA(1, 0), cA + kstep, voffA); PG8_STAGE(PG8_SB(1, 1), cB + hstepB + kstep, voffB);
    PG8_WAIT_V(6); PG8_BAR;
    for (;;) {
        const bool has_next = S.next(ui + 1, nxt);
        const char* nA = has_next ? (const char*)g.A + (size_t)nxt.pm * tstepA + (size_t)nxt.kt0 * kstep : cA;
        const char* nB = has_next ? (const char*)g.Bt + (size_t)nxt.pn * tstepB + (size_t)nxt.kt0 * kstep : cB;
        const int nt = cur.nkt;
        for (int t = 0; t < nt; t += 2) {
            const bool last = (t == nt - 2);
            const char* a1 = cA + (size_t)(t + 1) * kstep;
            const char* a2 = last ? nA : cA + (size_t)(t + 2) * kstep; const char* b2 = last ? nB : cB + (size_t)(t + 2) * kstep;
            const char* a3 = a2 + kstep; const char* b3 = b2 + kstep;
            if constexpr (Epi::HAS_MID) { if (t == Epi::MID_T) E.mid(acc, cur, wr, wc, fr, fq); }
            PG8_LDB(B0, 0, 0); PG8_LDB(B1, 0, 1); PG8_SCHED; PG8_LDA(At, 0, 0); PG8_STAGE(PG8_SA(1, 1), a1 + hstepA, voffA);
            PG8_WAIT_V(8); PG8_WAIT_L(0); PG8_BAR; PG8_MMA(0, 0, At, B0); PG8_MMA(0, 1, At, B1); PG8_BAR; PG8_SCHED;
            PG8_LDA(At, 0, 1); PG8_STAGE(PG8_SB(0, 0), b2, voffB); PG8_STAGE(PG8_SB(0, 1), b2 + hstepB, voffB); PG8_STAGE(PG8_SA(0, 0), a2, voffA);
            PG8_WAIT_V(8); PG8_WAIT_L(0); PG8_BAR; PG8_MMA(1, 0, At, B0); PG8_MMA(1, 1, At, B1); PG8_BAR; PG8_SCHED;
            PG8_LDB(B0, 1, 0); PG8_LDB(B1, 1, 1); PG8_SCHED; PG8_LDA(At, 1, 0); PG8_STAGE(PG8_SA(0, 1), a2 + hstepA, voffA);
            PG8_WAIT_V(8); PG8_WAIT_L(0); PG8_BAR; PG8_MMA(0, 0, At, B0); PG8_MMA(0, 1, At, B1); PG8_BAR; PG8_SCHED;
            PG8_LDA(At, 1, 1); PG8_STAGE(PG8_SB(1, 0), b3, voffB); PG8_STAGE(PG8_SB(1, 1), b3 + hstepB, voffB); PG8_STAGE(PG8_SA(1, 0), a3, voffA);
            PG8_WAIT_V(8); PG8_WAIT_L(0); PG8_BAR; PG8_MMA(1, 0, At, B0); PG8_MMA(1, 1, At, B1); PG8_BAR; PG8_SCHED;
        }
        if (wr == 0) PG8_BAR;
        E(acc, cur, wr, wc, fr, fq);
        if (!has_next) break;
#pragma unroll
        for (int a = 0; a < 2; ++a)
#pragma unroll
            for (int b = 0; b < 2; ++b)
#pragma unroll
                for (int m = 0; m < 4; ++m)
#pragma unroll
                    for (int n = 0; n < 2; ++n) acc[a][b][m][n] = (f32x4){0.f, 0.f, 0.f, 0.f};
        cur = nxt; cA = nA; cB = nB; ++ui;
        if (wr == 1) PG8_BAR;
    }
    PG8_WAIT_V(0);
    PG8_BAR;
#undef PG8_SA
#undef PG8_SB
#undef PG8_STAGE
#undef PG8_LDA
#undef PG8_LDB
#undef PG8_MMA
#undef PG8_WAIT_V
#undef PG8_WAIT_L
#undef PG8_BAR
#undef PG8_SCHED
}


typedef f32x4 Acc[2][2][4][2];
__device__ __forceinline__ void slab_store(const Acc& acc, const Unit& u, float* slab, int wr, int wc, int fr, int fq) {
    int rowl = wr * 64 + fr, col0 = u.pn * BM + wc * 32 + 8 * fq; asm volatile("" : "+v"(rowl), "+v"(col0));
    float* base = slab + (size_t)(u.kt0 / u.nkt) * ((size_t)MS * D);
#pragma unroll
    for (int m = 0; m < 4; ++m)
#pragma unroll
        for (int bj = 0; bj < 2; ++bj) { float* p = base + (size_t)(rowl + m * 16) * D + col0 + bj * HALF; *(f32x4*)p = acc[0][bj][m][0]; *(f32x4*)(p + 4) = acc[0][bj][m][1]; }
}
struct EpiSwiGLU {
    static constexpr bool PERM = true, HAS_MID = false; static constexpr int MID_T = -1;
    bf16_t* O; const float* ssq;
    __device__ __forceinline__ void mid(Acc&, const Unit&, int, int, int, int) const {}
    __device__ __forceinline__ void operator()(const Acc& acc, const Unit& u, int wr, int wc, int fr, int fq) const {
        int row0 = u.pm * BM + wr * 64 + fr, colh = u.pn * 128 + wc * 32 + 8 * fq; asm volatile("" : "+v"(row0), "+v"(colh));
#pragma unroll
        for (int ai = 0; ai < 2; ++ai)
#pragma unroll
            for (int m = 0; m < 4; ++m) {
                const int row = row0 + ai * HALF + m * 16;
                const float r = rsqrtf(ssq[row] * (1.0f / D) + EPS);
                f32x4 h0, h1;
#pragma unroll
                for (int j = 0; j < 4; ++j) { h0[j] = fsilu(acc[ai][0][m][0][j] * r) * (acc[ai][1][m][0][j] * r); h1[j] = fsilu(acc[ai][0][m][1][j] * r) * (acc[ai][1][m][1][j] * r); }
                *(u32x4*)(O + (size_t)row * FF + colh) = pack8(h0, h1);
            }
    }
};
struct EpiResid {
    static constexpr bool PERM = true, HAS_MID = false; static constexpr int MID_T = -1;
    const float* xp; float* slab; float* X1; bf16_t* XB; float* ssq;
    __device__ __forceinline__ void mid(Acc&, const Unit&, int, int, int, int) const {}
    __device__ __forceinline__ void operator()(const Acc& acc, const Unit& u, int wr, int wc, int fr, int fq) const {
        if (u.pm == 32) { slab_store(acc, u, slab, wr, wc, fr, fq); return; }
        int row0 = u.pm * BM + wr * 64 + fr, col0 = u.pn * BM + wc * 32 + 8 * fq; asm volatile("" : "+v"(row0), "+v"(col0));
#pragma unroll
        for (int ai = 0; ai < 2; ++ai)
#pragma unroll
            for (int m = 0; m < 4; ++m) {
                const int row = row0 + ai * HALF + m * 16;
                const float* xr = xp + (size_t)row * D;
                float s = 0.f;
#pragma unroll
                for (int bj = 0; bj < 2; ++bj) {
                    const int c = col0 + bj * HALF;
                    const f32x4 r0 = *(const f32x4*)(xr + c), r1 = *(const f32x4*)(xr + c + 4);
                    const f32x4 v0 = r0 + 0.5f * acc[ai][bj][m][0], v1 = r1 + 0.5f * acc[ai][bj][m][1];
                    *(f32x4*)(X1 + (size_t)row * D + c) = v0; *(f32x4*)(X1 + (size_t)row * D + c + 4) = v1;
                    *(u32x4*)(XB + (size_t)row * D + c) = pack8(v0, v1);
                    s += dot4(v0) + dot4(v1);
                }
                s += __shfl_xor(s, 16); s += __shfl_xor(s, 32);
                if (fq == 0) atomicAdd(ssq + row, s);
            }
    }
};
struct EpiProj {
    static constexpr bool PERM = true, HAS_MID = false; static constexpr int MID_T = -1;
    bf16_t* U; float* XL; bf16_t* GG; const float* ssq;
    __device__ __forceinline__ void mid(Acc&, const Unit&, int, int, int, int) const {}
    __device__ __forceinline__ void operator()(const Acc& acc, const Unit& u, int wr, int wc, int fr, int fq) const {
        int row0 = u.pm * BM + wr * 64 + fr, col0 = (u.pn & 3) * BM + wc * 32 + 8 * fq; const int seg = u.pn >> 2; asm volatile("" : "+v"(row0), "+v"(col0));
#pragma unroll
        for (int ai = 0; ai < 2; ++ai)
#pragma unroll
            for (int m = 0; m < 4; ++m) {
                const int row = row0 + ai * HALF + m * 16;
                const float r = rsqrtf(ssq[row] * (1.0f / D) + EPS);
#pragma unroll
                for (int bj = 0; bj < 2; ++bj) {
                    const size_t o = (size_t)row * DH + col0 + bj * HALF;
                    f32x4 v0 = acc[ai][bj][m][0] * r, v1 = acc[ai][bj][m][1] * r;
                    if (seg == 0) { *(u32x4*)(U + o) = pack8(v0, v1); }
                    else if (seg == 1) { *(f32x4*)(XL + o) = v0; *(f32x4*)(XL + o + 4) = v1; }
                    else {
#pragma unroll
                        for (int j = 0; j < 4; ++j) { v0[j] = fgelu(v0[j]); v1[j] = fgelu(v1[j]); }
                        *(u32x4*)(GG + o) = pack8(v0, v1);
                    }
                }
            }
    }
};
struct EpiGlu {
    static constexpr bool PERM = true, HAS_MID = false; static constexpr int MID_T = -1;
    const bf16_t* GS; const float* bias; bf16_t* MRG; float* ssq;
    __device__ __forceinline__ void mid(Acc&, const Unit&, int, int, int, int) const {}
    __device__ __forceinline__ void operator()(const Acc& acc, const Unit& u, int wr, int wc, int fr, int fq) const {
        int row0 = u.pm * BM + wr * 64 + fr, col0 = u.pn * BM + wc * 32 + 8 * fq; asm volatile("" : "+v"(row0), "+v"(col0));
#pragma unroll
        for (int ai = 0; ai < 2; ++ai)
#pragma unroll
            for (int m = 0; m < 4; ++m) {
                const int row = row0 + ai * HALF + m * 16;
                float s = 0.f;
#pragma unroll
                for (int bj = 0; bj < 2; ++bj) {
                    const int c = col0 + bj * HALF;
                    const u32x4 gw = *(const u32x4*)(GS + (size_t)row * DH + c);
                    const f32x4 b0 = *(const f32x4*)(bias + c), b1 = *(const f32x4*)(bias + c + 4);
                    const f32x4 g0 = (f32x4){bf_lo(gw.x), bf_hi(gw.x), bf_lo(gw.y), bf_hi(gw.y)}, g1 = (f32x4){bf_lo(gw.z), bf_hi(gw.z), bf_lo(gw.w), bf_hi(gw.w)};
                    f32x4 v0, v1;
#pragma unroll
                    for (int j = 0; j < 4; ++j) { v0[j] = g0[j] * fsigmoid(acc[ai][bj][m][0][j] + b0[j]); v1[j] = g1[j] * fsigmoid(acc[ai][bj][m][1][j] + b1[j]); }
                    *(u32x4*)(MRG + (size_t)row * D + c) = pack8(v0, v1);
                    s += dot4(v0) + dot4(v1);
                }
                s += __shfl_xor(s, 16); s += __shfl_xor(s, 32);
                if (fq == 0) atomicAdd(ssq + row, s);
            }
    }
};
struct EpiOut {
    static constexpr bool PERM = true, HAS_MID = true; static constexpr int MID_T = 16;
    const float* ssq_s5; const float* ssq_lru; float* X1; bf16_t* XB; float* ssq; float* slab;
    __device__ __forceinline__ void mid(Acc& acc, const Unit& u, int wr, int wc, int fr, int fq) const {
        if (u.pm == 32) return;
        int row0 = u.pm * BM + wr * 64 + fr; asm volatile("" : "+v"(row0));
#pragma unroll
        for (int ai = 0; ai < 2; ++ai)
#pragma unroll
            for (int m = 0; m < 4; ++m) {
                const int row = row0 + ai * HALF + m * 16;
                const float f = rsqrtf(ssq_s5[row] * (1.0f / DH) + EPS) * sqrtf(ssq_lru[row] * (1.0f / DH) + EPS);
#pragma unroll
                for (int bj = 0; bj < 2; ++bj)
#pragma unroll
                    for (int n = 0; n < 2; ++n) acc[ai][bj][m][n] = acc[ai][bj][m][n] * f;
            }
    }
    __device__ __forceinline__ void operator()(const Acc& acc, const Unit& u, int wr, int wc, int fr, int fq) const {
        if (u.pm == 32) { slab_store(acc, u, slab, wr, wc, fr, fq); return; }
        int row0 = u.pm * BM + wr * 64 + fr, col0 = u.pn * BM + wc * 32 + 8 * fq; asm volatile("" : "+v"(row0), "+v"(col0));
#pragma unroll
        for (int ai = 0; ai < 2; ++ai)
#pragma unroll
            for (int m = 0; m < 4; ++m) {
                const int row = row0 + ai * HALF + m * 16;
                const float r = rsqrtf(ssq_lru[row] * (1.0f / DH) + EPS);
                float s = 0.f;
#pragma unroll
                for (int bj = 0; bj < 2; ++bj) {
                    float* p = X1 + (size_t)row * D + col0 + bj * HALF;
                    const f32x4 v0 = *(const f32x4*)p + r * acc[ai][bj][m][0], v1 = *(const f32x4*)(p + 4) + r * acc[ai][bj][m][1];
                    *(f32x4*)p = v0; *(f32x4*)(p + 4) = v1;
                    *(u32x4*)(XB + (size_t)row * D + col0 + bj * HALF) = pack8(v0, v1);
                    s += dot4(v0) + dot4(v1);
                }
                s += __shfl_xor(s, 16); s += __shfl_xor(s, 32);
                if (fq == 0) atomicAdd(ssq + row, s);
            }
    }
};
struct EpiFinal {
    static constexpr bool PERM = true, HAS_MID = false; static constexpr int MID_T = -1;
    const float* X1; float* out; float* ssq; float* slab;
    __device__ __forceinline__ void mid(Acc&, const Unit&, int, int, int, int) const {}
    __device__ __forceinline__ void operator()(const Acc& acc, const Unit& u, int wr, int wc, int fr, int fq) const {
        if (u.pm == 32) { slab_store(acc, u, slab, wr, wc, fr, fq); return; }
        int row0 = u.pm * BM + wr * 64 + fr, col0 = u.pn * BM + wc * 32 + 8 * fq; asm volatile("" : "+v"(row0), "+v"(col0));
#pragma unroll
        for (int ai = 0; ai < 2; ++ai)
#pragma unroll
            for (int m = 0; m < 4; ++m) {
                const int row = row0 + ai * HALF + m * 16;
                float s = 0.f;
#pragma unroll
                for (int bj = 0; bj < 2; ++bj) {
                    const size_t o = (size_t)row * D + col0 + bj * HALF;
                    const f32x4 v0 = *(const f32x4*)(X1 + o) + 0.5f * acc[ai][bj][m][0], v1 = *(const f32x4*)(X1 + o + 4) + 0.5f * acc[ai][bj][m][1];
                    *(f32x4*)(out + o) = v0; *(f32x4*)(out + o + 4) = v1;
                    s += dot4(v0) + dot4(v1);
                }
                s += __shfl_xor(s, 16); s += __shfl_xor(s, 32);
                if (fq == 0) atomicAdd(ssq + row, s);
            }
    }
};
}

#define XB_TMO      128
#define XB_XCNT(j)  (256  + 64 * (j))
#define XB_XSUB(j)  (1280 + 64 * (j))
#define XB_XGEN(j)  (2304 + 64 * (j))
#define XB_TOP      3328
#define XB_TOPGEN   3392
#define XCD_BAR_WORDS 3456
#define XB_SPIN_CAP (1u << 18)
__device__ __forceinline__ unsigned xb_ld(unsigned* p)              { return __hip_atomic_load(p, __ATOMIC_RELAXED, __HIP_MEMORY_SCOPE_AGENT); }
__device__ __forceinline__ unsigned xb_add(unsigned* p, unsigned v) { return __hip_atomic_fetch_add(p, v, __ATOMIC_RELAXED, __HIP_MEMORY_SCOPE_AGENT); }
__device__ __forceinline__ unsigned xb_xcc_id() { return (unsigned)__builtin_amdgcn_s_getreg((3 << 11) | 20) & 0xFu; }
#define XB_SPIN(cond, bar) do { unsigned _sp = 0; while (cond) { __builtin_amdgcn_s_sleep(1); \
    if ((++_sp & 255u) == 0u) { if (xb_ld(&(bar)[XB_TMO])) break; if (_sp > XB_SPIN_CAP) { atomicAdd(&(bar)[XB_TMO], 1u); break; } } } } while (0)
struct XcdBarrier { unsigned* bar; unsigned x; volatile LAS unsigned* st; };
__device__ __forceinline__ XcdBarrier xcd_barrier_post(unsigned* bar, volatile LAS unsigned* st) {
    XcdBarrier b; b.bar = bar; b.x = xb_xcc_id(); b.st = st;
    if (threadIdx.x == 0) (void)xb_add(&bar[XB_XCNT(b.x)], 1u);
    return b;
}
__device__ __forceinline__ void xcd_barrier_complete(unsigned* bar, unsigned x, unsigned& nloc, unsigned& nx) {
    const unsigned G = gridDim.x * gridDim.y * gridDim.z;
    unsigned sum, cnt, mine, sp = 0u;
    for (;;) {
        sum = 0u; cnt = 0u; mine = 0u;
#pragma unroll
        for (unsigned j = 0; j < 16; ++j) { const unsigned c = xb_ld(&bar[XB_XCNT(j)]); sum += c; cnt += (c > 0u) ? 1u : 0u; mine = (j == x) ? c : mine; }
        if (sum == G) break;
        __builtin_amdgcn_s_sleep(1);
        if ((++sp & 255u) == 0u) { if (xb_ld(&bar[XB_TMO])) break; if (sp > XB_SPIN_CAP) { atomicAdd(&bar[XB_TMO], 1u); break; } }
    }
    nloc = mine > 0u ? mine : 1u; nx = cnt > 0u ? cnt : 1u;
}
__device__ __forceinline__ void xcd_barrier(const XcdBarrier& b) {
    asm volatile("s_waitcnt vmcnt(0)" ::: "memory");
    __syncthreads();
    if (threadIdx.x == 0) {
        unsigned* bar = b.bar;
        __builtin_amdgcn_s_waitcnt(0);
        unsigned nloc = b.st[0], nx = b.st[1];
        if (nloc == 0u) { xcd_barrier_complete(bar, b.x, nloc, nx); b.st[0] = nloc; b.st[1] = nx; }
        const unsigned old = xb_add(&bar[XB_XSUB(b.x)], 1u);
        const unsigned gen = old / nloc;
        if (old + 1u == (gen + 1u) * nloc) {
            __builtin_amdgcn_fence(__ATOMIC_RELEASE, "agent");
            asm volatile("s_waitcnt vmcnt(0)" ::: "memory");
            const unsigned og = xb_add(&bar[XB_TOP], 1u);
            const unsigned tg = og / nx;
            if (og + 1u == (tg + 1u) * nx) xb_add(&bar[XB_TOPGEN], 1u);
            else XB_SPIN(xb_ld(&bar[XB_TOPGEN]) == tg, bar);
            __builtin_amdgcn_fence(__ATOMIC_ACQUIRE, "agent");
            xb_add(&bar[XB_XGEN(b.x)], 1u);
            asm volatile("s_waitcnt vmcnt(0)" ::: "memory");
        } else {
            XB_SPIN(xb_ld(&bar[XB_XGEN(b.x)]) == gen, bar);
            __builtin_amdgcn_fence(__ATOMIC_ACQUIRE, "agent");
            asm volatile("s_waitcnt vmcnt(0)" ::: "memory");
        }
    }
    __syncthreads();
}

enum { I_XP = 0, I_XS, I_S5RE, I_S5IM, I_LRUH, I_LRUCONV, I_GFFN1, I_W1A, I_W3A, I_W2A, I_GMIX, I_WIN, I_LAMRE, I_LAMIM, I_LOGDT, I_BRE, I_BIM, I_CRE, I_CIM,
       I_DSKIP, I_WGLU, I_BGLU, I_CONVW, I_CONVB, I_WA, I_BA, I_WX, I_BX, I_LAML, I_GS5, I_GLRU, I_WOUT, I_GFFN2, I_W1B, I_W3B, I_W2B, I_GFINAL, N_IN };
struct Args { const float* in[N_IN]; float* out; unsigned char* ws; int ph_lo, ph_hi; };
constexpr size_t O_Y = 0, O_PS5RE = (size_t)M * D, O_PS5IM = O_PS5RE + NB * NG * NP, O_PLRUH = O_PS5IM + NB * NG * NP, O_PLRUC = O_PLRUH + NB * DH,
                 O_SS5RE = O_PLRUC + NB * 3 * DH, O_SS5IM = O_SS5RE + (size_t)MS * NG * NP, O_SLRUH = O_SS5IM + (size_t)MS * NG * NP, O_SLRUC = O_SLRUH + (size_t)MS * DH,
                 O_END = O_SLRUC + (size_t)MS * 3 * DH;
static_assert(O_END == 18661376, "output size");

__device__ __forceinline__ void p0_transpose_item(const float* W, int N, const float* gk, bf16_t* WT, int ldt, int k0, int n0, int nd0, LAS float* scr, int lane) {
#pragma unroll 8
    for (int i = 0; i < 32; ++i) { const int kk = 2 * i + (lane >> 5); float v = W[(size_t)(k0 + kk) * N + n0 + (lane & 31)]; if (gk) v *= gk[k0 + kk]; scr[kk * 33 + (lane & 31)] = v; }
    LDS_WAIT(); asm volatile("" ::: "memory");
    const int c = lane & 7;
#pragma unroll
    for (int j = 0; j < 4; ++j) { const int n = (lane >> 3) + 8 * j; const LAS float* s = scr + (8 * c) * 33 + n;
        u32x4 o; o.x = cvt_pk_bf16(s[0 * 33], s[1 * 33]); o.y = cvt_pk_bf16(s[2 * 33], s[3 * 33]); o.z = cvt_pk_bf16(s[4 * 33], s[5 * 33]); o.w = cvt_pk_bf16(s[6 * 33], s[7 * 33]);
        *(u32x4*)(WT + (size_t)(nd0 + n) * ldt + k0 + 8 * c) = o; }
    LDS_WAIT(); asm volatile("" ::: "memory");
}
__device__ __forceinline__ void p0_weight(const float* W, int K, int N, const float* gk, bf16_t* WT, int dual, int off, LAS float* scr, int lane, int gw, int NGW) {
    const int nblk = N / 32, nitems = (K / 64) * nblk;
    for (int it = gw; it < nitems; it += NGW) {
        const int kb = it / nblk, nb = it % nblk, n0 = nb * 32;
        const int nd0 = dual ? ((n0 >> 7) * 256 + (n0 & 127) + off) : n0;
        p0_transpose_item(W, N, gk, WT, K, kb * 64, n0, nd0, scr, lane);
    }
}
__device__ __forceinline__ void sincos_d(double x, double& s, double& c) {
    const double k = rint(x * 0.63661977236758134308);
    double r = fma(-k, 1.57079632679489655800, x); r = fma(-k, 6.12323399573676603587e-17, r);
    const double r2 = r * r;
    double sp = -7.6471637318198164759e-13; sp = fma(sp, r2, 1.6059043836821614599e-10); sp = fma(sp, r2, -2.5052108385441718775e-8); sp = fma(sp, r2, 2.7557319223985890653e-6);
    sp = fma(sp, r2, -1.9841269841269841270e-4); sp = fma(sp, r2, 8.3333333333333333333e-3); sp = fma(sp, r2, -1.6666666666666666667e-1);
    const double sr = fma(sp * r2, r, r);
    double cp = 4.7794773323873852974e-14; cp = fma(cp, r2, -1.1470745597729724714e-11); cp = fma(cp, r2, 2.0876756987868098979e-9); cp = fma(cp, r2, -2.7557319223985890653e-7);
    cp = fma(cp, r2, 2.4801587301587301587e-5); cp = fma(cp, r2, -1.3888888888888888889e-3); cp = fma(cp, r2, 4.1666666666666666667e-2); cp = fma(cp, r2, -0.5);
    const double cr = fma(cp, r2, 1.0);
    const int q = ((int)k) & 3;
    s = (q == 0) ? sr : (q == 1) ? cr : (q == 2) ? -sr : -cr;
    c = (q == 0) ? cr : (q == 1) ? -sr : (q == 2) ? -cr : sr;
}
__device__ __forceinline__ void p0_s5_matrices(const Args& a, LAS unsigned char* lds, int vc, int tid) {
    const int g = vc >> 2, part = vc & 3;
    LAS float* LPre = (LAS float*)lds;
    LAS float* LPim = LPre + 17 * 64;
    LAS float* BBre = LPim + 17 * 64;
    LAS float* BBim = BBre + 1024;
    LAS float* CRe = BBim + 1024;
    LAS float* CIm = CRe + 1024;
    LAS float* Kt = CIm + 1024;
    const double dt = exp((double)a.in[I_LOGDT][g]);
    for (int idx = tid; idx < 17 * 64; idx += NWAVES * 64) {
        const int k = idx >> 6, p = idx & 63;
        const double lre = (double)a.in[I_LAMRE][g * 64 + p], lim = (double)a.in[I_LAMIM][g * 64 + p];
        const double mag = exp(lre * dt * (double)k); double s, c; sincos_d(lim * dt * (double)k, s, c);
        LPre[idx] = (float)(mag * c); LPim[idx] = (float)(mag * s);
    }
    for (int idx = tid; idx < 1024; idx += NWAVES * 64) {
        const int p = idx >> 4;
        const double lre = (double)a.in[I_LAMRE][g * 64 + p], lim = (double)a.in[I_LAMIM][g * 64 + p];
        const double mag = exp(lre * dt); double s, c; sincos_d(lim * dt, s, c);
        const double nr = mag * c - 1.0, ni = mag * s, den = lre * lre + lim * lim;
        const double qr = (nr * lre + ni * lim) / den, qi = (ni * lre - nr * lim) / den;
        const double br = (double)a.in[I_BRE][(size_t)g * 1024 + idx], bi = (double)a.in[I_BIM][(size_t)g * 1024 + idx];
        BBre[idx] = (float)(qr * br - qi * bi); BBim[idx] = (float)(qr * bi + qi * br);
        CRe[idx] = a.in[I_CRE][(size_t)g * 1024 + idx]; CIm[idx] = a.in[I_CIM][(size_t)g * 1024 + idx];
    }
    __syncthreads();
    for (int idx = tid; idx < 4096; idx += NWAVES * 64) {
        const int k = idx >> 8, c = (idx >> 4) & 15, cp = idx & 15;
        float acc = 0.f;
        for (int p = 0; p < 64; ++p) {
            const float lr = LPre[k * 64 + p], li = LPim[k * 64 + p], br = BBre[p * 16 + cp], bi = BBim[p * 16 + cp];
            const float tr = lr * br - li * bi, ti = lr * bi + li * br;
            acc += CRe[c * 64 + p] * tr - CIm[c * 64 + p] * ti;
        }
        if (k == 0 && c == cp) acc += a.in[I_DSKIP][g * 16 + c];
        Kt[idx] = acc;
    }
    __syncthreads();
    bf16_t* Win = (bf16_t*)(a.ws + WS_S5M + (size_t)g * S5M_GROUP_BYTES);
    bf16_t* MW = Win + 128 * 256;
    for (int idx = tid; idx < 64 * 48; idx += NWAVES * 64) {
        const int rr = idx / 48, cg = idx % 48, s = 4 * part + (rr >> 4), c = rr & 15;
        float v[8];
        if (cg < 32) { const int sp = cg >> 1, c0 = (cg & 1) * 8;
#pragma unroll
            for (int i = 0; i < 8; ++i) v[i] = (sp <= s) ? Kt[((s - sp) * 16 + c) * 16 + c0 + i] : 0.f;
        } else { const int im = cg >= 40, p0 = (cg - (im ? 40 : 32)) * 8;
#pragma unroll
            for (int i = 0; i < 8; ++i) { const int p = p0 + i; const float cr = CRe[c * 64 + p], ci = CIm[c * 64 + p], lr = LPre[(s + 1) * 64 + p], li = LPim[(s + 1) * 64 + p];
                v[i] = im ? -(cr * li + ci * lr) : (cr * lr - ci * li); }
        }
        u32x4 o; o.x = cvt_pk_bf16(v[0], v[1]); o.y = cvt_pk_bf16(v[2], v[3]); o.z = cvt_pk_bf16(v[4], v[5]); o.w = cvt_pk_bf16(v[6], v[7]);
        *(u32x4*)(MW + (size_t)(s * 16 + c) * 384 + cg * 8) = o;
    }
    for (int idx = tid; idx < 32 * 32; idx += NWAVES * 64) {
        const int n = 32 * part + (idx >> 5), cg = idx & 31, p = n & 63, im = n >> 6, sp = cg >> 1, c0 = (cg & 1) * 8;
        const float lr = LPre[(15 - sp) * 64 + p], li = LPim[(15 - sp) * 64 + p];
        float v[8];
#pragma unroll
        for (int i = 0; i < 8; ++i) { const float br = BBre[p * 16 + c0 + i], bi = BBim[p * 16 + c0 + i]; v[i] = im ? (lr * bi + li * br) : (lr * br - li * bi); }
        u32x4 o; o.x = cvt_pk_bf16(v[0], v[1]); o.y = cvt_pk_bf16(v[2], v[3]); o.z = cvt_pk_bf16(v[4], v[5]); o.w = cvt_pk_bf16(v[6], v[7]);
        *(u32x4*)(Win + (size_t)n * 256 + cg * 8) = o;
    }
    if (part == 0) {
        float* aux = (float*)(a.ws + WS_S5AUX) + (size_t)g * S5AUX_GROUP_FLOATS;
        for (int idx = tid; idx < 64; idx += NWAVES * 64) { aux[idx] = LPre[64 + idx]; aux[64 + idx] = LPim[64 + idx]; aux[128 + idx] = LPre[16 * 64 + idx]; aux[192 + idx] = LPim[16 * 64 + idx]; }
        for (int idx = tid; idx < 1024; idx += NWAVES * 64) { aux[256 + idx] = BBre[idx]; aux[1280 + idx] = BBim[idx]; }
    }
    __syncthreads();
}
__device__ __forceinline__ void p0_prologue(const Args& a, LAS unsigned char* lds, int vcu, int G, int tid, int lane, int wave) {
    p0_s5_matrices(a, lds, vcu, tid);
    LAS float* scr = (LAS float*)(lds + wave * 16384);
    const int gw = vcu * NWAVES + wave, NGW = G * NWAVES;
    unsigned char* ws = a.ws;
    bf16_t* XB = (bf16_t*)(ws + WS_XB); float* ssq0 = (float*)(ws + WS_CTL + CTL_SSQ_BYTE);
    for (int m = gw; m < MPAD; m += NGW) {
        u32x2* o = (u32x2*)(XB + (size_t)m * D) + lane;
        if (m < M) {
            const float* xr = m < MP ? a.in[I_XP] + (size_t)m * D : a.in[I_XS] + (size_t)(m - MP) * D;
            const f32x4* x4 = (const f32x4*)xr + lane; f32x4 v[8]; float s = 0.f;
#pragma unroll
            for (int j = 0; j < 8; ++j) { v[j] = x4[64 * j]; s += dot4(v[j]); }
            s = wave_sum(s);
#pragma unroll
            for (int j = 0; j < 8; ++j) { u32x2 w; w.x = cvt_pk_bf16(v[j][0], v[j][1]); w.y = cvt_pk_bf16(v[j][2], v[j][3]); o[64 * j] = w; }
            if (lane == 0) ssq0[m] = s;
        } else {
#pragma unroll
            for (int j = 0; j < 8; ++j) o[64 * j] = (u32x2){0u, 0u};
        }
    }
    p0_weight(a.in[I_W1A], D, FF, a.in[I_GFFN1], (bf16_t*)(ws + WS_W13A), 1, 0, scr, lane, gw, NGW);
    p0_weight(a.in[I_W3A], D, FF, a.in[I_GFFN1], (bf16_t*)(ws + WS_W13A), 1, 128, scr, lane, gw, NGW);
    p0_weight(a.in[I_W2A], FF, D, nullptr, (bf16_t*)(ws + WS_W2A), 0, 0, scr, lane, gw, NGW);
    p0_weight(a.in[I_WIN], D, DIN, a.in[I_GMIX], (bf16_t*)(ws + WS_WIN), 0, 0, scr, lane, gw, NGW);
    p0_weight(a.in[I_WGLU], DH, DH, nullptr, (bf16_t*)(ws + WS_WGLU), 0, 0, scr, lane, gw, NGW);
    {
        const int nblk = D / 32, nitems = (D / 64) * nblk;
        for (int it = gw; it < nitems; it += NGW) {
            const int kb = it / nblk, nb = it % nblk, k0 = kb * 64;
            const float* gk = k0 < DH ? a.in[I_GS5] : a.in[I_GLRU] - DH;
            p0_transpose_item(a.in[I_WOUT], D, gk, (bf16_t*)(ws + WS_WOUT), D, k0, nb * 32, nb * 32, scr, lane);
        }
    }
    p0_weight(a.in[I_W1B], D, FF, a.in[I_GFFN2], (bf16_t*)(ws + WS_W13B), 1, 0, scr, lane, gw, NGW);
    p0_weight(a.in[I_W3B], D, FF, a.in[I_GFFN2], (bf16_t*)(ws + WS_W13B), 1, 128, scr, lane, gw, NGW);
    p0_weight(a.in[I_W2B], FF, D, nullptr, (bf16_t*)(ws + WS_W2B), 0, 0, scr, lane, gw, NGW);
}

#define MFMA32(a, b, c) __builtin_amdgcn_mfma_f32_32x32x16_bf16((a), (b), (c), 0, 0, 0)
constexpr int SP_PITCH = 272;
__device__ __forceinline__ void s5_prompt(const Args& a, LAS unsigned char* lds, int b, int g, int tid, int lane, int wave) {
    const bf16_t* U = (const bf16_t*)(a.ws + WS_U);
    const bf16_t* Win = (const bf16_t*)(a.ws + WS_S5M + (size_t)g * S5M_GROUP_BYTES);
    const bf16_t* MW = Win + 128 * 256;
    bf16_t* GS5 = (bf16_t*)(a.ws + WS_XB);
    LAS float* Z = (LAS float*)lds;
    LAS unsigned char* SP = lds + 65536;
    const int r32 = lane & 31, hh = lane >> 5;
    {
        const int mt = wave & 3, nt0 = (wave >> 2) * 2;
        f32x16 acc0, acc1;
#pragma unroll
        for (int i = 0; i < 16; ++i) { acc0[i] = 0.f; acc1[i] = 0.f; }
        const bf16_t* xa = U + ((size_t)(b * SEQ + 16 * (32 * mt + r32))) * DH + 16 * g + 8 * hh;
        const bf16_t* w0 = Win + (size_t)(32 * nt0 + r32) * 256 + 8 * hh;
        const bf16_t* w1 = w0 + 32 * 256;
#pragma unroll 4
        for (int ks = 0; ks < 16; ++ks) {
            const bf16x8 af = *(const bf16x8*)(xa + (size_t)ks * DH);
            const bf16x8 b0 = *(const bf16x8*)(w0 + 16 * ks), b1 = *(const bf16x8*)(w1 + 16 * ks);
            acc0 = MFMA32(af, b0, acc0); acc1 = MFMA32(af, b1, acc1);
        }
#pragma unroll
        for (int i = 0; i < 16; ++i) { const int j = 32 * mt + (i & 3) + 8 * (i >> 2) + 4 * hh;
            Z[j * 128 + 32 * nt0 + r32] = acc0[i]; Z[j * 128 + 32 * nt0 + 32 + r32] = acc1[i]; }
    }
    __syncthreads();
    if (wave == 0) {
        const float* aux = (const float*)(a.ws + WS_S5AUX) + (size_t)g * S5AUX_GROUP_FLOATS;
        const float l16r = aux[128 + lane], l16i = aux[192 + lane];
        float sr = 0.f, si = 0.f;
        for (int j = 0; j < 128; ++j) {
            const float zr = Z[j * 128 + lane], zi = Z[j * 128 + 64 + lane];
            const unsigned w = cvt_pk_bf16(sr, si);
            *(LAS unsigned short*)(SP + j * SP_PITCH + 2 * lane) = (unsigned short)(w & 0xffffu);
            *(LAS unsigned short*)(SP + j * SP_PITCH + 128 + 2 * lane) = (unsigned short)(w >> 16);
            const float nr = l16r * sr - l16i * si + zr, ni = l16r * si + l16i * sr + zi;
            sr = nr; si = ni;
        }
        a.out[O_PS5RE + (size_t)(b * NG + g) * NP + lane] = sr;
        a.out[O_PS5IM + (size_t)(b * NG + g) * NP + lane] = si;
    }
    __syncthreads();
    {
        f32x16 acc[4];
#pragma unroll
        for (int n = 0; n < 4; ++n)
#pragma unroll
            for (int i = 0; i < 16; ++i) acc[n][i] = 0.f;
        const bf16_t* mw = MW + (size_t)(32 * wave + r32) * 384 + 8 * hh;
        const bf16_t* xb = U + ((size_t)(b * SEQ + 16 * r32)) * DH + 16 * g + 8 * hh;
        const int nks = 2 * wave + 2;
        for (int ks = 0; ks < nks; ++ks) {
            const bf16x8 af = *(const bf16x8*)(mw + 16 * ks);
#pragma unroll
            for (int n = 0; n < 4; ++n) { const bf16x8 bf = *(const bf16x8*)(xb + (size_t)n * 512 * DH + (size_t)ks * DH); acc[n] = MFMA32(af, bf, acc[n]); }
        }
#pragma unroll
        for (int kq = 0; kq < 8; ++kq) {
            const bf16x8 af = *(const bf16x8*)(mw + 256 + 16 * kq);
#pragma unroll
            for (int n = 0; n < 4; ++n) { const bf16x8 bf = *(const LAS bf16x8*)(SP + (32 * n + r32) * SP_PITCH + 32 * kq + 16 * hh); acc[n] = MFMA32(af, bf, acc[n]); }
        }
#pragma unroll
        for (int n = 0; n < 4; ++n)
#pragma unroll
            for (int q = 0; q < 4; ++q) {
                const int s = 2 * wave + (q >> 1), c0 = 8 * (q & 1) + 4 * hh, t = 16 * (32 * n + r32) + s;
                u32x2 w; w.x = cvt_pk_bf16(fgelu(acc[n][4 * q]), fgelu(acc[n][4 * q + 1])); w.y = cvt_pk_bf16(fgelu(acc[n][4 * q + 2]), fgelu(acc[n][4 * q + 3]));
                *(u32x2*)(GS5 + (size_t)(b * SEQ + t) * DH + 16 * g + c0) = w;
            }
    }
    __syncthreads();
}
__device__ __forceinline__ void s5_sample(const Args& a, int bs, int g, int lane) {
    const bf16_t* U = (const bf16_t*)(a.ws + WS_U);
    bf16_t* GS5 = (bf16_t*)(a.ws + WS_XB);
    const float* aux = (const float*)(a.ws + WS_S5AUX) + (size_t)g * S5AUX_GROUP_FLOATS;
    const int row = MP + bs;
    float u[16];
    { const u32x4 w0 = *(const u32x4*)(U + (size_t)row * DH + 16 * g), w1 = *(const u32x4*)(U + (size_t)row * DH + 16 * g + 8);
      u[0] = bf_lo(w0.x); u[1] = bf_hi(w0.x); u[2] = bf_lo(w0.y); u[3] = bf_hi(w0.y); u[4] = bf_lo(w0.z); u[5] = bf_hi(w0.z); u[6] = bf_lo(w0.w); u[7] = bf_hi(w0.w);
      u[8] = bf_lo(w1.x); u[9] = bf_hi(w1.x); u[10] = bf_lo(w1.y); u[11] = bf_hi(w1.y); u[12] = bf_lo(w1.z); u[13] = bf_hi(w1.z); u[14] = bf_lo(w1.w); u[15] = bf_hi(w1.w); }
    const float lr = aux[lane], li = aux[64 + lane];
    const size_t so = (size_t)(bs * NG + g) * NP + lane;
    const float h0r = a.in[I_S5RE][so], h0i = a.in[I_S5IM][so];
    float hr = lr * h0r - li * h0i, hi = lr * h0i + li * h0r;
    const f32x4* bbr = (const f32x4*)(aux + 256 + lane * 16); const f32x4* bbi = (const f32x4*)(aux + 1280 + lane * 16);
#pragma unroll
    for (int q = 0; q < 4; ++q) { const f32x4 br = bbr[q], bi = bbi[q];
#pragma unroll
        for (int j = 0; j < 4; ++j) { hr += br[j] * u[4 * q + j]; hi += bi[j] * u[4 * q + j]; } }
    a.out[O_SS5RE + so] = hr; a.out[O_SS5IM + so] = hi;
    float ymine = 0.f;
#pragma unroll
    for (int c = 0; c < 16; ++c) {
        const float cr = a.in[I_CRE][(size_t)(g * 16 + c) * 64 + lane], ci = a.in[I_CIM][(size_t)(g * 16 + c) * 64 + lane];
        const float y = wave_sum(cr * hr - ci * hi);
        if (lane == c) ymine = y + a.in[I_DSKIP][g * 16 + c] * u[c];
    }
    float uc = 0.f;
    (void)uc;
    if (lane < 16) { const float gv = fgelu(ymine); const unsigned w = cvt_pk_bf16(gv, gv); GS5[(size_t)row * DH + 16 * g + lane] = (bf16_t)(w & 0xffffu); }
}

constexpr int XC_PITCH = 144;
__device__ __forceinline__ void lru_item(const Args& a, LAS unsigned char* lds, bool sample, int b, int head, int q, int tid, int lane, int wave) {
    const float* XL = (const float*)(a.ws + WS_XLRU);
    const bf16_t* GG = (const bf16_t*)(a.ws + WS_GG);
    bf16_t* MRG = (bf16_t*)(a.ws + WS_MRG);
    float* ssq_lru = (float*)(a.ws + WS_CTL + CTL_SSQ_BYTE) + 3 * MPAD;
    LAS unsigned char* XC = lds;
    LAS float* XCF = (LAS float*)(lds + 36864);
    LAS float* AA = XCF + 4096;
    LAS float* BX = AA + 4096;
    const int ch0 = 64 * head + 16 * q;
    const int fr = lane & 15, fq = lane >> 4;
    bf16x8 Bf[2][2];
#pragma unroll
    for (int mat = 0; mat < 2; ++mat)
#pragma unroll
        for (int ks = 0; ks < 2; ++ks) {
            const float* w = (mat ? a.in[I_WX] : a.in[I_WA]) + ((size_t)(head * 64 + 32 * ks + 8 * fq)) * 64 + 16 * q + fr;
            u32x4 p; p.x = cvt_pk_bf16(w[0], w[64]); p.y = cvt_pk_bf16(w[128], w[192]); p.z = cvt_pk_bf16(w[256], w[320]); p.w = cvt_pk_bf16(w[384], w[448]);
            Bf[mat][ks] = __builtin_bit_cast(bf16x8, p);
        }
    const int chn = ch0 + fr;
    const float ba = a.in[I_BA][chn], bx_ = a.in[I_BX][chn];
    const float spl = log1pf(expf(-a.in[I_LAML][chn]));
    const int ci = tid & 63, cch = 64 * head + ci;
    const float cw0 = a.in[I_CONVW][cch], cw1 = a.in[I_CONVW][DH + cch], cw2 = a.in[I_CONVW][2 * DH + cch], cw3 = a.in[I_CONVW][3 * DH + cch], cb = a.in[I_CONVB][cch];
    const int nchunk = sample ? 1 : 8, T = sample ? 128 : 256;
    float hcar = 0.f;
    for (int chk = 0; chk < nchunk; ++chk) {
        const int R0 = sample ? MP : b * SEQ + chk * 256;
        {
            const int RPT = T / 8, rg = tid >> 6, r0 = rg * RPT;
            if (!sample) {
                const int t0 = chk * 256 + r0;
                float xm3 = (t0 >= 3) ? XL[(size_t)(R0 + r0 - 3) * DH + cch] : 0.f;
                float xm2 = (t0 >= 2) ? XL[(size_t)(R0 + r0 - 2) * DH + cch] : 0.f;
                float xm1 = (t0 >= 1) ? XL[(size_t)(R0 + r0 - 1) * DH + cch] : 0.f;
#pragma unroll 8
                for (int rr = 0; rr < 32; ++rr) {
                    const float x0 = XL[(size_t)(R0 + r0 + rr) * DH + cch];
                    const float xc = cb + cw0 * xm3 + cw1 * xm2 + cw2 * xm1 + cw3 * x0;
                    xm3 = xm2; xm2 = xm1; xm1 = x0;
                    const unsigned w = cvt_pk_bf16(xc, xc);
                    *(LAS unsigned short*)(XC + (r0 + rr) * XC_PITCH + 2 * ci) = (unsigned short)(w & 0xffffu);
                    if ((ci >> 4) == q) XCF[(r0 + rr) * 16 + (ci & 15)] = xc;
                }
            } else {
                const float* cbuf = a.in[I_LRUCONV];
#pragma unroll 4
                for (int rr = 0; rr < 16; ++rr) {
                    const int bs = r0 + rr;
                    const float x0 = XL[(size_t)(R0 + bs) * DH + cch];
                    const float c0 = cbuf[((size_t)bs * 3 + 0) * DH + cch], c1 = cbuf[((size_t)bs * 3 + 1) * DH + cch], c2 = cbuf[((size_t)bs * 3 + 2) * DH + cch];
                    const float xc = cb + cw0 * c0 + cw1 * c1 + cw2 * c2 + cw3 * x0;
                    const unsigned w = cvt_pk_bf16(xc, xc);
                    *(LAS unsigned short*)(XC + bs * XC_PITCH + 2 * ci) = (unsigned short)(w & 0xffffu);
                    if ((ci >> 4) == q) {
                        XCF[bs * 16 + (ci & 15)] = xc;
                        float* oc = a.out + O_SLRUC + (size_t)bs * 3 * DH + cch;
                        oc[0] = c1; oc[DH] = c2; oc[2 * DH] = x0;
                    }
                }
            }
        }
        __syncthreads();
        {
            const int ntile = T / 16;
            for (int tile = wave; tile < ntile; tile += NWAVES) {
                f32x4 ar = (f32x4){0.f, 0.f, 0.f, 0.f}, ax = ar;
#pragma unroll
                for (int ks = 0; ks < 2; ++ks) {
                    const bf16x8 af = *(const LAS bf16x8*)(XC + (16 * tile + fr) * XC_PITCH + 64 * ks + 16 * fq);
                    ar = __builtin_amdgcn_mfma_f32_16x16x32_bf16(af, Bf[0][ks], ar, 0, 0, 0);
                    ax = __builtin_amdgcn_mfma_f32_16x16x32_bf16(af, Bf[1][ks], ax, 0, 0, 0);
                }
#pragma unroll
                for (int r4 = 0; r4 < 4; ++r4) {
                    const int rr = 16 * tile + 4 * fq + r4;
                    const float xcv = XCF[rr * 16 + fr];
                    const float rg_ = fsigmoid(ar[r4] + ba), ig = fsigmoid(ax[r4] + bx_);
                    const float la = -8.0f * rg_ * spl;
                    const float av = fexp(la);
                    const float bv = sqrtf(-expm1f(2.0f * la)) * (ig * xcv);
                    AA[rr * 16 + fr] = av; BX[rr * 16 + fr] = bv;
                }
            }
        }
        __syncthreads();
        if (!sample) {
            if (wave == 0 && lane < 16) {
                float h = hcar;
#pragma unroll 8
                for (int rr = 0; rr < 256; ++rr) { h = AA[rr * 16 + lane] * h + BX[rr * 16 + lane]; BX[rr * 16 + lane] = h; }
                hcar = h;
            }
        } else {
            for (int idx = tid; idx < 128 * 16; idx += NWAVES * 64) {
                const int bs = idx >> 4, n = idx & 15;
                const float h = AA[idx] * a.in[I_LRUH][(size_t)bs * DH + ch0 + n] + BX[idx];
                BX[idx] = h; a.out[O_SLRUH + (size_t)bs * DH + ch0 + n] = h;
            }
        }
        __syncthreads();
        {
            const int rr = tid >> 1, half = tid & 1;
            if (rr < T) {
                const size_t row = (size_t)R0 + rr;
                const f32x4 h0 = *(const LAS f32x4*)(BX + rr * 16 + 8 * half), h1 = *(const LAS f32x4*)(BX + rr * 16 + 8 * half + 4);
                const u32x4 gw = *(const u32x4*)(GG + row * DH + ch0 + 8 * half);
                const f32x4 y0 = (f32x4){h0[0] * bf_lo(gw.x), h0[1] * bf_hi(gw.x), h0[2] * bf_lo(gw.y), h0[3] * bf_hi(gw.y)};
                const f32x4 y1 = (f32x4){h1[0] * bf_lo(gw.z), h1[1] * bf_hi(gw.z), h1[2] * bf_lo(gw.w), h1[3] * bf_hi(gw.w)};
                *(u32x4*)(MRG + row * D + DH + ch0 + 8 * half) = pack8(y0, y1);
                float s = dot4(y0) + dot4(y1);
                s += __shfl_xor(s, 1);
                if (half == 0) atomicAdd(ssq_lru + row, s);
            }
        }
    }
    if (!sample) {
        if (wave == 0 && lane < 16) a.out[O_PLRUH + (size_t)b * DH + ch0 + lane] = hcar;
        if (wave == 1 && lane < 48) { const int k = lane >> 4, n = lane & 15;
            a.out[O_PLRUC + ((size_t)b * 3 + k) * DH + ch0 + n] = XL[(size_t)(b * SEQ + SEQ - 3 + k) * DH + ch0 + n]; }
    }
    __syncthreads();
}

__global__ void __launch_bounds__(NWAVES * 64, 2) hymba_fwd(Args args) {
    extern __shared__ __attribute__((aligned(16))) unsigned char lds_raw[];
    LAS unsigned char* lds = (LAS unsigned char*)lds_raw;
    volatile LAS unsigned* MISC = (volatile LAS unsigned*)(lds + MISC_OFF);
    const int tid = threadIdx.x, lane = tid & 63, wave = __builtin_amdgcn_readfirstlane(tid >> 6);
    const int G = gridDim.x, bx = blockIdx.x;
    const int vcu = (G % 8 == 0) ? (bx % 8) * (G / 8) + bx / 8 : bx;
    unsigned char* ws = args.ws;
    unsigned* ctl = (unsigned*)(ws + WS_CTL);
    for (int u = tid; u < (LDS_BYTES - LDSCTL_OFF) / 4; u += NWAVES * 64) ((LAS unsigned*)(lds + LDSCTL_OFF))[u] = 0u;
    __syncthreads();
    XcdBarrier bar; bar.bar = ctl + CW_BAR; bar.x = 0; bar.st = nullptr;
    if (MK_N_LAUNCHES == 1) bar = xcd_barrier_post(ctl + CW_BAR, MISC + 8);
#define GRID_BAR() do { if (MK_N_LAUNCHES == 1) xcd_barrier(bar); } while (0)
    const int lo = args.ph_lo, hi = args.ph_hi;
#define IN(k) (lo <= (k) && (k) < hi)
#define BOTH(k) (IN(k) && IN((k) + 1))
    float* ssq = (float*)(ws + WS_CTL + CTL_SSQ_BYTE);
    float *ssq0 = ssq, *ssq1 = ssq + MPAD, *ssq_s5 = ssq + 2 * MPAD, *ssq_lru = ssq + 3 * MPAD, *ssq2 = ssq + 4 * MPAD, *ssq3 = ssq + 5 * MPAD;
    bf16_t* XB = (bf16_t*)(ws + WS_XB); float* X1 = (float*)(ws + WS_X1); bf16_t* HID = (bf16_t*)(ws + WS_H);
    bf16_t* U = (bf16_t*)(ws + WS_U); float* XL = (float*)(ws + WS_XLRU); bf16_t* GG = (bf16_t*)(ws + WS_GG); bf16_t* MRG = (bf16_t*)(ws + WS_MRG);
    float* SLAB = (float*)(ws + WS_SLAB); float* SLAB5 = (float*)(ws + WS_U);
    const int gws = wave * G + bx;

    if (IN(0)) { p0_prologue(args, lds, vcu, G, tid, lane, wave); if (BOTH(0)) GRID_BAR(); }
    if (IN(1)) {
        pg8::Gemm g{XB, (const bf16_t*)(ws + WS_W13A), D, D}; pg8::PanelOrder S; S.init(2 * FF / 256, D / 64, D / 64, G, bx);
        pg8::EpiSwiGLU E{HID, ssq0};
        pg8::gemm_phase(lds, g, S, E);
        if (BOTH(1)) GRID_BAR();
    }
    if (IN(2)) {
        pg8::Gemm g{HID, (const bf16_t*)(ws + WS_W2A), FF, FF}; pg8::PanelOrder S; S.init(D / 256, FF / 64, 8, G, bx);
        pg8::EpiResid E{args.in[I_XP], SLAB, X1, XB, ssq1};
        pg8::gemm_phase(lds, g, S, E);
        if (BOTH(2)) GRID_BAR();
    }
    if (IN(3)) {
        if (gws < MS) {
            const int row = MP + gws;
            const f32x4* xr = (const f32x4*)(args.in[I_XS] + (size_t)gws * D) + lane; f32x4 v[8]; float sq = 0.f;
#pragma unroll
            for (int j = 0; j < 8; ++j) { f32x4 t = (f32x4){0.f, 0.f, 0.f, 0.f};
#pragma unroll
                for (int sl = 0; sl < 11; ++sl) t += ((const f32x4*)(SLAB + ((size_t)sl * MS + gws) * D) + lane)[64 * j];
                v[j] = xr[64 * j] + 0.5f * t; sq += dot4(v[j]); }
            sq = wave_sum(sq);
#pragma unroll
            for (int j = 0; j < 8; ++j) { ((f32x4*)(X1 + (size_t)row * D) + lane)[64 * j] = v[j];
                u32x2 w; w.x = cvt_pk_bf16(v[j][0], v[j][1]); w.y = cvt_pk_bf16(v[j][2], v[j][3]); ((u32x2*)(XB + (size_t)row * D) + lane)[64 * j] = w; }
            if (lane == 0) ssq1[row] = sq;
        }
        if (BOTH(3)) GRID_BAR();
    }
    if (IN(4)) {
        pg8::Gemm g{XB, (const bf16_t*)(ws + WS_WIN), D, D}; pg8::PanelOrder S; S.init(DIN / 256, D / 64, D / 64, G, bx);
        pg8::EpiProj E{U, XL, GG, ssq1};
        pg8::gemm_phase(lds, g, S, E);
        if (BOTH(4)) GRID_BAR();
    }
    if (IN(5)) {
        { bf16_t* GS5 = XB; const int gw = bx * NWAVES + wave, NGW = G * NWAVES;
          for (int m = M + gw; m < MPAD; m += NGW) {
              ((u32x4*)(GS5 + (size_t)m * DH))[lane] = (u32x4){0u, 0u, 0u, 0u}; ((u32x4*)(GS5 + (size_t)m * DH))[64 + lane] = (u32x4){0u, 0u, 0u, 0u};
              ((u32x4*)(MRG + (size_t)m * D + DH))[lane] = (u32x4){0u, 0u, 0u, 0u}; ((u32x4*)(MRG + (size_t)m * D + DH))[64 + lane] = (u32x4){0u, 0u, 0u, 0u}; } }
        for (int it = bx; it < NB * NG; it += G) { const int b = it >> 6, g = ((it & 7) << 3) | ((it >> 3) & 7); s5_prompt(args, lds, b, g, tid, lane, wave); }
        for (int it = bx * NWAVES + wave; it < MS * NG; it += G * NWAVES) s5_sample(args, it >> 6, it & 63, lane);
        __syncthreads();
        for (int it = bx; it < NB * 64; it += G) lru_item(args, lds, false, it >> 6, (it >> 2) & 15, it & 3, tid, lane, wave);
        for (int it = bx; it < 64; it += G) lru_item(args, lds, true, 0, it >> 2, it & 3, tid, lane, wave);
        if (BOTH(5)) GRID_BAR();
    }
    if (IN(6)) {
        pg8::Gemm g{XB, (const bf16_t*)(ws + WS_WGLU), DH, DH}; pg8::PanelOrder S; S.init(DH / 256, DH / 64, DH / 64, G, bx);
        pg8::EpiGlu E{XB, args.in[I_BGLU], MRG, ssq_s5};
        pg8::gemm_phase(lds, g, S, E);
        if (BOTH(6)) GRID_BAR();
    }
    if (IN(7)) {
        pg8::Gemm g{MRG, (const bf16_t*)(ws + WS_WOUT), D, D}; pg8::PanelOrder S; S.init(D / 256, D / 64, 4, G, bx);
        pg8::EpiOut E{ssq_s5, ssq_lru, X1, XB, ssq2, SLAB5};
        pg8::gemm_phase(lds, g, S, E);
        if (BOTH(7)) GRID_BAR();
    }
    if (IN(8)) {
        if (gws < MS) {
            const int row = MP + gws;
            const float rs = rsqrtf(ssq_s5[row] * (1.0f / DH) + EPS), rl = rsqrtf(ssq_lru[row] * (1.0f / DH) + EPS);
            f32x4 v[8]; float sq = 0.f;
#pragma unroll
            for (int j = 0; j < 8; ++j) { f32x4 t0 = (f32x4){0.f, 0.f, 0.f, 0.f}, t1 = t0;
#pragma unroll
                for (int sl = 0; sl < 4; ++sl) { t0 += ((const f32x4*)(SLAB5 + ((size_t)sl * MS + gws) * D) + lane)[64 * j]; t1 += ((const f32x4*)(SLAB5 + ((size_t)(sl + 4) * MS + gws) * D) + lane)[64 * j]; }
                v[j] = ((const f32x4*)(X1 + (size_t)row * D) + lane)[64 * j] + rs * t0 + rl * t1; sq += dot4(v[j]); }
            sq = wave_sum(sq);
#pragma unroll
            for (int j = 0; j < 8; ++j) { ((f32x4*)(X1 + (size_t)row * D) + lane)[64 * j] = v[j];
                u32x2 w; w.x = cvt_pk_bf16(v[j][0], v[j][1]); w.y = cvt_pk_bf16(v[j][2], v[j][3]); ((u32x2*)(XB + (size_t)row * D) + lane)[64 * j] = w; }
            if (lane == 0) ssq2[row] = sq;
        }
        if (BOTH(8)) GRID_BAR();
    }
    if (IN(9)) {
        pg8::Gemm g{XB, (const bf16_t*)(ws + WS_W13B), D, D}; pg8::PanelOrder S; S.init(2 * FF / 256, D / 64, D / 64, G, bx);
        pg8::EpiSwiGLU E{HID, ssq2};
        pg8::gemm_phase(lds, g, S, E);
        if (BOTH(9)) GRID_BAR();
    }
    if (IN(10)) {
        pg8::Gemm g{HID, (const bf16_t*)(ws + WS_W2B), FF, FF}; pg8::PanelOrder S; S.init(D / 256, FF / 64, 8, G, bx);
        pg8::EpiFinal E{X1, args.out, ssq3, SLAB};
        pg8::gemm_phase(lds, g, S, E);
        if (BOTH(10)) GRID_BAR();
    }
    if (IN(11)) {
        const f32x4* gf = (const f32x4*)args.in[I_GFINAL] + lane;
        if (gws < MS) {
            const int row = MP + gws; f32x4 v[8]; float sq = 0.f;
#pragma unroll
            for (int j = 0; j < 8; ++j) { f32x4 t = (f32x4){0.f, 0.f, 0.f, 0.f};
#pragma unroll
                for (int sl = 0; sl < 11; ++sl) t += ((const f32x4*)(SLAB + ((size_t)sl * MS + gws) * D) + lane)[64 * j];
                v[j] = ((const f32x4*)(X1 + (size_t)row * D) + lane)[64 * j] + 0.5f * t; sq += dot4(v[j]); }
            const float r = rsqrtf(wave_sum(sq) * (1.0f / D) + EPS);
#pragma unroll
            for (int j = 0; j < 8; ++j) ((f32x4*)(args.out + (size_t)row * D) + lane)[64 * j] = v[j] * gf[64 * j] * r;
        }
        const int gw = bx * NWAVES + wave, NGW = G * NWAVES;
        for (int m = gw; m < MP; m += NGW) {
            const float r = rsqrtf(ssq3[m] * (1.0f / D) + EPS);
            f32x4* o = (f32x4*)(args.out + (size_t)m * D) + lane;
#pragma unroll
            for (int j = 0; j < 8; ++j) o[64 * j] = o[64 * j] * gf[64 * j] * r;
        }
    }
#undef IN
#undef BOTH
#undef GRID_BAR
}

extern "C" void kernel_launch(void* const* d_in, const int* in_sizes, int n_in, void* d_out, int out_size, void* d_ws, size_t ws_size, hipStream_t stream) {
    static int grid = 0;
    if (grid == 0) {
        if (n_in != N_IN || in_sizes[0] != MP * D || (size_t)out_size != O_END || ws_size < WS_END) {
            fprintf(stderr, "kernel_launch: unexpected problem: n_in %d in0 %d out %d ws %zu (need %zu)\n", n_in, n_in > 0 ? in_sizes[0] : -1, out_size, ws_size, (size_t)WS_END); grid = -1; return; }
        int dev = 0, cus = 0;
        if (hipGetDevice(&dev) != hipSuccess || hipDeviceGetAttribute(&cus, hipDeviceAttributeMultiprocessorCount, dev) != hipSuccess) { grid = -1; return; }
        if (hipFuncSetAttribute((const void*)hymba_fwd, hipFuncAttributeMaxDynamicSharedMemorySize, LDS_BYTES) != hipSuccess) { fprintf(stderr, "kernel_launch: hipFuncSetAttribute failed\n"); grid = -1; return; }
        int per_cu = 0;
        if (hipOccupancyMaxActiveBlocksPerMultiprocessor(&per_cu, (const void*)hymba_fwd, NWAVES * 64, LDS_BYTES) != hipSuccess || per_cu < 1)
            fprintf(stderr, "kernel_launch: note: occupancy query reports %d workgroups per CU\n", per_cu);
        (void)hipGetLastError();
        grid = cus;
    }
    if (grid < 0) return;
    if (hipMemsetAsync((char*)d_ws + WS_CTL, 0, CTL_ZERO_BYTES, stream) != hipSuccess) { fprintf(stderr, "kernel_launch: memset failed\n"); return; }
    Args a{};
    for (int i = 0; i < N_IN; ++i) a.in[i] = (const float*)d_in[i];
    a.out = (float*)d_out; a.ws = (unsigned char*)d_ws;
    if (MK_N_LAUNCHES == 1) {
        a.ph_lo = 0; a.ph_hi = NPHASE;
        hipLaunchKernelGGL(hymba_fwd, dim3(grid), dim3(NWAVES * 64), LDS_BYTES, stream, a);
    } else {
        for (int p = 0; p < NPHASE; ++p) { a.ph_lo = p; a.ph_hi = p + 1; hipLaunchKernelGGL(hymba_fwd, dim3(grid), dim3(NWAVES * 64), LDS_BYTES, stream, a); }
    }
}
```

```cpp
#include <hip/hip_runtime.h>
#include <cstdio>
#include <cstdint>

#define LAS __attribute__((address_space(3)))
#define GAS __attribute__((address_space(1)))
typedef unsigned short bf16_t;
typedef short bf16x8 __attribute__((ext_vector_type(8)));
typedef float f32x4 __attribute__((ext_vector_type(4)));
typedef float f32x16 __attribute__((ext_vector_type(16)));
typedef unsigned u32x4 __attribute__((ext_vector_type(4)));
typedef unsigned u32x2 __attribute__((ext_vector_type(2)));

#ifndef PROBE_PHASE
#define PROBE_PHASE -1
#endif
#ifndef MK_N_LAUNCHES
#define MK_N_LAUNCHES 1
#endif

constexpr int D = 2048, FF = 5632, DIN = 3072, DH = 1024;
constexpr int MP = 8192, MS = 128, M = MP + MS, MPAD = 8448;
constexpr int SEQ = 2048, NB = 4, NG = 64, NP = 64, GS = 16;
constexpr float EPS = 1e-6f;
constexpr int NPHASE = 10;
constexpr int NMP = MP / 256;
constexpr int NWAVES = 8;

constexpr size_t MiB = 1u << 20;
constexpr size_t WS_CTL = 0, CTL_ZERO_BYTES = 1 * MiB;
constexpr size_t WS_W13A = 1 * MiB, WS_W2A = 45 * MiB, WS_WIN = 67 * MiB, WS_WGLU = 79 * MiB, WS_WOUT = 81 * MiB, WS_W13B = 89 * MiB, WS_W2B = 133 * MiB;
constexpr size_t WS_S5M = 155 * MiB, WS_S5AUX = 171 * MiB;
constexpr size_t WS_XB = 172 * MiB;
constexpr size_t WS_X1 = 205 * MiB;
constexpr size_t WS_GS5 = WS_X1;
constexpr size_t WS_H = 271 * MiB;
constexpr size_t WS_U = 271 * MiB, WS_XLRU = WS_U + (size_t)MPAD * DH * 2, WS_GG = WS_XLRU + (size_t)MPAD * DH * 4, WS_MRG = WS_GG + (size_t)MPAD * DH * 2;
constexpr size_t WS_SLAB = 362 * MiB;
constexpr size_t WS_END = 373 * MiB;
static_assert(WS_MRG + (size_t)MPAD * D * 2 <= WS_END && WS_H + (size_t)MPAD * FF * 2 <= WS_SLAB && WS_SLAB + (size_t)11 * MS * D * 4 <= WS_END, "ws map");
constexpr int S5M_GROUP_BYTES = 256 * 1024;
constexpr int S5AUX_GROUP_FLOATS = 2304;
constexpr int CW_BAR = 4096;
constexpr int CW_CNT = 8192;
constexpr size_t CTL_SSQ_BYTE = 262144;

constexpr int RING_BYTES = 139264;
constexpr int LDSCTL_OFF = RING_BYTES, MISC_OFF = LDSCTL_OFF + 320;
constexpr int LDS_BYTES = 147456;

__device__ __forceinline__ unsigned cvt_pk_bf16(float lo, float hi) { unsigned r; asm volatile("v_cvt_pk_bf16_f32 %0, %1, %2" : "=v"(r) : "v"(lo), "v"(hi)); return r; }
__device__ __forceinline__ float bf_lo(unsigned w) { return __uint_as_float(w << 16); }
__device__ __forceinline__ float bf_hi(unsigned w) { return __uint_as_float(w & 0xffff0000u); }
__device__ __forceinline__ float fexp(float x) { return __builtin_amdgcn_exp2f(x * 1.44269504089f); }
__device__ __forceinline__ float fsigmoid(float x) { return __builtin_amdgcn_rcpf(1.0f + fexp(-x)); }
__device__ __forceinline__ float fsilu(float x) { return x * fsigmoid(x); }
__device__ __forceinline__ float fgelu(float x) { return x * fsigmoid(1.5957691216057308f * (x + 0.044715f * x * x * x)); }
__device__ __forceinline__ u32x4 pack8(const f32x4 a, const f32x4 b) { u32x4 w; w.x = cvt_pk_bf16(a[0], a[1]); w.y = cvt_pk_bf16(a[2], a[3]); w.z = cvt_pk_bf16(b[0], b[1]); w.w = cvt_pk_bf16(b[2], b[3]); return w; }
__device__ __forceinline__ void st16_wt(void* p, const u32x4 v) { asm volatile("global_store_dwordx4 %0, %1, off sc1\n\ts_nop 1" :: "v"(p), "v"(v) : "memory"); }
__device__ __forceinline__ void st16_wt(void* p, const f32x4 v) { st16_wt(p, __builtin_bit_cast(u32x4, v)); }
__device__ __forceinline__ void st16_sel(void* p, const u32x4 v, int wt) { if (wt) st16_wt(p, v); else *(u32x4*)p = v; }
__device__ __forceinline__ void st16_sel(void* p, const f32x4 v, int wt) { if (wt) st16_wt(p, v); else *(f32x4*)p = v; }
__device__ __forceinline__ float dot4(const f32x4 a) { return (a[0] * a[0] + a[1] * a[1]) + (a[2] * a[2] + a[3] * a[3]); }
__device__ __forceinline__ float wave_sum(float v) {
#pragma unroll
    for (int o = 1; o < 64; o <<= 1) v += __shfl_xor(v, o);
    return v;
}
__device__ __forceinline__ float neg_expm1(float x) {
    float p = 1.0f / 5040.0f; p = fmaf(p, x, 1.0f / 720.0f); p = fmaf(p, x, 1.0f / 120.0f); p = fmaf(p, x, 1.0f / 24.0f); p = fmaf(p, x, 1.0f / 6.0f); p = fmaf(p, x, 0.5f); p = fmaf(p, x, 1.0f);
    const float small = -(p * x), big = 1.0f - fexp(x);
    return x > -0.35f ? small : big;
}
#define LDS_WAIT() asm volatile("s_waitcnt lgkmcnt(0)" ::: "memory")
#define VM_WAIT() asm volatile("s_waitcnt vmcnt(0)" ::: "memory")

namespace pg8 {
constexpr int BM = 256, BK = 64, HALF = 128, HTB = HALF * BK * 2, STAGE_BYTES = 8 * HTB, NXCD = 8, WGM = 8;
__host__ __device__ __forceinline__ int lds_byte(int r, int c) { const int st = (r >> 4) * 2 + (c >> 5), rr = r & 15, cc = c & 31, ob = rr * 64 + cc * 2; return st * 1024 + (ob ^ (((ob >> 9) & 1) << 5)); }
__host__ __device__ __forceinline__ void stage_rc(int b, int& R, int& C) { const int st = b / 1024, sb = b % 1024, swz = sb ^ (((sb >> 9) & 1) << 5); R = (st >> 1) * 16 + swz / 64; C = (st & 1) * 32 + (swz % 64) / 2; }
__host__ __device__ __forceinline__ int perm32(int rho) { const int n = rho >> 4, i = rho & 15; return 8 * (i >> 2) + 4 * n + (i & 3); }

struct Unit { int pm, pn, kt0, nkt; };
struct Gemm { const bf16_t* A; const bf16_t* Bt; int lda, ldb; };

struct PanelOrder {
    int nN, nwgP, G, c, nktFull, sliceKt, nExtra;
    unsigned* ready; unsigned need;
    __device__ void init(int nN_, int nktFull_, int sliceKt_, int G_, int c_) { nN = nN_; nwgP = 32 * nN_; G = G_; c = c_; nktFull = nktFull_; sliceKt = sliceKt_; nExtra = nN_ * (nktFull_ / sliceKt_); ready = nullptr; need = 0u; }
    __device__ __forceinline__ void a_ready(const Unit& u) const {
        if (ready == nullptr || u.pm != 32) return;
        if (threadIdx.x < 64) {
            unsigned polls = 0;
            while ((unsigned)__builtin_amdgcn_readfirstlane(__hip_atomic_load(ready, __ATOMIC_RELAXED, __HIP_MEMORY_SCOPE_AGENT)) < need) { __builtin_amdgcn_s_sleep(2); if (++polls > (1u << 22)) break; }
            __builtin_amdgcn_fence(__ATOMIC_ACQUIRE, "agent");
            asm volatile("s_waitcnt vmcnt(0)" ::: "memory");
        }
        asm volatile("" ::: "memory"); __builtin_amdgcn_s_barrier(); asm volatile("" ::: "memory");
    }
    __device__ bool next(int i, Unit& u) const {
        const long L = (long)i * G + c;
        if (L < nwgP) {
            int wgid = (int)L; { const int q = nwgP / NXCD, r = nwgP % NXCD, xcd = wgid % NXCD, off = wgid / NXCD; wgid = (xcd < r ? xcd * (q + 1) : r * (q + 1) + (xcd - r) * q) + off; }
            const int nig = WGM * nN, gid = wgid / nig, fm = gid * WGM, gsz = (32 - fm) < WGM ? (32 - fm) : WGM;
            u.pm = fm + ((wgid % nig) % gsz); u.pn = (wgid % nig) / gsz; u.kt0 = 0; u.nkt = nktFull; return true;
        }
        const int e = (int)(L - nwgP); if (e >= nExtra) return false;
        u.pm = 32; u.pn = e % nN; u.kt0 = (e / nN) * sliceKt; u.nkt = sliceKt; return true;
    }
};

template <class Epi, class Sched>
__device__ __forceinline__ void gemm_phase(LAS unsigned char* lds, const Gemm g, const Sched& S, const Epi& E) {
    const int tid = threadIdx.x, wid = __builtin_amdgcn_readfirstlane(tid >> 6), lane = tid & 63, wr = wid >> 2, wc = wid & 3, fr = lane & 15, fq = lane >> 4;
    unsigned voffA[2], voffB[2];
#pragma unroll
    for (int i = 0; i < 2; ++i) { int R, C; stage_rc(tid * 16 + i * 8192, R, C); const int Rb = Epi::PERM ? ((R & ~31) + perm32(R & 31)) : R;
        voffA[i] = (unsigned)(R * g.lda + C) * 2u; voffB[i] = (unsigned)(Rb * g.ldb + C) * 2u; }
    const size_t kstep = (size_t)(BK * 2);
    const size_t hstepA = (size_t)HALF * g.lda * 2, hstepB = (size_t)HALF * g.ldb * 2;
    const size_t tstepA = 2 * hstepA, tstepB = 2 * hstepB;
    const unsigned ldsw = (unsigned)wid * 1024u;
    const int aoff = lds_byte(wr * 64 + fr, fq * 8), boff = lds_byte(wc * 32 + fr, fq * 8);
#define PG8_SA(b, h) (((b) * 2 + (h)) * HTB)
#define PG8_SB(b, h) ((4 + (b) * 2 + (h)) * HTB)
#define PG8_STAGE(bufoff, gbase, voff) do { _Pragma("unroll") for (int _i = 0; _i < 2; ++_i) \
        __builtin_amdgcn_global_load_lds((const unsigned*)((const char*)(gbase) + (voff)[_i]), (LAS unsigned*)(lds + (bufoff) + ldsw + _i * 8192), 16, 0, 0); } while (0)
#define PG8_LDA(dst, b, h) do { _Pragma("unroll") for (int m = 0; m < 4; ++m) _Pragma("unroll") for (int k = 0; k < 2; ++k) dst[m][k] = *(const LAS bf16x8*)(lds + PG8_SA(b, h) + aoff + m * 2048 + k * 1024); } while (0)
#define PG8_LDB(dst, b, h) do { _Pragma("unroll") for (int n = 0; n < 2; ++n) _Pragma("unroll") for (int k = 0; k < 2; ++k) dst[n][k] = *(const LAS bf16x8*)(lds + PG8_SB(b, h) + boff + n * 2048 + k * 1024); } while (0)
#define PG8_MMA(ai, bj, At, Bt) do { __builtin_amdgcn_s_setprio(1); _Pragma("unroll") for (int m = 0; m < 4; ++m) _Pragma("unroll") for (int n = 0; n < 2; ++n) _Pragma("unroll") for (int k = 0; k < 2; ++k) \
        acc[ai][bj][m][n] = __builtin_amdgcn_mfma_f32_16x16x32_bf16(Bt[n][k], At[m][k], acc[ai][bj][m][n], 0, 0, 0); __builtin_amdgcn_s_setprio(0); } while (0)
#define PG8_WAIT_V(n) asm volatile("s_waitcnt vmcnt(" #n ")" ::: "memory")
#define PG8_WAIT_L(n) asm volatile("s_waitcnt lgkmcnt(" #n ")" ::: "memory")
#define PG8_BAR __builtin_amdgcn_s_barrier()
#define PG8_SCHED __builtin_amdgcn_sched_barrier(0)
    Unit cur, nxt; int ui = 0;
    if (!S.next(0, cur)) return;
    f32x4 acc[2][2][4][2];
#pragma unroll
    for (int a = 0; a < 2; ++a)
#pragma unroll
        for (int b = 0; b < 2; ++b)
#pragma unroll
            for (int m = 0; m < 4; ++m)
#pragma unroll
                for (int n = 0; n < 2; ++n) acc[a][b][m][n] = (f32x4){0.f, 0.f, 0.f, 0.f};
    bf16x8 At[4][2], B0[2][2], B1[2][2];
    const char* cA = (const char*)g.A + (size_t)cur.pm * tstepA + (size_t)cur.kt0 * kstep;
    const char* cB = (const char*)g.Bt + (size_t)cur.pn * tstepB + (size_t)cur.kt0 * kstep;
    S.a_ready(cur);
    PG8_STAGE(PG8_SB(0, 0), cB, voffB); PG8_STAGE(PG8_SB(0, 1), cB + hstepB, voffB); PG8_STAGE(PG8_SA(0, 0), cA, voffA); PG8_STAGE(PG8_SA(0, 1), cA + hstepA, voffA);
    if (wr == 1) PG8_BAR;
    PG8_WAIT_V(2); PG8_BAR;
    PG8_STAGE(PG8_SB(1, 0), cB + kstep, voffB); PG8_STAGE(PG8_SA(1, 0), cA + kstep, voffA); PG8_STAGE(PG8_SB(1, 1), cB + hstepB + kstep, voffB);
    PG8_WAIT_V(6); PG8_BAR;
    for (;;) {
        const bool has_next = S.next(ui + 1, nxt);
        const char* nA = has_next ? (const char*)g.A + (size_t)nxt.pm * tstepA + (size_t)nxt.kt0 * kstep : cA;
        const char* nB = has_next ? (const char*)g.Bt + (size_t)nxt.pn * tstepB + (size_t)nxt.kt0 * kstep : cB;
        const int nt = cur.nkt;
        for (int t = 0; t < nt; t += 2) {
            const bool last = (t == nt - 2);
            if (last && has_next) S.a_ready(nxt);
            const char* a1 = cA + (size_t)(t + 1) * kstep;
            const char* a2 = last ? nA : cA + (size_t)(t + 2) * kstep; const char* b2 = last ? nB : cB + (size_t)(t + 2) * kstep;
            const char* a3 = a2 + kstep; const char* b3 = b2 + kstep;
            if constexpr (Epi::HAS_MID) { if (t == Epi::MID_T) E.mid(acc, cur, wr, wc, fr, fq); }
            PG8_LDB(B0, 0, 0); PG8_LDB(B1, 0, 1); PG8_SCHED; PG8_LDA(At, 0, 0); PG8_STAGE(PG8_SA(1, 1), a1 + hstepA, voffA);
            PG8_WAIT_V(8); PG8_WAIT_L(0); PG8_BAR; PG8_MMA(0, 0, At, B0); PG8_MMA(0, 1, At, B1); PG8_BAR; PG8_SCHED;
            PG8_LDA(At, 0, 1); PG8_STAGE(PG8_SB(0, 0), b2, voffB); PG8_STAGE(PG8_SB(0, 1), b2 + hstepB, voffB); PG8_STAGE(PG8_SA(0, 0), a2, voffA);
            PG8_WAIT_V(8); PG8_WAIT_L(0); PG8_BAR; PG8_MMA(1, 0, At, B0); PG8_MMA(1, 1, At, B1); PG8_BAR; PG8_SCHED;
            PG8_LDB(B0, 1, 0); PG8_LDB(B1, 1, 1); PG8_SCHED; PG8_LDA(At, 1, 0); PG8_STAGE(PG8_SA(0, 1), a2 + hstepA, voffA);
            PG8_WAIT_V(8); PG8_WAIT_L(0); PG8_BAR; PG8_MMA(0, 0, At, B0); PG8_MMA(0, 1, At, B1); PG8_BAR; PG8_SCHED;
            PG8_LDA(At, 1, 1); PG8_STAGE(PG8_SB(1, 0), b3, voffB); PG8_STAGE(PG8_SB(1, 1), b3 + hstepB, voffB); PG8_STAGE(PG8_SA(1, 0), a3, voffA);
            PG8_WAIT_V(8); PG8_WAIT_L(0); PG8_BAR; PG8_MMA(1, 0, At, B0); PG8_MMA(1, 1, At, B1); PG8_BAR; PG8_SCHED;
        }
        if (wr == 0) PG8_BAR;
        E(acc, cur, wr, wc, fr, fq);
        if (!has_next) break;
#pragma unroll
        for (int a = 0; a < 2; ++a)
#pragma unroll
            for (int b = 0; b < 2; ++b)
#pragma unroll
                for (int m = 0; m < 4; ++m)
#pragma unroll
                    for (int n = 0; n < 2; ++n) acc[a][b][m][n] = (f32x4){0.f, 0.f, 0.f, 0.f};
        cur = nxt; cA = nA; cB = nB; ++ui;
        if (wr == 1) PG8_BAR;
    }
    PG8_WAIT_V(0);
    PG8_BAR;
#undef PG8_SA
#undef PG8_SB
#undef PG8_STAGE
#undef PG8_LDA
#undef PG8_LDB
#undef PG8_MMA
#undef PG8_WAIT_V
#undef PG8_WAIT_L
#undef PG8_BAR
#undef PG8_SCHED
}


typedef f32x4 Acc[2][2][4][2];
__device__ __forceinline__ void slab_store(const Acc& acc, const Unit& u, float* slab, int wr, int wc, int fr, int fq) {
    int rowl = wr * 64 + fr, col0 = u.pn * BM + wc * 32 + 8 * fq; asm volatile("" : "+v"(rowl), "+v"(col0));
    float* base = slab + (size_t)(u.kt0 / u.nkt) * ((size_t)MS * D);
#pragma unroll
    for (int m = 0; m < 4; ++m)
#pragma unroll
        for (int bj = 0; bj < 2; ++bj) { float* p = base + (size_t)(rowl + m * 16) * D + col0 + bj * HALF; st16_wt(p, acc[0][bj][m][0]); st16_wt(p + 4, acc[0][bj][m][1]); }
}
struct EpiSwiGLU {
    static constexpr bool PERM = true, HAS_MID = false; static constexpr int MID_T = -1;
    bf16_t* O; const float* ssq;
    __device__ __forceinline__ void mid(Acc&, const Unit&, int, int, int, int) const {}
    __device__ __forceinline__ void operator()(const Acc& acc, const Unit& u, int wr, int wc, int fr, int fq) const {
        int row0 = u.pm * BM + wr * 64 + fr, colh = u.pn * 128 + wc * 32 + 8 * fq; asm volatile("" : "+v"(row0), "+v"(colh));
        float sq[2][4];
#pragma unroll
        for (int ai = 0; ai < 2; ++ai)
#pragma unroll
            for (int m = 0; m < 4; ++m) sq[ai][m] = ssq[row0 + ai * HALF + m * 16];
        asm volatile("" ::: "memory");
#pragma unroll
        for (int ai = 0; ai < 2; ++ai)
#pragma unroll
            for (int m = 0; m < 4; ++m) {
                const int row = row0 + ai * HALF + m * 16;
                const float r = rsqrtf(sq[ai][m] * (1.0f / D) + EPS);
                f32x4 h0, h1;
#pragma unroll
                for (int j = 0; j < 4; ++j) { h0[j] = fsilu(acc[ai][0][m][0][j] * r) * (acc[ai][1][m][0][j] * r); h1[j] = fsilu(acc[ai][0][m][1][j] * r) * (acc[ai][1][m][1][j] * r); }
                *(u32x4*)(O + (size_t)row * FF + colh) = pack8(h0, h1);
            }
    }
};
typedef u32x4 ResTile[2][4][2];
typedef u32x4 ResHalf[4][2];
__device__ __forceinline__ void res_load(ResTile& res, const bf16_t* XB, int row0, int col0) {
#pragma unroll
    for (int ai = 0; ai < 2; ++ai)
#pragma unroll
        for (int m = 0; m < 4; ++m)
#pragma unroll
            for (int bj = 0; bj < 2; ++bj) res[ai][m][bj] = *(const u32x4*)(XB + (size_t)(row0 + ai * HALF + m * 16) * D + col0 + bj * HALF);
    asm volatile("" ::: "memory");
}
__device__ __forceinline__ void res_load_half(ResHalf& res, const bf16_t* XB, int rowh, int col0) {
#pragma unroll
    for (int m = 0; m < 4; ++m)
#pragma unroll
        for (int bj = 0; bj < 2; ++bj) res[m][bj] = *(const u32x4*)(XB + (size_t)(rowh + m * 16) * D + col0 + bj * HALF);
    asm volatile("" ::: "memory");
}
__device__ __forceinline__ f32x4 res_lo(const u32x4 w) { return (f32x4){bf_lo(w.x), bf_hi(w.x), bf_lo(w.y), bf_hi(w.y)}; }
__device__ __forceinline__ f32x4 res_hi(const u32x4 w) { return (f32x4){bf_lo(w.z), bf_hi(w.z), bf_lo(w.w), bf_hi(w.w)}; }
struct EpiResid {
    static constexpr bool PERM = true, HAS_MID = false; static constexpr int MID_T = -1;
    float* slab; bf16_t* XB; float* ssq;
    __device__ __forceinline__ void mid(Acc&, const Unit&, int, int, int, int) const {}
    __device__ __forceinline__ void operator()(const Acc& acc, const Unit& u, int wr, int wc, int fr, int fq) const {
        if (u.pm == 32) { slab_store(acc, u, slab, wr, wc, fr, fq); return; }
        int row0 = u.pm * BM + wr * 64 + fr, col0 = u.pn * BM + wc * 32 + 8 * fq; asm volatile("" : "+v"(row0), "+v"(col0));
#pragma unroll
        for (int ai = 0; ai < 2; ++ai) {
            ResHalf res; res_load_half(res, XB, row0 + ai * HALF, col0);
#pragma unroll
            for (int m = 0; m < 4; ++m) {
                const int row = row0 + ai * HALF + m * 16;
                float s = 0.f;
#pragma unroll
                for (int bj = 0; bj < 2; ++bj) {
                    const f32x4 v0 = res_lo(res[m][bj]) + 0.5f * acc[ai][bj][m][0], v1 = res_hi(res[m][bj]) + 0.5f * acc[ai][bj][m][1];
                    st16_wt(XB + (size_t)row * D + col0 + bj * HALF, pack8(v0, v1));
                    s += dot4(v0) + dot4(v1);
                }
                s += __shfl_xor(s, 16); s += __shfl_xor(s, 32);
                if (fq == 0) atomicAdd(ssq + row, s);
            }
        }
    }
};
struct EpiProj {
    static constexpr bool PERM = true, HAS_MID = false; static constexpr int MID_T = -1;
    bf16_t* U; float* XL; bf16_t* GG; const float* ssq;
    __device__ __forceinline__ void mid(Acc&, const Unit&, int, int, int, int) const {}
    __device__ __forceinline__ void operator()(const Acc& acc, const Unit& u, int wr, int wc, int fr, int fq) const {
        int row0 = u.pm * BM + wr * 64 + fr, col0 = (u.pn & 3) * BM + wc * 32 + 8 * fq; const int seg = u.pn >> 2; asm volatile("" : "+v"(row0), "+v"(col0));
        float sq[2][4];
#pragma unroll
        for (int ai = 0; ai < 2; ++ai)
#pragma unroll
            for (int m = 0; m < 4; ++m) sq[ai][m] = ssq[row0 + ai * HALF + m * 16];
        asm volatile("" ::: "memory");
#pragma unroll
        for (int ai = 0; ai < 2; ++ai)
#pragma unroll
            for (int m = 0; m < 4; ++m) {
                const int row = row0 + ai * HALF + m * 16;
                const float r = rsqrtf(sq[ai][m] * (1.0f / D) + EPS);
#pragma unroll
                for (int bj = 0; bj < 2; ++bj) {
                    const size_t o = (size_t)row * DH + col0 + bj * HALF;
                    f32x4 v0 = acc[ai][bj][m][0] * r, v1 = acc[ai][bj][m][1] * r;
                    if (seg == 0) { *(u32x4*)(U + o) = pack8(v0, v1); }
                    else if (seg == 1) { *(f32x4*)(XL + o) = v0; *(f32x4*)(XL + o + 4) = v1; }
                    else {
#pragma unroll
                        for (int j = 0; j < 4; ++j) { v0[j] = fgelu(v0[j]); v1[j] = fgelu(v1[j]); }
                        *(u32x4*)(GG + o) = pack8(v0, v1);
                    }
                }
            }
    }
};
struct EpiGlu {
    static constexpr bool PERM = true, HAS_MID = false; static constexpr int MID_T = -1;
    const bf16_t* GS; const float* bias; bf16_t* MRG; float* ssq;
    __device__ __forceinline__ void mid(Acc&, const Unit&, int, int, int, int) const {}
    __device__ __forceinline__ void operator()(const Acc& acc, const Unit& u, int wr, int wc, int fr, int fq) const {
        int row0 = u.pm * BM + wr * 64 + fr, col0 = u.pn * BM + wc * 32 + 8 * fq; asm volatile("" : "+v"(row0), "+v"(col0));
        ResTile gt;
#pragma unroll
        for (int ai = 0; ai < 2; ++ai)
#pragma unroll
            for (int m = 0; m < 4; ++m)
#pragma unroll
                for (int bj = 0; bj < 2; ++bj) gt[ai][m][bj] = *(const u32x4*)(GS + (size_t)(row0 + ai * HALF + m * 16) * DH + col0 + bj * HALF);
        f32x4 bb[2][2];
#pragma unroll
        for (int bj = 0; bj < 2; ++bj) { bb[bj][0] = *(const f32x4*)(bias + col0 + bj * HALF); bb[bj][1] = *(const f32x4*)(bias + col0 + bj * HALF + 4); }
        asm volatile("" ::: "memory");
#pragma unroll
        for (int ai = 0; ai < 2; ++ai)
#pragma unroll
            for (int m = 0; m < 4; ++m) {
                const int row = row0 + ai * HALF + m * 16;
                float s = 0.f;
#pragma unroll
                for (int bj = 0; bj < 2; ++bj) {
                    const f32x4 g0 = res_lo(gt[ai][m][bj]), g1 = res_hi(gt[ai][m][bj]);
                    f32x4 v0, v1;
#pragma unroll
                    for (int j = 0; j < 4; ++j) { v0[j] = g0[j] * fsigmoid(acc[ai][bj][m][0][j] + bb[bj][0][j]); v1[j] = g1[j] * fsigmoid(acc[ai][bj][m][1][j] + bb[bj][1][j]); }
                    st16_wt(MRG + (size_t)row * D + col0 + bj * HALF, pack8(v0, v1));
                    s += dot4(v0) + dot4(v1);
                }
                s += __shfl_xor(s, 16); s += __shfl_xor(s, 32);
                if (fq == 0) atomicAdd(ssq + row, s);
            }
    }
};
struct EpiOut {
    static constexpr bool PERM = true, HAS_MID = true; static constexpr int MID_T = 16;
    const float* ssq_s5; const float* ssq_lru; bf16_t* XB; float* ssq; float* slab;
    __device__ __forceinline__ void mid(Acc& acc, const Unit& u, int wr, int wc, int fr, int fq) const {
        if (u.pm == 32 && slab) return;
        int row0 = u.pm * BM + wr * 64 + fr; asm volatile("" : "+v"(row0));
        float f[2][4];
#pragma unroll
        for (int ai = 0; ai < 2; ++ai)
#pragma unroll
            for (int m = 0; m < 4; ++m) { const int row = row0 + ai * HALF + m * 16; f[ai][m] = rsqrtf(ssq_s5[row] * (1.0f / DH) + EPS) * sqrtf(ssq_lru[row] * (1.0f / DH) + EPS); }
#pragma unroll
        for (int ai = 0; ai < 2; ++ai)
#pragma unroll
            for (int m = 0; m < 4; ++m)
#pragma unroll
                for (int bj = 0; bj < 2; ++bj)
#pragma unroll
                    for (int n = 0; n < 2; ++n) acc[ai][bj][m][n] = acc[ai][bj][m][n] * f[ai][m];
    }
    __device__ __forceinline__ void operator()(const Acc& acc, const Unit& u, int wr, int wc, int fr, int fq) const {
        if (u.pm == 32 && slab) { slab_store(acc, u, slab, wr, wc, fr, fq); return; }
        int row0 = u.pm * BM + wr * 64 + fr, col0 = u.pn * BM + wc * 32 + 8 * fq; asm volatile("" : "+v"(row0), "+v"(col0));
        float rl[2][4];
#pragma unroll
        for (int ai = 0; ai < 2; ++ai)
#pragma unroll
            for (int m = 0; m < 4; ++m) rl[ai][m] = ssq_lru[row0 + ai * HALF + m * 16];
#pragma unroll
        for (int ai = 0; ai < 2; ++ai) {
            ResHalf res; res_load_half(res, XB, row0 + ai * HALF, col0);
#pragma unroll
            for (int m = 0; m < 4; ++m) {
                const int row = row0 + ai * HALF + m * 16;
                const float r = rsqrtf(rl[ai][m] * (1.0f / DH) + EPS);
                float s = 0.f;
#pragma unroll
                for (int bj = 0; bj < 2; ++bj) {
                    const f32x4 v0 = res_lo(res[m][bj]) + r * acc[ai][bj][m][0], v1 = res_hi(res[m][bj]) + r * acc[ai][bj][m][1];
                    st16_wt(XB + (size_t)row * D + col0 + bj * HALF, pack8(v0, v1));
                    s += dot4(v0) + dot4(v1);
                }
                s += __shfl_xor(s, 16); s += __shfl_xor(s, 32);
                if (fq == 0) atomicAdd(ssq + row, s);
            }
        }
    }
};
struct EpiFinal {
    static constexpr bool PERM = true, HAS_MID = false; static constexpr int MID_T = -1;
    bf16_t* XB; float* ssq; float* slab;
    __device__ __forceinline__ void mid(Acc&, const Unit&, int, int, int, int) const {}
    __device__ __forceinline__ void operator()(const Acc& acc, const Unit& u, int wr, int wc, int fr, int fq) const {
        if (u.pm == 32) { slab_store(acc, u, slab, wr, wc, fr, fq); return; }
        int row0 = u.pm * BM + wr * 64 + fr, col0 = u.pn * BM + wc * 32 + 8 * fq; asm volatile("" : "+v"(row0), "+v"(col0));
#pragma unroll
        for (int ai = 0; ai < 2; ++ai) {
            ResHalf res; res_load_half(res, XB, row0 + ai * HALF, col0);
#pragma unroll
            for (int m = 0; m < 4; ++m) {
                const int row = row0 + ai * HALF + m * 16;
                float s = 0.f;
#pragma unroll
                for (int bj = 0; bj < 2; ++bj) {
                    const f32x4 v0 = res_lo(res[m][bj]) + 0.5f * acc[ai][bj][m][0], v1 = res_hi(res[m][bj]) + 0.5f * acc[ai][bj][m][1];
                    st16_wt(XB + (size_t)row * D + col0 + bj * HALF, pack8(v0, v1));
                    s += dot4(v0) + dot4(v1);
                }
                s += __shfl_xor(s, 16); s += __shfl_xor(s, 32);
                if (fq == 0) atomicAdd(ssq + row, s);
            }
        }
    }
};
}

#define XB_TMO      128
#define XB_XCNT(j)  (256  + 64 * (j))
#define XB_XSUB(j)  (1280 + 64 * (j))
#define XB_XGEN(j)  (2304 + 64 * (j))
#define XB_TOP      3328
#define XB_TOPGEN   3392
#define XCD_BAR_WORDS 3456
#define XB_SPIN_CAP (1u << 18)
__device__ __forceinline__ unsigned xb_ld(unsigned* p)              { return __hip_atomic_load(p, __ATOMIC_RELAXED, __HIP_MEMORY_SCOPE_AGENT); }
__device__ __forceinline__ unsigned xb_add(unsigned* p, unsigned v) { return __hip_atomic_fetch_add(p, v, __ATOMIC_RELAXED, __HIP_MEMORY_SCOPE_AGENT); }
__device__ __forceinline__ unsigned xb_xcc_id() { return (unsigned)__builtin_amdgcn_s_getreg((3 << 11) | 20) & 0xFu; }
#define XB_SPIN(cond, bar) do { unsigned _sp = 0; while (cond) { __builtin_amdgcn_s_sleep(1); \
    if ((++_sp & 255u) == 0u) { if (xb_ld(&(bar)[XB_TMO])) break; if (_sp > XB_SPIN_CAP) { atomicAdd(&(bar)[XB_TMO], 1u); break; } } } } while (0)
struct XcdBarrier { unsigned* bar; unsigned x; volatile LAS unsigned* st; };
__device__ __forceinline__ XcdBarrier xcd_barrier_post(unsigned* bar, volatile LAS unsigned* st) {
    XcdBarrier b; b.bar = bar; b.x = xb_xcc_id(); b.st = st;
    if (threadIdx.x == 0) (void)xb_add(&bar[XB_XCNT(b.x)], 1u);
    return b;
}
__device__ __forceinline__ void xcd_barrier_complete(unsigned* bar, unsigned x, unsigned& nloc, unsigned& nx) {
    const unsigned G = gridDim.x * gridDim.y * gridDim.z;
    unsigned sum, cnt, mine, sp = 0u;
    for (;;) {
        sum = 0u; cnt = 0u; mine = 0u;
#pragma unroll
        for (unsigned j = 0; j < 16; ++j) { const unsigned c = xb_ld(&bar[XB_XCNT(j)]); sum += c; cnt += (c > 0u) ? 1u : 0u; mine = (j == x) ? c : mine; }
        if (sum == G) break;
        __builtin_amdgcn_s_sleep(1);
        if ((++sp & 255u) == 0u) { if (xb_ld(&bar[XB_TMO])) break; if (sp > XB_SPIN_CAP) { atomicAdd(&bar[XB_TMO], 1u); break; } }
    }
    nloc = mine > 0u ? mine : 1u; nx = cnt > 0u ? cnt : 1u;
}
__device__ __forceinline__ void xcd_barrier(const XcdBarrier& b) {
    asm volatile("s_waitcnt vmcnt(0)" ::: "memory");
    __syncthreads();
    if (threadIdx.x == 0) {
        unsigned* bar = b.bar;
        __builtin_amdgcn_s_waitcnt(0);
        unsigned nloc = b.st[0], nx = b.st[1];
        if (nloc == 0u) { xcd_barrier_complete(bar, b.x, nloc, nx); b.st[0] = nloc; b.st[1] = nx; }
        const unsigned old = xb_add(&bar[XB_XSUB(b.x)], 1u);
        const unsigned gen = old / nloc;
        if (old + 1u == (gen + 1u) * nloc) {
            __builtin_amdgcn_fence(__ATOMIC_RELEASE, "agent");
            asm volatile("s_waitcnt vmcnt(0)" ::: "memory");
            const unsigned og = xb_add(&bar[XB_TOP], 1u);
            const unsigned tg = og / nx;
            if (og + 1u == (tg + 1u) * nx) xb_add(&bar[XB_TOPGEN], 1u);
            else XB_SPIN(xb_ld(&bar[XB_TOPGEN]) == tg, bar);
            __builtin_amdgcn_fence(__ATOMIC_ACQUIRE, "agent");
            xb_add(&bar[XB_XGEN(b.x)], 1u);
            asm volatile("s_waitcnt vmcnt(0)" ::: "memory");
        } else {
            XB_SPIN(xb_ld(&bar[XB_XGEN(b.x)]) == gen, bar);
            __builtin_amdgcn_fence(__ATOMIC_ACQUIRE, "agent");
            asm volatile("s_waitcnt vmcnt(0)" ::: "memory");
        }
    }
    __syncthreads();
}

enum { I_XP = 0, I_XS, I_S5RE, I_S5IM, I_LRUH, I_LRUCONV, I_GFFN1, I_W1A, I_W3A, I_W2A, I_GMIX, I_WIN, I_LAMRE, I_LAMIM, I_LOGDT, I_BRE, I_BIM, I_CRE, I_CIM,
       I_DSKIP, I_WGLU, I_BGLU, I_CONVW, I_CONVB, I_WA, I_BA, I_WX, I_BX, I_LAML, I_GS5, I_GLRU, I_WOUT, I_GFFN2, I_W1B, I_W3B, I_W2B, I_GFINAL, N_IN };
struct Args { const float* in[N_IN]; float* out; unsigned char* ws; int ph_lo, ph_hi; };
constexpr size_t O_Y = 0, O_PS5RE = (size_t)M * D, O_PS5IM = O_PS5RE + NB * NG * NP, O_PLRUH = O_PS5IM + NB * NG * NP, O_PLRUC = O_PLRUH + NB * DH,
                 O_SS5RE = O_PLRUC + NB * 3 * DH, O_SS5IM = O_SS5RE + (size_t)MS * NG * NP, O_SLRUH = O_SS5IM + (size_t)MS * NG * NP, O_SLRUC = O_SLRUH + (size_t)MS * DH,
                 O_END = O_SLRUC + (size_t)MS * 3 * DH;
static_assert(O_END == 18661376, "output size");

typedef float f32x2 __attribute__((ext_vector_type(2)));
constexpr int STG_PITCH = 144, STG_BYTES = 64 * STG_PITCH;
__device__ __forceinline__ void p0_task(const float* W, int N, const float* gk, bf16_t* WT, int ldt, int k0, int n0, int nd0, LAS unsigned char* stg, int lane) {
    const float* src = W + (size_t)k0 * N + n0 + 2 * lane;
    f32x2 v[64];
#if PROBE_PHASE >= 0
    { const float* p = src; const size_t step = (size_t)N;
#pragma unroll
      for (int i = 0; i < 64; ++i) { v[i] = __builtin_nontemporal_load((const f32x2*)p); p += step; if ((i & 7) == 7) asm volatile("" : "+v"(p)); } }
#else
#pragma unroll
    for (int i = 0; i < 64; ++i) v[i] = __builtin_nontemporal_load((const f32x2*)(src + (size_t)i * N));
#endif
    if (gk) {
#pragma unroll
        for (int i = 0; i < 64; ++i) v[i] = v[i] * gk[k0 + i];
    }
#pragma unroll
    for (int j = 0; j < 2; ++j) {
#pragma unroll
        for (int kb = 0; kb < 8; ++kb) {
            u32x4 o; o.x = cvt_pk_bf16(v[8 * kb][j], v[8 * kb + 1][j]); o.y = cvt_pk_bf16(v[8 * kb + 2][j], v[8 * kb + 3][j]); o.z = cvt_pk_bf16(v[8 * kb + 4][j], v[8 * kb + 5][j]); o.w = cvt_pk_bf16(v[8 * kb + 6][j], v[8 * kb + 7][j]);
            *(LAS u32x4*)(stg + lane * STG_PITCH + kb * 16) = o;
        }
        LDS_WAIT(); asm volatile("" ::: "memory");
#pragma unroll
        for (int it = 0; it < 8; ++it) {
            const int rr = 8 * it + (lane >> 3), kb = lane & 7;
            const u32x4 o = *(const LAS u32x4*)(stg + rr * STG_PITCH + kb * 16);
            *(u32x4*)(WT + (size_t)(nd0 + 2 * rr + j) * ldt + k0 + 8 * kb) = o;
        }
        LDS_WAIT(); asm volatile("" ::: "memory");
    }
}
__device__ __forceinline__ void sincos_d(double x, double& s, double& c) {
    const double k = rint(x * 0.63661977236758134308);
    double r = fma(-k, 1.57079632679489655800, x); r = fma(-k, 6.12323399573676603587e-17, r);
    const double r2 = r * r;
    double sp = -7.6471637318198164759e-13; sp = fma(sp, r2, 1.6059043836821614599e-10); sp = fma(sp, r2, -2.5052108385441718775e-8); sp = fma(sp, r2, 2.7557319223985890653e-6);
    sp = fma(sp, r2, -1.9841269841269841270e-4); sp = fma(sp, r2, 8.3333333333333333333e-3); sp = fma(sp, r2, -1.6666666666666666667e-1);
    const double sr = fma(sp * r2, r, r);
    double cp = 4.7794773323873852974e-14; cp = fma(cp, r2, -1.1470745597729724714e-11); cp = fma(cp, r2, 2.0876756987868098979e-9); cp = fma(cp, r2, -2.7557319223985890653e-7);
    cp = fma(cp, r2, 2.4801587301587301587e-5); cp = fma(cp, r2, -1.3888888888888888889e-3); cp = fma(cp, r2, 4.1666666666666666667e-2); cp = fma(cp, r2, -0.5);
    const double cr = fma(cp, r2, 1.0);
    const int q = ((int)k) & 3;
    s = (q == 0) ? sr : (q == 1) ? cr : (q == 2) ? -sr : -cr;
    c = (q == 0) ? cr : (q == 1) ? -sr : (q == 2) ? -cr : sr;
}
__device__ __forceinline__ void p0_s5_group(const Args& a, LAS unsigned char* lds, int g, int tid) {
    LAS float* LPre = (LAS float*)lds;
    LAS float* LPim = LPre + 17 * 64;
    LAS float* BBre = LPim + 17 * 64;
    LAS float* BBim = BBre + 1024;
    LAS float* CRe = BBim + 1024;
    LAS float* CIm = CRe + 1024;
    LAS float* Kt = CIm + 1024;
    LAS float* Kt2 = Kt + 4096;
    LAS float* QQ = Kt2 + 4096;
    const float ldt = a.in[I_LOGDT][g];
    float lre_[3], lim_[3];
#pragma unroll
    for (int i = 0; i < 3; ++i) { const int idx = tid + 512 * i, p = idx & 63; lre_[i] = a.in[I_LAMRE][g * 64 + p]; lim_[i] = a.in[I_LAMIM][g * 64 + p]; }
    float cr_[2], ci_[2], br_[2], bi_[2];
#pragma unroll
    for (int i = 0; i < 2; ++i) { const int idx = tid + 512 * i; cr_[i] = a.in[I_CRE][(size_t)g * 1024 + idx]; ci_[i] = a.in[I_CIM][(size_t)g * 1024 + idx]; br_[i] = a.in[I_BRE][(size_t)g * 1024 + idx]; bi_[i] = a.in[I_BIM][(size_t)g * 1024 + idx]; }
    const float dsk = a.in[I_DSKIP][g * 16 + (tid & 15)];
    const double dt = exp((double)ldt);
#pragma unroll
    for (int i = 0; i < 3; ++i) {
        const int idx = tid + 512 * i;
        if (idx < 17 * 64) {
            const int k = idx >> 6, p = idx & 63;
            const double lre = (double)lre_[i], lim = (double)lim_[i];
            const double mag = exp(lre * dt * (double)k); double sn, cs; sincos_d(lim * dt * (double)k, sn, cs);
            LPre[idx] = (float)(mag * cs); LPim[idx] = (float)(mag * sn);
            if (k == 1) {
                const double nr = mag * cs - 1.0, ni = mag * sn, den = lre * lre + lim * lim;
                QQ[2 * p] = (float)((nr * lre + ni * lim) / den); QQ[2 * p + 1] = (float)((ni * lre - nr * lim) / den);
            }
        }
    }
#pragma unroll
    for (int i = 0; i < 2; ++i) { const int idx = tid + 512 * i; CRe[idx] = cr_[i]; CIm[idx] = ci_[i]; }
    __syncthreads();
#pragma unroll
    for (int i = 0; i < 2; ++i) { const int idx = tid + 512 * i, p = idx >> 4; const float qr = QQ[2 * p], qi = QQ[2 * p + 1];
        BBre[idx] = qr * br_[i] - qi * bi_[i]; BBim[idx] = qr * bi_[i] + qi * br_[i]; }
    __syncthreads();
    {
        const int c = (tid >> 4) & 15, cp = tid & 15, ph = tid >> 8;
        float acc[16];
#pragma unroll
        for (int k = 0; k < 16; ++k) acc[k] = 0.f;
        for (int pp = 0; pp < 32; ++pp) {
            const int p = 32 * ph + pp;
            const float cr = CRe[c * 64 + p], ci = CIm[c * 64 + p], br = BBre[p * 16 + cp], bi = BBim[p * 16 + cp];
            const float gr = cr * br - ci * bi, gi = cr * bi + ci * br;
#pragma unroll
            for (int k = 0; k < 16; ++k) acc[k] += gr * LPre[k * 64 + p] - gi * LPim[k * 64 + p];
        }
        if (ph == 0 && c == cp) acc[0] += dsk;
        LAS float* dst = ph ? Kt2 : Kt;
#pragma unroll
        for (int k = 0; k < 16; ++k) dst[(k * 16 + c) * 16 + cp] = acc[k];
    }
    __syncthreads();
    bf16_t* Win = (bf16_t*)(a.ws + WS_S5M + (size_t)g * S5M_GROUP_BYTES);
    bf16_t* MW = Win + 128 * 256;
    for (int idx = tid; idx < 256 * 48; idx += NWAVES * 64) {
        const int rr = idx / 48, cg = idx % 48, s = rr >> 4, c = rr & 15;
        float v[8];
        if (cg < 32) { const int sp = cg >> 1, c0 = (cg & 1) * 8;
#pragma unroll
            for (int i = 0; i < 8; ++i) { const int o = (((s - sp) & 15) * 16 + c) * 16 + c0 + i; v[i] = (sp <= s) ? Kt[o] + Kt2[o] : 0.f; }
        } else { const int im = cg >= 40, p0 = (cg - (im ? 40 : 32)) * 8;
#pragma unroll
            for (int i = 0; i < 8; ++i) { const int p = p0 + i; const float cr = CRe[c * 64 + p], ci = CIm[c * 64 + p], lr = LPre[(s + 1) * 64 + p], li = LPim[(s + 1) * 64 + p];
                v[i] = im ? -(cr * li + ci * lr) : (cr * lr - ci * li); }
        }
        u32x4 o; o.x = cvt_pk_bf16(v[0], v[1]); o.y = cvt_pk_bf16(v[2], v[3]); o.z = cvt_pk_bf16(v[4], v[5]); o.w = cvt_pk_bf16(v[6], v[7]);
        *(u32x4*)(MW + (size_t)rr * 384 + cg * 8) = o;
    }
    for (int idx = tid; idx < 128 * 32; idx += NWAVES * 64) {
        const int n = idx >> 5, cg = idx & 31, p = n & 63, im = n >> 6, sp = cg >> 1, c0 = (cg & 1) * 8;
        const float lr = LPre[(15 - sp) * 64 + p], li = LPim[(15 - sp) * 64 + p];
        float v[8];
#pragma unroll
        for (int i = 0; i < 8; ++i) { const float br = BBre[p * 16 + c0 + i], bi = BBim[p * 16 + c0 + i]; v[i] = im ? (lr * bi + li * br) : (lr * br - li * bi); }
        u32x4 o; o.x = cvt_pk_bf16(v[0], v[1]); o.y = cvt_pk_bf16(v[2], v[3]); o.z = cvt_pk_bf16(v[4], v[5]); o.w = cvt_pk_bf16(v[6], v[7]);
        *(u32x4*)(Win + (size_t)n * 256 + cg * 8) = o;
    }
    {
        float* aux = (float*)(a.ws + WS_S5AUX) + (size_t)g * S5AUX_GROUP_FLOATS;
        for (int idx = tid; idx < 64; idx += NWAVES * 64) { aux[idx] = LPre[64 + idx]; aux[64 + idx] = LPim[64 + idx]; aux[128 + idx] = LPre[16 * 64 + idx]; aux[192 + idx] = LPim[16 * 64 + idx]; }
        for (int idx = tid; idx < 1024; idx += NWAVES * 64) { aux[256 + idx] = BBre[idx]; aux[1280 + idx] = BBim[idx]; }
    }
    __syncthreads();
}
__device__ __forceinline__ void conv_tasks(const Args& a, LAS unsigned char* stg, int first, int last, int wv, int nwv, int lane) {
    constexpr int T_W1 = (D / 64) * (FF / 128), T_W2 = (FF / 64) * (D / 128), T_IN = (D / 64) * (DIN / 128), T_GLU = (DH / 64) * (DH / 128), T_OUT = (D / 64) * (D / 128);
    const int cnt[9] = {T_W1, T_W1, T_W2, T_IN, T_GLU, T_OUT, T_W1, T_W1, T_W2};
    int NT = 0;
#pragma unroll
    for (int m = 0; m < 9; ++m) if (m >= first && m <= last) NT += cnt[m];
    const int t_lo = (int)(((long)wv * NT) / nwv), t_hi = (int)(((long)(wv + 1) * NT) / nwv);
    unsigned char* ws = a.ws;
    for (int it = t_lo; it < t_hi; ++it) {
        int r = it, mat = first;
#pragma unroll
        for (int m = 0; m < 9; ++m) if (m >= first && m < last && mat == m && r >= cnt[m]) { r -= cnt[m]; mat = m + 1; }
        const float* W; const float* gk = nullptr; bf16_t* WT; int K, N, dual = 0, off = 0;
        switch (mat) {
            case 0: W = a.in[I_W1A]; gk = a.in[I_GFFN1]; WT = (bf16_t*)(ws + WS_W13A); K = D; N = FF; dual = 1; break;
            case 1: W = a.in[I_W3A]; gk = a.in[I_GFFN1]; WT = (bf16_t*)(ws + WS_W13A); K = D; N = FF; dual = 1; off = 128; break;
            case 2: W = a.in[I_W2A]; WT = (bf16_t*)(ws + WS_W2A); K = FF; N = D; break;
            case 3: W = a.in[I_WIN]; gk = a.in[I_GMIX]; WT = (bf16_t*)(ws + WS_WIN); K = D; N = DIN; break;
            case 4: W = a.in[I_WGLU]; WT = (bf16_t*)(ws + WS_WGLU); K = DH; N = DH; break;
            case 5: W = a.in[I_WOUT]; WT = (bf16_t*)(ws + WS_WOUT); K = D; N = D; dual = 2; break;
            case 6: W = a.in[I_W1B]; gk = a.in[I_GFFN2]; WT = (bf16_t*)(ws + WS_W13B); K = D; N = FF; dual = 1; break;
            case 7: W = a.in[I_W3B]; gk = a.in[I_GFFN2]; WT = (bf16_t*)(ws + WS_W13B); K = D; N = FF; dual = 1; off = 128; break;
            default: W = a.in[I_W2B]; WT = (bf16_t*)(ws + WS_W2B); K = FF; N = D; break;
        }
        const int nkb = K / 64, nb = r / nkb, kb = r % nkb, k0 = kb * 64, n0 = nb * 128;
        if (dual == 2) { gk = k0 < DH ? a.in[I_GS5] : a.in[I_GLRU] - DH; dual = 0; }
        p0_task(W, N, gk, WT, K, k0, n0, dual ? (nb * 256 + off) : n0, stg, lane);
    }
}
__device__ __forceinline__ void p0_prologue(const Args& a, LAS unsigned char* lds, int vcu, int G, int lane, int wave) {
    const int gw = vcu * NWAVES + wave, NGW = G * NWAVES;
    unsigned char* ws = a.ws;
    bf16_t* XB = (bf16_t*)(ws + WS_XB); float* ssq0 = (float*)(ws + WS_CTL + CTL_SSQ_BYTE);
    for (int grp = gw; grp < MPAD / 4; grp += NGW) {
        const int m0 = 4 * grp;
        u32x2* o = (u32x2*)(XB + (size_t)m0 * D) + lane;
        if (m0 < M) {
            const float* xr = m0 < MP ? a.in[I_XP] + (size_t)m0 * D : a.in[I_XS] + (size_t)(m0 - MP) * D;
            const f32x4* x4 = (const f32x4*)xr + lane; f32x4 v[4][8];
#pragma unroll
            for (int r = 0; r < 4; ++r)
#pragma unroll
                for (int j = 0; j < 8; ++j) v[r][j] = __builtin_nontemporal_load(x4 + r * (D / 4) + 64 * j);
#pragma unroll
            for (int r = 0; r < 4; ++r) {
                float s = 0.f;
#pragma unroll
                for (int j = 0; j < 8; ++j) s += dot4(v[r][j]);
                s = wave_sum(s);
#pragma unroll
                for (int j = 0; j < 8; ++j) { u32x2 w; w.x = cvt_pk_bf16(v[r][j][0], v[r][j][1]); w.y = cvt_pk_bf16(v[r][j][2], v[r][j][3]); o[r * (D / 4) + 64 * j] = w; }
                if (lane == 0) ssq0[m0 + r] = s;
            }
        } else {
#pragma unroll
            for (int r = 0; r < 4; ++r)
#pragma unroll
                for (int j = 0; j < 8; ++j) o[r * (D / 4) + 64 * j] = (u32x2){0u, 0u};
        }
    }
    conv_tasks(a, lds + wave * STG_BYTES, 0, 3, gw, NGW, lane);
}

#define MFMA32(a, b, c) __builtin_amdgcn_mfma_f32_32x32x16_bf16((a), (b), (c), 0, 0, 0)
constexpr int S5_PITCH = 528;
constexpr int S5_XC_OFF = 0, S5_Z_OFF = 128 * S5_PITCH;
static_assert(2 * 128 * S5_PITCH <= RING_BYTES, "S5 LDS map");
__device__ __forceinline__ void s5_prompt(const Args& a, LAS unsigned char* lds, int b, int g, int tid, int lane, int wave) {
    const bf16_t* U = (const bf16_t*)(a.ws + WS_U);
    const bf16_t* Win = (const bf16_t*)(a.ws + WS_S5M + (size_t)g * S5M_GROUP_BYTES);
    const bf16_t* MW = Win + 128 * 256;
    bf16_t* GS5 = (bf16_t*)(a.ws + WS_GS5);
    LAS unsigned char* XCs = lds + S5_XC_OFF;
    LAS unsigned char* ZS = lds + S5_Z_OFF;
    const int r32 = lane & 31, hh = lane >> 5;
    {
        u32x4 v[8];
#pragma unroll
        for (int i = 0; i < 8; ++i) { const int q = tid + 512 * i, t = q >> 1, half = q & 1; v[i] = *(const u32x4*)(U + (size_t)(b * SEQ + t) * DH + 16 * g + 8 * half); }
#pragma unroll
        for (int i = 0; i < 8; ++i) { const int q = tid + 512 * i, t = q >> 1, half = q & 1; *(LAS u32x4*)(XCs + (t >> 4) * S5_PITCH + (t & 15) * 32 + 16 * half) = v[i]; }
    }
    {
        const int mt = wave & 3, nt0 = (wave >> 2) * 2;
        const bf16_t* w0 = Win + (size_t)(32 * nt0 + r32) * 256 + 8 * hh;
        bf16x8 bw[2][8];
#pragma unroll
        for (int ks = 0; ks < 8; ++ks) { bw[0][ks] = *(const bf16x8*)(w0 + 16 * ks); bw[1][ks] = *(const bf16x8*)(w0 + 32 * 256 + 16 * ks); }
        __syncthreads();
        f32x16 acc0, acc1;
#pragma unroll
        for (int i = 0; i < 16; ++i) { acc0[i] = 0.f; acc1[i] = 0.f; }
        const LAS unsigned char* xa = XCs + (32 * mt + r32) * S5_PITCH + 16 * hh;
#pragma unroll 1
        for (int kh = 0; kh < 2; ++kh) {
#pragma unroll
            for (int ks = 0; ks < 8; ++ks) { const bf16x8 af = *(const LAS bf16x8*)(xa + 32 * (8 * kh + ks)); acc0 = MFMA32(af, bw[0][ks], acc0); acc1 = MFMA32(af, bw[1][ks], acc1); }
            if (kh == 0) {
#pragma unroll
                for (int ks = 0; ks < 8; ++ks) { bw[0][ks] = *(const bf16x8*)(w0 + 128 + 16 * ks); bw[1][ks] = *(const bf16x8*)(w0 + 32 * 256 + 128 + 16 * ks); }
            }
        }
        LAS float* Z = (LAS float*)ZS;
#pragma unroll
        for (int i = 0; i < 16; ++i) { const int j = 32 * mt + (i & 3) + 8 * (i >> 2) + 4 * hh;
            Z[j * (S5_PITCH / 4) + 32 * nt0 + r32] = acc0[i]; Z[j * (S5_PITCH / 4) + 32 * nt0 + 32 + r32] = acc1[i]; }
    }
    __syncthreads();
    if (wave == 0) {
        const float* aux = (const float*)(a.ws + WS_S5AUX) + (size_t)g * S5AUX_GROUP_FLOATS;
        const float l16r = aux[128 + lane], l16i = aux[192 + lane];
        const LAS float* Z = (const LAS float*)ZS;
        float sr = 0.f, si = 0.f;
        for (int jb = 0; jb < 16; ++jb) {
            float zr[8], zi[8];
#pragma unroll
            for (int i = 0; i < 8; ++i) { zr[i] = Z[(8 * jb + i) * (S5_PITCH / 4) + lane]; zi[i] = Z[(8 * jb + i) * (S5_PITCH / 4) + 64 + lane]; }
            LDS_WAIT();
#pragma unroll
            for (int i = 0; i < 8; ++i) {
                const unsigned w = cvt_pk_bf16(sr, si);
                *(LAS unsigned short*)(ZS + (8 * jb + i) * S5_PITCH + 2 * lane) = (unsigned short)(w & 0xffffu);
                *(LAS unsigned short*)(ZS + (8 * jb + i) * S5_PITCH + 128 + 2 * lane) = (unsigned short)(w >> 16);
                const float nr = l16r * sr - l16i * si + zr[i], ni = l16r * si + l16i * sr + zi[i];
                sr = nr; si = ni;
            }
        }
        a.out[O_PS5RE + (size_t)(b * NG + g) * NP + lane] = sr;
        a.out[O_PS5IM + (size_t)(b * NG + g) * NP + lane] = si;
    }
#pragma unroll 1
    for (int pass = 0; pass < 2; ++pass) {
        const int mt = pass ? 7 - wave : wave, n0 = 2 * pass;
        const int nks = 2 * mt + 2;
        const bf16_t* mw = MW + (size_t)(32 * mt + r32) * 384 + 8 * hh;
        bf16x8 am[24];
#pragma unroll
        for (int ks = 0; ks < 16; ++ks) if (ks < nks) am[ks] = *(const bf16x8*)(mw + 16 * ks);
#pragma unroll
        for (int kq = 0; kq < 8; ++kq) am[16 + kq] = *(const bf16x8*)(mw + 256 + 16 * kq);
        if (pass == 0) __syncthreads();
        f32x16 acc[2];
#pragma unroll
        for (int n = 0; n < 2; ++n)
#pragma unroll
            for (int i = 0; i < 16; ++i) acc[n][i] = 0.f;
#pragma unroll
        for (int ks = 0; ks < 16; ++ks) if (ks < nks) {
#pragma unroll
            for (int n = 0; n < 2; ++n) { const bf16x8 bf = *(const LAS bf16x8*)(XCs + (32 * (n0 + n) + r32) * S5_PITCH + 32 * ks + 16 * hh); acc[n] = MFMA32(am[ks], bf, acc[n]); }
        }
#pragma unroll
        for (int kq = 0; kq < 8; ++kq) {
#pragma unroll
            for (int n = 0; n < 2; ++n) { const bf16x8 bf = *(const LAS bf16x8*)(ZS + (32 * (n0 + n) + r32) * S5_PITCH + 32 * kq + 16 * hh); acc[n] = MFMA32(am[16 + kq], bf, acc[n]); }
        }
#pragma unroll
        for (int n = 0; n < 2; ++n)
#pragma unroll
            for (int q = 0; q < 4; ++q) {
                const int s = 2 * mt + (q >> 1), c0 = 8 * (q & 1) + 4 * hh, t = 16 * (32 * (n0 + n) + r32) + s;
                u32x2 w; w.x = cvt_pk_bf16(fgelu(acc[n][4 * q]), fgelu(acc[n][4 * q + 1])); w.y = cvt_pk_bf16(fgelu(acc[n][4 * q + 2]), fgelu(acc[n][4 * q + 3]));
                *(u32x2*)(GS5 + (size_t)(b * SEQ + t) * DH + 16 * g + c0) = w;
            }
    }
    __syncthreads();
}
__device__ __forceinline__ void s5_sample(const Args& a, LAS unsigned char* lds, int g, int bs0, int tid) {
    const bf16_t* U = (const bf16_t*)(a.ws + WS_U);
    bf16_t* GS5 = (bf16_t*)(a.ws + WS_GS5);
    const float* aux = (const float*)(a.ws + WS_S5AUX) + (size_t)g * S5AUX_GROUP_FLOATS;
    LAS float* HR = (LAS float*)lds;
    LAS float* HI = HR + 2048;
    LAS float* UU = HI + 2048;
    LAS float* CR = UU + 512;
    LAS float* CI = CR + 1024;
    LAS float* BR = CI + 1024;
    LAS float* BI = BR + 1024;
    const int bl0 = tid >> 4, c0 = tid & 15;
    const unsigned short uraw = U[(size_t)(MP + bs0 + bl0) * DH + 16 * g + c0];
    float cr_[2], ci_[2], br_[2], bi_[2], h0r[4], h0i[4];
#pragma unroll
    for (int i = 0; i < 2; ++i) { const int idx = tid + 512 * i; cr_[i] = a.in[I_CRE][(size_t)g * 1024 + idx]; ci_[i] = a.in[I_CIM][(size_t)g * 1024 + idx]; br_[i] = aux[256 + idx]; bi_[i] = aux[1280 + idx]; }
#pragma unroll
    for (int i = 0; i < 4; ++i) { const int idx = tid + 512 * i, bl = idx >> 6, p = idx & 63; const size_t so = (size_t)((bs0 + bl) * NG + g) * NP + p; h0r[i] = a.in[I_S5RE][so]; h0i[i] = a.in[I_S5IM][so]; }
    const float lr = aux[tid & 63], li = aux[64 + (tid & 63)];
    const float dsk = a.in[I_DSKIP][g * 16 + c0];
    UU[tid] = __uint_as_float((unsigned)uraw << 16);
#pragma unroll
    for (int i = 0; i < 2; ++i) { const int idx = tid + 512 * i; CR[idx] = cr_[i]; CI[idx] = ci_[i]; BR[idx] = br_[i]; BI[idx] = bi_[i]; }
    __syncthreads();
#pragma unroll
    for (int i = 0; i < 4; ++i) {
        const int idx = tid + 512 * i, bl = idx >> 6, p = idx & 63;
        float hr = lr * h0r[i] - li * h0i[i], hi = lr * h0i[i] + li * h0r[i];
#pragma unroll
        for (int q = 0; q < 4; ++q) { const f32x4 br = *(const LAS f32x4*)(BR + p * 16 + 4 * q), bi = *(const LAS f32x4*)(BI + p * 16 + 4 * q); const f32x4 u4 = *(const LAS f32x4*)(UU + bl * 16 + 4 * q);
#pragma unroll
            for (int j = 0; j < 4; ++j) { hr += br[j] * u4[j]; hi += bi[j] * u4[j]; } }
        const size_t so = (size_t)((bs0 + bl) * NG + g) * NP + p;
        a.out[O_SS5RE + so] = hr; a.out[O_SS5IM + so] = hi;
        HR[idx] = hr; HI[idx] = hi;
    }
    __syncthreads();
    {
        float y = 0.f;
#pragma unroll 16
        for (int p = 0; p < 64; ++p) y += CR[c0 * 64 + p] * HR[bl0 * 64 + p] - CI[c0 * 64 + p] * HI[bl0 * 64 + p];
        y += dsk * UU[tid];
        const float gv = fgelu(y); const unsigned w = cvt_pk_bf16(gv, gv);
        GS5[(size_t)(MP + bs0 + bl0) * DH + 16 * g + c0] = (bf16_t)(w & 0xffffu);
    }
    __syncthreads();
}

constexpr int XC_PITCH = 144;
__device__ __forceinline__ void lru_item(const Args& a, LAS unsigned char* lds, bool sample, int b, int head, int q, int tid, int lane, int wave) {
    const float* XL = (const float*)(a.ws + WS_XLRU);
    const bf16_t* GG = (const bf16_t*)(a.ws + WS_GG);
    bf16_t* MRG = (bf16_t*)(a.ws + WS_MRG);
    float* ssq_lru = (float*)(a.ws + WS_CTL + CTL_SSQ_BYTE) + 3 * MPAD;
    LAS unsigned char* XC = lds;
    LAS float* XCF = (LAS float*)(lds + 36864);
    LAS float* AA = XCF + 4096;
    LAS float* BX = AA + 4096;
    LAS float* SEGP = BX + 4096;
    LAS float* SEGH = SEGP + 512;
    LAS float* CAR = SEGH + 512;
    const int ch0 = 64 * head + 16 * q;
    const int fr = lane & 15, fq = lane >> 4;
    bf16x8 Bf[2][2];
#pragma unroll
    for (int mat = 0; mat < 2; ++mat)
#pragma unroll
        for (int ks = 0; ks < 2; ++ks) {
            const float* w = (mat ? a.in[I_WX] : a.in[I_WA]) + ((size_t)(head * 64 + 32 * ks + 8 * fq)) * 64 + 16 * q + fr;
            u32x4 p; p.x = cvt_pk_bf16(w[0], w[64]); p.y = cvt_pk_bf16(w[128], w[192]); p.z = cvt_pk_bf16(w[256], w[320]); p.w = cvt_pk_bf16(w[384], w[448]);
            Bf[mat][ks] = __builtin_bit_cast(bf16x8, p);
        }
    const int chn = ch0 + fr;
    const float ba = a.in[I_BA][chn], bx_ = a.in[I_BX][chn];
    const float spl = log1pf(expf(-a.in[I_LAML][chn]));
    const int cq = tid & 15, cch = 64 * head + 4 * cq, rg = tid >> 4;
    const f32x4 cw0 = *(const f32x4*)(a.in[I_CONVW] + cch), cw1 = *(const f32x4*)(a.in[I_CONVW] + DH + cch), cw2 = *(const f32x4*)(a.in[I_CONVW] + 2 * DH + cch),
                cw3 = *(const f32x4*)(a.in[I_CONVW] + 3 * DH + cch), cb = *(const f32x4*)(a.in[I_CONVB] + cch);
    const int er = tid >> 1, eh = tid & 1;
    if (!sample) {
        float hcar = 0.f;
        f32x4 xin[11]; u32x4 ggn;
        { const int R0 = b * SEQ, r0 = rg * 8;
#pragma unroll
          for (int i = 0; i < 11; ++i) { const int t = r0 + i - 3; xin[i] = (t >= 0) ? *(const f32x4*)(XL + (size_t)(R0 + t) * DH + cch) : (f32x4){0.f, 0.f, 0.f, 0.f}; }
          ggn = *(const u32x4*)(GG + (size_t)(R0 + er) * DH + ch0 + 8 * eh); }
        for (int chk = 0; chk < 8; ++chk) {
            const int R0 = b * SEQ + chk * 256, r0 = rg * 8;
#pragma unroll
            for (int rr = 0; rr < 8; ++rr) {
                const f32x4 xc = cb + cw0 * xin[rr] + cw1 * xin[rr + 1] + cw2 * xin[rr + 2] + cw3 * xin[rr + 3];
                u32x2 w; w.x = cvt_pk_bf16(xc[0], xc[1]); w.y = cvt_pk_bf16(xc[2], xc[3]);
                *(LAS u32x2*)(XC + (r0 + rr) * XC_PITCH + 8 * cq) = w;
                if ((cq >> 2) == q) *(LAS f32x4*)(XCF + (r0 + rr) * 16 + 4 * (cq & 3)) = xc;
            }
            const u32x4 gw = ggn;
            if (chk < 7) {
                const float* p = XL + (size_t)(R0 + 256 + r0 - 3) * DH + cch;
#pragma unroll
                for (int i = 0; i < 11; ++i) xin[i] = *(const f32x4*)(p + (size_t)i * DH);
                ggn = *(const u32x4*)(GG + (size_t)(R0 + 256 + er) * DH + ch0 + 8 * eh);
            }
            __syncthreads();
#pragma unroll
            for (int tt = 0; tt < 2; ++tt) {
                const int tile = 2 * wave + tt;
                f32x4 ar = (f32x4){0.f, 0.f, 0.f, 0.f}, ax = ar;
#pragma unroll
                for (int ks = 0; ks < 2; ++ks) {
                    const bf16x8 af = *(const LAS bf16x8*)(XC + (16 * tile + fr) * XC_PITCH + 64 * ks + 16 * fq);
                    ar = __builtin_amdgcn_mfma_f32_16x16x32_bf16(af, Bf[0][ks], ar, 0, 0, 0);
                    ax = __builtin_amdgcn_mfma_f32_16x16x32_bf16(af, Bf[1][ks], ax, 0, 0, 0);
                }
#pragma unroll
                for (int r4 = 0; r4 < 4; ++r4) {
                    const int rr = 16 * tile + 4 * fq + r4;
                    const float xcv = XCF[rr * 16 + fr];
                    const float rg_ = fsigmoid(ar[r4] + ba), ig = fsigmoid(ax[r4] + bx_);
                    const float la = -8.0f * rg_ * spl;
                    const float av = fexp(la); AA[rr * 16 + fr] = av; BX[rr * 16 + fr] = __builtin_amdgcn_sqrtf(fmaxf(fmaf(-av, av, 1.0f), 0.f)) * (ig * xcv);
                }
            }
            __syncthreads();
            const int sn = tid & 15, sg = tid >> 4;
            float av[8], bv[8];
            { float P = 1.f, h = 0.f;
#pragma unroll
              for (int i = 0; i < 8; ++i) { av[i] = AA[(8 * sg + i) * 16 + sn]; bv[i] = BX[(8 * sg + i) * 16 + sn]; }
#pragma unroll
              for (int i = 0; i < 8; ++i) { h = av[i] * h + bv[i]; P *= av[i]; }
              SEGP[tid] = P; SEGH[tid] = h; }
            __syncthreads();
            if (wave == 0 && lane < 16) {
                float run = hcar;
#pragma unroll 8
                for (int s2 = 0; s2 < 32; ++s2) { CAR[s2 * 16 + lane] = run; run = SEGP[s2 * 16 + lane] * run + SEGH[s2 * 16 + lane]; }
                hcar = run;
            }
            __syncthreads();
            { float h = CAR[tid];
#pragma unroll
              for (int i = 0; i < 8; ++i) { h = av[i] * h + bv[i]; BX[(8 * sg + i) * 16 + sn] = h; } }
            __syncthreads();
            {
                const size_t row = (size_t)R0 + er;
                const f32x4 h0 = *(const LAS f32x4*)(BX + er * 16 + 8 * eh), h1 = *(const LAS f32x4*)(BX + er * 16 + 8 * eh + 4);
                const f32x4 y0 = (f32x4){h0[0] * bf_lo(gw.x), h0[1] * bf_hi(gw.x), h0[2] * bf_lo(gw.y), h0[3] * bf_hi(gw.y)};
                const f32x4 y1 = (f32x4){h1[0] * bf_lo(gw.z), h1[1] * bf_hi(gw.z), h1[2] * bf_lo(gw.w), h1[3] * bf_hi(gw.w)};
                *(u32x4*)(MRG + row * D + DH + ch0 + 8 * eh) = pack8(y0, y1);
                float s = dot4(y0) + dot4(y1);
                s += __shfl_xor(s, 1);
                if (eh == 0) atomicAdd(ssq_lru + row, s);
            }
        }
        if (wave == 0 && lane < 16) a.out[O_PLRUH + (size_t)b * DH + ch0 + lane] = hcar;
        if (wave == 1 && lane < 48) { const int k = lane >> 4, n = lane & 15;
            a.out[O_PLRUC + ((size_t)b * 3 + k) * DH + ch0 + n] = XL[(size_t)(b * SEQ + SEQ - 3 + k) * DH + ch0 + n]; }
    } else {
        const int R0 = MP, bs0 = 32 * b;
        {
            const float* cbuf = a.in[I_LRUCONV];
            const int bs = bs0 + rg;
            const f32x4 x0 = *(const f32x4*)(XL + (size_t)(R0 + bs) * DH + cch);
            const f32x4 c0 = *(const f32x4*)(cbuf + ((size_t)bs * 3 + 0) * DH + cch), c1 = *(const f32x4*)(cbuf + ((size_t)bs * 3 + 1) * DH + cch), c2 = *(const f32x4*)(cbuf + ((size_t)bs * 3 + 2) * DH + cch);
            const f32x4 xc = cb + cw0 * c0 + cw1 * c1 + cw2 * c2 + cw3 * x0;
            u32x2 w; w.x = cvt_pk_bf16(xc[0], xc[1]); w.y = cvt_pk_bf16(xc[2], xc[3]);
            *(LAS u32x2*)(XC + rg * XC_PITCH + 8 * cq) = w;
            if ((cq >> 2) == q) {
                *(LAS f32x4*)(XCF + rg * 16 + 4 * (cq & 3)) = xc;
                float* oc = a.out + O_SLRUC + (size_t)bs * 3 * DH + cch;
                *(f32x4*)oc = c1; *(f32x4*)(oc + DH) = c2; *(f32x4*)(oc + 2 * DH) = x0;
            }
        }
        __syncthreads();
        if (wave < 2) {
            const int tile = wave;
            f32x4 ar = (f32x4){0.f, 0.f, 0.f, 0.f}, ax = ar;
#pragma unroll
            for (int ks = 0; ks < 2; ++ks) {
                const bf16x8 af = *(const LAS bf16x8*)(XC + (16 * tile + fr) * XC_PITCH + 64 * ks + 16 * fq);
                ar = __builtin_amdgcn_mfma_f32_16x16x32_bf16(af, Bf[0][ks], ar, 0, 0, 0);
                ax = __builtin_amdgcn_mfma_f32_16x16x32_bf16(af, Bf[1][ks], ax, 0, 0, 0);
            }
#pragma unroll
            for (int r4 = 0; r4 < 4; ++r4) {
                const int rl = 16 * tile + 4 * fq + r4, bs = bs0 + rl;
                const float xcv = XCF[rl * 16 + fr];
                const float rg_ = fsigmoid(ar[r4] + ba), ig = fsigmoid(ax[r4] + bx_);
                const float la = -8.0f * rg_ * spl;
                const float av = fexp(la); const float h = av * a.in[I_LRUH][(size_t)bs * DH + chn] + __builtin_amdgcn_sqrtf(fmaxf(fmaf(-av, av, 1.0f), 0.f)) * (ig * xcv);
                BX[rl * 16 + fr] = h; a.out[O_SLRUH + (size_t)bs * DH + chn] = h;
            }
        }
        __syncthreads();
        if (er < 32) {
            const size_t row = (size_t)R0 + bs0 + er;
            const u32x4 gw = *(const u32x4*)(GG + row * DH + ch0 + 8 * eh);
            const f32x4 h0 = *(const LAS f32x4*)(BX + er * 16 + 8 * eh), h1 = *(const LAS f32x4*)(BX + er * 16 + 8 * eh + 4);
            const f32x4 y0 = (f32x4){h0[0] * bf_lo(gw.x), h0[1] * bf_hi(gw.x), h0[2] * bf_lo(gw.y), h0[3] * bf_hi(gw.y)};
            const f32x4 y1 = (f32x4){h1[0] * bf_lo(gw.z), h1[1] * bf_hi(gw.z), h1[2] * bf_lo(gw.w), h1[3] * bf_hi(gw.w)};
            *(u32x4*)(MRG + row * D + DH + ch0 + 8 * eh) = pack8(y0, y1);
            float s = dot4(y0) + dot4(y1);
            s += __shfl_xor(s, 1);
            if (eh == 0) atomicAdd(ssq_lru + row, s);
        }
    }
    __syncthreads();
}

__global__ void __launch_bounds__(NWAVES * 64, 2) hymba_fwd(Args args) {
    extern __shared__ __attribute__((aligned(16))) unsigned char lds_raw[];
    LAS unsigned char* lds = (LAS unsigned char*)lds_raw;
    volatile LAS unsigned* MISC = (volatile LAS unsigned*)(lds + MISC_OFF);
    const int tid = threadIdx.x, lane = tid & 63, wave = __builtin_amdgcn_readfirstlane(tid >> 6);
    const int G = gridDim.x, bx = blockIdx.x;
    const int vcu = (G % 8 == 0) ? (bx % 8) * (G / 8) + bx / 8 : bx;
    unsigned char* ws = args.ws;
    unsigned* ctl = (unsigned*)(ws + WS_CTL);
    for (int u = tid; u < (LDS_BYTES - LDSCTL_OFF) / 4; u += NWAVES * 64) ((LAS unsigned*)(lds + LDSCTL_OFF))[u] = 0u;
    __syncthreads();
    XcdBarrier bar; bar.bar = ctl + CW_BAR; bar.x = 0; bar.st = nullptr;
    if (MK_N_LAUNCHES == 1) bar = xcd_barrier_post(ctl + CW_BAR, MISC + 8);
#define GRID_BAR() do { if (MK_N_LAUNCHES == 1) xcd_barrier(bar); } while (0)
#define STAMP(k) do { if (PROBE_PHASE >= 0 && bx == 0 && tid == 0) { const unsigned long long now_ = __builtin_amdgcn_s_memrealtime(); \
        const unsigned long long prev_ = ((unsigned long long)MISC[17] << 32) | MISC[16]; if ((k) == PROBE_PHASE) { const unsigned long long d_ = now_ - prev_; MISC[18] = (unsigned)d_; } \
        MISC[16] = (unsigned)now_; MISC[17] = (unsigned)(now_ >> 32); } } while (0)
    STAMP(-1);
    const int lo = args.ph_lo, hi = args.ph_hi;
#define IN(k) (lo <= (k) && (k) < hi)
#define BOTH(k) (IN(k) && IN((k) + 1))
    float* ssq = (float*)(ws + WS_CTL + CTL_SSQ_BYTE);
    float *ssq0 = ssq, *ssq1 = ssq + MPAD, *ssq_s5 = ssq + 2 * MPAD, *ssq_lru = ssq + 3 * MPAD, *ssq2 = ssq + 4 * MPAD, *ssq3 = ssq + 5 * MPAD;
    bf16_t* XB = (bf16_t*)(ws + WS_XB); float* X1 = (float*)(ws + WS_X1); bf16_t* HID = (bf16_t*)(ws + WS_H);
    bf16_t* U = (bf16_t*)(ws + WS_U); float* XL = (float*)(ws + WS_XLRU); bf16_t* GG = (bf16_t*)(ws + WS_GG); bf16_t* MRG = (bf16_t*)(ws + WS_MRG);
    float* SLAB = (float*)(ws + WS_SLAB); float* SLAB5 = (float*)(ws + WS_U);
    const int gws = wave * G + bx;

    unsigned* cnt_fin2 = ctl + CW_CNT; unsigned* cnt_fin5 = ctl + CW_CNT + 64;
#define PUBLISH(cnt) do { asm volatile("s_waitcnt vmcnt(0)" ::: "memory"); __builtin_amdgcn_fence(__ATOMIC_RELEASE, "agent"); asm volatile("s_waitcnt vmcnt(0)" ::: "memory"); \
        if (lane == 0) __hip_atomic_fetch_add((cnt), 1u, __ATOMIC_RELAXED, __HIP_MEMORY_SCOPE_AGENT); } while (0)

    if (IN(0)) { p0_prologue(args, lds, vcu, G, lane, wave); if (BOTH(0)) GRID_BAR(); STAMP(0); }
    if (IN(1)) {
        constexpr int GG1 = 242;
        if (bx < GG1) {
            pg8::Gemm g{XB, (const bf16_t*)(ws + WS_W13A), D, D}; pg8::PanelOrder S; S.init(2 * FF / 256, D / 64, D / 64, GG1, bx);
            pg8::EpiSwiGLU E{HID, ssq0};
            pg8::gemm_phase(lds, g, S, E);
        } else {
            for (int gj = bx - GG1; gj < NG; gj += G - GG1) p0_s5_group(args, lds, gj, tid);
        }
        if (BOTH(1)) GRID_BAR();
        STAMP(1);
    }
    if (IN(2)) {
        pg8::Gemm g{HID, (const bf16_t*)(ws + WS_W2A), FF, FF}; pg8::PanelOrder S; S.init(D / 256, FF / 64, 8, G, bx);
        pg8::EpiResid E{SLAB, XB, ssq1};
        pg8::gemm_phase(lds, g, S, E);
        if (bx >= 88) conv_tasks(args, lds + wave * STG_BYTES, 4, 5, (bx - 88) * NWAVES + wave, (G - 88) * NWAVES, lane);
        if (BOTH(2)) GRID_BAR();
        STAMP(2);
    }
    if (IN(3)) {
        constexpr int GG3 = 198;
        { const int r = (bx >= GG3 && wave < 3) ? (bx - GG3) + (G - GG3) * wave : MS;
          if (r < MS) {
            const int row = MP + r;
            const f32x4* xr = (const f32x4*)(args.in[I_XS] + (size_t)r * D) + lane; f32x4 v[8]; float sq = 0.f;
#pragma unroll
            for (int j = 0; j < 8; ++j) { f32x4 t = (f32x4){0.f, 0.f, 0.f, 0.f};
#pragma unroll
                for (int sl = 0; sl < 11; ++sl) t += ((const f32x4*)(SLAB + ((size_t)sl * MS + r) * D) + lane)[64 * j];
                v[j] = xr[64 * j] + 0.5f * t; sq += dot4(v[j]); }
            sq = wave_sum(sq);
#pragma unroll
            for (int j = 0; j < 8; ++j) { ((f32x4*)(X1 + (size_t)row * D) + lane)[64 * j] = v[j];
                u32x2 w; w.x = cvt_pk_bf16(v[j][0], v[j][1]); w.y = cvt_pk_bf16(v[j][2], v[j][3]); ((u32x2*)(XB + (size_t)row * D) + lane)[64 * j] = w; }
            if (lane == 0) ssq1[row] = sq;
            PUBLISH(cnt_fin2);
          } }
        if (bx < GG3) {
            pg8::Gemm g{XB, (const bf16_t*)(ws + WS_WIN), D, D}; pg8::PanelOrder S; S.init(DIN / 256, D / 64, D / 64, GG3, bx); S.ready = cnt_fin2; S.need = MS;
            pg8::EpiProj E{U, XL, GG, ssq1};
            pg8::gemm_phase(lds, g, S, E);
        } else conv_tasks(args, lds + wave * STG_BYTES, 6, 7, (bx - GG3) * NWAVES + wave, (G - GG3) * NWAVES, lane);
        if (BOTH(3)) GRID_BAR();
        STAMP(3);
    }
    if (IN(4)) {
        { bf16_t* GS5 = (bf16_t*)(ws + WS_GS5); const int gw = bx * NWAVES + wave, NGW = G * NWAVES;
          for (int m = M + gw; m < MPAD; m += NGW) {
              ((u32x4*)(GS5 + (size_t)m * DH))[lane] = (u32x4){0u, 0u, 0u, 0u}; ((u32x4*)(GS5 + (size_t)m * DH))[64 + lane] = (u32x4){0u, 0u, 0u, 0u};
              ((u32x4*)(MRG + (size_t)m * D + DH))[lane] = (u32x4){0u, 0u, 0u, 0u}; ((u32x4*)(MRG + (size_t)m * D + DH))[64 + lane] = (u32x4){0u, 0u, 0u, 0u}; } }
        for (int it = bx; it < NB * NG; it += G) { const int b = it >> 6, g = ((it & 7) << 3) | ((it >> 3) & 7); s5_prompt(args, lds, b, g, tid, lane, wave); }
        STAMP(20);
        for (int it = bx; it < 4 * NG; it += G) s5_sample(args, lds, it >> 2, 32 * (it & 3), tid);
        STAMP(21);
        for (int it = bx; it < NB * 64; it += G) lru_item(args, lds, false, it >> 6, ((it & 7) << 1) | ((it >> 5) & 1), (it >> 3) & 3, tid, lane, wave);
        STAMP(22);
        if (BOTH(4)) GRID_BAR();
        STAMP(4);
    }
    if (IN(5)) {
        pg8::Gemm g{(const bf16_t*)(ws + WS_GS5), (const bf16_t*)(ws + WS_WGLU), DH, DH}; pg8::PanelOrder S; S.init(DH / 256, DH / 64, DH / 64, G, bx);
        pg8::EpiGlu E{(const bf16_t*)(ws + WS_GS5), args.in[I_BGLU], MRG, ssq_s5};
        pg8::gemm_phase(lds, g, S, E);
        if (bx >= 132) for (int it = bx - 132; it < 256; it += G - 132) lru_item(args, lds, true, it & 3, it >> 4, (it >> 2) & 3, tid, lane, wave);
        if (BOTH(5)) GRID_BAR();
        STAMP(5);
    }
    if (IN(6)) {
        pg8::Gemm g{MRG, (const bf16_t*)(ws + WS_WOUT), D, D}; pg8::PanelOrder S; S.init(D / 256, D / 64, D / 64, G, bx); S.nExtra = 0;
        pg8::EpiOut E{ssq_s5, ssq_lru, XB, ssq2, nullptr};
        pg8::gemm_phase(lds, g, S, E);
        if (BOTH(6)) GRID_BAR();
        STAMP(6);
    }
    if (IN(7)) {
        constexpr int GG7 = 242;
        if (bx >= GG7) {
            pg8::Gemm g{MRG, (const bf16_t*)(ws + WS_WOUT), D, D}; pg8::PanelOrder S; S.init(D / 256, D / 64, D / 64, 8, bx - GG7); S.nwgP = 0;
            pg8::EpiOut E{ssq_s5, ssq_lru, XB, ssq2, nullptr};
            pg8::gemm_phase(lds, g, S, E);
            if (bx - GG7 < 8) { asm volatile("s_waitcnt vmcnt(0)" ::: "memory"); __syncthreads();
                if (tid == 0) { __builtin_amdgcn_fence(__ATOMIC_RELEASE, "agent"); asm volatile("s_waitcnt vmcnt(0)" ::: "memory"); __hip_atomic_fetch_add(cnt_fin5, 1u, __ATOMIC_RELAXED, __HIP_MEMORY_SCOPE_AGENT); } }
        }
        if (bx < GG7) {
            pg8::Gemm g{XB, (const bf16_t*)(ws + WS_W13B), D, D}; pg8::PanelOrder S; S.init(2 * FF / 256, D / 64, D / 64, GG7, bx); S.ready = cnt_fin5; S.need = 8;
            pg8::EpiSwiGLU E{HID, ssq2};
            pg8::gemm_phase(lds, g, S, E);
        } else conv_tasks(args, lds + wave * STG_BYTES, 8, 8, (bx - GG7) * NWAVES + wave, (G - GG7) * NWAVES, lane);
        if (BOTH(7)) GRID_BAR();
        STAMP(7);
    }
    if (IN(8)) {
        pg8::Gemm g{HID, (const bf16_t*)(ws + WS_W2B), FF, FF}; pg8::PanelOrder S; S.init(D / 256, FF / 64, 8, G, bx);
        pg8::EpiFinal E{XB, ssq3, SLAB};
        pg8::gemm_phase(lds, g, S, E);
        if (BOTH(8)) GRID_BAR();
        STAMP(8);
    }
    if (IN(9)) {
        const f32x4* gf = (const f32x4*)args.in[I_GFINAL] + lane;
        if (gws < MS) {
            const int row = MP + gws; f32x4 v[8]; float sq = 0.f;
#pragma unroll
            for (int j = 0; j < 8; ++j) { f32x4 t = (f32x4){0.f, 0.f, 0.f, 0.f};
#pragma unroll
                for (int sl = 0; sl < 11; ++sl) t += ((const f32x4*)(SLAB + ((size_t)sl * MS + gws) * D) + lane)[64 * j];
                const u32x2 xw = ((const u32x2*)(XB + (size_t)row * D) + lane)[64 * j];
                v[j] = (f32x4){bf_lo(xw.x), bf_hi(xw.x), bf_lo(xw.y), bf_hi(xw.y)} + 0.5f * t; sq += dot4(v[j]); }
            const float r = rsqrtf(wave_sum(sq) * (1.0f / D) + EPS);
#pragma unroll
            for (int j = 0; j < 8; ++j) ((f32x4*)(args.out + (size_t)row * D) + lane)[64 * j] = v[j] * gf[64 * j] * r;
        }
        const int gw = bx * NWAVES + wave, NGW = G * NWAVES;
        for (int m = gw; m < MP; m += NGW) {
            const float r = rsqrtf(ssq3[m] * (1.0f / D) + EPS);
            const u32x4* xb = (const u32x4*)(XB + (size_t)m * D) + lane;
            f32x4* o = (f32x4*)(args.out + (size_t)m * D) + 2 * lane;
            const f32x4* g2 = (const f32x4*)args.in[I_GFINAL] + 2 * lane;
            u32x4 w[4];
#pragma unroll
            for (int j = 0; j < 4; ++j) w[j] = xb[64 * j];
#pragma unroll
            for (int j = 0; j < 4; ++j) { o[128 * j] = pg8::res_lo(w[j]) * g2[128 * j] * r; o[128 * j + 1] = pg8::res_hi(w[j]) * g2[128 * j + 1] * r; }
        }
    }
    if (PROBE_PHASE >= 0 && bx == 0 && tid == 0) {
        STAMP(9);
        const unsigned long long t0_ = __builtin_amdgcn_s_memrealtime(), d_ = 4ull * MISC[18];
        while (__builtin_amdgcn_s_memrealtime() - t0_ < d_) __builtin_amdgcn_s_sleep(8);
    }
#undef IN
#undef BOTH
#undef GRID_BAR
}

extern "C" void kernel_launch(void* const* d_in, const int* in_sizes, int n_in, void* d_out, int out_size, void* d_ws, size_t ws_size, hipStream_t stream) {
    static int grid = 0;
    if (grid == 0) {
        if (n_in != N_IN || in_sizes[0] != MP * D || (size_t)out_size != O_END || ws_size < WS_END) {
            fprintf(stderr, "kernel_launch: unexpected problem: n_in %d in0 %d out %d ws %zu (need %zu)\n", n_in, n_in > 0 ? in_sizes[0] : -1, out_size, ws_size, (size_t)WS_END); grid = -1; return; }
        int dev = 0, cus = 0;
        if (hipGetDevice(&dev) != hipSuccess || hipDeviceGetAttribute(&cus, hipDeviceAttributeMultiprocessorCount, dev) != hipSuccess) { grid = -1; return; }
        if (hipFuncSetAttribute((const void*)hymba_fwd, hipFuncAttributeMaxDynamicSharedMemorySize, LDS_BYTES) != hipSuccess) { fprintf(stderr, "kernel_launch: hipFuncSetAttribute failed\n"); grid = -1; return; }
        int per_cu = 0;
        if (hipOccupancyMaxActiveBlocksPerMultiprocessor(&per_cu, (const void*)hymba_fwd, NWAVES * 64, LDS_BYTES) != hipSuccess || per_cu < 1)
            fprintf(stderr, "kernel_launch: note: occupancy query reports %d workgroups per CU\n", per_cu);
        (void)hipGetLastError();
        grid = cus;
    }
    if (grid < 0) return;
    if (hipMemsetAsync((char*)d_ws + WS_CTL, 0, CTL_ZERO_BYTES, stream) != hipSuccess) { fprintf(stderr, "kernel_launch: memset failed\n"); return; }
    Args a{};
    for (int i = 0; i < N_IN; ++i) a.in[i] = (const float*)d_in[i];
    a.out = (float*)d_out; a.ws = (unsigned char*)d_ws;
    if (MK_N_LAUNCHES == 1) {
        a.ph_lo = 0; a.ph_hi = NPHASE;
        hipLaunchKernelGGL(hymba_fwd, dim3(grid), dim3(NWAVES * 64), LDS_BYTES, stream, a);
    } else {
        for (int p = 0; p < NPHASE; ++p) { a.ph_lo = p; a.ph_hi = p + 1; hipLaunchKernelGGL(hymba_fwd, dim3(grid), dim3(NWAVES * 64), LDS_BYTES, stream, a); }
    }
}
```

```cpp
#include <hip/hip_runtime.h>
#include <cstdio>
#include <cstdint>

#define LAS __attribute__((address_space(3)))
#define GAS __attribute__((address_space(1)))
typedef unsigned short bf16_t;
typedef short bf16x8 __attribute__((ext_vector_type(8)));
typedef float f32x4 __attribute__((ext_vector_type(4)));
typedef float f32x16 __attribute__((ext_vector_type(16)));
typedef unsigned u32x4 __attribute__((ext_vector_type(4)));
typedef unsigned u32x2 __attribute__((ext_vector_type(2)));

#ifndef PROBE_PHASE
#define PROBE_PHASE -1
#endif
#ifndef MK_N_LAUNCHES
#define MK_N_LAUNCHES 1
#endif

constexpr int D = 2048, FF = 5632, DIN = 3072, DH = 1024;
constexpr int MP = 8192, MS = 128, M = MP + MS, MPAD = 8448;
constexpr int SEQ = 2048, NB = 4, NG = 64, NP = 64, GS = 16;
constexpr float EPS = 1e-6f;
constexpr int NPHASE = 10;
constexpr int NMP = MP / 256;
constexpr int NWAVES = 8;

constexpr size_t MiB = 1u << 20;
constexpr size_t WS_CTL = 0, CTL_ZERO_BYTES = 1 * MiB;
constexpr size_t WS_W13A = 1 * MiB, WS_W2A = 45 * MiB, WS_WIN = 67 * MiB, WS_WGLU = 79 * MiB, WS_WOUT = 81 * MiB, WS_W13B = 89 * MiB, WS_W2B = 133 * MiB;
constexpr size_t WS_S5M = 155 * MiB, WS_S5AUX = 171 * MiB;
constexpr size_t WS_XB = 172 * MiB;
constexpr size_t WS_X1 = 205 * MiB;
constexpr size_t WS_GS5 = WS_X1;
constexpr size_t WS_H = 271 * MiB;
constexpr size_t WS_U = 271 * MiB, WS_XLRU = WS_U + (size_t)MPAD * DH * 2, WS_GG = WS_XLRU + (size_t)MPAD * DH * 4, WS_MRG = WS_GG + (size_t)MPAD * DH * 2;
constexpr size_t WS_SLAB = 362 * MiB;
constexpr size_t WS_END = 373 * MiB;
static_assert(WS_MRG + (size_t)MPAD * D * 2 <= WS_END && WS_H + (size_t)MPAD * FF * 2 <= WS_SLAB && WS_SLAB + (size_t)11 * MS * D * 4 <= WS_END, "ws map");
constexpr int S5M_GROUP_BYTES = 256 * 1024;
constexpr int S5AUX_GROUP_FLOATS = 2304;
constexpr int CW_BAR = 4096;
constexpr int CW_CNT = 8192;
constexpr size_t CTL_SSQ_BYTE = 262144;

constexpr int RING_BYTES = 139264;
constexpr int LDSCTL_OFF = RING_BYTES, MISC_OFF = LDSCTL_OFF + 320;
constexpr int LDS_BYTES = 147456;

__device__ __forceinline__ unsigned cvt_pk_bf16(float lo, float hi) { unsigned r; asm volatile("v_cvt_pk_bf16_f32 %0, %1, %2" : "=v"(r) : "v"(lo), "v"(hi)); return r; }
__device__ __forceinline__ float bf_lo(unsigned w) { return __uint_as_float(w << 16); }
__device__ __forceinline__ float bf_hi(unsigned w) { return __uint_as_float(w & 0xffff0000u); }
__device__ __forceinline__ float fexp(float x) { return __builtin_amdgcn_exp2f(x * 1.44269504089f); }
__device__ __forceinline__ float fsigmoid(float x) { return __builtin_amdgcn_rcpf(1.0f + fexp(-x)); }
__device__ __forceinline__ float fsilu(float x) { return x * fsigmoid(x); }
__device__ __forceinline__ float fgelu(float x) { return x * fsigmoid(1.5957691216057308f * (x + 0.044715f * x * x * x)); }
__device__ __forceinline__ u32x4 pack8(const f32x4 a, const f32x4 b) { u32x4 w; w.x = cvt_pk_bf16(a[0], a[1]); w.y = cvt_pk_bf16(a[2], a[3]); w.z = cvt_pk_bf16(b[0], b[1]); w.w = cvt_pk_bf16(b[2], b[3]); return w; }
__device__ __forceinline__ float dot4(const f32x4 a) { return (a[0] * a[0] + a[1] * a[1]) + (a[2] * a[2] + a[3] * a[3]); }
__device__ __forceinline__ float wave_sum(float v) {
#pragma unroll
    for (int o = 1; o < 64; o <<= 1) v += __shfl_xor(v, o);
    return v;
}
__device__ __forceinline__ float neg_expm1(float x) {
    float p = 1.0f / 5040.0f; p = fmaf(p, x, 1.0f / 720.0f); p = fmaf(p, x, 1.0f / 120.0f); p = fmaf(p, x, 1.0f / 24.0f); p = fmaf(p, x, 1.0f / 6.0f); p = fmaf(p, x, 0.5f); p = fmaf(p, x, 1.0f);
    const float small = -(p * x), big = 1.0f - fexp(x);
    return x > -0.35f ? small : big;
}
#define LDS_WAIT() asm volatile("s_waitcnt lgkmcnt(0)" ::: "memory")
#define VM_WAIT() asm volatile("s_waitcnt vmcnt(0)" ::: "memory")

namespace pg8 {
constexpr int BM = 256, BK = 64, HALF = 128, HTB = HALF * BK * 2, STAGE_BYTES = 8 * HTB, NXCD = 8, WGM = 8;
__host__ __device__ __forceinline__ int lds_byte(int r, int c) { const int st = (r >> 4) * 2 + (c >> 5), rr = r & 15, cc = c & 31, ob = rr * 64 + cc * 2; return st * 1024 + (ob ^ (((ob >> 9) & 1) << 5)); }
__host__ __device__ __forceinline__ void stage_rc(int b, int& R, int& C) { const int st = b / 1024, sb = b % 1024, swz = sb ^ (((sb >> 9) & 1) << 5); R = (st >> 1) * 16 + swz / 64; C = (st & 1) * 32 + (swz % 64) / 2; }
__host__ __device__ __forceinline__ int perm32(int rho) { const int n = rho >> 4, i = rho & 15; return 8 * (i >> 2) + 4 * n + (i & 3); }

struct Unit { int pm, pn, kt0, nkt; };
struct Gemm { const bf16_t* A; const bf16_t* Bt; int lda, ldb; };

struct PanelOrder {
    int nN, nwgP, G, c, nktFull, sliceKt, nExtra;
    unsigned* ready; unsigned need;
    __device__ void init(int nN_, int nktFull_, int sliceKt_, int G_, int c_) { nN = nN_; nwgP = 32 * nN_; G = G_; c = c_; nktFull = nktFull_; sliceKt = sliceKt_; nExtra = nN_ * (nktFull_ / sliceKt_); ready = nullptr; need = 0u; }
    __device__ __forceinline__ void a_ready(const Unit& u) const {
        if (ready == nullptr || u.pm != 32) return;
        if (threadIdx.x < 64) {
            unsigned polls = 0;
            while ((unsigned)__builtin_amdgcn_readfirstlane(__hip_atomic_load(ready, __ATOMIC_RELAXED, __HIP_MEMORY_SCOPE_AGENT)) < need) { __builtin_amdgcn_s_sleep(2); if (++polls > (1u << 22)) break; }
            __builtin_amdgcn_fence(__ATOMIC_ACQUIRE, "agent");
            asm volatile("s_waitcnt vmcnt(0)" ::: "memory");
        }
        asm volatile("" ::: "memory"); __builtin_amdgcn_s_barrier(); asm volatile("" ::: "memory");
    }
    __device__ bool next(int i, Unit& u) const {
        const long L = (long)i * G + c;
        if (L < nwgP) {
            int wgid = (int)L; { const int q = nwgP / NXCD, r = nwgP % NXCD, xcd = wgid % NXCD, off = wgid / NXCD; wgid = (xcd < r ? xcd * (q + 1) : r * (q + 1) + (xcd - r) * q) + off; }
            const int nig = WGM * nN, gid = wgid / nig, fm = gid * WGM, gsz = (32 - fm) < WGM ? (32 - fm) : WGM;
            u.pm = fm + ((wgid % nig) % gsz); u.pn = (wgid % nig) / gsz; u.kt0 = 0; u.nkt = nktFull; return true;
        }
        const int e = (int)(L - nwgP); if (e >= nExtra) return false;
        u.pm = 32; u.pn = e % nN; u.kt0 = (e / nN) * sliceKt; u.nkt = sliceKt; return true;
    }
};

template <class Epi, class Sched>
__device__ __forceinline__ void gemm_phase(LAS unsigned char* lds, const Gemm g, const Sched& S, const Epi& E) {
    const int tid = threadIdx.x, wid = __builtin_amdgcn_readfirstlane(tid >> 6), lane = tid & 63, wr = wid >> 2, wc = wid & 3, fr = lane & 15, fq = lane >> 4;
    unsigned voffA[2], voffB[2];
#pragma unroll
    for (int i = 0; i < 2; ++i) { int R, C; stage_rc(tid * 16 + i * 8192, R, C); const int Rb = Epi::PERM ? ((R & ~31) + perm32(R & 31)) : R;
        voffA[i] = (unsigned)(R * g.lda + C) * 2u; voffB[i] = (unsigned)(Rb * g.ldb + C) * 2u; }
    const size_t kstep = (size_t)(BK * 2);
    const size_t hstepA = (size_t)HALF * g.lda * 2, hstepB = (size_t)HALF * g.ldb * 2;
    const size_t tstepA = 2 * hstepA, tstepB = 2 * hstepB;
    const unsigned ldsw = (unsigned)wid * 1024u;
    const int aoff = lds_byte(wr * 64 + fr, fq * 8), boff = lds_byte(wc * 32 + fr, fq * 8);
#define PG8_SA(b, h) (((b) * 2 + (h)) * HTB)
#define PG8_SB(b, h) ((4 + (b) * 2 + (h)) * HTB)
#define PG8_STAGE(bufoff, gbase, voff) do { _Pragma("unroll") for (int _i = 0; _i < 2; ++_i) \
        __builtin_amdgcn_global_load_lds((const unsigned*)((const char*)(gbase) + (voff)[_i]), (LAS unsigned*)(lds + (bufoff) + ldsw + _i * 8192), 16, 0, 0); } while (0)
#define PG8_LDA(dst, b, h) do { _Pragma("unroll") for (int m = 0; m < 4; ++m) _Pragma("unroll") for (int k = 0; k < 2; ++k) dst[m][k] = *(const LAS bf16x8*)(lds + PG8_SA(b, h) + aoff + m * 2048 + k * 1024); } while (0)
#define PG8_LDB(dst, b, h) do { _Pragma("unroll") for (int n = 0; n < 2; ++n) _Pragma("unroll") for (int k = 0; k < 2; ++k) dst[n][k] = *(const LAS bf16x8*)(lds + PG8_SB(b, h) + boff + n * 2048 + k * 1024); } while (0)
#define PG8_MMA(ai, bj, At, Bt) do { __builtin_amdgcn_s_setprio(1); _Pragma("unroll") for (int m = 0; m < 4; ++m) _Pragma("unroll") for (int n = 0; n < 2; ++n) _Pragma("unroll") for (int k = 0; k < 2; ++k) \
        acc[ai][bj][m][n] = __builtin_amdgcn_mfma_f32_16x16x32_bf16(Bt[n][k], At[m][k], acc[ai][bj][m][n], 0, 0, 0); __builtin_amdgcn_s_setprio(0); } while (0)
#define PG8_WAIT_V(n) asm volatile("s_waitcnt vmcnt(" #n ")" ::: "memory")
#define PG8_WAIT_L(n) asm volatile("s_waitcnt lgkmcnt(" #n ")" ::: "memory")
#define PG8_BAR __builtin_amdgcn_s_barrier()
#define PG8_SCHED __builtin_amdgcn_sched_barrier(0)
    Unit cur, nxt; int ui = 0;
    if (!S.next(0, cur)) return;
    LAS float* rtab = (LAS float*)(lds + STAGE_BYTES);
    if constexpr (Epi::TAB) { Unit tu; for (int i = 0; i < 8; ++i) { if (!S.next(i, tu)) break; if (tid < 256) rtab[i * 256 + tid] = rsqrtf(E.ssq[tu.pm * BM + tid] * (1.0f / D) + EPS); } }
    f32x4 acc[2][2][4][2];
#pragma unroll
    for (int a = 0; a < 2; ++a)
#pragma unroll
        for (int b = 0; b < 2; ++b)
#pragma unroll
            for (int m = 0; m < 4; ++m)
#pragma unroll
                for (int n = 0; n < 2; ++n) acc[a][b][m][n] = (f32x4){0.f, 0.f, 0.f, 0.f};
    bf16x8 At[4][2], B0[2][2], B1[2][2];
    const char* cA = (const char*)g.A + (size_t)cur.pm * tstepA + (size_t)cur.kt0 * kstep;
    const char* cB = (const char*)g.Bt + (size_t)cur.pn * tstepB + (size_t)cur.kt0 * kstep;
    S.a_ready(cur);
    PG8_STAGE(PG8_SB(0, 0), cB, voffB); PG8_STAGE(PG8_SB(0, 1), cB + hstepB, voffB); PG8_STAGE(PG8_SA(0, 0), cA, voffA); PG8_STAGE(PG8_SA(0, 1), cA + hstepA, voffA);
    if (wr == 1) PG8_BAR;
    PG8_WAIT_V(2); PG8_BAR;
    PG8_STAGE(PG8_SB(1, 0), cB + kstep, voffB); PG8_STAGE(PG8_SA(1, 0), cA + kstep, voffA); PG8_STAGE(PG8_SB(1, 1), cB + hstepB + kstep, voffB);
    PG8_WAIT_V(6); PG8_BAR;
    for (;;) {
        const bool has_next = S.next(ui + 1, nxt);
        const char* nA = has_next ? (const char*)g.A + (size_t)nxt.pm * tstepA + (size_t)nxt.kt0 * kstep : cA;
        const char* nB = has_next ? (const char*)g.Bt + (size_t)nxt.pn * tstepB + (size_t)nxt.kt0 * kstep : cB;
        const int nt = cur.nkt;
        for (int t = 0; t < nt; t += 2) {
            const bool last = (t == nt - 2);
            if (last && has_next) S.a_ready(nxt);
            const char* a1 = cA + (size_t)(t + 1) * kstep;
            const char* a2 = last ? nA : cA + (size_t)(t + 2) * kstep; const char* b2 = last ? nB : cB + (size_t)(t + 2) * kstep;
            const char* a3 = a2 + kstep; const char* b3 = b2 + kstep;
            if constexpr (Epi::HAS_MID) { if (t == Epi::MID_T) E.mid(acc, cur, wr, wc, fr, fq); }
            PG8_LDB(B0, 0, 0); PG8_LDB(B1, 0, 1); PG8_SCHED; PG8_LDA(At, 0, 0); PG8_STAGE(PG8_SA(1, 1), a1 + hstepA, voffA);
            PG8_WAIT_V(8); PG8_WAIT_L(0); PG8_BAR; PG8_MMA(0, 0, At, B0); PG8_MMA(0, 1, At, B1); PG8_BAR; PG8_SCHED;
            PG8_LDA(At, 0, 1); PG8_STAGE(PG8_SB(0, 0), b2, voffB); PG8_STAGE(PG8_SB(0, 1), b2 + hstepB, voffB); PG8_STAGE(PG8_SA(0, 0), a2, voffA);
            PG8_WAIT_V(8); PG8_WAIT_L(0); PG8_BAR; PG8_MMA(1, 0, At, B0); PG8_MMA(1, 1, At, B1); PG8_BAR; PG8_SCHED;
            PG8_LDB(B0, 1, 0); PG8_LDB(B1, 1, 1); PG8_SCHED; PG8_LDA(At, 1, 0); PG8_STAGE(PG8_SA(0, 1), a2 + hstepA, voffA);
            PG8_WAIT_V(8); PG8_WAIT_L(0); PG8_BAR; PG8_MMA(0, 0, At, B0); PG8_MMA(0, 1, At, B1); PG8_BAR; PG8_SCHED;
            PG8_LDA(At, 1, 1); PG8_STAGE(PG8_SB(1, 0), b3, voffB); PG8_STAGE(PG8_SB(1, 1), b3 + hstepB, voffB); PG8_STAGE(PG8_SA(1, 0), a3, voffA);
            PG8_WAIT_V(8); PG8_WAIT_L(0); PG8_BAR; PG8_MMA(1, 0, At, B0); PG8_MMA(1, 1, At, B1); PG8_BAR; PG8_SCHED;
        }
        if (wr == 0) PG8_BAR;
        E(acc, cur, wr, wc, fr, fq, rtab + (ui & 7) * 256);
        if (!has_next) break;
#pragma unroll
        for (int a = 0; a < 2; ++a)
#pragma unroll
            for (int b = 0; b < 2; ++b)
#pragma unroll
                for (int m = 0; m < 4; ++m)
#pragma unroll
                    for (int n = 0; n < 2; ++n) acc[a][b][m][n] = (f32x4){0.f, 0.f, 0.f, 0.f};
        cur = nxt; cA = nA; cB = nB; ++ui;
        if (wr == 1) PG8_BAR;
    }
    PG8_WAIT_V(0);
    PG8_BAR;
#undef PG8_SA
#undef PG8_SB
#undef PG8_STAGE
#undef PG8_LDA
#undef PG8_LDB
#undef PG8_MMA
#undef PG8_WAIT_V
#undef PG8_WAIT_L
#undef PG8_BAR
#undef PG8_SCHED
}


typedef f32x4 Acc[2][2][4][2];
__device__ __forceinline__ void slab_store(const Acc& acc, const Unit& u, float* slab, int wr, int wc, int fr, int fq) {
    int rowl = wr * 64 + fr, col0 = u.pn * BM + wc * 32 + 8 * fq; asm volatile("" : "+v"(rowl), "+v"(col0));
    float* base = slab + (size_t)(u.kt0 / u.nkt) * ((size_t)MS * D);
#pragma unroll
    for (int m = 0; m < 4; ++m)
#pragma unroll
        for (int bj = 0; bj < 2; ++bj) { float* p = base + (size_t)(rowl + m * 16) * D + col0 + bj * HALF; *(f32x4*)p = acc[0][bj][m][0]; *(f32x4*)(p + 4) = acc[0][bj][m][1]; }
}
struct EpiSwiGLU {
    static constexpr bool PERM = true, HAS_MID = false, TAB = true; static constexpr int MID_T = -1;
    bf16_t* O; const float* ssq;
    __device__ __forceinline__ void mid(Acc&, const Unit&, int, int, int, int) const {}
    __device__ __forceinline__ void operator()(const Acc& acc, const Unit& u, int wr, int wc, int fr, int fq, const LAS float* rt) const {
        int row0 = u.pm * BM + wr * 64 + fr, colh = u.pn * 128 + wc * 32 + 8 * fq; asm volatile("" : "+v"(row0), "+v"(colh));
        float sq[2][4];
#pragma unroll
        for (int ai = 0; ai < 2; ++ai)
#pragma unroll
            for (int m = 0; m < 4; ++m) sq[ai][m] = rt[wr * 64 + fr + ai * HALF + m * 16];
        if (u.pm == 32) {
#pragma unroll
            for (int ai = 0; ai < 2; ++ai)
#pragma unroll
                for (int m = 0; m < 4; ++m) sq[ai][m] = rsqrtf(ssq[row0 + ai * HALF + m * 16] * (1.0f / D) + EPS);
        }
#pragma unroll
        for (int ai = 0; ai < 2; ++ai)
#pragma unroll
            for (int m = 0; m < 4; ++m) {
                const int row = row0 + ai * HALF + m * 16;
                const float r = sq[ai][m];
                f32x4 h0, h1;
#pragma unroll
                for (int j = 0; j < 4; ++j) { h0[j] = fsilu(acc[ai][0][m][0][j] * r) * (acc[ai][1][m][0][j] * r); h1[j] = fsilu(acc[ai][0][m][1][j] * r) * (acc[ai][1][m][1][j] * r); }
                *(u32x4*)(O + (size_t)row * FF + colh) = pack8(h0, h1);
            }
    }
};
typedef u32x4 ResTile[2][4][2];
typedef u32x4 ResHalf[4][2];
__device__ __forceinline__ void res_load(ResTile& res, const bf16_t* XB, int row0, int col0) {
#pragma unroll
    for (int ai = 0; ai < 2; ++ai)
#pragma unroll
        for (int m = 0; m < 4; ++m)
#pragma unroll
            for (int bj = 0; bj < 2; ++bj) res[ai][m][bj] = *(const u32x4*)(XB + (size_t)(row0 + ai * HALF + m * 16) * D + col0 + bj * HALF);
    asm volatile("" ::: "memory");
}
__device__ __forceinline__ void res_load_half(ResHalf& res, const bf16_t* XB, int rowh, int col0) {
#pragma unroll
    for (int m = 0; m < 4; ++m)
#pragma unroll
        for (int bj = 0; bj < 2; ++bj) res[m][bj] = *(const u32x4*)(XB + (size_t)(rowh + m * 16) * D + col0 + bj * HALF);
    asm volatile("" ::: "memory");
}
__device__ __forceinline__ f32x4 res_lo(const u32x4 w) { return (f32x4){bf_lo(w.x), bf_hi(w.x), bf_lo(w.y), bf_hi(w.y)}; }
__device__ __forceinline__ f32x4 res_hi(const u32x4 w) { return (f32x4){bf_lo(w.z), bf_hi(w.z), bf_lo(w.w), bf_hi(w.w)}; }
struct EpiResid {
    static constexpr bool PERM = true, HAS_MID = false, TAB = false; static constexpr int MID_T = -1;
    float* slab; bf16_t* XB; float* ssq;
    __device__ __forceinline__ void mid(Acc&, const Unit&, int, int, int, int) const {}
    __device__ __forceinline__ void operator()(const Acc& acc, const Unit& u, int wr, int wc, int fr, int fq, const LAS float* rt) const {
        if (u.pm == 32) { slab_store(acc, u, slab, wr, wc, fr, fq); return; }
        int row0 = u.pm * BM + wr * 64 + fr, col0 = u.pn * BM + wc * 32 + 8 * fq; asm volatile("" : "+v"(row0), "+v"(col0));
#pragma unroll
        for (int ai = 0; ai < 2; ++ai) {
            ResHalf res; res_load_half(res, XB, row0 + ai * HALF, col0);
#pragma unroll
            for (int m = 0; m < 4; ++m) {
                const int row = row0 + ai * HALF + m * 16;
                float s = 0.f;
#pragma unroll
                for (int bj = 0; bj < 2; ++bj) {
                    const f32x4 v0 = res_lo(res[m][bj]) + 0.5f * acc[ai][bj][m][0], v1 = res_hi(res[m][bj]) + 0.5f * acc[ai][bj][m][1];
                    *(u32x4*)(XB + (size_t)row * D + col0 + bj * HALF) = pack8(v0, v1);
                    s += dot4(v0) + dot4(v1);
                }
                s += __shfl_xor(s, 16); s += __shfl_xor(s, 32);
                if (fq == 0) atomicAdd(ssq + row, s);
            }
        }
    }
};
struct EpiProj {
    static constexpr bool PERM = true, HAS_MID = false, TAB = true; static constexpr int MID_T = -1;
    bf16_t* U; float* XL; bf16_t* GG; const float* ssq;
    __device__ __forceinline__ void mid(Acc&, const Unit&, int, int, int, int) const {}
    __device__ __forceinline__ void operator()(const Acc& acc, const Unit& u, int wr, int wc, int fr, int fq, const LAS float* rt) const {
        int row0 = u.pm * BM + wr * 64 + fr, col0 = (u.pn & 3) * BM + wc * 32 + 8 * fq; const int seg = u.pn >> 2; asm volatile("" : "+v"(row0), "+v"(col0));
        float sq[2][4];
#pragma unroll
        for (int ai = 0; ai < 2; ++ai)
#pragma unroll
            for (int m = 0; m < 4; ++m) sq[ai][m] = rt[wr * 64 + fr + ai * HALF + m * 16];
        if (u.pm == 32) {
#pragma unroll
            for (int ai = 0; ai < 2; ++ai)
#pragma unroll
                for (int m = 0; m < 4; ++m) sq[ai][m] = rsqrtf(ssq[row0 + ai * HALF + m * 16] * (1.0f / D) + EPS);
        }
#pragma unroll
        for (int ai = 0; ai < 2; ++ai)
#pragma unroll
            for (int m = 0; m < 4; ++m) {
                const int row = row0 + ai * HALF + m * 16;
                const float r = sq[ai][m];
#pragma unroll
                for (int bj = 0; bj < 2; ++bj) {
                    const size_t o = (size_t)row * DH + col0 + bj * HALF;
                    f32x4 v0 = acc[ai][bj][m][0] * r, v1 = acc[ai][bj][m][1] * r;
                    if (seg == 0) { *(u32x4*)(U + o) = pack8(v0, v1); }
                    else if (seg == 1) { *(f32x4*)(XL + o) = v0; *(f32x4*)(XL + o + 4) = v1; }
                    else {
#pragma unroll
                        for (int j = 0; j < 4; ++j) { v0[j] = fgelu(v0[j]); v1[j] = fgelu(v1[j]); }
                        *(u32x4*)(GG + o) = pack8(v0, v1);
                    }
                }
            }
    }
};
struct EpiGlu {
    static constexpr bool PERM = true, HAS_MID = false, TAB = false; static constexpr int MID_T = -1;
    const bf16_t* GS; const float* bias; bf16_t* MRG; float* ssq;
    __device__ __forceinline__ void mid(Acc&, const Unit&, int, int, int, int) const {}
    __device__ __forceinline__ void operator()(const Acc& acc, const Unit& u, int wr, int wc, int fr, int fq, const LAS float* rt) const {
        int row0 = u.pm * BM + wr * 64 + fr, col0 = u.pn * BM + wc * 32 + 8 * fq; asm volatile("" : "+v"(row0), "+v"(col0));
        ResTile gt;
#pragma unroll
        for (int ai = 0; ai < 2; ++ai)
#pragma unroll
            for (int m = 0; m < 4; ++m)
#pragma unroll
                for (int bj = 0; bj < 2; ++bj) gt[ai][m][bj] = *(const u32x4*)(GS + (size_t)(row0 + ai * HALF + m * 16) * DH + col0 + bj * HALF);
        f32x4 bb[2][2];
#pragma unroll
        for (int bj = 0; bj < 2; ++bj) { bb[bj][0] = *(const f32x4*)(bias + col0 + bj * HALF); bb[bj][1] = *(const f32x4*)(bias + col0 + bj * HALF + 4); }
        asm volatile("" ::: "memory");
#pragma unroll
        for (int ai = 0; ai < 2; ++ai)
#pragma unroll
            for (int m = 0; m < 4; ++m) {
                const int row = row0 + ai * HALF + m * 16;
                float s = 0.f;
#pragma unroll
                for (int bj = 0; bj < 2; ++bj) {
                    const f32x4 g0 = res_lo(gt[ai][m][bj]), g1 = res_hi(gt[ai][m][bj]);
                    f32x4 v0, v1;
#pragma unroll
                    for (int j = 0; j < 4; ++j) { v0[j] = g0[j] * fsigmoid(acc[ai][bj][m][0][j] + bb[bj][0][j]); v1[j] = g1[j] * fsigmoid(acc[ai][bj][m][1][j] + bb[bj][1][j]); }
                    *(u32x4*)(MRG + (size_t)row * D + col0 + bj * HALF) = pack8(v0, v1);
                    s += dot4(v0) + dot4(v1);
                }
                s += __shfl_xor(s, 16); s += __shfl_xor(s, 32);
                if (fq == 0) atomicAdd(ssq + row, s);
            }
    }
};
struct EpiOut {
    static constexpr bool PERM = true, HAS_MID = true, TAB = false; static constexpr int MID_T = 16;
    const float* ssq_s5; const float* ssq_lru; bf16_t* XB; float* ssq; float* slab;
    __device__ __forceinline__ void mid(Acc& acc, const Unit& u, int wr, int wc, int fr, int fq) const {
        if (u.pm == 32 && slab) return;
        int row0 = u.pm * BM + wr * 64 + fr; asm volatile("" : "+v"(row0));
        float f[2][4];
#pragma unroll
        for (int ai = 0; ai < 2; ++ai)
#pragma unroll
            for (int m = 0; m < 4; ++m) { const int row = row0 + ai * HALF + m * 16; f[ai][m] = rsqrtf(ssq_s5[row] * (1.0f / DH) + EPS) * sqrtf(ssq_lru[row] * (1.0f / DH) + EPS); }
#pragma unroll
        for (int ai = 0; ai < 2; ++ai)
#pragma unroll
            for (int m = 0; m < 4; ++m)
#pragma unroll
                for (int bj = 0; bj < 2; ++bj)
#pragma unroll
                    for (int n = 0; n < 2; ++n) acc[ai][bj][m][n] = acc[ai][bj][m][n] * f[ai][m];
    }
    __device__ __forceinline__ void operator()(const Acc& acc, const Unit& u, int wr, int wc, int fr, int fq, const LAS float* rt) const {
        if (u.pm == 32 && slab) { slab_store(acc, u, slab, wr, wc, fr, fq); return; }
        int row0 = u.pm * BM + wr * 64 + fr, col0 = u.pn * BM + wc * 32 + 8 * fq; asm volatile("" : "+v"(row0), "+v"(col0));
        float rl[2][4];
#pragma unroll
        for (int ai = 0; ai < 2; ++ai)
#pragma unroll
            for (int m = 0; m < 4; ++m) rl[ai][m] = ssq_lru[row0 + ai * HALF + m * 16];
#pragma unroll
        for (int ai = 0; ai < 2; ++ai) {
            ResHalf res; res_load_half(res, XB, row0 + ai * HALF, col0);
#pragma unroll
            for (int m = 0; m < 4; ++m) {
                const int row = row0 + ai * HALF + m * 16;
                const float r = rsqrtf(rl[ai][m] * (1.0f / DH) + EPS);
                float s = 0.f;
#pragma unroll
                for (int bj = 0; bj < 2; ++bj) {
                    const f32x4 v0 = res_lo(res[m][bj]) + r * acc[ai][bj][m][0], v1 = res_hi(res[m][bj]) + r * acc[ai][bj][m][1];
                    *(u32x4*)(XB + (size_t)row * D + col0 + bj * HALF) = pack8(v0, v1);
                    s += dot4(v0) + dot4(v1);
                }
                s += __shfl_xor(s, 16); s += __shfl_xor(s, 32);
                if (fq == 0) atomicAdd(ssq + row, s);
            }
        }
    }
};
struct EpiFinal {
    static constexpr bool PERM = true, HAS_MID = false, TAB = false; static constexpr int MID_T = -1;
    bf16_t* XB; float* ssq; float* slab;
    __device__ __forceinline__ void mid(Acc&, const Unit&, int, int, int, int) const {}
    __device__ __forceinline__ void operator()(const Acc& acc, const Unit& u, int wr, int wc, int fr, int fq, const LAS float* rt) const {
        if (u.pm == 32) { slab_store(acc, u, slab, wr, wc, fr, fq); return; }
        int row0 = u.pm * BM + wr * 64 + fr, col0 = u.pn * BM + wc * 32 + 8 * fq; asm volatile("" : "+v"(row0), "+v"(col0));
#pragma unroll
        for (int ai = 0; ai < 2; ++ai) {
            ResHalf res; res_load_half(res, XB, row0 + ai * HALF, col0);
#pragma unroll
            for (int m = 0; m < 4; ++m) {
                const int row = row0 + ai * HALF + m * 16;
                float s = 0.f;
#pragma unroll
                for (int bj = 0; bj < 2; ++bj) {
                    const f32x4 v0 = res_lo(res[m][bj]) + 0.5f * acc[ai][bj][m][0], v1 = res_hi(res[m][bj]) + 0.5f * acc[ai][bj][m][1];
                    *(u32x4*)(XB + (size_t)row * D + col0 + bj * HALF) = pack8(v0, v1);
                    s += dot4(v0) + dot4(v1);
                }
                s += __shfl_xor(s, 16); s += __shfl_xor(s, 32);
                if (fq == 0) atomicAdd(ssq + row, s);
            }
        }
    }
};
}

#define XB_TMO      128
#define XB_XCNT(j)  (256  + 64 * (j))
#define XB_XSUB(j)  (1280 + 64 * (j))
#define XB_XGEN(j)  (2304 + 64 * (j))
#define XB_TOP      3328
#define XB_TOPGEN   3392
#define XCD_BAR_WORDS 3456
#define XB_SPIN_CAP (1u << 18)
__device__ __forceinline__ unsigned xb_ld(unsigned* p)              { return __hip_atomic_load(p, __ATOMIC_RELAXED, __HIP_MEMORY_SCOPE_AGENT); }
__device__ __forceinline__ unsigned xb_add(unsigned* p, unsigned v) { return __hip_atomic_fetch_add(p, v, __ATOMIC_RELAXED, __HIP_MEMORY_SCOPE_AGENT); }
__device__ __forceinline__ unsigned xb_xcc_id() { return (unsigned)__builtin_amdgcn_s_getreg((3 << 11) | 20) & 0xFu; }
#define XB_SPIN(cond, bar) do { unsigned _sp = 0; while (cond) { __builtin_amdgcn_s_sleep(1); \
    if ((++_sp & 255u) == 0u) { if (xb_ld(&(bar)[XB_TMO])) break; if (_sp > XB_SPIN_CAP) { atomicAdd(&(bar)[XB_TMO], 1u); break; } } } } while (0)
struct XcdBarrier { unsigned* bar; unsigned x; volatile LAS unsigned* st; };
__device__ __forceinline__ XcdBarrier xcd_barrier_post(unsigned* bar, volatile LAS unsigned* st) {
    XcdBarrier b; b.bar = bar; b.x = xb_xcc_id(); b.st = st;
    if (threadIdx.x == 0) (void)xb_add(&bar[XB_XCNT(b.x)], 1u);
    return b;
}
__device__ __forceinline__ void xcd_barrier_complete(unsigned* bar, unsigned x, unsigned& nloc, unsigned& nx) {
    const unsigned G = gridDim.x * gridDim.y * gridDim.z;
    unsigned sum, cnt, mine, sp = 0u;
    for (;;) {
        sum = 0u; cnt = 0u; mine = 0u;
#pragma unroll
        for (unsigned j = 0; j < 16; ++j) { const unsigned c = xb_ld(&bar[XB_XCNT(j)]); sum += c; cnt += (c > 0u) ? 1u : 0u; mine = (j == x) ? c : mine; }
        if (sum == G) break;
        __builtin_amdgcn_s_sleep(1);
        if ((++sp & 255u) == 0u) { if (xb_ld(&bar[XB_TMO])) break; if (sp > XB_SPIN_CAP) { atomicAdd(&bar[XB_TMO], 1u); break; } }
    }
    nloc = mine > 0u ? mine : 1u; nx = cnt > 0u ? cnt : 1u;
}
__device__ __forceinline__ void xcd_barrier(const XcdBarrier& b) {
    asm volatile("s_waitcnt vmcnt(0)" ::: "memory");
    __syncthreads();
    if (threadIdx.x == 0) {
        unsigned* bar = b.bar;
        __builtin_amdgcn_s_waitcnt(0);
        unsigned nloc = b.st[0], nx = b.st[1];
        if (nloc == 0u) { xcd_barrier_complete(bar, b.x, nloc, nx); b.st[0] = nloc; b.st[1] = nx; }
        const unsigned old = xb_add(&bar[XB_XSUB(b.x)], 1u);
        const unsigned gen = old / nloc;
        if (old + 1u == (gen + 1u) * nloc) {
            __builtin_amdgcn_fence(__ATOMIC_RELEASE, "agent");
            asm volatile("s_waitcnt vmcnt(0)" ::: "memory");
            const unsigned og = xb_add(&bar[XB_TOP], 1u);
            const unsigned tg = og / nx;
            if (og + 1u == (tg + 1u) * nx) xb_add(&bar[XB_TOPGEN], 1u);
            else XB_SPIN(xb_ld(&bar[XB_TOPGEN]) == tg, bar);
            __builtin_amdgcn_fence(__ATOMIC_ACQUIRE, "agent");
            xb_add(&bar[XB_XGEN(b.x)], 1u);
            asm volatile("s_waitcnt vmcnt(0)" ::: "memory");
        } else {
            XB_SPIN(xb_ld(&bar[XB_XGEN(b.x)]) == gen, bar);
            __builtin_amdgcn_fence(__ATOMIC_ACQUIRE, "agent");
            asm volatile("s_waitcnt vmcnt(0)" ::: "memory");
        }
    }
    __syncthreads();
}

enum { I_XP = 0, I_XS, I_S5RE, I_S5IM, I_LRUH, I_LRUCONV, I_GFFN1, I_W1A, I_W3A, I_W2A, I_GMIX, I_WIN, I_LAMRE, I_LAMIM, I_LOGDT, I_BRE, I_BIM, I_CRE, I_CIM,
       I_DSKIP, I_WGLU, I_BGLU, I_CONVW, I_CONVB, I_WA, I_BA, I_WX, I_BX, I_LAML, I_GS5, I_GLRU, I_WOUT, I_GFFN2, I_W1B, I_W3B, I_W2B, I_GFINAL, N_IN };
struct Args { const float* in[N_IN]; float* out; unsigned char* ws; int ph_lo, ph_hi; };
constexpr size_t O_Y = 0, O_PS5RE = (size_t)M * D, O_PS5IM = O_PS5RE + NB * NG * NP, O_PLRUH = O_PS5IM + NB * NG * NP, O_PLRUC = O_PLRUH + NB * DH,
                 O_SS5RE = O_PLRUC + NB * 3 * DH, O_SS5IM = O_SS5RE + (size_t)MS * NG * NP, O_SLRUH = O_SS5IM + (size_t)MS * NG * NP, O_SLRUC = O_SLRUH + (size_t)MS * DH,
                 O_END = O_SLRUC + (size_t)MS * 3 * DH;
static_assert(O_END == 18661376, "output size");

typedef float f32x2 __attribute__((ext_vector_type(2)));
constexpr int STG_PITCH = 144, STG_BYTES = 64 * STG_PITCH;
__device__ __forceinline__ void p0_task(const float* W, int N, const float* gk, bf16_t* WT, int ldt, int k0, int n0, int nd0, LAS unsigned char* stg, int lane) {
    const float* src = W + (size_t)k0 * N + n0 + 2 * lane;
    f32x2 v[64];
#if PROBE_PHASE >= 0
    { const float* p = src; const size_t step = (size_t)N;
#pragma unroll
      for (int i = 0; i < 64; ++i) { v[i] = __builtin_nontemporal_load((const f32x2*)p); p += step; if ((i & 7) == 7) asm volatile("" : "+v"(p)); } }
#else
#pragma unroll
    for (int i = 0; i < 64; ++i) v[i] = __builtin_nontemporal_load((const f32x2*)(src + (size_t)i * N));
#endif
    if (gk) {
#pragma unroll
        for (int i = 0; i < 64; ++i) v[i] = v[i] * gk[k0 + i];
    }
#pragma unroll
    for (int j = 0; j < 2; ++j) {
#pragma unroll
        for (int kb = 0; kb < 8; ++kb) {
            u32x4 o; o.x = cvt_pk_bf16(v[8 * kb][j], v[8 * kb + 1][j]); o.y = cvt_pk_bf16(v[8 * kb + 2][j], v[8 * kb + 3][j]); o.z = cvt_pk_bf16(v[8 * kb + 4][j], v[8 * kb + 5][j]); o.w = cvt_pk_bf16(v[8 * kb + 6][j], v[8 * kb + 7][j]);
            *(LAS u32x4*)(stg + lane * STG_PITCH + kb * 16) = o;
        }
        LDS_WAIT(); asm volatile("" ::: "memory");
#pragma unroll
        for (int it = 0; it < 8; ++it) {
            const int rr = 8 * it + (lane >> 3), kb = lane & 7;
            const u32x4 o = *(const LAS u32x4*)(stg + rr * STG_PITCH + kb * 16);
            *(u32x4*)(WT + (size_t)(nd0 + 2 * rr + j) * ldt + k0 + 8 * kb) = o;
        }
        LDS_WAIT(); asm volatile("" ::: "memory");
    }
}
__device__ __forceinline__ void sincos_d(double x, double& s, double& c) {
    const double k = rint(x * 0.63661977236758134308);
    double r = fma(-k, 1.57079632679489655800, x); r = fma(-k, 6.12323399573676603587e-17, r);
    const double r2 = r * r;
    double sp = -7.6471637318198164759e-13; sp = fma(sp, r2, 1.6059043836821614599e-10); sp = fma(sp, r2, -2.5052108385441718775e-8); sp = fma(sp, r2, 2.7557319223985890653e-6);
    sp = fma(sp, r2, -1.9841269841269841270e-4); sp = fma(sp, r2, 8.3333333333333333333e-3); sp = fma(sp, r2, -1.6666666666666666667e-1);
    const double sr = fma(sp * r2, r, r);
    double cp = 4.7794773323873852974e-14; cp = fma(cp, r2, -1.1470745597729724714e-11); cp = fma(cp, r2, 2.0876756987868098979e-9); cp = fma(cp, r2, -2.7557319223985890653e-7);
    cp = fma(cp, r2, 2.4801587301587301587e-5); cp = fma(cp, r2, -1.3888888888888888889e-3); cp = fma(cp, r2, 4.1666666666666666667e-2); cp = fma(cp, r2, -0.5);
    const double cr = fma(cp, r2, 1.0);
    const int q = ((int)k) & 3;
    s = (q == 0) ? sr : (q == 1) ? cr : (q == 2) ? -sr : -cr;
    c = (q == 0) ? cr : (q == 1) ? -sr : (q == 2) ? -cr : sr;
}
__device__ __forceinline__ void p0_s5_group(const Args& a, LAS unsigned char* lds, int g, int tid) {
    LAS float* LPre = (LAS float*)lds;
    LAS float* LPim = LPre + 17 * 64;
    LAS float* BBre = LPim + 17 * 64;
    LAS float* BBim = BBre + 1024;
    LAS float* CRe = BBim + 1024;
    LAS float* CIm = CRe + 1024;
    LAS float* Kt = CIm + 1024;
    LAS float* Kt2 = Kt + 4096;
    LAS float* QQ = Kt2 + 4096;
    const float ldt = a.in[I_LOGDT][g];
    float lre_[3], lim_[3];
#pragma unroll
    for (int i = 0; i < 3; ++i) { const int idx = tid + 512 * i, p = idx & 63; lre_[i] = a.in[I_LAMRE][g * 64 + p]; lim_[i] = a.in[I_LAMIM][g * 64 + p]; }
    float cr_[2], ci_[2], br_[2], bi_[2];
#pragma unroll
    for (int i = 0; i < 2; ++i) { const int idx = tid + 512 * i; cr_[i] = a.in[I_CRE][(size_t)g * 1024 + idx]; ci_[i] = a.in[I_CIM][(size_t)g * 1024 + idx]; br_[i] = a.in[I_BRE][(size_t)g * 1024 + idx]; bi_[i] = a.in[I_BIM][(size_t)g * 1024 + idx]; }
    const float dsk = a.in[I_DSKIP][g * 16 + (tid & 15)];
    const double dt = exp((double)ldt);
#pragma unroll
    for (int i = 0; i < 3; ++i) {
        const int idx = tid + 512 * i;
        if (idx < 17 * 64) {
            const int k = idx >> 6, p = idx & 63;
            const double lre = (double)lre_[i], lim = (double)lim_[i];
            const double mag = exp(lre * dt * (double)k); double sn, cs; sincos_d(lim * dt * (double)k, sn, cs);
            LPre[idx] = (float)(mag * cs); LPim[idx] = (float)(mag * sn);
            if (k == 1) {
                const double nr = mag * cs - 1.0, ni = mag * sn, den = lre * lre + lim * lim;
                QQ[2 * p] = (float)((nr * lre + ni * lim) / den); QQ[2 * p + 1] = (float)((ni * lre - nr * lim) / den);
            }
        }
    }
#pragma unroll
    for (int i = 0; i < 2; ++i) { const int idx = tid + 512 * i; CRe[idx] = cr_[i]; CIm[idx] = ci_[i]; }
    __syncthreads();
#pragma unroll
    for (int i = 0; i < 2; ++i) { const int idx = tid + 512 * i, p = idx >> 4; const float qr = QQ[2 * p], qi = QQ[2 * p + 1];
        BBre[idx] = qr * br_[i] - qi * bi_[i]; BBim[idx] = qr * bi_[i] + qi * br_[i]; }
    __syncthreads();
    {
        const int c = (tid >> 4) & 15, cp = tid & 15, ph = tid >> 8;
        float acc[16];
#pragma unroll
        for (int k = 0; k < 16; ++k) acc[k] = 0.f;
        for (int pp = 0; pp < 32; ++pp) {
            const int p = 32 * ph + pp;
            const float cr = CRe[c * 64 + p], ci = CIm[c * 64 + p], br = BBre[p * 16 + cp], bi = BBim[p * 16 + cp];
            const float gr = cr * br - ci * bi, gi = cr * bi + ci * br;
#pragma unroll
            for (int k = 0; k < 16; ++k) acc[k] += gr * LPre[k * 64 + p] - gi * LPim[k * 64 + p];
        }
        if (ph == 0 && c == cp) acc[0] += dsk;
        LAS float* dst = ph ? Kt2 : Kt;
#pragma unroll
        for (int k = 0; k < 16; ++k) dst[(k * 16 + c) * 16 + cp] = acc[k];
    }
    __syncthreads();
    bf16_t* Win = (bf16_t*)(a.ws + WS_S5M + (size_t)g * S5M_GROUP_BYTES);
    bf16_t* MW = Win + 128 * 256;
    for (int idx = tid; idx < 256 * 48; idx += NWAVES * 64) {
        const int rr = idx / 48, cg = idx % 48, s = rr >> 4, c = rr & 15;
        float v[8];
        if (cg < 32) { const int sp = cg >> 1, c0 = (cg & 1) * 8;
#pragma unroll
            for (int i = 0; i < 8; ++i) { const int o = (((s - sp) & 15) * 16 + c) * 16 + c0 + i; v[i] = (sp <= s) ? Kt[o] + Kt2[o] : 0.f; }
        } else { const int im = cg >= 40, p0 = (cg - (im ? 40 : 32)) * 8;
#pragma unroll
            for (int i = 0; i < 8; ++i) { const int p = p0 + i; const float cr = CRe[c * 64 + p], ci = CIm[c * 64 + p], lr = LPre[(s + 1) * 64 + p], li = LPim[(s + 1) * 64 + p];
                v[i] = im ? -(cr * li + ci * lr) : (cr * lr - ci * li); }
        }
        u32x4 o; o.x = cvt_pk_bf16(v[0], v[1]); o.y = cvt_pk_bf16(v[2], v[3]); o.z = cvt_pk_bf16(v[4], v[5]); o.w = cvt_pk_bf16(v[6], v[7]);
        *(u32x4*)(MW + (size_t)rr * 384 + cg * 8) = o;
    }
    for (int idx = tid; idx < 128 * 32; idx += NWAVES * 64) {
        const int n = idx >> 5, cg = idx & 31, p = n & 63, im = n >> 6, sp = cg >> 1, c0 = (cg & 1) * 8;
        const float lr = LPre[(15 - sp) * 64 + p], li = LPim[(15 - sp) * 64 + p];
        float v[8];
#pragma unroll
        for (int i = 0; i < 8; ++i) { const float br = BBre[p * 16 + c0 + i], bi = BBim[p * 16 + c0 + i]; v[i] = im ? (lr * bi + li * br) : (lr * br - li * bi); }
        u32x4 o; o.x = cvt_pk_bf16(v[0], v[1]); o.y = cvt_pk_bf16(v[2], v[3]); o.z = cvt_pk_bf16(v[4], v[5]); o.w = cvt_pk_bf16(v[6], v[7]);
        *(u32x4*)(Win + (size_t)n * 256 + cg * 8) = o;
    }
    {
        float* aux = (float*)(a.ws + WS_S5AUX) + (size_t)g * S5AUX_GROUP_FLOATS;
        for (int idx = tid; idx < 64; idx += NWAVES * 64) { aux[idx] = LPre[64 + idx]; aux[64 + idx] = LPim[64 + idx]; aux[128 + idx] = LPre[16 * 64 + idx]; aux[192 + idx] = LPim[16 * 64 + idx]; }
        for (int idx = tid; idx < 1024; idx += NWAVES * 64) { aux[256 + idx] = BBre[idx]; aux[1280 + idx] = BBim[idx]; }
    }
    __syncthreads();
}
__device__ __forceinline__ void conv_tasks(const Args& a, LAS unsigned char* stg, int first, int last, int wv, int nwv, int lane) {
    constexpr int T_W1 = (D / 64) * (FF / 128), T_W2 = (FF / 64) * (D / 128), T_IN = (D / 64) * (DIN / 128), T_GLU = (DH / 64) * (DH / 128), T_OUT = (D / 64) * (D / 128);
    const int cnt[9] = {T_W1, T_W1, T_W2, T_IN, T_GLU, T_OUT, T_W1, T_W1, T_W2};
    int NT = 0;
#pragma unroll
    for (int m = 0; m < 9; ++m) if (m >= first && m <= last) NT += cnt[m];
    const int t_lo = (int)(((long)wv * NT) / nwv), t_hi = (int)(((long)(wv + 1) * NT) / nwv);
    unsigned char* ws = a.ws;
    for (int it = t_lo; it < t_hi; ++it) {
        int r = it, mat = first;
#pragma unroll
        for (int m = 0; m < 9; ++m) if (m >= first && m < last && mat == m && r >= cnt[m]) { r -= cnt[m]; mat = m + 1; }
        const float* W; const float* gk = nullptr; bf16_t* WT; int K, N, dual = 0, off = 0;
        switch (mat) {
            case 0: W = a.in[I_W1A]; gk = a.in[I_GFFN1]; WT = (bf16_t*)(ws + WS_W13A); K = D; N = FF; dual = 1; break;
            case 1: W = a.in[I_W3A]; gk = a.in[I_GFFN1]; WT = (bf16_t*)(ws + WS_W13A); K = D; N = FF; dual = 1; off = 128; break;
            case 2: W = a.in[I_W2A]; WT = (bf16_t*)(ws + WS_W2A); K = FF; N = D; break;
            case 3: W = a.in[I_WIN]; gk = a.in[I_GMIX]; WT = (bf16_t*)(ws + WS_WIN); K = D; N = DIN; break;
            case 4: W = a.in[I_WGLU]; WT = (bf16_t*)(ws + WS_WGLU); K = DH; N = DH; break;
            case 5: W = a.in[I_WOUT]; WT = (bf16_t*)(ws + WS_WOUT); K = D; N = D; dual = 2; break;
            case 6: W = a.in[I_W1B]; gk = a.in[I_GFFN2]; WT = (bf16_t*)(ws + WS_W13B); K = D; N = FF; dual = 1; break;
            case 7: W = a.in[I_W3B]; gk = a.in[I_GFFN2]; WT = (bf16_t*)(ws + WS_W13B); K = D; N = FF; dual = 1; off = 128; break;
            default: W = a.in[I_W2B]; WT = (bf16_t*)(ws + WS_W2B); K = FF; N = D; break;
        }
        const int nkb = K / 64, nb = r / nkb, kb = r % nkb, k0 = kb * 64, n0 = nb * 128;
        if (dual == 2) { gk = k0 < DH ? a.in[I_GS5] : a.in[I_GLRU] - DH; dual = 0; }
        p0_task(W, N, gk, WT, K, k0, n0, dual ? (nb * 256 + off) : n0, stg, lane);
    }
}
__device__ __forceinline__ void p0_prologue(const Args& a, LAS unsigned char* lds, int vcu, int G, int lane, int wave) {
    const int gw = vcu * NWAVES + wave, NGW = G * NWAVES;
    unsigned char* ws = a.ws;
    bf16_t* XB = (bf16_t*)(ws + WS_XB); float* ssq0 = (float*)(ws + WS_CTL + CTL_SSQ_BYTE);
    for (int grp = gw; grp < MPAD / 4; grp += NGW) {
        const int m0 = 4 * grp;
        u32x2* o = (u32x2*)(XB + (size_t)m0 * D) + lane;
        if (m0 < M) {
            const float* xr = m0 < MP ? a.in[I_XP] + (size_t)m0 * D : a.in[I_XS] + (size_t)(m0 - MP) * D;
            const f32x4* x4 = (const f32x4*)xr + lane; f32x4 v[4][8];
#pragma unroll
            for (int r = 0; r < 4; ++r)
#pragma unroll
                for (int j = 0; j < 8; ++j) v[r][j] = __builtin_nontemporal_load(x4 + r * (D / 4) + 64 * j);
#pragma unroll
            for (int r = 0; r < 4; ++r) {
                float s = 0.f;
#pragma unroll
                for (int j = 0; j < 8; ++j) s += dot4(v[r][j]);
                s = wave_sum(s);
#pragma unroll
                for (int j = 0; j < 8; ++j) { u32x2 w; w.x = cvt_pk_bf16(v[r][j][0], v[r][j][1]); w.y = cvt_pk_bf16(v[r][j][2], v[r][j][3]); o[r * (D / 4) + 64 * j] = w; }
                if (lane == 0) ssq0[m0 + r] = s;
            }
        } else {
#pragma unroll
            for (int r = 0; r < 4; ++r)
#pragma unroll
                for (int j = 0; j < 8; ++j) o[r * (D / 4) + 64 * j] = (u32x2){0u, 0u};
        }
    }
    conv_tasks(a, lds + wave * STG_BYTES, 0, 3, gw, NGW, lane);
}

#define MFMA32(a, b, c) __builtin_amdgcn_mfma_f32_32x32x16_bf16((a), (b), (c), 0, 0, 0)
constexpr int S5_PITCH = 528;
constexpr int S5_XC_OFF = 0, S5_Z_OFF = 128 * S5_PITCH;
static_assert(2 * 128 * S5_PITCH <= RING_BYTES, "S5 LDS map");
__device__ __forceinline__ void s5_prompt(const Args& a, LAS unsigned char* lds, int b, int g, int tid, int lane, int wave) {
    const bf16_t* U = (const bf16_t*)(a.ws + WS_U);
    const bf16_t* Win = (const bf16_t*)(a.ws + WS_S5M + (size_t)g * S5M_GROUP_BYTES);
    const bf16_t* MW = Win + 128 * 256;
    bf16_t* GS5 = (bf16_t*)(a.ws + WS_GS5);
    LAS unsigned char* XCs = lds + S5_XC_OFF;
    LAS unsigned char* ZS = lds + S5_Z_OFF;
    const int r32 = lane & 31, hh = lane >> 5;
    {
        u32x4 v[8];
#pragma unroll
        for (int i = 0; i < 8; ++i) { const int q = tid + 512 * i, t = q >> 1, half = q & 1; v[i] = *(const u32x4*)(U + (size_t)(b * SEQ + t) * DH + 16 * g + 8 * half); }
#pragma unroll
        for (int i = 0; i < 8; ++i) { const int q = tid + 512 * i, t = q >> 1, half = q & 1; *(LAS u32x4*)(XCs + (t >> 4) * S5_PITCH + (t & 15) * 32 + 16 * half) = v[i]; }
    }
    {
        const int mt = wave & 3, nt0 = (wave >> 2) * 2;
        const bf16_t* w0 = Win + (size_t)(32 * nt0 + r32) * 256 + 8 * hh;
        bf16x8 bw[2][8];
#pragma unroll
        for (int ks = 0; ks < 8; ++ks) { bw[0][ks] = *(const bf16x8*)(w0 + 16 * ks); bw[1][ks] = *(const bf16x8*)(w0 + 32 * 256 + 16 * ks); }
        __syncthreads();
        f32x16 acc0, acc1;
#pragma unroll
        for (int i = 0; i < 16; ++i) { acc0[i] = 0.f; acc1[i] = 0.f; }
        const LAS unsigned char* xa = XCs + (32 * mt + r32) * S5_PITCH + 16 * hh;
#pragma unroll 1
        for (int kh = 0; kh < 2; ++kh) {
#pragma unroll
            for (int ks = 0; ks < 8; ++ks) { const bf16x8 af = *(const LAS bf16x8*)(xa + 32 * (8 * kh + ks)); acc0 = MFMA32(af, bw[0][ks], acc0); acc1 = MFMA32(af, bw[1][ks], acc1); }
            if (kh == 0) {
#pragma unroll
                for (int ks = 0; ks < 8; ++ks) { bw[0][ks] = *(const bf16x8*)(w0 + 128 + 16 * ks); bw[1][ks] = *(const bf16x8*)(w0 + 32 * 256 + 128 + 16 * ks); }
            }
        }
        LAS float* Z = (LAS float*)ZS;
#pragma unroll
        for (int i = 0; i < 16; ++i) { const int j = 32 * mt + (i & 3) + 8 * (i >> 2) + 4 * hh;
            Z[j * (S5_PITCH / 4) + 32 * nt0 + r32] = acc0[i]; Z[j * (S5_PITCH / 4) + 32 * nt0 + 32 + r32] = acc1[i]; }
    }
    __syncthreads();
    if (wave == 0) {
        const float* aux = (const float*)(a.ws + WS_S5AUX) + (size_t)g * S5AUX_GROUP_FLOATS;
        const float l16r = aux[128 + lane], l16i = aux[192 + lane];
        const LAS float* Z = (const LAS float*)ZS;
        float sr = 0.f, si = 0.f;
        for (int jb = 0; jb < 16; ++jb) {
            float zr[8], zi[8];
#pragma unroll
            for (int i = 0; i < 8; ++i) { zr[i] = Z[(8 * jb + i) * (S5_PITCH / 4) + lane]; zi[i] = Z[(8 * jb + i) * (S5_PITCH / 4) + 64 + lane]; }
            LDS_WAIT();
#pragma unroll
            for (int i = 0; i < 8; ++i) {
                const unsigned w = cvt_pk_bf16(sr, si);
                *(LAS unsigned short*)(ZS + (8 * jb + i) * S5_PITCH + 2 * lane) = (unsigned short)(w & 0xffffu);
                *(LAS unsigned short*)(ZS + (8 * jb + i) * S5_PITCH + 128 + 2 * lane) = (unsigned short)(w >> 16);
                const float nr = l16r * sr - l16i * si + zr[i], ni = l16r * si + l16i * sr + zi[i];
                sr = nr; si = ni;
            }
        }
        a.out[O_PS5RE + (size_t)(b * NG + g) * NP + lane] = sr;
        a.out[O_PS5IM + (size_t)(b * NG + g) * NP + lane] = si;
    }
#pragma unroll 1
    for (int pass = 0; pass < 2; ++pass) {
        const int mt = pass ? 7 - wave : wave, n0 = 2 * pass;
        const int nks = 2 * mt + 2;
        const bf16_t* mw = MW + (size_t)(32 * mt + r32) * 384 + 8 * hh;
        bf16x8 am[24];
#pragma unroll
        for (int ks = 0; ks < 16; ++ks) if (ks < nks) am[ks] = *(const bf16x8*)(mw + 16 * ks);
#pragma unroll
        for (int kq = 0; kq < 8; ++kq) am[16 + kq] = *(const bf16x8*)(mw + 256 + 16 * kq);
        if (pass == 0) __syncthreads();
        f32x16 acc[2];
#pragma unroll
        for (int n = 0; n < 2; ++n)
#pragma unroll
            for (int i = 0; i < 16; ++i) acc[n][i] = 0.f;
#pragma unroll
        for (int ks = 0; ks < 16; ++ks) if (ks < nks) {
#pragma unroll
            for (int n = 0; n < 2; ++n) { const bf16x8 bf = *(const LAS bf16x8*)(XCs + (32 * (n0 + n) + r32) * S5_PITCH + 32 * ks + 16 * hh); acc[n] = MFMA32(am[ks], bf, acc[n]); }
        }
#pragma unroll
        for (int kq = 0; kq < 8; ++kq) {
#pragma unroll
            for (int n = 0; n < 2; ++n) { const bf16x8 bf = *(const LAS bf16x8*)(ZS + (32 * (n0 + n) + r32) * S5_PITCH + 32 * kq + 16 * hh); acc[n] = MFMA32(am[16 + kq], bf, acc[n]); }
        }
#pragma unroll
        for (int n = 0; n < 2; ++n)
#pragma unroll
            for (int q = 0; q < 4; ++q) {
                const int s = 2 * mt + (q >> 1), c0 = 8 * (q & 1) + 4 * hh, t = 16 * (32 * (n0 + n) + r32) + s;
                u32x2 w; w.x = cvt_pk_bf16(fgelu(acc[n][4 * q]), fgelu(acc[n][4 * q + 1])); w.y = cvt_pk_bf16(fgelu(acc[n][4 * q + 2]), fgelu(acc[n][4 * q + 3]));
                *(u32x2*)(GS5 + (size_t)(b * SEQ + t) * DH + 16 * g + c0) = w;
            }
    }
    __syncthreads();
}
__device__ __forceinline__ void s5_sample(const Args& a, LAS unsigned char* lds, int g, int bs0, int tid) {
    const bf16_t* U = (const bf16_t*)(a.ws + WS_U);
    bf16_t* GS5 = (bf16_t*)(a.ws + WS_GS5);
    const float* aux = (const float*)(a.ws + WS_S5AUX) + (size_t)g * S5AUX_GROUP_FLOATS;
    LAS float* HR = (LAS float*)lds;
    LAS float* HI = HR + 2048;
    LAS float* UU = HI + 2048;
    LAS float* CR = UU + 512;
    LAS float* CI = CR + 1024;
    LAS float* BR = CI + 1024;
    LAS float* BI = BR + 1024;
    const int bl0 = tid >> 4, c0 = tid & 15;
    const unsigned short uraw = U[(size_t)(MP + bs0 + bl0) * DH + 16 * g + c0];
    float cr_[2], ci_[2], br_[2], bi_[2], h0r[4], h0i[4];
#pragma unroll
    for (int i = 0; i < 2; ++i) { const int idx = tid + 512 * i; cr_[i] = a.in[I_CRE][(size_t)g * 1024 + idx]; ci_[i] = a.in[I_CIM][(size_t)g * 1024 + idx]; br_[i] = aux[256 + idx]; bi_[i] = aux[1280 + idx]; }
#pragma unroll
    for (int i = 0; i < 4; ++i) { const int idx = tid + 512 * i, bl = idx >> 6, p = idx & 63; const size_t so = (size_t)((bs0 + bl) * NG + g) * NP + p; h0r[i] = a.in[I_S5RE][so]; h0i[i] = a.in[I_S5IM][so]; }
    const float lr = aux[tid & 63], li = aux[64 + (tid & 63)];
    const float dsk = a.in[I_DSKIP][g * 16 + c0];
    UU[tid] = __uint_as_float((unsigned)uraw << 16);
#pragma unroll
    for (int i = 0; i < 2; ++i) { const int idx = tid + 512 * i; CR[idx] = cr_[i]; CI[idx] = ci_[i]; BR[idx] = br_[i]; BI[idx] = bi_[i]; }
    __syncthreads();
#pragma unroll
    for (int i = 0; i < 4; ++i) {
        const int idx = tid + 512 * i, bl = idx >> 6, p = idx & 63;
        float hr = lr * h0r[i] - li * h0i[i], hi = lr * h0i[i] + li * h0r[i];
#pragma unroll
        for (int q = 0; q < 4; ++q) { const f32x4 br = *(const LAS f32x4*)(BR + p * 16 + 4 * q), bi = *(const LAS f32x4*)(BI + p * 16 + 4 * q); const f32x4 u4 = *(const LAS f32x4*)(UU + bl * 16 + 4 * q);
#pragma unroll
            for (int j = 0; j < 4; ++j) { hr += br[j] * u4[j]; hi += bi[j] * u4[j]; } }
        const size_t so = (size_t)((bs0 + bl) * NG + g) * NP + p;
        a.out[O_SS5RE + so] = hr; a.out[O_SS5IM + so] = hi;
        HR[idx] = hr; HI[idx] = hi;
    }
    __syncthreads();
    {
        float y = 0.f;
#pragma unroll 16
        for (int p = 0; p < 64; ++p) y += CR[c0 * 64 + p] * HR[bl0 * 64 + p] - CI[c0 * 64 + p] * HI[bl0 * 64 + p];
        y += dsk * UU[tid];
        const float gv = fgelu(y); const unsigned w = cvt_pk_bf16(gv, gv);
        GS5[(size_t)(MP + bs0 + bl0) * DH + 16 * g + c0] = (bf16_t)(w & 0xffffu);
    }
    __syncthreads();
}

constexpr int XC_PITCH = 144;
__device__ __forceinline__ void lru_item(const Args& a, LAS unsigned char* lds, bool sample, int b, int head, int q, int tid, int lane, int wave) {
    const float* XL = (const float*)(a.ws + WS_XLRU);
    const bf16_t* GG = (const bf16_t*)(a.ws + WS_GG);
    bf16_t* MRG = (bf16_t*)(a.ws + WS_MRG);
    float* ssq_lru = (float*)(a.ws + WS_CTL + CTL_SSQ_BYTE) + 3 * MPAD;
    LAS unsigned char* XC = lds;
    LAS float* XCF = (LAS float*)(lds + 36864);
    LAS float* AA = XCF + 4096;
    LAS float* BX = AA + 4096;
    LAS float* SEGP = BX + 4096;
    LAS float* SEGH = SEGP + 512;
    LAS float* CAR = SEGH + 512;
    const int ch0 = 64 * head + 16 * q;
    const int fr = lane & 15, fq = lane >> 4;
    bf16x8 Bf[2][2];
#pragma unroll
    for (int mat = 0; mat < 2; ++mat)
#pragma unroll
        for (int ks = 0; ks < 2; ++ks) {
            const float* w = (mat ? a.in[I_WX] : a.in[I_WA]) + ((size_t)(head * 64 + 32 * ks + 8 * fq)) * 64 + 16 * q + fr;
            u32x4 p; p.x = cvt_pk_bf16(w[0], w[64]); p.y = cvt_pk_bf16(w[128], w[192]); p.z = cvt_pk_bf16(w[256], w[320]); p.w = cvt_pk_bf16(w[384], w[448]);
            Bf[mat][ks] = __builtin_bit_cast(bf16x8, p);
        }
    const int chn = ch0 + fr;
    const float ba = a.in[I_BA][chn], bx_ = a.in[I_BX][chn];
    const float spl = log1pf(expf(-a.in[I_LAML][chn]));
    const int cq = tid & 15, cch = 64 * head + 4 * cq, rg = tid >> 4;
    const f32x4 cw0 = *(const f32x4*)(a.in[I_CONVW] + cch), cw1 = *(const f32x4*)(a.in[I_CONVW] + DH + cch), cw2 = *(const f32x4*)(a.in[I_CONVW] + 2 * DH + cch),
                cw3 = *(const f32x4*)(a.in[I_CONVW] + 3 * DH + cch), cb = *(const f32x4*)(a.in[I_CONVB] + cch);
    const int er = tid >> 1, eh = tid & 1;
    if (!sample) {
        float hcar = 0.f;
        f32x4 xin[11]; u32x4 ggn;
        { const int R0 = b * SEQ, r0 = rg * 8;
#pragma unroll
          for (int i = 0; i < 11; ++i) { const int t = r0 + i - 3; xin[i] = (t >= 0) ? *(const f32x4*)(XL + (size_t)(R0 + t) * DH + cch) : (f32x4){0.f, 0.f, 0.f, 0.f}; }
          ggn = *(const u32x4*)(GG + (size_t)(R0 + er) * DH + ch0 + 8 * eh); }
        for (int chk = 0; chk < 8; ++chk) {
            const int R0 = b * SEQ + chk * 256, r0 = rg * 8;
#pragma unroll
            for (int rr = 0; rr < 8; ++rr) {
                const f32x4 xc = cb + cw0 * xin[rr] + cw1 * xin[rr + 1] + cw2 * xin[rr + 2] + cw3 * xin[rr + 3];
                u32x2 w; w.x = cvt_pk_bf16(xc[0], xc[1]); w.y = cvt_pk_bf16(xc[2], xc[3]);
                *(LAS u32x2*)(XC + (r0 + rr) * XC_PITCH + 8 * cq) = w;
                if ((cq >> 2) == q) *(LAS f32x4*)(XCF + (r0 + rr) * 16 + 4 * (cq & 3)) = xc;
            }
            const u32x4 gw = ggn;
            if (chk < 7) {
                const float* p = XL + (size_t)(R0 + 256 + r0 - 3) * DH + cch;
#pragma unroll
                for (int i = 0; i < 11; ++i) xin[i] = *(const f32x4*)(p + (size_t)i * DH);
                ggn = *(const u32x4*)(GG + (size_t)(R0 + 256 + er) * DH + ch0 + 8 * eh);
            }
            __syncthreads();
#pragma unroll
            for (int tt = 0; tt < 2; ++tt) {
                const int tile = 2 * wave + tt;
                f32x4 ar = (f32x4){0.f, 0.f, 0.f, 0.f}, ax = ar;
#pragma unroll
                for (int ks = 0; ks < 2; ++ks) {
                    const bf16x8 af = *(const LAS bf16x8*)(XC + (16 * tile + fr) * XC_PITCH + 64 * ks + 16 * fq);
                    ar = __builtin_amdgcn_mfma_f32_16x16x32_bf16(af, Bf[0][ks], ar, 0, 0, 0);
                    ax = __builtin_amdgcn_mfma_f32_16x16x32_bf16(af, Bf[1][ks], ax, 0, 0, 0);
                }
#pragma unroll
                for (int r4 = 0; r4 < 4; ++r4) {
                    const int rr = 16 * tile + 4 * fq + r4;
                    const float xcv = XCF[rr * 16 + fr];
                    const float rg_ = fsigmoid(ar[r4] + ba), ig = fsigmoid(ax[r4] + bx_);
                    const float la = -8.0f * rg_ * spl;
                    const float av = fexp(la); AA[rr * 16 + fr] = av; BX[rr * 16 + fr] = __builtin_amdgcn_sqrtf(fmaxf(fmaf(-av, av, 1.0f), 0.f)) * (ig * xcv);
                }
            }
            __syncthreads();
            const int sn = tid & 15, sg = tid >> 4;
            float av[8], bv[8];
            { float P = 1.f, h = 0.f;
#pragma unroll
              for (int i = 0; i < 8; ++i) { av[i] = AA[(8 * sg + i) * 16 + sn]; bv[i] = BX[(8 * sg + i) * 16 + sn]; }
#pragma unroll
              for (int i = 0; i < 8; ++i) { h = av[i] * h + bv[i]; P *= av[i]; }
              SEGP[tid] = P; SEGH[tid] = h; }
            __syncthreads();
            if (wave == 0 && lane < 16) {
                float run = hcar;
#pragma unroll 8
                for (int s2 = 0; s2 < 32; ++s2) { CAR[s2 * 16 + lane] = run; run = SEGP[s2 * 16 + lane] * run + SEGH[s2 * 16 + lane]; }
                hcar = run;
            }
            __syncthreads();
            { float h = CAR[tid];
#pragma unroll
              for (int i = 0; i < 8; ++i) { h = av[i] * h + bv[i]; BX[(8 * sg + i) * 16 + sn] = h; } }
            __syncthreads();
            {
                const size_t row = (size_t)R0 + er;
                const f32x4 h0 = *(const LAS f32x4*)(BX + er * 16 + 8 * eh), h1 = *(const LAS f32x4*)(BX + er * 16 + 8 * eh + 4);
                const f32x4 y0 = (f32x4){h0[0] * bf_lo(gw.x), h0[1] * bf_hi(gw.x), h0[2] * bf_lo(gw.y), h0[3] * bf_hi(gw.y)};
                const f32x4 y1 = (f32x4){h1[0] * bf_lo(gw.z), h1[1] * bf_hi(gw.z), h1[2] * bf_lo(gw.w), h1[3] * bf_hi(gw.w)};
                *(u32x4*)(MRG + row * D + DH + ch0 + 8 * eh) = pack8(y0, y1);
                float s = dot4(y0) + dot4(y1);
                s += __shfl_xor(s, 1);
                if (eh == 0) atomicAdd(ssq_lru + row, s);
            }
        }
        if (wave == 0 && lane < 16) a.out[O_PLRUH + (size_t)b * DH + ch0 + lane] = hcar;
        if (wave == 1 && lane < 48) { const int k = lane >> 4, n = lane & 15;
            a.out[O_PLRUC + ((size_t)b * 3 + k) * DH + ch0 + n] = XL[(size_t)(b * SEQ + SEQ - 3 + k) * DH + ch0 + n]; }
    } else {
        const int R0 = MP, bs0 = 32 * b;
        {
            const float* cbuf = a.in[I_LRUCONV];
            const int bs = bs0 + rg;
            const f32x4 x0 = *(const f32x4*)(XL + (size_t)(R0 + bs) * DH + cch);
            const f32x4 c0 = *(const f32x4*)(cbuf + ((size_t)bs * 3 + 0) * DH + cch), c1 = *(const f32x4*)(cbuf + ((size_t)bs * 3 + 1) * DH + cch), c2 = *(const f32x4*)(cbuf + ((size_t)bs * 3 + 2) * DH + cch);
            const f32x4 xc = cb + cw0 * c0 + cw1 * c1 + cw2 * c2 + cw3 * x0;
            u32x2 w; w.x = cvt_pk_bf16(xc[0], xc[1]); w.y = cvt_pk_bf16(xc[2], xc[3]);
            *(LAS u32x2*)(XC + rg * XC_PITCH + 8 * cq) = w;
            if ((cq >> 2) == q) {
                *(LAS f32x4*)(XCF + rg * 16 + 4 * (cq & 3)) = xc;
                float* oc = a.out + O_SLRUC + (size_t)bs * 3 * DH + cch;
                *(f32x4*)oc = c1; *(f32x4*)(oc + DH) = c2; *(f32x4*)(oc + 2 * DH) = x0;
            }
        }
        __syncthreads();
        if (wave < 2) {
            const int tile = wave;
            f32x4 ar = (f32x4){0.f, 0.f, 0.f, 0.f}, ax = ar;
#pragma unroll
            for (int ks = 0; ks < 2; ++ks) {
                const bf16x8 af = *(const LAS bf16x8*)(XC + (16 * tile + fr) * XC_PITCH + 64 * ks + 16 * fq);
                ar = __builtin_amdgcn_mfma_f32_16x16x32_bf16(af, Bf[0][ks], ar, 0, 0, 0);
                ax = __builtin_amdgcn_mfma_f32_16x16x32_bf16(af, Bf[1][ks], ax, 0, 0, 0);
            }
#pragma unroll
            for (int r4 = 0; r4 < 4; ++r4) {
                const int rl = 16 * tile + 4 * fq + r4, bs = bs0 + rl;
                const float xcv = XCF[rl * 16 + fr];
                const float rg_ = fsigmoid(ar[r4] + ba), ig = fsigmoid(ax[r4] + bx_);
                const float la = -8.0f * rg_ * spl;
                const float av = fexp(la); const float h = av * a.in[I_LRUH][(size_t)bs * DH + chn] + __builtin_amdgcn_sqrtf(fmaxf(fmaf(-av, av, 1.0f), 0.f)) * (ig * xcv);
                BX[rl * 16 + fr] = h; a.out[O_SLRUH + (size_t)bs * DH + chn] = h;
            }
        }
        __syncthreads();
        if (er < 32) {
            const size_t row = (size_t)R0 + bs0 + er;
            const u32x4 gw = *(const u32x4*)(GG + row * DH + ch0 + 8 * eh);
            const f32x4 h0 = *(const LAS f32x4*)(BX + er * 16 + 8 * eh), h1 = *(const LAS f32x4*)(BX + er * 16 + 8 * eh + 4);
            const f32x4 y0 = (f32x4){h0[0] * bf_lo(gw.x), h0[1] * bf_hi(gw.x), h0[2] * bf_lo(gw.y), h0[3] * bf_hi(gw.y)};
            const f32x4 y1 = (f32x4){h1[0] * bf_lo(gw.z), h1[1] * bf_hi(gw.z), h1[2] * bf_lo(gw.w), h1[3] * bf_hi(gw.w)};
            *(u32x4*)(MRG + row * D + DH + ch0 + 8 * eh) = pack8(y0, y1);
            float s = dot4(y0) + dot4(y1);
            s += __shfl_xor(s, 1);
            if (eh == 0) atomicAdd(ssq_lru + row, s);
        }
    }
    __syncthreads();
}

__global__ void __launch_bounds__(NWAVES * 64, 2) hymba_fwd(Args args) {
    extern __shared__ __attribute__((aligned(16))) unsigned char lds_raw[];
    LAS unsigned char* lds = (LAS unsigned char*)lds_raw;
    volatile LAS unsigned* MISC = (volatile LAS unsigned*)(lds + MISC_OFF);
    const int tid = threadIdx.x, lane = tid & 63, wave = __builtin_amdgcn_readfirstlane(tid >> 6);
    const int G = gridDim.x, bx = blockIdx.x;
    const int vcu = (G % 8 == 0) ? (bx % 8) * (G / 8) + bx / 8 : bx;
    unsigned char* ws = args.ws;
    unsigned* ctl = (unsigned*)(ws + WS_CTL);
    for (int u = tid; u < (LDS_BYTES - LDSCTL_OFF) / 4; u += NWAVES * 64) ((LAS unsigned*)(lds + LDSCTL_OFF))[u] = 0u;
    __syncthreads();
    XcdBarrier bar; bar.bar = ctl + CW_BAR; bar.x = 0; bar.st = nullptr;
    if (MK_N_LAUNCHES == 1) bar = xcd_barrier_post(ctl + CW_BAR, MISC + 8);
#define GRID_BAR() do { if (MK_N_LAUNCHES == 1) xcd_barrier(bar); } while (0)
#define STAMP(k) do { if (PROBE_PHASE >= 0 && bx == 0 && tid == 0) { const unsigned long long now_ = __builtin_amdgcn_s_memrealtime(); \
        const unsigned long long prev_ = ((unsigned long long)MISC[17] << 32) | MISC[16]; if ((k) == PROBE_PHASE) { const unsigned long long d_ = now_ - prev_; MISC[18] = (unsigned)d_; } \
        MISC[16] = (unsigned)now_; MISC[17] = (unsigned)(now_ >> 32); } } while (0)
    STAMP(-1);
    const int lo = args.ph_lo, hi = args.ph_hi;
#define IN(k) (lo <= (k) && (k) < hi)
#define BOTH(k) (IN(k) && IN((k) + 1))
    float* ssq = (float*)(ws + WS_CTL + CTL_SSQ_BYTE);
    float *ssq0 = ssq, *ssq1 = ssq + MPAD, *ssq_s5 = ssq + 2 * MPAD, *ssq_lru = ssq + 3 * MPAD, *ssq2 = ssq + 4 * MPAD, *ssq3 = ssq + 5 * MPAD;
    bf16_t* XB = (bf16_t*)(ws + WS_XB); float* X1 = (float*)(ws + WS_X1); bf16_t* HID = (bf16_t*)(ws + WS_H);
    bf16_t* U = (bf16_t*)(ws + WS_U); float* XL = (float*)(ws + WS_XLRU); bf16_t* GG = (bf16_t*)(ws + WS_GG); bf16_t* MRG = (bf16_t*)(ws + WS_MRG);
    float* SLAB = (float*)(ws + WS_SLAB); float* SLAB5 = (float*)(ws + WS_U);
    const int gws = wave * G + bx;

    unsigned* cnt_fin2 = ctl + CW_CNT; unsigned* cnt_fin5 = ctl + CW_CNT + 64;
#define PUBLISH(cnt) do { asm volatile("s_waitcnt vmcnt(0)" ::: "memory"); __builtin_amdgcn_fence(__ATOMIC_RELEASE, "agent"); asm volatile("s_waitcnt vmcnt(0)" ::: "memory"); \
        if (lane == 0) __hip_atomic_fetch_add((cnt), 1u, __ATOMIC_RELAXED, __HIP_MEMORY_SCOPE_AGENT); } while (0)

    if (IN(0)) { p0_prologue(args, lds, vcu, G, lane, wave); if (BOTH(0)) GRID_BAR(); STAMP(0); }
    if (IN(1)) {
        constexpr int GG1 = 242;
        if (bx < GG1) {
            pg8::Gemm g{XB, (const bf16_t*)(ws + WS_W13A), D, D}; pg8::PanelOrder S; S.init(2 * FF / 256, D / 64, D / 64, GG1, bx);
            pg8::EpiSwiGLU E{HID, ssq0};
            pg8::gemm_phase(lds, g, S, E);
        } else {
            for (int gj = bx - GG1; gj < NG; gj += G - GG1) p0_s5_group(args, lds, gj, tid);
        }
        if (BOTH(1)) GRID_BAR();
        STAMP(1);
    }
    if (IN(2)) {
        pg8::Gemm g{HID, (const bf16_t*)(ws + WS_W2A), FF, FF}; pg8::PanelOrder S; S.init(D / 256, FF / 64, 8, G, bx);
        pg8::EpiResid E{SLAB, XB, ssq1};
        pg8::gemm_phase(lds, g, S, E);
        if (bx >= 88) conv_tasks(args, lds + wave * STG_BYTES, 4, 5, (bx - 88) * NWAVES + wave, (G - 88) * NWAVES, lane);
        if (BOTH(2)) GRID_BAR();
        STAMP(2);
    }
    if (IN(3)) {
        constexpr int GG3 = 198;
        { const int r = (bx >= GG3 && wave < 3) ? (bx - GG3) + (G - GG3) * wave : MS;
          if (r < MS) {
            const int row = MP + r;
            const f32x4* xr = (const f32x4*)(args.in[I_XS] + (size_t)r * D) + lane; f32x4 v[8]; float sq = 0.f;
#pragma unroll
            for (int j = 0; j < 8; ++j) { f32x4 t = (f32x4){0.f, 0.f, 0.f, 0.f};
#pragma unroll
                for (int sl = 0; sl < 11; ++sl) t += ((const f32x4*)(SLAB + ((size_t)sl * MS + r) * D) + lane)[64 * j];
                v[j] = xr[64 * j] + 0.5f * t; sq += dot4(v[j]); }
            sq = wave_sum(sq);
#pragma unroll
            for (int j = 0; j < 8; ++j) { ((f32x4*)(X1 + (size_t)row * D) + lane)[64 * j] = v[j];
                u32x2 w; w.x = cvt_pk_bf16(v[j][0], v[j][1]); w.y = cvt_pk_bf16(v[j][2], v[j][3]); ((u32x2*)(XB + (size_t)row * D) + lane)[64 * j] = w; }
            if (lane == 0) ssq1[row] = sq;
            PUBLISH(cnt_fin2);
          } }
        if (bx < GG3) {
            pg8::Gemm g{XB, (const bf16_t*)(ws + WS_WIN), D, D}; pg8::PanelOrder S; S.init(DIN / 256, D / 64, D / 64, GG3, bx); S.ready = cnt_fin2; S.need = MS;
            pg8::EpiProj E{U, XL, GG, ssq1};
            pg8::gemm_phase(lds, g, S, E);
        } else conv_tasks(args, lds + wave * STG_BYTES, 6, 7, (bx - GG3) * NWAVES + wave, (G - GG3) * NWAVES, lane);
        if (BOTH(3)) GRID_BAR();
        STAMP(3);
    }
    if (IN(4)) {
        { bf16_t* GS5 = (bf16_t*)(ws + WS_GS5); const int gw = bx * NWAVES + wave, NGW = G * NWAVES;
          for (int m = M + gw; m < MPAD; m += NGW) {
              ((u32x4*)(GS5 + (size_t)m * DH))[lane] = (u32x4){0u, 0u, 0u, 0u}; ((u32x4*)(GS5 + (size_t)m * DH))[64 + lane] = (u32x4){0u, 0u, 0u, 0u};
              ((u32x4*)(MRG + (size_t)m * D + DH))[lane] = (u32x4){0u, 0u, 0u, 0u}; ((u32x4*)(MRG + (size_t)m * D + DH))[64 + lane] = (u32x4){0u, 0u, 0u, 0u}; } }
        for (int it = bx; it < NB * NG; it += G) { const int b = it >> 6, g = ((it & 7) << 3) | ((it >> 3) & 7); s5_prompt(args, lds, b, g, tid, lane, wave); }
        STAMP(20);
        for (int it = bx; it < 4 * NG; it += G) s5_sample(args, lds, it >> 2, 32 * (it & 3), tid);
        STAMP(21);
        for (int it = bx; it < NB * 64; it += G) lru_item(args, lds, false, it >> 6, ((it & 7) << 1) | ((it >> 5) & 1), (it >> 3) & 3, tid, lane, wave);
        STAMP(22);
        if (BOTH(4)) GRID_BAR();
        STAMP(4);
    }
    if (IN(5)) {
        pg8::Gemm g{(const bf16_t*)(ws + WS_GS5), (const bf16_t*)(ws + WS_WGLU), DH, DH}; pg8::PanelOrder S; S.init(DH / 256, DH / 64, DH / 64, G, bx);
        pg8::EpiGlu E{(const bf16_t*)(ws + WS_GS5), args.in[I_BGLU], MRG, ssq_s5};
        pg8::gemm_phase(lds, g, S, E);
        if (bx >= 132) for (int it = bx - 132; it < 256; it += G - 132) lru_item(args, lds, true, it & 3, it >> 4, (it >> 2) & 3, tid, lane, wave);
        if (BOTH(5)) GRID_BAR();
        STAMP(5);
    }
    if (IN(6)) {
        pg8::Gemm g{MRG, (const bf16_t*)(ws + WS_WOUT), D, D}; pg8::PanelOrder S; S.init(D / 256, D / 64, D / 64, G, bx); S.nExtra = 0;
        pg8::EpiOut E{ssq_s5, ssq_lru, XB, ssq2, nullptr};
        pg8::gemm_phase(lds, g, S, E);
        if (BOTH(6)) GRID_BAR();
        STAMP(6);
    }
    if (IN(7)) {
        constexpr int GG7 = 242;
        if (bx >= GG7) {
            pg8::Gemm g{MRG, (const bf16_t*)(ws + WS_WOUT), D, D}; pg8::PanelOrder S; S.init(D / 256, D / 64, D / 64, 8, bx - GG7); S.nwgP = 0;
            pg8::EpiOut E{ssq_s5, ssq_lru, XB, ssq2, nullptr};
            pg8::gemm_phase(lds, g, S, E);
            if (bx - GG7 < 8) { asm volatile("s_waitcnt vmcnt(0)" ::: "memory"); __syncthreads();
                if (tid == 0) { __builtin_amdgcn_fence(__ATOMIC_RELEASE, "agent"); asm volatile("s_waitcnt vmcnt(0)" ::: "memory"); __hip_atomic_fetch_add(cnt_fin5, 1u, __ATOMIC_RELAXED, __HIP_MEMORY_SCOPE_AGENT); } }
        }
        if (bx < GG7) {
            pg8::Gemm g{XB, (const bf16_t*)(ws + WS_W13B), D, D}; pg8::PanelOrder S; S.init(2 * FF / 256, D / 64, D / 64, GG7, bx); S.ready = cnt_fin5; S.need = 8;
            pg8::EpiSwiGLU E{HID, ssq2};
            pg8::gemm_phase(lds, g, S, E);
        } else conv_tasks(args, lds + wave * STG_BYTES, 8, 8, (bx - GG7) * NWAVES + wave, (G - GG7) * NWAVES, lane);
        if (BOTH(7)) GRID_BAR();
        STAMP(7);
    }
    if (IN(8)) {
        pg8::Gemm g{HID, (const bf16_t*)(ws + WS_W2B), FF, FF}; pg8::PanelOrder S; S.init(D / 256, FF / 64, 8, G, bx);
        pg8::EpiFinal E{XB, ssq3, SLAB};
        pg8::gemm_phase(lds, g, S, E);
        if (BOTH(8)) GRID_BAR();
        STAMP(8);
    }
    if (IN(9)) {
        const f32x4* gf = (const f32x4*)args.in[I_GFINAL] + lane;
        if (gws < MS) {
            const int row = MP + gws; f32x4 v[8]; float sq = 0.f;
#pragma unroll
            for (int j = 0; j < 8; ++j) { f32x4 t = (f32x4){0.f, 0.f, 0.f, 0.f};
#pragma unroll
                for (int sl = 0; sl < 11; ++sl) t += ((const f32x4*)(SLAB + ((size_t)sl * MS + gws) * D) + lane)[64 * j];
                const u32x2 xw = ((const u32x2*)(XB + (size_t)row * D) + lane)[64 * j];
                v[j] = (f32x4){bf_lo(xw.x), bf_hi(xw.x), bf_lo(xw.y), bf_hi(xw.y)} + 0.5f * t; sq += dot4(v[j]); }
            const float r = rsqrtf(wave_sum(sq) * (1.0f / D) + EPS);
#pragma unroll
            for (int j = 0; j < 8; ++j) ((f32x4*)(args.out + (size_t)row * D) + lane)[64 * j] = v[j] * gf[64 * j] * r;
        }
        const int gw = bx * NWAVES + wave, NGW = G * NWAVES;
        for (int m = gw; m < MP; m += NGW) {
            const float r = rsqrtf(ssq3[m] * (1.0f / D) + EPS);
            const u32x4* xb = (const u32x4*)(XB + (size_t)m * D) + lane;
            f32x4* o = (f32x4*)(args.out + (size_t)m * D) + 2 * lane;
            const f32x4* g2 = (const f32x4*)args.in[I_GFINAL] + 2 * lane;
            u32x4 w[4];
#pragma unroll
            for (int j = 0; j < 4; ++j) w[j] = xb[64 * j];
#pragma unroll
            for (int j = 0; j < 4; ++j) { o[128 * j] = pg8::res_lo(w[j]) * g2[128 * j] * r; o[128 * j + 1] = pg8::res_hi(w[j]) * g2[128 * j + 1] * r; }
        }
    }
    if (PROBE_PHASE >= 0 && bx == 0 && tid == 0) {
        STAMP(9);
        const unsigned long long t0_ = __builtin_amdgcn_s_memrealtime(), d_ = 4ull * MISC[18];
        while (__builtin_amdgcn_s_memrealtime() - t0_ < d_) __builtin_amdgcn_s_sleep(8);
    }
#undef IN
#undef BOTH
#undef GRID_BAR
}

extern "C" void kernel_launch(void* const* d_in, const int* in_sizes, int n_in, void* d_out, int out_size, void* d_ws, size_t ws_size, hipStream_t stream) {
    static int grid = 0;
    if (grid == 0) {
        if (n_in != N_IN || in_sizes[0] != MP * D || (size_t)out_size != O_END || ws_size < WS_END) {
            fprintf(stderr, "kernel_launch: unexpected problem: n_in %d in0 %d out %d ws %zu (need %zu)\n", n_in, n_in > 0 ? in_sizes[0] : -1, out_size, ws_size, (size_t)WS_END); grid = -1; return; }
        int dev = 0, cus = 0;
        if (hipGetDevice(&dev) != hipSuccess || hipDeviceGetAttribute(&cus, hipDeviceAttributeMultiprocessorCount, dev) != hipSuccess) { grid = -1; return; }
        if (hipFuncSetAttribute((const void*)hymba_fwd, hipFuncAttributeMaxDynamicSharedMemorySize, LDS_BYTES) != hipSuccess) { fprintf(stderr, "kernel_launch: hipFuncSetAttribute failed\n"); grid = -1; return; }
        int per_cu = 0;
        if (hipOccupancyMaxActiveBlocksPerMultiprocessor(&per_cu, (const void*)hymba_fwd, NWAVES * 64, LDS_BYTES) != hipSuccess || per_cu < 1)
            fprintf(stderr, "kernel_launch: note: occupancy query reports %d workgroups per CU\n", per_cu);
        (void)hipGetLastError();
        grid = cus;
    }
    if (grid < 0) return;
    if (hipMemsetAsync((char*)d_ws + WS_CTL, 0, CTL_ZERO_BYTES, stream) != hipSuccess) { fprintf(stderr, "kernel_launch: memset failed\n"); return; }
    Args a{};
    for (int i = 0; i < N_IN; ++i) a.in[i] = (const float*)d_in[i];
    a.out = (float*)d_out; a.ws = (unsigned char*)d_ws;
    if (MK_N_LAUNCHES == 1) {
        a.ph_lo = 0; a.ph_hi = NPHASE;
        hipLaunchKernelGGL(hymba_fwd, dim3(grid), dim3(NWAVES * 64), LDS_BYTES, stream, a);
    } else {
        for (int p = 0; p < NPHASE; ++p) { a.ph_lo = p; a.ph_hi = p + 1; hipLaunchKernelGGL(hymba_fwd, dim3(grid), dim3(NWAVES * 64), LDS_BYTES, stream, a); }
    }
}
```

```cpp
#include <hip/hip_runtime.h>
#include <cstdio>
#include <cstdint>

#define LAS __attribute__((address_space(3)))
#define GAS __attribute__((address_space(1)))
typedef unsigned short bf16_t;
typedef short bf16x8 __attribute__((ext_vector_type(8)));
typedef float f32x4 __attribute__((ext_vector_type(4)));
typedef float f32x16 __attribute__((ext_vector_type(16)));
typedef unsigned u32x4 __attribute__((ext_vector_type(4)));
typedef unsigned u32x2 __attribute__((ext_vector_type(2)));

#ifndef PROBE_PHASE
#define PROBE_PHASE -1
#endif
#ifndef MK_N_LAUNCHES
#define MK_N_LAUNCHES 1
#endif

constexpr int D = 2048, FF = 5632, DIN = 3072, DH = 1024;
constexpr int MP = 8192, MS = 128, M = MP + MS, MPAD = 8448;
constexpr int SEQ = 2048, NB = 4, NG = 64, NP = 64, GS = 16;
constexpr float EPS = 1e-6f;
constexpr int NPHASE = 10;
constexpr int NMP = MP / 256;
constexpr int NWAVES = 8;

constexpr size_t MiB = 1u << 20;
constexpr size_t WS_CTL = 0, CTL_ZERO_BYTES = 1 * MiB;
constexpr size_t WS_W13A = 1 * MiB, WS_W2A = 45 * MiB, WS_WIN = 67 * MiB, WS_WGLU = 79 * MiB, WS_WOUT = 81 * MiB, WS_W13B = 89 * MiB, WS_W2B = 133 * MiB;
constexpr size_t WS_S5M = 155 * MiB, WS_S5AUX = 171 * MiB;
constexpr size_t WS_XB = 172 * MiB;
constexpr size_t WS_X1 = 205 * MiB;
constexpr size_t WS_GS5 = WS_X1;
constexpr size_t WS_H = 271 * MiB;
constexpr size_t WS_U = 271 * MiB, WS_XLRU = WS_U + (size_t)MPAD * DH * 2, WS_GG = WS_XLRU + (size_t)MPAD * DH * 4, WS_MRG = WS_GG + (size_t)MPAD * DH * 2;
constexpr size_t WS_SLAB = 362 * MiB;
constexpr size_t WS_END = 373 * MiB;
static_assert(WS_MRG + (size_t)MPAD * D * 2 <= WS_END && WS_H + (size_t)MPAD * FF * 2 <= WS_SLAB && WS_SLAB + (size_t)11 * MS * D * 4 <= WS_END, "ws map");
constexpr int S5M_GROUP_BYTES = 256 * 1024;
constexpr int S5AUX_GROUP_FLOATS = 2304;
constexpr int CW_BAR = 4096;
constexpr int CW_CNT = 8192;
constexpr size_t CTL_SSQ_BYTE = 262144;

constexpr int RING_BYTES = 139264;
constexpr int LDSCTL_OFF = RING_BYTES, MISC_OFF = LDSCTL_OFF + 320;
constexpr int LDS_BYTES = 147456;

__device__ __forceinline__ unsigned cvt_pk_bf16(float lo, float hi) { unsigned r; asm volatile("v_cvt_pk_bf16_f32 %0, %1, %2" : "=v"(r) : "v"(lo), "v"(hi)); return r; }
__device__ __forceinline__ float bf_lo(unsigned w) { return __uint_as_float(w << 16); }
__device__ __forceinline__ float bf_hi(unsigned w) { return __uint_as_float(w & 0xffff0000u); }
__device__ __forceinline__ float fexp(float x) { return __builtin_amdgcn_exp2f(x * 1.44269504089f); }
__device__ __forceinline__ float fsigmoid(float x) { return __builtin_amdgcn_rcpf(1.0f + fexp(-x)); }
__device__ __forceinline__ float fsilu(float x) { return x * fsigmoid(x); }
__device__ __forceinline__ float fgelu(float x) { return x * fsigmoid(1.5957691216057308f * (x + 0.044715f * x * x * x)); }
__device__ __forceinline__ u32x4 pack8(const f32x4 a, const f32x4 b) { u32x4 w; w.x = cvt_pk_bf16(a[0], a[1]); w.y = cvt_pk_bf16(a[2], a[3]); w.z = cvt_pk_bf16(b[0], b[1]); w.w = cvt_pk_bf16(b[2], b[3]); return w; }
__device__ __forceinline__ float dot4(const f32x4 a) { return (a[0] * a[0] + a[1] * a[1]) + (a[2] * a[2] + a[3] * a[3]); }
__device__ __forceinline__ float wave_sum(float v) {
#pragma unroll
    for (int o = 1; o < 64; o <<= 1) v += __shfl_xor(v, o);
    return v;
}
__device__ __forceinline__ float neg_expm1(float x) {
    float p = 1.0f / 5040.0f; p = fmaf(p, x, 1.0f / 720.0f); p = fmaf(p, x, 1.0f / 120.0f); p = fmaf(p, x, 1.0f / 24.0f); p = fmaf(p, x, 1.0f / 6.0f); p = fmaf(p, x, 0.5f); p = fmaf(p, x, 1.0f);
    const float small = -(p * x), big = 1.0f - fexp(x);
    return x > -0.35f ? small : big;
}
#define LDS_WAIT() asm volatile("s_waitcnt lgkmcnt(0)" ::: "memory")
#define VM_WAIT() asm volatile("s_waitcnt vmcnt(0)" ::: "memory")

namespace pg8 {
constexpr int BM = 256, BK = 64, HALF = 128, HTB = HALF * BK * 2, STAGE_BYTES = 8 * HTB, NXCD = 8, WGM = 8;
__host__ __device__ __forceinline__ int lds_byte(int r, int c) { const int st = (r >> 4) * 2 + (c >> 5), rr = r & 15, cc = c & 31, ob = rr * 64 + cc * 2; return st * 1024 + (ob ^ (((ob >> 9) & 1) << 5)); }
__host__ __device__ __forceinline__ void stage_rc(int b, int& R, int& C) { const int st = b / 1024, sb = b % 1024, swz = sb ^ (((sb >> 9) & 1) << 5); R = (st >> 1) * 16 + swz / 64; C = (st & 1) * 32 + (swz % 64) / 2; }
__host__ __device__ __forceinline__ int perm32(int rho) { const int n = rho >> 4, i = rho & 15; return 8 * (i >> 2) + 4 * n + (i & 3); }

struct Unit { int pm, pn, kt0, nkt; };
struct Gemm { const bf16_t* A; const bf16_t* Bt; int lda, ldb; };

struct PanelOrder {
    int nN, nwgP, G, c, nktFull, sliceKt, nExtra;
    unsigned* ready; unsigned need;
    __device__ void init(int nN_, int nktFull_, int sliceKt_, int G_, int c_) { nN = nN_; nwgP = 32 * nN_; G = G_; c = c_; nktFull = nktFull_; sliceKt = sliceKt_; nExtra = nN_ * (nktFull_ / sliceKt_); ready = nullptr; need = 0u; }
    __device__ __forceinline__ void a_ready(const Unit& u) const {
        if (ready == nullptr || u.pm != 32) return;
        if (threadIdx.x < 64) {
            unsigned polls = 0;
            while ((unsigned)__builtin_amdgcn_readfirstlane(__hip_atomic_load(ready, __ATOMIC_RELAXED, __HIP_MEMORY_SCOPE_AGENT)) < need) { __builtin_amdgcn_s_sleep(2); if (++polls > (1u << 22)) break; }
            __builtin_amdgcn_fence(__ATOMIC_ACQUIRE, "agent");
            asm volatile("s_waitcnt vmcnt(0)" ::: "memory");
        }
        asm volatile("" ::: "memory"); __builtin_amdgcn_s_barrier(); asm volatile("" ::: "memory");
    }
    __device__ bool next(int i, Unit& u) const {
        const long L = (long)i * G + c;
        if (L < nwgP) {
            int wgid = (int)L; { const int q = nwgP / NXCD, r = nwgP % NXCD, xcd = wgid % NXCD, off = wgid / NXCD; wgid = (xcd < r ? xcd * (q + 1) : r * (q + 1) + (xcd - r) * q) + off; }
            const int nig = WGM * nN, gid = wgid / nig, fm = gid * WGM, gsz = (32 - fm) < WGM ? (32 - fm) : WGM;
            u.pm = fm + ((wgid % nig) % gsz); u.pn = (wgid % nig) / gsz; u.kt0 = 0; u.nkt = nktFull; return true;
        }
        const int e = (int)(L - nwgP); if (e >= nExtra) return false;
        u.pm = 32; u.pn = e % nN; u.kt0 = (e / nN) * sliceKt; u.nkt = sliceKt; return true;
    }
};

template <class Epi, class Sched>
__device__ __forceinline__ void gemm_phase(LAS unsigned char* lds, const Gemm g, const Sched& S, const Epi& E) {
    const int tid = threadIdx.x, wid = __builtin_amdgcn_readfirstlane(tid >> 6), lane = tid & 63, wr = wid >> 2, wc = wid & 3, fr = lane & 15, fq = lane >> 4;
    unsigned voffA[2], voffB[2];
#pragma unroll
    for (int i = 0; i < 2; ++i) { int R, C; stage_rc(tid * 16 + i * 8192, R, C); const int Rb = Epi::PERM ? ((R & ~31) + perm32(R & 31)) : R;
        voffA[i] = (unsigned)(R * g.lda + C) * 2u; voffB[i] = (unsigned)(Rb * g.ldb + C) * 2u; }
    const size_t kstep = (size_t)(BK * 2);
    const size_t hstepA = (size_t)HALF * g.lda * 2, hstepB = (size_t)HALF * g.ldb * 2;
    const size_t tstepA = 2 * hstepA, tstepB = 2 * hstepB;
    const unsigned ldsw = (unsigned)wid * 1024u;
    const int aoff = lds_byte(wr * 64 + fr, fq * 8), boff = lds_byte(wc * 32 + fr, fq * 8);
#define PG8_SA(b, h) (((b) * 2 + (h)) * HTB)
#define PG8_SB(b, h) ((4 + (b) * 2 + (h)) * HTB)
#define PG8_STAGE(bufoff, gbase, voff) do { _Pragma("unroll") for (int _i = 0; _i < 2; ++_i) \
        __builtin_amdgcn_global_load_lds((const unsigned*)((const char*)(gbase) + (voff)[_i]), (LAS unsigned*)(lds + (bufoff) + ldsw + _i * 8192), 16, 0, 0); } while (0)
#define PG8_LDA(dst, b, h) do { _Pragma("unroll") for (int m = 0; m < 4; ++m) _Pragma("unroll") for (int k = 0; k < 2; ++k) dst[m][k] = *(const LAS bf16x8*)(lds + PG8_SA(b, h) + aoff + m * 2048 + k * 1024); } while (0)
#define PG8_LDB(dst, b, h) do { _Pragma("unroll") for (int n = 0; n < 2; ++n) _Pragma("unroll") for (int k = 0; k < 2; ++k) dst[n][k] = *(const LAS bf16x8*)(lds + PG8_SB(b, h) + boff + n * 2048 + k * 1024); } while (0)
#define PG8_MMA(ai, bj, At, Bt) do { __builtin_amdgcn_s_setprio(1); _Pragma("unroll") for (int m = 0; m < 4; ++m) _Pragma("unroll") for (int n = 0; n < 2; ++n) _Pragma("unroll") for (int k = 0; k < 2; ++k) \
        acc[ai][bj][m][n] = __builtin_amdgcn_mfma_f32_16x16x32_bf16(Bt[n][k], At[m][k], acc[ai][bj][m][n], 0, 0, 0); __builtin_amdgcn_s_setprio(0); } while (0)
#define PG8_WAIT_V(n) asm volatile("s_waitcnt vmcnt(" #n ")" ::: "memory")
#define PG8_WAIT_L(n) asm volatile("s_waitcnt lgkmcnt(" #n ")" ::: "memory")
#define PG8_BAR __builtin_amdgcn_s_barrier()
#define PG8_SCHED __builtin_amdgcn_sched_barrier(0)
    Unit cur, nxt; int ui = 0;
    if (!S.next(0, cur)) return;
    f32x4 acc[2][2][4][2];
#pragma unroll
    for (int a = 0; a < 2; ++a)
#pragma unroll
        for (int b = 0; b < 2; ++b)
#pragma unroll
            for (int m = 0; m < 4; ++m)
#pragma unroll
                for (int n = 0; n < 2; ++n) acc[a][b][m][n] = (f32x4){0.f, 0.f, 0.f, 0.f};
    bf16x8 At[4][2], B0[2][2], B1[2][2];
    const char* cA = (const char*)g.A + (size_t)cur.pm * tstepA + (size_t)cur.kt0 * kstep;
    const char* cB = (const char*)g.Bt + (size_t)cur.pn * tstepB + (size_t)cur.kt0 * kstep;
    S.a_ready(cur);
    PG8_STAGE(PG8_SB(0, 0), cB, voffB); PG8_STAGE(PG8_SB(0, 1), cB + hstepB, voffB); PG8_STAGE(PG8_SA(0, 0), cA, voffA); PG8_STAGE(PG8_SA(0, 1), cA + hstepA, voffA);
    if (wr == 1) PG8_BAR;
    PG8_WAIT_V(2); PG8_BAR;
    PG8_STAGE(PG8_SB(1, 0), cB + kstep, voffB); PG8_STAGE(PG8_SA(1, 0), cA + kstep, voffA); PG8_STAGE(PG8_SB(1, 1), cB + hstepB + kstep, voffB);
    PG8_WAIT_V(6); PG8_BAR;
    for (;;) {
        const bool has_next = S.next(ui + 1, nxt);
        const char* nA = has_next ? (const char*)g.A + (size_t)nxt.pm * tstepA + (size_t)nxt.kt0 * kstep : cA;
        const char* nB = has_next ? (const char*)g.Bt + (size_t)nxt.pn * tstepB + (size_t)nxt.kt0 * kstep : cB;
        const int nt = cur.nkt;
        for (int t = 0; t < nt; t += 2) {
            const bool last = (t == nt - 2);
            if (last && has_next) S.a_ready(nxt);
            const char* a1 = cA + (size_t)(t + 1) * kstep;
            const char* a2 = last ? nA : cA + (size_t)(t + 2) * kstep; const char* b2 = last ? nB : cB + (size_t)(t + 2) * kstep;
            const char* a3 = a2 + kstep; const char* b3 = b2 + kstep;
            if constexpr (Epi::HAS_MID) { if (t == Epi::MID_T) E.mid(acc, cur, wr, wc, fr, fq); }
            PG8_LDB(B0, 0, 0); PG8_LDB(B1, 0, 1); PG8_SCHED; PG8_LDA(At, 0, 0); PG8_STAGE(PG8_SA(1, 1), a1 + hstepA, voffA);
            PG8_WAIT_V(8); PG8_WAIT_L(0); PG8_BAR; PG8_MMA(0, 0, At, B0); PG8_MMA(0, 1, At, B1); PG8_BAR; PG8_SCHED;
            PG8_LDA(At, 0, 1); PG8_STAGE(PG8_SB(0, 0), b2, voffB); PG8_STAGE(PG8_SB(0, 1), b2 + hstepB, voffB); PG8_STAGE(PG8_SA(0, 0), a2, voffA);
            PG8_WAIT_V(8); PG8_WAIT_L(0); PG8_BAR; PG8_MMA(1, 0, At, B0); PG8_MMA(1, 1, At, B1); PG8_BAR; PG8_SCHED;
            PG8_LDB(B0, 1, 0); PG8_LDB(B1, 1, 1); PG8_SCHED; PG8_LDA(At, 1, 0); PG8_STAGE(PG8_SA(0, 1), a2 + hstepA, voffA);
            PG8_WAIT_V(8); PG8_WAIT_L(0); PG8_BAR; PG8_MMA(0, 0, At, B0); PG8_MMA(0, 1, At, B1); PG8_BAR; PG8_SCHED;
            PG8_LDA(At, 1, 1); PG8_STAGE(PG8_SB(1, 0), b3, voffB); PG8_STAGE(PG8_SB(1, 1), b3 + hstepB, voffB); PG8_STAGE(PG8_SA(1, 0), a3, voffA);
            PG8_WAIT_V(8); PG8_WAIT_L(0); PG8_BAR; PG8_MMA(1, 0, At, B0); PG8_MMA(1, 1, At, B1); PG8_BAR; PG8_SCHED;
        }
        if (wr == 0) PG8_BAR;
        E(acc, cur, wr, wc, fr, fq);
        if (!has_next) break;
#pragma unroll
        for (int a = 0; a < 2; ++a)
#pragma unroll
            for (int b = 0; b < 2; ++b)
#pragma unroll
                for (int m = 0; m < 4; ++m)
#pragma unroll
                    for (int n = 0; n < 2; ++n) acc[a][b][m][n] = (f32x4){0.f, 0.f, 0.f, 0.f};
        cur = nxt; cA = nA; cB = nB; ++ui;
        if (wr == 1) PG8_BAR;
    }
    PG8_WAIT_V(0);
    PG8_BAR;
#undef PG8_SA
#undef PG8_SB
#undef PG8_STAGE
#undef PG8_LDA
#undef PG8_LDB
#undef PG8_MMA
#undef PG8_WAIT_V
#undef PG8_WAIT_L
#undef PG8_BAR
#undef PG8_SCHED
}


typedef f32x4 Acc[2][2][4][2];
__device__ __forceinline__ void slab_store(const Acc& acc, const Unit& u, float* slab, int wr, int wc, int fr, int fq) {
    int rowl = wr * 64 + fr, col0 = u.pn * BM + wc * 32 + 8 * fq; asm volatile("" : "+v"(rowl), "+v"(col0));
    float* base = slab + (size_t)(u.kt0 / u.nkt) * ((size_t)MS * D);
#pragma unroll
    for (int m = 0; m < 4; ++m)
#pragma unroll
        for (int bj = 0; bj < 2; ++bj) { float* p = base + (size_t)(rowl + m * 16) * D + col0 + bj * HALF; *(f32x4*)p = acc[0][bj][m][0]; *(f32x4*)(p + 4) = acc[0][bj][m][1]; }
}
struct EpiSwiGLU {
    static constexpr bool PERM = true, HAS_MID = false; static constexpr int MID_T = -1;
    bf16_t* O; const float* ssq;
    __device__ __forceinline__ void mid(Acc&, const Unit&, int, int, int, int) const {}
    __device__ __forceinline__ void operator()(const Acc& acc, const Unit& u, int wr, int wc, int fr, int fq) const {
        int row0 = u.pm * BM + wr * 64 + fr, colh = u.pn * 128 + wc * 32 + 8 * fq; asm volatile("" : "+v"(row0), "+v"(colh));
        float sq[2][4];
#pragma unroll
        for (int ai = 0; ai < 2; ++ai)
#pragma unroll
            for (int m = 0; m < 4; ++m) sq[ai][m] = ssq[row0 + ai * HALF + m * 16];
        asm volatile("" ::: "memory");
#pragma unroll
        for (int ai = 0; ai < 2; ++ai)
#pragma unroll
            for (int m = 0; m < 4; ++m) {
                const int row = row0 + ai * HALF + m * 16;
                const float r = rsqrtf(sq[ai][m] * (1.0f / D) + EPS);
                f32x4 h0, h1;
#pragma unroll
                for (int j = 0; j < 4; ++j) { h0[j] = fsilu(acc[ai][0][m][0][j] * r) * (acc[ai][1][m][0][j] * r); h1[j] = fsilu(acc[ai][0][m][1][j] * r) * (acc[ai][1][m][1][j] * r); }
                *(u32x4*)(O + (size_t)row * FF + colh) = pack8(h0, h1);
            }
    }
};
typedef u32x4 ResTile[2][4][2];
typedef u32x4 ResHalf[4][2];
__device__ __forceinline__ void res_load(ResTile& res, const bf16_t* XB, int row0, int col0) {
#pragma unroll
    for (int ai = 0; ai < 2; ++ai)
#pragma unroll
        for (int m = 0; m < 4; ++m)
#pragma unroll
            for (int bj = 0; bj < 2; ++bj) res[ai][m][bj] = *(const u32x4*)(XB + (size_t)(row0 + ai * HALF + m * 16) * D + col0 + bj * HALF);
    asm volatile("" ::: "memory");
}
__device__ __forceinline__ void res_load_half(ResHalf& res, const bf16_t* XB, int rowh, int col0) {
#pragma unroll
    for (int m = 0; m < 4; ++m)
#pragma unroll
        for (int bj = 0; bj < 2; ++bj) res[m][bj] = *(const u32x4*)(XB + (size_t)(rowh + m * 16) * D + col0 + bj * HALF);
    asm volatile("" ::: "memory");
}
__device__ __forceinline__ f32x4 res_lo(const u32x4 w) { return (f32x4){bf_lo(w.x), bf_hi(w.x), bf_lo(w.y), bf_hi(w.y)}; }
__device__ __forceinline__ f32x4 res_hi(const u32x4 w) { return (f32x4){bf_lo(w.z), bf_hi(w.z), bf_lo(w.w), bf_hi(w.w)}; }
struct EpiResid {
    static constexpr bool PERM = true, HAS_MID = false; static constexpr int MID_T = -1;
    float* slab; bf16_t* XB; float* ssq;
    __device__ __forceinline__ void mid(Acc&, const Unit&, int, int, int, int) const {}
    __device__ __forceinline__ void operator()(const Acc& acc, const Unit& u, int wr, int wc, int fr, int fq) const {
        if (u.pm == 32) { slab_store(acc, u, slab, wr, wc, fr, fq); return; }
        int row0 = u.pm * BM + wr * 64 + fr, col0 = u.pn * BM + wc * 32 + 8 * fq; asm volatile("" : "+v"(row0), "+v"(col0));
#pragma unroll
        for (int ai = 0; ai < 2; ++ai) {
            ResHalf res; res_load_half(res, XB, row0 + ai * HALF, col0);
#pragma unroll
            for (int m = 0; m < 4; ++m) {
                const int row = row0 + ai * HALF + m * 16;
                float s = 0.f;
#pragma unroll
                for (int bj = 0; bj < 2; ++bj) {
                    const f32x4 v0 = res_lo(res[m][bj]) + 0.5f * acc[ai][bj][m][0], v1 = res_hi(res[m][bj]) + 0.5f * acc[ai][bj][m][1];
                    *(u32x4*)(XB + (size_t)row * D + col0 + bj * HALF) = pack8(v0, v1);
                    s += dot4(v0) + dot4(v1);
                }
                s += __shfl_xor(s, 16); s += __shfl_xor(s, 32);
                if (fq == 0) atomicAdd(ssq + row, s);
            }
        }
    }
};
struct EpiProj {
    static constexpr bool PERM = true, HAS_MID = false; static constexpr int MID_T = -1;
    bf16_t* U; float* XL; bf16_t* GG; const float* ssq;
    __device__ __forceinline__ void mid(Acc&, const Unit&, int, int, int, int) const {}
    __device__ __forceinline__ void operator()(const Acc& acc, const Unit& u, int wr, int wc, int fr, int fq) const {
        int row0 = u.pm * BM + wr * 64 + fr, col0 = (u.pn & 3) * BM + wc * 32 + 8 * fq; const int seg = u.pn >> 2; asm volatile("" : "+v"(row0), "+v"(col0));
        float sq[2][4];
#pragma unroll
        for (int ai = 0; ai < 2; ++ai)
#pragma unroll
            for (int m = 0; m < 4; ++m) sq[ai][m] = ssq[row0 + ai * HALF + m * 16];
        asm volatile("" ::: "memory");
#pragma unroll
        for (int ai = 0; ai < 2; ++ai)
#pragma unroll
            for (int m = 0; m < 4; ++m) {
                const int row = row0 + ai * HALF + m * 16;
                const float r = rsqrtf(sq[ai][m] * (1.0f / D) + EPS);
#pragma unroll
                for (int bj = 0; bj < 2; ++bj) {
                    const size_t o = (size_t)row * DH + col0 + bj * HALF;
                    f32x4 v0 = acc[ai][bj][m][0] * r, v1 = acc[ai][bj][m][1] * r;
                    if (seg == 0) { *(u32x4*)(U + o) = pack8(v0, v1); }
                    else if (seg == 1) { *(f32x4*)(XL + o) = v0; *(f32x4*)(XL + o + 4) = v1; }
                    else {
#pragma unroll
                        for (int j = 0; j < 4; ++j) { v0[j] = fgelu(v0[j]); v1[j] = fgelu(v1[j]); }
                        *(u32x4*)(GG + o) = pack8(v0, v1);
                    }
                }
            }
    }
};
struct EpiGlu {
    static constexpr bool PERM = true, HAS_MID = false; static constexpr int MID_T = -1;
    const bf16_t* GS; const float* bias; bf16_t* MRG; float* ssq;
    __device__ __forceinline__ void mid(Acc&, const Unit&, int, int, int, int) const {}
    __device__ __forceinline__ void operator()(const Acc& acc, const Unit& u, int wr, int wc, int fr, int fq) const {
        int row0 = u.pm * BM + wr * 64 + fr, col0 = u.pn * BM + wc * 32 + 8 * fq; asm volatile("" : "+v"(row0), "+v"(col0));
        ResTile gt;
#pragma unroll
        for (int ai = 0; ai < 2; ++ai)
#pragma unroll
            for (int m = 0; m < 4; ++m)
#pragma unroll
                for (int bj = 0; bj < 2; ++bj) gt[ai][m][bj] = *(const u32x4*)(GS + (size_t)(row0 + ai * HALF + m * 16) * DH + col0 + bj * HALF);
        f32x4 bb[2][2];
#pragma unroll
        for (int bj = 0; bj < 2; ++bj) { bb[bj][0] = *(const f32x4*)(bias + col0 + bj * HALF); bb[bj][1] = *(const f32x4*)(bias + col0 + bj * HALF + 4); }
        asm volatile("" ::: "memory");
#pragma unroll
        for (int ai = 0; ai < 2; ++ai)
#pragma unroll
            for (int m = 0; m < 4; ++m) {
                const int row = row0 + ai * HALF + m * 16;
                float s = 0.f;
#pragma unroll
                for (int bj = 0; bj < 2; ++bj) {
                    const f32x4 g0 = res_lo(gt[ai][m][bj]), g1 = res_hi(gt[ai][m][bj]);
                    f32x4 v0, v1;
#pragma unroll
                    for (int j = 0; j < 4; ++j) { v0[j] = g0[j] * fsigmoid(acc[ai][bj][m][0][j] + bb[bj][0][j]); v1[j] = g1[j] * fsigmoid(acc[ai][bj][m][1][j] + bb[bj][1][j]); }
                    *(u32x4*)(MRG + (size_t)row * D + col0 + bj * HALF) = pack8(v0, v1);
                    s += dot4(v0) + dot4(v1);
                }
                s += __shfl_xor(s, 16); s += __shfl_xor(s, 32);
                if (fq == 0) atomicAdd(ssq + row, s);
            }
    }
};
struct EpiOut {
    static constexpr bool PERM = true, HAS_MID = true; static constexpr int MID_T = 16;
    const float* ssq_s5; const float* ssq_lru; bf16_t* XB; float* ssq; float* slab;
    __device__ __forceinline__ void mid(Acc& acc, const Unit& u, int wr, int wc, int fr, int fq) const {
        if (u.pm == 32 && slab) return;
        int row0 = u.pm * BM + wr * 64 + fr; asm volatile("" : "+v"(row0));
        float f[2][4];
#pragma unroll
        for (int ai = 0; ai < 2; ++ai)
#pragma unroll
            for (int m = 0; m < 4; ++m) { const int row = row0 + ai * HALF + m * 16; f[ai][m] = rsqrtf(ssq_s5[row] * (1.0f / DH) + EPS) * sqrtf(ssq_lru[row] * (1.0f / DH) + EPS); }
#pragma unroll
        for (int ai = 0; ai < 2; ++ai)
#pragma unroll
            for (int m = 0; m < 4; ++m)
#pragma unroll
                for (int bj = 0; bj < 2; ++bj)
#pragma unroll
                    for (int n = 0; n < 2; ++n) acc[ai][bj][m][n] = acc[ai][bj][m][n] * f[ai][m];
    }
    __device__ __forceinline__ void operator()(const Acc& acc, const Unit& u, int wr, int wc, int fr, int fq) const {
        if (u.pm == 32 && slab) { slab_store(acc, u, slab, wr, wc, fr, fq); return; }
        int row0 = u.pm * BM + wr * 64 + fr, col0 = u.pn * BM + wc * 32 + 8 * fq; asm volatile("" : "+v"(row0), "+v"(col0));
        float rl[2][4];
#pragma unroll
        for (int ai = 0; ai < 2; ++ai)
#pragma unroll
            for (int m = 0; m < 4; ++m) rl[ai][m] = ssq_lru[row0 + ai * HALF + m * 16];
#pragma unroll
        for (int ai = 0; ai < 2; ++ai) {
            ResHalf res; res_load_half(res, XB, row0 + ai * HALF, col0);
#pragma unroll
            for (int m = 0; m < 4; ++m) {
                const int row = row0 + ai * HALF + m * 16;
                const float r = rsqrtf(rl[ai][m] * (1.0f / DH) + EPS);
                float s = 0.f;
#pragma unroll
                for (int bj = 0; bj < 2; ++bj) {
                    const f32x4 v0 = res_lo(res[m][bj]) + r * acc[ai][bj][m][0], v1 = res_hi(res[m][bj]) + r * acc[ai][bj][m][1];
                    *(u32x4*)(XB + (size_t)row * D + col0 + bj * HALF) = pack8(v0, v1);
                    s += dot4(v0) + dot4(v1);
                }
                s += __shfl_xor(s, 16); s += __shfl_xor(s, 32);
                if (fq == 0) atomicAdd(ssq + row, s);
            }
        }
    }
};
struct EpiFinal {
    static constexpr bool PERM = true, HAS_MID = false; static constexpr int MID_T = -1;
    bf16_t* XB; float* ssq; float* slab;
    __device__ __forceinline__ void mid(Acc&, const Unit&, int, int, int, int) const {}
    __device__ __forceinline__ void operator()(const Acc& acc, const Unit& u, int wr, int wc, int fr, int fq) const {
        if (u.pm == 32) { slab_store(acc, u, slab, wr, wc, fr, fq); return; }
        int row0 = u.pm * BM + wr * 64 + fr, col0 = u.pn * BM + wc * 32 + 8 * fq; asm volatile("" : "+v"(row0), "+v"(col0));
#pragma unroll
        for (int ai = 0; ai < 2; ++ai) {
            ResHalf res; res_load_half(res, XB, row0 + ai * HALF, col0);
#pragma unroll
            for (int m = 0; m < 4; ++m) {
                const int row = row0 + ai * HALF + m * 16;
                float s = 0.f;
#pragma unroll
                for (int bj = 0; bj < 2; ++bj) {
                    const f32x4 v0 = res_lo(res[m][bj]) + 0.5f * acc[ai][bj][m][0], v1 = res_hi(res[m][bj]) + 0.5f * acc[ai][bj][m][1];
                    *(u32x4*)(XB + (size_t)row * D + col0 + bj * HALF) = pack8(v0, v1);
                    s += dot4(v0) + dot4(v1);
                }
                s += __shfl_xor(s, 16); s += __shfl_xor(s, 32);
                if (fq == 0) atomicAdd(ssq + row, s);
            }
        }
    }
};
}

#define XB_TMO      128
#define XB_XCNT(j)  (256  + 64 * (j))
#define XB_XSUB(j)  (1280 + 64 * (j))
#define XB_XGEN(j)  (2304 + 64 * (j))
#define XB_TOP      3328
#define XB_TOPGEN   3392
#define XCD_BAR_WORDS 3456
#define XB_SPIN_CAP (1u << 18)
__device__ __forceinline__ unsigned xb_ld(unsigned* p)              { return __hip_atomic_load(p, __ATOMIC_RELAXED, __HIP_MEMORY_SCOPE_AGENT); }
__device__ __forceinline__ unsigned xb_add(unsigned* p, unsigned v) { return __hip_atomic_fetch_add(p, v, __ATOMIC_RELAXED, __HIP_MEMORY_SCOPE_AGENT); }
__device__ __forceinline__ unsigned xb_xcc_id() { return (unsigned)__builtin_amdgcn_s_getreg((3 << 11) | 20) & 0xFu; }
#define XB_SPIN(cond, bar) do { unsigned _sp = 0; while (cond) { __builtin_amdgcn_s_sleep(1); \
    if ((++_sp & 255u) == 0u) { if (xb_ld(&(bar)[XB_TMO])) break; if (_sp > XB_SPIN_CAP) { atomicAdd(&(bar)[XB_TMO], 1u); break; } } } } while (0)
struct XcdBarrier { unsigned* bar; unsigned x; volatile LAS unsigned* st; };
__device__ __forceinline__ XcdBarrier xcd_barrier_post(unsigned* bar, volatile LAS unsigned* st) {
    XcdBarrier b; b.bar = bar; b.x = xb_xcc_id(); b.st = st;
    if (threadIdx.x == 0) (void)xb_add(&bar[XB_XCNT(b.x)], 1u);
    return b;
}
__device__ __forceinline__ void xcd_barrier_complete(unsigned* bar, unsigned x, unsigned& nloc, unsigned& nx) {
    const unsigned G = gridDim.x * gridDim.y * gridDim.z;
    unsigned sum, cnt, mine, sp = 0u;
    for (;;) {
        sum = 0u; cnt = 0u; mine = 0u;
#pragma unroll
        for (unsigned j = 0; j < 16; ++j) { const unsigned c = xb_ld(&bar[XB_XCNT(j)]); sum += c; cnt += (c > 0u) ? 1u : 0u; mine = (j == x) ? c : mine; }
        if (sum == G) break;
        __builtin_amdgcn_s_sleep(1);
        if ((++sp & 255u) == 0u) { if (xb_ld(&bar[XB_TMO])) break; if (sp > XB_SPIN_CAP) { atomicAdd(&bar[XB_TMO], 1u); break; } }
    }
    nloc = mine > 0u ? mine : 1u; nx = cnt > 0u ? cnt : 1u;
}
__device__ __forceinline__ void xcd_barrier(const XcdBarrier& b) {
    asm volatile("s_waitcnt vmcnt(0)" ::: "memory");
    __syncthreads();
    if (threadIdx.x == 0) {
        unsigned* bar = b.bar;
        __builtin_amdgcn_s_waitcnt(0);
        unsigned nloc = b.st[0], nx = b.st[1];
        if (nloc == 0u) { xcd_barrier_complete(bar, b.x, nloc, nx); b.st[0] = nloc; b.st[1] = nx; }
        const unsigned old = xb_add(&bar[XB_XSUB(b.x)], 1u);
        const unsigned gen = old / nloc;
        if (old + 1u == (gen + 1u) * nloc) {
            __builtin_amdgcn_fence(__ATOMIC_RELEASE, "agent");
            asm volatile("s_waitcnt vmcnt(0)" ::: "memory");
            const unsigned og = xb_add(&bar[XB_TOP], 1u);
            const unsigned tg = og / nx;
            __builtin_amdgcn_fence(__ATOMIC_ACQUIRE, "agent");
            if (og + 1u == (tg + 1u) * nx) xb_add(&bar[XB_TOPGEN], 1u);
            else XB_SPIN(xb_ld(&bar[XB_TOPGEN]) == tg, bar);
            asm volatile("s_waitcnt vmcnt(0)" ::: "memory");
            xb_add(&bar[XB_XGEN(b.x)], 1u);
        } else {
            __builtin_amdgcn_fence(__ATOMIC_ACQUIRE, "agent");
            XB_SPIN(xb_ld(&bar[XB_XGEN(b.x)]) == gen, bar);
            asm volatile("s_waitcnt vmcnt(0)" ::: "memory");
        }
    }
    __syncthreads();
}

enum { I_XP = 0, I_XS, I_S5RE, I_S5IM, I_LRUH, I_LRUCONV, I_GFFN1, I_W1A, I_W3A, I_W2A, I_GMIX, I_WIN, I_LAMRE, I_LAMIM, I_LOGDT, I_BRE, I_BIM, I_CRE, I_CIM,
       I_DSKIP, I_WGLU, I_BGLU, I_CONVW, I_CONVB, I_WA, I_BA, I_WX, I_BX, I_LAML, I_GS5, I_GLRU, I_WOUT, I_GFFN2, I_W1B, I_W3B, I_W2B, I_GFINAL, N_IN };
struct Args { const float* in[N_IN]; float* out; unsigned char* ws; int ph_lo, ph_hi; };
constexpr size_t O_Y = 0, O_PS5RE = (size_t)M * D, O_PS5IM = O_PS5RE + NB * NG * NP, O_PLRUH = O_PS5IM + NB * NG * NP, O_PLRUC = O_PLRUH + NB * DH,
                 O_SS5RE = O_PLRUC + NB * 3 * DH, O_SS5IM = O_SS5RE + (size_t)MS * NG * NP, O_SLRUH = O_SS5IM + (size_t)MS * NG * NP, O_SLRUC = O_SLRUH + (size_t)MS * DH,
                 O_END = O_SLRUC + (size_t)MS * 3 * DH;
static_assert(O_END == 18661376, "output size");

typedef float f32x2 __attribute__((ext_vector_type(2)));
constexpr int STG_PITCH = 144, STG_BYTES = 64 * STG_PITCH;
__device__ __forceinline__ void p0_task(const float* W, int N, const float* gk, bf16_t* WT, int ldt, int k0, int n0, int nd0, LAS unsigned char* stg, int lane) {
    const float* src = W + (size_t)k0 * N + n0 + 2 * lane;
    f32x2 v[64];
#if PROBE_PHASE >= 0
    { const float* p = src; const size_t step = (size_t)N;
#pragma unroll
      for (int i = 0; i < 64; ++i) { v[i] = __builtin_nontemporal_load((const f32x2*)p); p += step; if ((i & 7) == 7) asm volatile("" : "+v"(p)); } }
#else
#pragma unroll
    for (int i = 0; i < 64; ++i) v[i] = __builtin_nontemporal_load((const f32x2*)(src + (size_t)i * N));
#endif
    if (gk) {
#pragma unroll
        for (int i = 0; i < 64; ++i) v[i] = v[i] * gk[k0 + i];
    }
#pragma unroll
    for (int j = 0; j < 2; ++j) {
#pragma unroll
        for (int kb = 0; kb < 8; ++kb) {
            u32x4 o; o.x = cvt_pk_bf16(v[8 * kb][j], v[8 * kb + 1][j]); o.y = cvt_pk_bf16(v[8 * kb + 2][j], v[8 * kb + 3][j]); o.z = cvt_pk_bf16(v[8 * kb + 4][j], v[8 * kb + 5][j]); o.w = cvt_pk_bf16(v[8 * kb + 6][j], v[8 * kb + 7][j]);
            *(LAS u32x4*)(stg + lane * STG_PITCH + kb * 16) = o;
        }
        LDS_WAIT(); asm volatile("" ::: "memory");
#pragma unroll
        for (int it = 0; it < 8; ++it) {
            const int rr = 8 * it + (lane >> 3), kb = lane & 7;
            const u32x4 o = *(const LAS u32x4*)(stg + rr * STG_PITCH + kb * 16);
            *(u32x4*)(WT + (size_t)(nd0 + 2 * rr + j) * ldt + k0 + 8 * kb) = o;
        }
        LDS_WAIT(); asm volatile("" ::: "memory");
    }
}
__device__ __forceinline__ void sincos_d(double x, double& s, double& c) {
    const double k = rint(x * 0.63661977236758134308);
    double r = fma(-k, 1.57079632679489655800, x); r = fma(-k, 6.12323399573676603587e-17, r);
    const double r2 = r * r;
    double sp = -7.6471637318198164759e-13; sp = fma(sp, r2, 1.6059043836821614599e-10); sp = fma(sp, r2, -2.5052108385441718775e-8); sp = fma(sp, r2, 2.7557319223985890653e-6);
    sp = fma(sp, r2, -1.9841269841269841270e-4); sp = fma(sp, r2, 8.3333333333333333333e-3); sp = fma(sp, r2, -1.6666666666666666667e-1);
    const double sr = fma(sp * r2, r, r);
    double cp = 4.7794773323873852974e-14; cp = fma(cp, r2, -1.1470745597729724714e-11); cp = fma(cp, r2, 2.0876756987868098979e-9); cp = fma(cp, r2, -2.7557319223985890653e-7);
    cp = fma(cp, r2, 2.4801587301587301587e-5); cp = fma(cp, r2, -1.3888888888888888889e-3); cp = fma(cp, r2, 4.1666666666666666667e-2); cp = fma(cp, r2, -0.5);
    const double cr = fma(cp, r2, 1.0);
    const int q = ((int)k) & 3;
    s = (q == 0) ? sr : (q == 1) ? cr : (q == 2) ? -sr : -cr;
    c = (q == 0) ? cr : (q == 1) ? -sr : (q == 2) ? -cr : sr;
}
__device__ __forceinline__ void p0_s5_group(const Args& a, LAS unsigned char* lds, int g, int tid) {
    LAS float* LPre = (LAS float*)lds;
    LAS float* LPim = LPre + 17 * 64;
    LAS float* BBre = LPim + 17 * 64;
    LAS float* BBim = BBre + 1024;
    LAS float* CRe = BBim + 1024;
    LAS float* CIm = CRe + 1024;
    LAS float* Kt = CIm + 1024;
    LAS float* Kt2 = Kt + 4096;
    LAS float* QQ = Kt2 + 4096;
    const float ldt = a.in[I_LOGDT][g];
    float lre_[3], lim_[3];
#pragma unroll
    for (int i = 0; i < 3; ++i) { const int idx = tid + 512 * i, p = idx & 63; lre_[i] = a.in[I_LAMRE][g * 64 + p]; lim_[i] = a.in[I_LAMIM][g * 64 + p]; }
    float cr_[2], ci_[2], br_[2], bi_[2];
#pragma unroll
    for (int i = 0; i < 2; ++i) { const int idx = tid + 512 * i; cr_[i] = a.in[I_CRE][(size_t)g * 1024 + idx]; ci_[i] = a.in[I_CIM][(size_t)g * 1024 + idx]; br_[i] = a.in[I_BRE][(size_t)g * 1024 + idx]; bi_[i] = a.in[I_BIM][(size_t)g * 1024 + idx]; }
    const float dsk = a.in[I_DSKIP][g * 16 + (tid & 15)];
    const double dt = exp((double)ldt);
#pragma unroll
    for (int i = 0; i < 3; ++i) {
        const int idx = tid + 512 * i;
        if (idx < 17 * 64) {
            const int k = idx >> 6, p = idx & 63;
            const double lre = (double)lre_[i], lim = (double)lim_[i];
            const double mag = exp(lre * dt * (double)k); double sn, cs; sincos_d(lim * dt * (double)k, sn, cs);
            LPre[idx] = (float)(mag * cs); LPim[idx] = (float)(mag * sn);
            if (k == 1) {
                const double nr = mag * cs - 1.0, ni = mag * sn, den = lre * lre + lim * lim;
                QQ[2 * p] = (float)((nr * lre + ni * lim) / den); QQ[2 * p + 1] = (float)((ni * lre - nr * lim) / den);
            }
        }
    }
#pragma unroll
    for (int i = 0; i < 2; ++i) { const int idx = tid + 512 * i; CRe[idx] = cr_[i]; CIm[idx] = ci_[i]; }
    __syncthreads();
#pragma unroll
    for (int i = 0; i < 2; ++i) { const int idx = tid + 512 * i, p = idx >> 4; const float qr = QQ[2 * p], qi = QQ[2 * p + 1];
        BBre[idx] = qr * br_[i] - qi * bi_[i]; BBim[idx] = qr * bi_[i] + qi * br_[i]; }
    __syncthreads();
    {
        const int c = (tid >> 4) & 15, cp = tid & 15, ph = tid >> 8;
        float acc[16];
#pragma unroll
        for (int k = 0; k < 16; ++k) acc[k] = 0.f;
        for (int pp = 0; pp < 32; ++pp) {
            const int p = 32 * ph + pp;
            const float cr = CRe[c * 64 + p], ci = CIm[c * 64 + p], br = BBre[p * 16 + cp], bi = BBim[p * 16 + cp];
            const float gr = cr * br - ci * bi, gi = cr * bi + ci * br;
#pragma unroll
            for (int k = 0; k < 16; ++k) acc[k] += gr * LPre[k * 64 + p] - gi * LPim[k * 64 + p];
        }
        if (ph == 0 && c == cp) acc[0] += dsk;
        LAS float* dst = ph ? Kt2 : Kt;
#pragma unroll
        for (int k = 0; k < 16; ++k) dst[(k * 16 + c) * 16 + cp] = acc[k];
    }
    __syncthreads();
    bf16_t* Win = (bf16_t*)(a.ws + WS_S5M + (size_t)g * S5M_GROUP_BYTES);
    bf16_t* MW = Win + 128 * 256;
    for (int idx = tid; idx < 256 * 48; idx += NWAVES * 64) {
        const int rr = idx / 48, cg = idx % 48, s = rr >> 4, c = rr & 15;
        float v[8];
        if (cg < 32) { const int sp = cg >> 1, c0 = (cg & 1) * 8;
#pragma unroll
            for (int i = 0; i < 8; ++i) { const int o = (((s - sp) & 15) * 16 + c) * 16 + c0 + i; v[i] = (sp <= s) ? Kt[o] + Kt2[o] : 0.f; }
        } else { const int im = cg >= 40, p0 = (cg - (im ? 40 : 32)) * 8;
#pragma unroll
            for (int i = 0; i < 8; ++i) { const int p = p0 + i; const float cr = CRe[c * 64 + p], ci = CIm[c * 64 + p], lr = LPre[(s + 1) * 64 + p], li = LPim[(s + 1) * 64 + p];
                v[i] = im ? -(cr * li + ci * lr) : (cr * lr - ci * li); }
        }
        u32x4 o; o.x = cvt_pk_bf16(v[0], v[1]); o.y = cvt_pk_bf16(v[2], v[3]); o.z = cvt_pk_bf16(v[4], v[5]); o.w = cvt_pk_bf16(v[6], v[7]);
        *(u32x4*)(MW + (size_t)rr * 384 + cg * 8) = o;
    }
    for (int idx = tid; idx < 128 * 32; idx += NWAVES * 64) {
        const int n = idx >> 5, cg = idx & 31, p = n & 63, im = n >> 6, sp = cg >> 1, c0 = (cg & 1) * 8;
        const float lr = LPre[(15 - sp) * 64 + p], li = LPim[(15 - sp) * 64 + p];
        float v[8];
#pragma unroll
        for (int i = 0; i < 8; ++i) { const float br = BBre[p * 16 + c0 + i], bi = BBim[p * 16 + c0 + i]; v[i] = im ? (lr * bi + li * br) : (lr * br - li * bi); }
        u32x4 o; o.x = cvt_pk_bf16(v[0], v[1]); o.y = cvt_pk_bf16(v[2], v[3]); o.z = cvt_pk_bf16(v[4], v[5]); o.w = cvt_pk_bf16(v[6], v[7]);
        *(u32x4*)(Win + (size_t)n * 256 + cg * 8) = o;
    }
    {
        float* aux = (float*)(a.ws + WS_S5AUX) + (size_t)g * S5AUX_GROUP_FLOATS;
        for (int idx = tid; idx < 64; idx += NWAVES * 64) { aux[idx] = LPre[64 + idx]; aux[64 + idx] = LPim[64 + idx]; aux[128 + idx] = LPre[16 * 64 + idx]; aux[192 + idx] = LPim[16 * 64 + idx]; }
        for (int idx = tid; idx < 1024; idx += NWAVES * 64) { aux[256 + idx] = BBre[idx]; aux[1280 + idx] = BBim[idx]; }
    }
    __syncthreads();
}
__device__ __forceinline__ void conv_tasks(const Args& a, LAS unsigned char* stg, int first, int last, int wv, int nwv, int lane) {
    constexpr int T_W1 = (D / 64) * (FF / 128), T_W2 = (FF / 64) * (D / 128), T_IN = (D / 64) * (DIN / 128), T_GLU = (DH / 64) * (DH / 128), T_OUT = (D / 64) * (D / 128);
    const int cnt[9] = {T_W1, T_W1, T_W2, T_IN, T_GLU, T_OUT, T_W1, T_W1, T_W2};
    int NT = 0;
#pragma unroll
    for (int m = 0; m < 9; ++m) if (m >= first && m <= last) NT += cnt[m];
    const int t_lo = (int)(((long)wv * NT) / nwv), t_hi = (int)(((long)(wv + 1) * NT) / nwv);
    unsigned char* ws = a.ws;
    for (int it = t_lo; it < t_hi; ++it) {
        int r = it, mat = first;
#pragma unroll
        for (int m = 0; m < 9; ++m) if (m >= first && m < last && mat == m && r >= cnt[m]) { r -= cnt[m]; mat = m + 1; }
        const float* W; const float* gk = nullptr; bf16_t* WT; int K, N, dual = 0, off = 0;
        switch (mat) {
            case 0: W = a.in[I_W1A]; gk = a.in[I_GFFN1]; WT = (bf16_t*)(ws + WS_W13A); K = D; N = FF; dual = 1; break;
            case 1: W = a.in[I_W3A]; gk = a.in[I_GFFN1]; WT = (bf16_t*)(ws + WS_W13A); K = D; N = FF; dual = 1; off = 128; break;
            case 2: W = a.in[I_W2A]; WT = (bf16_t*)(ws + WS_W2A); K = FF; N = D; break;
            case 3: W = a.in[I_WIN]; gk = a.in[I_GMIX]; WT = (bf16_t*)(ws + WS_WIN); K = D; N = DIN; break;
            case 4: W = a.in[I_WGLU]; WT = (bf16_t*)(ws + WS_WGLU); K = DH; N = DH; break;
            case 5: W = a.in[I_WOUT]; WT = (bf16_t*)(ws + WS_WOUT); K = D; N = D; dual = 2; break;
            case 6: W = a.in[I_W1B]; gk = a.in[I_GFFN2]; WT = (bf16_t*)(ws + WS_W13B); K = D; N = FF; dual = 1; break;
            case 7: W = a.in[I_W3B]; gk = a.in[I_GFFN2]; WT = (bf16_t*)(ws + WS_W13B); K = D; N = FF; dual = 1; off = 128; break;
            default: W = a.in[I_W2B]; WT = (bf16_t*)(ws + WS_W2B); K = FF; N = D; break;
        }
        const int nkb = K / 64, nb = r / nkb, kb = r % nkb, k0 = kb * 64, n0 = nb * 128;
        if (dual == 2) { gk = k0 < DH ? a.in[I_GS5] : a.in[I_GLRU] - DH; dual = 0; }
        p0_task(W, N, gk, WT, K, k0, n0, dual ? (nb * 256 + off) : n0, stg, lane);
    }
}
__device__ __forceinline__ void p0_prologue(const Args& a, LAS unsigned char* lds, int vcu, int G, int lane, int wave) {
    const int gw = vcu * NWAVES + wave, NGW = G * NWAVES;
    unsigned char* ws = a.ws;
    bf16_t* XB = (bf16_t*)(ws + WS_XB); float* ssq0 = (float*)(ws + WS_CTL + CTL_SSQ_BYTE);
    for (int grp = gw; grp < MPAD / 4; grp += NGW) {
        const int m0 = 4 * grp;
        u32x2* o = (u32x2*)(XB + (size_t)m0 * D) + lane;
        if (m0 < M) {
            const float* xr = m0 < MP ? a.in[I_XP] + (size_t)m0 * D : a.in[I_XS] + (size_t)(m0 - MP) * D;
            const f32x4* x4 = (const f32x4*)xr + lane; f32x4 v[4][8];
#pragma unroll
            for (int r = 0; r < 4; ++r)
#pragma unroll
                for (int j = 0; j < 8; ++j) v[r][j] = __builtin_nontemporal_load(x4 + r * (D / 4) + 64 * j);
#pragma unroll
            for (int r = 0; r < 4; ++r) {
                float s = 0.f;
#pragma unroll
                for (int j = 0; j < 8; ++j) s += dot4(v[r][j]);
                s = wave_sum(s);
#pragma unroll
                for (int j = 0; j < 8; ++j) { u32x2 w; w.x = cvt_pk_bf16(v[r][j][0], v[r][j][1]); w.y = cvt_pk_bf16(v[r][j][2], v[r][j][3]); o[r * (D / 4) + 64 * j] = w; }
                if (lane == 0) ssq0[m0 + r] = s;
            }
        } else {
#pragma unroll
            for (int r = 0; r < 4; ++r)
#pragma unroll
                for (int j = 0; j < 8; ++j) o[r * (D / 4) + 64 * j] = (u32x2){0u, 0u};
        }
    }
    conv_tasks(a, lds + wave * STG_BYTES, 0, 3, gw, NGW, lane);
}

#define MFMA32(a, b, c) __builtin_amdgcn_mfma_f32_32x32x16_bf16((a), (b), (c), 0, 0, 0)
constexpr int S5_PITCH = 528;
constexpr int S5_XC_OFF = 0, S5_Z_OFF = 128 * S5_PITCH;
static_assert(2 * 128 * S5_PITCH <= RING_BYTES, "S5 LDS map");
__device__ __forceinline__ void s5_prompt(const Args& a, LAS unsigned char* lds, int b, int g, int tid, int lane, int wave) {
    const bf16_t* U = (const bf16_t*)(a.ws + WS_U);
    const bf16_t* Win = (const bf16_t*)(a.ws + WS_S5M + (size_t)g * S5M_GROUP_BYTES);
    const bf16_t* MW = Win + 128 * 256;
    bf16_t* GS5 = (bf16_t*)(a.ws + WS_GS5);
    LAS unsigned char* XCs = lds + S5_XC_OFF;
    LAS unsigned char* ZS = lds + S5_Z_OFF;
    const int r32 = lane & 31, hh = lane >> 5;
    {
        u32x4 v[8];
#pragma unroll
        for (int i = 0; i < 8; ++i) { const int q = tid + 512 * i, t = q >> 1, half = q & 1; v[i] = *(const u32x4*)(U + (size_t)(b * SEQ + t) * DH + 16 * g + 8 * half); }
#pragma unroll
        for (int i = 0; i < 8; ++i) { const int q = tid + 512 * i, t = q >> 1, half = q & 1; *(LAS u32x4*)(XCs + (t >> 4) * S5_PITCH + (t & 15) * 32 + 16 * half) = v[i]; }
    }
    {
        const int mt = wave & 3, nt0 = (wave >> 2) * 2;
        const bf16_t* w0 = Win + (size_t)(32 * nt0 + r32) * 256 + 8 * hh;
        bf16x8 bw[2][8];
#pragma unroll
        for (int ks = 0; ks < 8; ++ks) { bw[0][ks] = *(const bf16x8*)(w0 + 16 * ks); bw[1][ks] = *(const bf16x8*)(w0 + 32 * 256 + 16 * ks); }
        __syncthreads();
        f32x16 acc0, acc1;
#pragma unroll
        for (int i = 0; i < 16; ++i) { acc0[i] = 0.f; acc1[i] = 0.f; }
        const LAS unsigned char* xa = XCs + (32 * mt + r32) * S5_PITCH + 16 * hh;
#pragma unroll 1
        for (int kh = 0; kh < 2; ++kh) {
#pragma unroll
            for (int ks = 0; ks < 8; ++ks) { const bf16x8 af = *(const LAS bf16x8*)(xa + 32 * (8 * kh + ks)); acc0 = MFMA32(af, bw[0][ks], acc0); acc1 = MFMA32(af, bw[1][ks], acc1); }
            if (kh == 0) {
#pragma unroll
                for (int ks = 0; ks < 8; ++ks) { bw[0][ks] = *(const bf16x8*)(w0 + 128 + 16 * ks); bw[1][ks] = *(const bf16x8*)(w0 + 32 * 256 + 128 + 16 * ks); }
            }
        }
        LAS float* Z = (LAS float*)ZS;
#pragma unroll
        for (int i = 0; i < 16; ++i) { const int j = 32 * mt + (i & 3) + 8 * (i >> 2) + 4 * hh;
            Z[j * (S5_PITCH / 4) + 32 * nt0 + r32] = acc0[i]; Z[j * (S5_PITCH / 4) + 32 * nt0 + 32 + r32] = acc1[i]; }
    }
    __syncthreads();
    if (wave == 0) {
        const float* aux = (const float*)(a.ws + WS_S5AUX) + (size_t)g * S5AUX_GROUP_FLOATS;
        const float l16r = aux[128 + lane], l16i = aux[192 + lane];
        const LAS float* Z = (const LAS float*)ZS;
        float sr = 0.f, si = 0.f;
        for (int jb = 0; jb < 16; ++jb) {
            float zr[8], zi[8];
#pragma unroll
            for (int i = 0; i < 8; ++i) { zr[i] = Z[(8 * jb + i) * (S5_PITCH / 4) + lane]; zi[i] = Z[(8 * jb + i) * (S5_PITCH / 4) + 64 + lane]; }
            LDS_WAIT();
#pragma unroll
            for (int i = 0; i < 8; ++i) {
                const unsigned w = cvt_pk_bf16(sr, si);
                *(LAS unsigned short*)(ZS + (8 * jb + i) * S5_PITCH + 2 * lane) = (unsigned short)(w & 0xffffu);
                *(LAS unsigned short*)(ZS + (8 * jb + i) * S5_PITCH + 128 + 2 * lane) = (unsigned short)(w >> 16);
                const float nr = l16r * sr - l16i * si + zr[i], ni = l16r * si + l16i * sr + zi[i];
                sr = nr; si = ni;
            }
        }
        a.out[O_PS5RE + (size_t)(b * NG + g) * NP + lane] = sr;
        a.out[O_PS5IM + (size_t)(b * NG + g) * NP + lane] = si;
    }
#pragma unroll 1
    for (int pass = 0; pass < 2; ++pass) {
        const int mt = pass ? 7 - wave : wave, n0 = 2 * pass;
        const int nks = 2 * mt + 2;
        const bf16_t* mw = MW + (size_t)(32 * mt + r32) * 384 + 8 * hh;
        bf16x8 am[24];
#pragma unroll
        for (int ks = 0; ks < 16; ++ks) if (ks < nks) am[ks] = *(const bf16x8*)(mw + 16 * ks);
#pragma unroll
        for (int kq = 0; kq < 8; ++kq) am[16 + kq] = *(const bf16x8*)(mw + 256 + 16 * kq);
        if (pass == 0) __syncthreads();
        f32x16 acc[2];
#pragma unroll
        for (int n = 0; n < 2; ++n)
#pragma unroll
            for (int i = 0; i < 16; ++i) acc[n][i] = 0.f;
#pragma unroll
        for (int ks = 0; ks < 16; ++ks) if (ks < nks) {
#pragma unroll
            for (int n = 0; n < 2; ++n) { const bf16x8 bf = *(const LAS bf16x8*)(XCs + (32 * (n0 + n) + r32) * S5_PITCH + 32 * ks + 16 * hh); acc[n] = MFMA32(am[ks], bf, acc[n]); }
        }
#pragma unroll
        for (int kq = 0; kq < 8; ++kq) {
#pragma unroll
            for (int n = 0; n < 2; ++n) { const bf16x8 bf = *(const LAS bf16x8*)(ZS + (32 * (n0 + n) + r32) * S5_PITCH + 32 * kq + 16 * hh); acc[n] = MFMA32(am[16 + kq], bf, acc[n]); }
        }
#pragma unroll
        for (int n = 0; n < 2; ++n)
#pragma unroll
            for (int q = 0; q < 4; ++q) {
                const int s = 2 * mt + (q >> 1), c0 = 8 * (q & 1) + 4 * hh, t = 16 * (32 * (n0 + n) + r32) + s;
                u32x2 w; w.x = cvt_pk_bf16(fgelu(acc[n][4 * q]), fgelu(acc[n][4 * q + 1])); w.y = cvt_pk_bf16(fgelu(acc[n][4 * q + 2]), fgelu(acc[n][4 * q + 3]));
                *(u32x2*)(GS5 + (size_t)(b * SEQ + t) * DH + 16 * g + c0) = w;
            }
    }
    __syncthreads();
}
__device__ __forceinline__ void s5_sample(const Args& a, LAS unsigned char* lds, int g, int bs0, int tid) {
    const bf16_t* U = (const bf16_t*)(a.ws + WS_U);
    bf16_t* GS5 = (bf16_t*)(a.ws + WS_GS5);
    const float* aux = (const float*)(a.ws + WS_S5AUX) + (size_t)g * S5AUX_GROUP_FLOATS;
    LAS float* HR = (LAS float*)lds;
    LAS float* HI = HR + 2048;
    LAS float* UU = HI + 2048;
    LAS float* CR = UU + 512;
    LAS float* CI = CR + 1024;
    LAS float* BR = CI + 1024;
    LAS float* BI = BR + 1024;
    const int bl0 = tid >> 4, c0 = tid & 15;
    const unsigned short uraw = U[(size_t)(MP + bs0 + bl0) * DH + 16 * g + c0];
    float cr_[2], ci_[2], br_[2], bi_[2], h0r[4], h0i[4];
#pragma unroll
    for (int i = 0; i < 2; ++i) { const int idx = tid + 512 * i; cr_[i] = a.in[I_CRE][(size_t)g * 1024 + idx]; ci_[i] = a.in[I_CIM][(size_t)g * 1024 + idx]; br_[i] = aux[256 + idx]; bi_[i] = aux[1280 + idx]; }
#pragma unroll
    for (int i = 0; i < 4; ++i) { const int idx = tid + 512 * i, bl = idx >> 6, p = idx & 63; const size_t so = (size_t)((bs0 + bl) * NG + g) * NP + p; h0r[i] = a.in[I_S5RE][so]; h0i[i] = a.in[I_S5IM][so]; }
    const float lr = aux[tid & 63], li = aux[64 + (tid & 63)];
    const float dsk = a.in[I_DSKIP][g * 16 + c0];
    UU[tid] = __uint_as_float((unsigned)uraw << 16);
#pragma unroll
    for (int i = 0; i < 2; ++i) { const int idx = tid + 512 * i; CR[idx] = cr_[i]; CI[idx] = ci_[i]; BR[idx] = br_[i]; BI[idx] = bi_[i]; }
    __syncthreads();
#pragma unroll
    for (int i = 0; i < 4; ++i) {
        const int idx = tid + 512 * i, bl = idx >> 6, p = idx & 63;
        float hr = lr * h0r[i] - li * h0i[i], hi = lr * h0i[i] + li * h0r[i];
#pragma unroll
        for (int q = 0; q < 4; ++q) { const f32x4 br = *(const LAS f32x4*)(BR + p * 16 + 4 * q), bi = *(const LAS f32x4*)(BI + p * 16 + 4 * q); const f32x4 u4 = *(const LAS f32x4*)(UU + bl * 16 + 4 * q);
#pragma unroll
            for (int j = 0; j < 4; ++j) { hr += br[j] * u4[j]; hi += bi[j] * u4[j]; } }
        const size_t so = (size_t)((bs0 + bl) * NG + g) * NP + p;
        a.out[O_SS5RE + so] = hr; a.out[O_SS5IM + so] = hi;
        HR[idx] = hr; HI[idx] = hi;
    }
    __syncthreads();
    {
        float y = 0.f;
#pragma unroll 16
        for (int p = 0; p < 64; ++p) y += CR[c0 * 64 + p] * HR[bl0 * 64 + p] - CI[c0 * 64 + p] * HI[bl0 * 64 + p];
        y += dsk * UU[tid];
        const float gv = fgelu(y); const unsigned w = cvt_pk_bf16(gv, gv);
        GS5[(size_t)(MP + bs0 + bl0) * DH + 16 * g + c0] = (bf16_t)(w & 0xffffu);
    }
    __syncthreads();
}

constexpr int XC_PITCH = 144;
__device__ __forceinline__ void lru_item(const Args& a, LAS unsigned char* lds, bool sample, int b, int head, int q, int tid, int lane, int wave) {
    const float* XL = (const float*)(a.ws + WS_XLRU);
    const bf16_t* GG = (const bf16_t*)(a.ws + WS_GG);
    bf16_t* MRG = (bf16_t*)(a.ws + WS_MRG);
    float* ssq_lru = (float*)(a.ws + WS_CTL + CTL_SSQ_BYTE) + 3 * MPAD;
    LAS unsigned char* XC = lds;
    LAS float* XCF = (LAS float*)(lds + 36864);
    LAS float* AA = XCF + 4096;
    LAS float* BX = AA + 4096;
    LAS float* SEGP = BX + 4096;
    LAS float* SEGH = SEGP + 512;
    LAS float* CAR = SEGH + 512;
    const int ch0 = 64 * head + 16 * q;
    const int fr = lane & 15, fq = lane >> 4;
    bf16x8 Bf[2][2];
#pragma unroll
    for (int mat = 0; mat < 2; ++mat)
#pragma unroll
        for (int ks = 0; ks < 2; ++ks) {
            const float* w = (mat ? a.in[I_WX] : a.in[I_WA]) + ((size_t)(head * 64 + 32 * ks + 8 * fq)) * 64 + 16 * q + fr;
            u32x4 p; p.x = cvt_pk_bf16(w[0], w[64]); p.y = cvt_pk_bf16(w[128], w[192]); p.z = cvt_pk_bf16(w[256], w[320]); p.w = cvt_pk_bf16(w[384], w[448]);
            Bf[mat][ks] = __builtin_bit_cast(bf16x8, p);
        }
    const int chn = ch0 + fr;
    const float ba = a.in[I_BA][chn], bx_ = a.in[I_BX][chn];
    const float spl = log1pf(expf(-a.in[I_LAML][chn]));
    const int cq = tid & 15, cch = 64 * head + 4 * cq, rg = tid >> 4;
    const f32x4 cw0 = *(const f32x4*)(a.in[I_CONVW] + cch), cw1 = *(const f32x4*)(a.in[I_CONVW] + DH + cch), cw2 = *(const f32x4*)(a.in[I_CONVW] + 2 * DH + cch),
                cw3 = *(const f32x4*)(a.in[I_CONVW] + 3 * DH + cch), cb = *(const f32x4*)(a.in[I_CONVB] + cch);
    const int er = tid >> 1, eh = tid & 1;
    if (!sample) {
        float hcar = 0.f;
        f32x4 xin[11]; u32x4 ggn;
        { const int R0 = b * SEQ, r0 = rg * 8;
#pragma unroll
          for (int i = 0; i < 11; ++i) { const int t = r0 + i - 3; xin[i] = (t >= 0) ? *(const f32x4*)(XL + (size_t)(R0 + t) * DH + cch) : (f32x4){0.f, 0.f, 0.f, 0.f}; }
          ggn = *(const u32x4*)(GG + (size_t)(R0 + er) * DH + ch0 + 8 * eh); }
        for (int chk = 0; chk < 8; ++chk) {
            const int R0 = b * SEQ + chk * 256, r0 = rg * 8;
#pragma unroll
            for (int rr = 0; rr < 8; ++rr) {
                const f32x4 xc = cb + cw0 * xin[rr] + cw1 * xin[rr + 1] + cw2 * xin[rr + 2] + cw3 * xin[rr + 3];
                u32x2 w; w.x = cvt_pk_bf16(xc[0], xc[1]); w.y = cvt_pk_bf16(xc[2], xc[3]);
                *(LAS u32x2*)(XC + (r0 + rr) * XC_PITCH + 8 * cq) = w;
                if ((cq >> 2) == q) *(LAS f32x4*)(XCF + (r0 + rr) * 16 + 4 * (cq & 3)) = xc;
            }
            const u32x4 gw = ggn;
            if (chk < 7) {
                const float* p = XL + (size_t)(R0 + 256 + r0 - 3) * DH + cch;
#pragma unroll
                for (int i = 0; i < 11; ++i) xin[i] = *(const f32x4*)(p + (size_t)i * DH);
                ggn = *(const u32x4*)(GG + (size_t)(R0 + 256 + er) * DH + ch0 + 8 * eh);
            }
            __syncthreads();
#pragma unroll
            for (int tt = 0; tt < 2; ++tt) {
                const int tile = 2 * wave + tt;
                f32x4 ar = (f32x4){0.f, 0.f, 0.f, 0.f}, ax = ar;
#pragma unroll
                for (int ks = 0; ks < 2; ++ks) {
                    const bf16x8 af = *(const LAS bf16x8*)(XC + (16 * tile + fr) * XC_PITCH + 64 * ks + 16 * fq);
                    ar = __builtin_amdgcn_mfma_f32_16x16x32_bf16(af, Bf[0][ks], ar, 0, 0, 0);
                    ax = __builtin_amdgcn_mfma_f32_16x16x32_bf16(af, Bf[1][ks], ax, 0, 0, 0);
                }
#pragma unroll
                for (int r4 = 0; r4 < 4; ++r4) {
                    const int rr = 16 * tile + 4 * fq + r4;
                    const float xcv = XCF[rr * 16 + fr];
                    const float rg_ = fsigmoid(ar[r4] + ba), ig = fsigmoid(ax[r4] + bx_);
                    const float la = -8.0f * rg_ * spl;
                    const float av = fexp(la); AA[rr * 16 + fr] = av; BX[rr * 16 + fr] = __builtin_amdgcn_sqrtf(fmaxf(fmaf(-av, av, 1.0f), 0.f)) * (ig * xcv);
                }
            }
            __syncthreads();
            const int sn = tid & 15, sg = tid >> 4;
            float av[8], bv[8];
            { float P = 1.f, h = 0.f;
#pragma unroll
              for (int i = 0; i < 8; ++i) { av[i] = AA[(8 * sg + i) * 16 + sn]; bv[i] = BX[(8 * sg + i) * 16 + sn]; }
#pragma unroll
              for (int i = 0; i < 8; ++i) { h = av[i] * h + bv[i]; P *= av[i]; }
              SEGP[tid] = P; SEGH[tid] = h; }
            __syncthreads();
            if (wave == 0 && lane < 16) {
                float run = hcar;
#pragma unroll 8
                for (int s2 = 0; s2 < 32; ++s2) { CAR[s2 * 16 + lane] = run; run = SEGP[s2 * 16 + lane] * run + SEGH[s2 * 16 + lane]; }
                hcar = run;
            }
            __syncthreads();
            { float h = CAR[tid];
#pragma unroll
              for (int i = 0; i < 8; ++i) { h = av[i] * h + bv[i]; BX[(8 * sg + i) * 16 + sn] = h; } }
            __syncthreads();
            {
                const size_t row = (size_t)R0 + er;
                const f32x4 h0 = *(const LAS f32x4*)(BX + er * 16 + 8 * eh), h1 = *(const LAS f32x4*)(BX + er * 16 + 8 * eh + 4);
                const f32x4 y0 = (f32x4){h0[0] * bf_lo(gw.x), h0[1] * bf_hi(gw.x), h0[2] * bf_lo(gw.y), h0[3] * bf_hi(gw.y)};
                const f32x4 y1 = (f32x4){h1[0] * bf_lo(gw.z), h1[1] * bf_hi(gw.z), h1[2] * bf_lo(gw.w), h1[3] * bf_hi(gw.w)};
                *(u32x4*)(MRG + row * D + DH + ch0 + 8 * eh) = pack8(y0, y1);
                float s = dot4(y0) + dot4(y1);
                s += __shfl_xor(s, 1);
                if (eh == 0) atomicAdd(ssq_lru + row, s);
            }
        }
        if (wave == 0 && lane < 16) a.out[O_PLRUH + (size_t)b * DH + ch0 + lane] = hcar;
        if (wave == 1 && lane < 48) { const int k = lane >> 4, n = lane & 15;
            a.out[O_PLRUC + ((size_t)b * 3 + k) * DH + ch0 + n] = XL[(size_t)(b * SEQ + SEQ - 3 + k) * DH + ch0 + n]; }
    } else {
        const int R0 = MP, bs0 = 32 * b;
        {
            const float* cbuf = a.in[I_LRUCONV];
            const int bs = bs0 + rg;
            const f32x4 x0 = *(const f32x4*)(XL + (size_t)(R0 + bs) * DH + cch);
            const f32x4 c0 = *(const f32x4*)(cbuf + ((size_t)bs * 3 + 0) * DH + cch), c1 = *(const f32x4*)(cbuf + ((size_t)bs * 3 + 1) * DH + cch), c2 = *(const f32x4*)(cbuf + ((size_t)bs * 3 + 2) * DH + cch);
            const f32x4 xc = cb + cw0 * c0 + cw1 * c1 + cw2 * c2 + cw3 * x0;
            u32x2 w; w.x = cvt_pk_bf16(xc[0], xc[1]); w.y = cvt_pk_bf16(xc[2], xc[3]);
            *(LAS u32x2*)(XC + rg * XC_PITCH + 8 * cq) = w;
            if ((cq >> 2) == q) {
                *(LAS f32x4*)(XCF + rg * 16 + 4 * (cq & 3)) = xc;
                float* oc = a.out + O_SLRUC + (size_t)bs * 3 * DH + cch;
                *(f32x4*)oc = c1; *(f32x4*)(oc + DH) = c2; *(f32x4*)(oc + 2 * DH) = x0;
            }
        }
        __syncthreads();
        if (wave < 2) {
            const int tile = wave;
            f32x4 ar = (f32x4){0.f, 0.f, 0.f, 0.f}, ax = ar;
#pragma unroll
            for (int ks = 0; ks < 2; ++ks) {
                const bf16x8 af = *(const LAS bf16x8*)(XC + (16 * tile + fr) * XC_PITCH + 64 * ks + 16 * fq);
                ar = __builtin_amdgcn_mfma_f32_16x16x32_bf16(af, Bf[0][ks], ar, 0, 0, 0);
                ax = __builtin_amdgcn_mfma_f32_16x16x32_bf16(af, Bf[1][ks], ax, 0, 0, 0);
            }
#pragma unroll
            for (int r4 = 0; r4 < 4; ++r4) {
                const int rl = 16 * tile + 4 * fq + r4, bs = bs0 + rl;
                const float xcv = XCF[rl * 16 + fr];
                const float rg_ = fsigmoid(ar[r4] + ba), ig = fsigmoid(ax[r4] + bx_);
                const float la = -8.0f * rg_ * spl;
                const float av = fexp(la); const float h = av * a.in[I_LRUH][(size_t)bs * DH + chn] + __builtin_amdgcn_sqrtf(fmaxf(fmaf(-av, av, 1.0f), 0.f)) * (ig * xcv);
                BX[rl * 16 + fr] = h; a.out[O_SLRUH + (size_t)bs * DH + chn] = h;
            }
        }
        __syncthreads();
        if (er < 32) {
            const size_t row = (size_t)R0 + bs0 + er;
            const u32x4 gw = *(const u32x4*)(GG + row * DH + ch0 + 8 * eh);
            const f32x4 h0 = *(const LAS f32x4*)(BX + er * 16 + 8 * eh), h1 = *(const LAS f32x4*)(BX + er * 16 + 8 * eh + 4);
            const f32x4 y0 = (f32x4){h0[0] * bf_lo(gw.x), h0[1] * bf_hi(gw.x), h0[2] * bf_lo(gw.y), h0[3] * bf_hi(gw.y)};
            const f32x4 y1 = (f32x4){h1[0] * bf_lo(gw.z), h1[1] * bf_hi(gw.z), h1[2] * bf_lo(gw.w), h1[3] * bf_hi(gw.w)};
            *(u32x4*)(MRG + row * D + DH + ch0 + 8 * eh) = pack8(y0, y1);
            float s = dot4(y0) + dot4(y1);
            s += __shfl_xor(s, 1);
            if (eh == 0) atomicAdd(ssq_lru + row, s);
        }
    }
    __syncthreads();
}

__global__ void __launch_bounds__(NWAVES * 64, 2) hymba_fwd(Args args) {
    extern __shared__ __attribute__((aligned(16))) unsigned char lds_raw[];
    LAS unsigned char* lds = (LAS unsigned char*)lds_raw;
    volatile LAS unsigned* MISC = (volatile LAS unsigned*)(lds + MISC_OFF);
    const int tid = threadIdx.x, lane = tid & 63, wave = __builtin_amdgcn_readfirstlane(tid >> 6);
    const int G = gridDim.x, bx = blockIdx.x;
    const int vcu = (G % 8 == 0) ? (bx % 8) * (G / 8) + bx / 8 : bx;
    unsigned char* ws = args.ws;
    unsigned* ctl = (unsigned*)(ws + WS_CTL);
    for (int u = tid; u < (LDS_BYTES - LDSCTL_OFF) / 4; u += NWAVES * 64) ((LAS unsigned*)(lds + LDSCTL_OFF))[u] = 0u;
    __syncthreads();
    XcdBarrier bar; bar.bar = ctl + CW_BAR; bar.x = 0; bar.st = nullptr;
    if (MK_N_LAUNCHES == 1) bar = xcd_barrier_post(ctl + CW_BAR, MISC + 8);
#define GRID_BAR() do { if (MK_N_LAUNCHES == 1) xcd_barrier(bar); } while (0)
#define STAMP(k) do { if (PROBE_PHASE >= 0 && bx == 0 && tid == 0) { const unsigned long long now_ = __builtin_amdgcn_s_memrealtime(); \
        const unsigned long long prev_ = ((unsigned long long)MISC[17] << 32) | MISC[16]; if ((k) == PROBE_PHASE) { const unsigned long long d_ = now_ - prev_; MISC[18] = (unsigned)d_; } \
        MISC[16] = (unsigned)now_; MISC[17] = (unsigned)(now_ >> 32); } } while (0)
    STAMP(-1);
    const int lo = args.ph_lo, hi = args.ph_hi;
#define IN(k) (lo <= (k) && (k) < hi)
#define BOTH(k) (IN(k) && IN((k) + 1))
    float* ssq = (float*)(ws + WS_CTL + CTL_SSQ_BYTE);
    float *ssq0 = ssq, *ssq1 = ssq + MPAD, *ssq_s5 = ssq + 2 * MPAD, *ssq_lru = ssq + 3 * MPAD, *ssq2 = ssq + 4 * MPAD, *ssq3 = ssq + 5 * MPAD;
    bf16_t* XB = (bf16_t*)(ws + WS_XB); float* X1 = (float*)(ws + WS_X1); bf16_t* HID = (bf16_t*)(ws + WS_H);
    bf16_t* U = (bf16_t*)(ws + WS_U); float* XL = (float*)(ws + WS_XLRU); bf16_t* GG = (bf16_t*)(ws + WS_GG); bf16_t* MRG = (bf16_t*)(ws + WS_MRG);
    float* SLAB = (float*)(ws + WS_SLAB); float* SLAB5 = (float*)(ws + WS_U);
    const int gws = wave * G + bx;

    unsigned* cnt_fin2 = ctl + CW_CNT; unsigned* cnt_fin5 = ctl + CW_CNT + 64;
#define PUBLISH(cnt) do { asm volatile("s_waitcnt vmcnt(0)" ::: "memory"); __builtin_amdgcn_fence(__ATOMIC_RELEASE, "agent"); asm volatile("s_waitcnt vmcnt(0)" ::: "memory"); \
        if (lane == 0) __hip_atomic_fetch_add((cnt), 1u, __ATOMIC_RELAXED, __HIP_MEMORY_SCOPE_AGENT); } while (0)

    if (IN(0)) { p0_prologue(args, lds, vcu, G, lane, wave); if (BOTH(0)) GRID_BAR(); STAMP(0); }
    if (IN(1)) {
        constexpr int GG1 = 242;
        if (bx < GG1) {
            pg8::Gemm g{XB, (const bf16_t*)(ws + WS_W13A), D, D}; pg8::PanelOrder S; S.init(2 * FF / 256, D / 64, D / 64, GG1, bx);
            pg8::EpiSwiGLU E{HID, ssq0};
            pg8::gemm_phase(lds, g, S, E);
        } else {
            for (int gj = bx - GG1; gj < NG; gj += G - GG1) p0_s5_group(args, lds, gj, tid);
        }
        if (BOTH(1)) GRID_BAR();
        STAMP(1);
    }
    if (IN(2)) {
        pg8::Gemm g{HID, (const bf16_t*)(ws + WS_W2A), FF, FF}; pg8::PanelOrder S; S.init(D / 256, FF / 64, 8, G, bx);
        pg8::EpiResid E{SLAB, XB, ssq1};
        pg8::gemm_phase(lds, g, S, E);
        if (bx >= 88) conv_tasks(args, lds + wave * STG_BYTES, 4, 5, (bx - 88) * NWAVES + wave, (G - 88) * NWAVES, lane);
        if (BOTH(2)) GRID_BAR();
        STAMP(2);
    }
    if (IN(3)) {
        constexpr int GG3 = 198;
        { const int r = (bx >= GG3 && wave < 3) ? (bx - GG3) + (G - GG3) * wave : MS;
          if (r < MS) {
            const int row = MP + r;
            const f32x4* xr = (const f32x4*)(args.in[I_XS] + (size_t)r * D) + lane; f32x4 v[8]; float sq = 0.f;
#pragma unroll
            for (int j = 0; j < 8; ++j) { f32x4 t = (f32x4){0.f, 0.f, 0.f, 0.f};
#pragma unroll
                for (int sl = 0; sl < 11; ++sl) t += ((const f32x4*)(SLAB + ((size_t)sl * MS + r) * D) + lane)[64 * j];
                v[j] = xr[64 * j] + 0.5f * t; sq += dot4(v[j]); }
            sq = wave_sum(sq);
#pragma unroll
            for (int j = 0; j < 8; ++j) { ((f32x4*)(X1 + (size_t)row * D) + lane)[64 * j] = v[j];
                u32x2 w; w.x = cvt_pk_bf16(v[j][0], v[j][1]); w.y = cvt_pk_bf16(v[j][2], v[j][3]); ((u32x2*)(XB + (size_t)row * D) + lane)[64 * j] = w; }
            if (lane == 0) ssq1[row] = sq;
            PUBLISH(cnt_fin2);
          } }
        if (bx < GG3) {
            pg8::Gemm g{XB, (const bf16_t*)(ws + WS_WIN), D, D}; pg8::PanelOrder S; S.init(DIN / 256, D / 64, D / 64, GG3, bx); S.ready = cnt_fin2; S.need = MS;
            pg8::EpiProj E{U, XL, GG, ssq1};
            pg8::gemm_phase(lds, g, S, E);
        } else conv_tasks(args, lds + wave * STG_BYTES, 6, 7, (bx - GG3) * NWAVES + wave, (G - GG3) * NWAVES, lane);
        if (BOTH(3)) GRID_BAR();
        STAMP(3);
    }
    if (IN(4)) {
        { bf16_t* GS5 = (bf16_t*)(ws + WS_GS5); const int gw = bx * NWAVES + wave, NGW = G * NWAVES;
          for (int m = M + gw; m < MPAD; m += NGW) {
              ((u32x4*)(GS5 + (size_t)m * DH))[lane] = (u32x4){0u, 0u, 0u, 0u}; ((u32x4*)(GS5 + (size_t)m * DH))[64 + lane] = (u32x4){0u, 0u, 0u, 0u};
              ((u32x4*)(MRG + (size_t)m * D + DH))[lane] = (u32x4){0u, 0u, 0u, 0u}; ((u32x4*)(MRG + (size_t)m * D + DH))[64 + lane] = (u32x4){0u, 0u, 0u, 0u}; } }
        for (int it = bx; it < NB * NG; it += G) { const int b = it >> 6, g = ((it & 7) << 3) | ((it >> 3) & 7); s5_prompt(args, lds, b, g, tid, lane, wave); }
        STAMP(20);
        for (int it = bx; it < 4 * NG; it += G) s5_sample(args, lds, it >> 2, 32 * (it & 3), tid);
        STAMP(21);
        for (int it = bx; it < NB * 64; it += G) lru_item(args, lds, false, it >> 6, ((it & 7) << 1) | ((it >> 5) & 1), (it >> 3) & 3, tid, lane, wave);
        STAMP(22);
        if (BOTH(4)) GRID_BAR();
        STAMP(4);
    }
    if (IN(5)) {
        pg8::Gemm g{(const bf16_t*)(ws + WS_GS5), (const bf16_t*)(ws + WS_WGLU), DH, DH}; pg8::PanelOrder S; S.init(DH / 256, DH / 64, DH / 64, G, bx);
        pg8::EpiGlu E{(const bf16_t*)(ws + WS_GS5), args.in[I_BGLU], MRG, ssq_s5};
        pg8::gemm_phase(lds, g, S, E);
        if (bx >= 132) for (int it = bx - 132; it < 256; it += G - 132) lru_item(args, lds, true, it & 3, it >> 4, (it >> 2) & 3, tid, lane, wave);
        if (BOTH(5)) GRID_BAR();
        STAMP(5);
    }
    if (IN(6)) {
        pg8::Gemm g{MRG, (const bf16_t*)(ws + WS_WOUT), D, D}; pg8::PanelOrder S; S.init(D / 256, D / 64, D / 64, G, bx); S.nExtra = 0;
        pg8::EpiOut E{ssq_s5, ssq_lru, XB, ssq2, nullptr};
        pg8::gemm_phase(lds, g, S, E);
        if (BOTH(6)) GRID_BAR();
        STAMP(6);
    }
    if (IN(7)) {
        constexpr int GG7 = 242;
        if (bx >= GG7) {
            pg8::Gemm g{MRG, (const bf16_t*)(ws + WS_WOUT), D, D}; pg8::PanelOrder S; S.init(D / 256, D / 64, D / 64, 8, bx - GG7); S.nwgP = 0;
            pg8::EpiOut E{ssq_s5, ssq_lru, XB, ssq2, nullptr};
            pg8::gemm_phase(lds, g, S, E);
            if (bx - GG7 < 8) { asm volatile("s_waitcnt vmcnt(0)" ::: "memory"); __syncthreads();
                if (tid == 0) { __builtin_amdgcn_fence(__ATOMIC_RELEASE, "agent"); asm volatile("s_waitcnt vmcnt(0)" ::: "memory"); __hip_atomic_fetch_add(cnt_fin5, 1u, __ATOMIC_RELAXED, __HIP_MEMORY_SCOPE_AGENT); } }
        }
        if (bx < GG7) {
            pg8::Gemm g{XB, (const bf16_t*)(ws + WS_W13B), D, D}; pg8::PanelOrder S; S.init(2 * FF / 256, D / 64, D / 64, GG7, bx); S.ready = cnt_fin5; S.need = 8;
            pg8::EpiSwiGLU E{HID, ssq2};
            pg8::gemm_phase(lds, g, S, E);
        } else conv_tasks(args, lds + wave * STG_BYTES, 8, 8, (bx - GG7) * NWAVES + wave, (G - GG7) * NWAVES, lane);
        if (BOTH(7)) GRID_BAR();
        STAMP(7);
    }
    if (IN(8)) {
        pg8::Gemm g{HID, (const bf16_t*)(ws + WS_W2B), FF, FF}; pg8::PanelOrder S; S.init(D / 256, FF / 64, 8, G, bx);
        pg8::EpiFinal E{XB, ssq3, SLAB};
        pg8::gemm_phase(lds, g, S, E);
        if (BOTH(8)) GRID_BAR();
        STAMP(8);
    }
    if (IN(9)) {
        const f32x4* gf = (const f32x4*)args.in[I_GFINAL] + lane;
        if (gws < MS) {
            const int row = MP + gws; f32x4 v[8]; float sq = 0.f;
#pragma unroll
            for (int j = 0; j < 8; ++j) { f32x4 t = (f32x4){0.f, 0.f, 0.f, 0.f};
#pragma unroll
                for (int sl = 0; sl < 11; ++sl) t += ((const f32x4*)(SLAB + ((size_t)sl * MS + gws) * D) + lane)[64 * j];
                const u32x2 xw = ((const u32x2*)(XB + (size_t)row * D) + lane)[64 * j];
                v[j] = (f32x4){bf_lo(xw.x), bf_hi(xw.x), bf_lo(xw.y), bf_hi(xw.y)} + 0.5f * t; sq += dot4(v[j]); }
            const float r = rsqrtf(wave_sum(sq) * (1.0f / D) + EPS);
#pragma unroll
            for (int j = 0; j < 8; ++j) ((f32x4*)(args.out + (size_t)row * D) + lane)[64 * j] = v[j] * gf[64 * j] * r;
        }
        const int gw = bx * NWAVES + wave, NGW = G * NWAVES;
        for (int m = gw; m < MP; m += NGW) {
            const float r = rsqrtf(ssq3[m] * (1.0f / D) + EPS);
            const u32x4* xb = (const u32x4*)(XB + (size_t)m * D) + lane;
            f32x4* o = (f32x4*)(args.out + (size_t)m * D) + 2 * lane;
            const f32x4* g2 = (const f32x4*)args.in[I_GFINAL] + 2 * lane;
            u32x4 w[4];
#pragma unroll
            for (int j = 0; j < 4; ++j) w[j] = xb[64 * j];
#pragma unroll
            for (int j = 0; j < 4; ++j) { o[128 * j] = pg8::res_lo(w[j]) * g2[128 * j] * r; o[128 * j + 1] = pg8::res_hi(w[j]) * g2[128 * j + 1] * r; }
        }
    }
    if (PROBE_PHASE >= 0 && bx == 0 && tid == 0) {
        STAMP(9);
        const unsigned long long t0_ = __builtin_amdgcn_s_memrealtime(), d_ = 4ull * MISC[18];
        while (__builtin_amdgcn_s_memrealtime() - t0_ < d_) __builtin_amdgcn_s_sleep(8);
    }
#undef IN
#undef BOTH
#undef GRID_BAR
}

extern "C" void kernel_launch(void* const* d_in, const int* in_sizes, int n_in, void* d_out, int out_size, void* d_ws, size_t ws_size, hipStream_t stream) {
    static int grid = 0;
    if (grid == 0) {
        if (n_in != N_IN || in_sizes[0] != MP * D || (size_t)out_size != O_END || ws_size < WS_END) {
            fprintf(stderr, "kernel_launch: unexpected problem: n_in %d in0 %d out %d ws %zu (need %zu)\n", n_in, n_in > 0 ? in_sizes[0] : -1, out_size, ws_size, (size_t)WS_END); grid = -1; return; }
        int dev = 0, cus = 0;
        if (hipGetDevice(&dev) != hipSuccess || hipDeviceGetAttribute(&cus, hipDeviceAttributeMultiprocessorCount, dev) != hipSuccess) { grid = -1; return; }
        if (hipFuncSetAttribute((const void*)hymba_fwd, hipFuncAttributeMaxDynamicSharedMemorySize, LDS_BYTES) != hipSuccess) { fprintf(stderr, "kernel_launch: hipFuncSetAttribute failed\n"); grid = -1; return; }
        int per_cu = 0;
        if (hipOccupancyMaxActiveBlocksPerMultiprocessor(&per_cu, (const void*)hymba_fwd, NWAVES * 64, LDS_BYTES) != hipSuccess || per_cu < 1)
            fprintf(stderr, "kernel_launch: note: occupancy query reports %d workgroups per CU\n", per_cu);
        (void)hipGetLastError();
        grid = cus;
    }
    if (grid < 0) return;
    if (hipMemsetAsync((char*)d_ws + WS_CTL, 0, CTL_ZERO_BYTES, stream) != hipSuccess) { fprintf(stderr, "kernel_launch: memset failed\n"); return; }
    Args a{};
    for (int i = 0; i < N_IN; ++i) a.in[i] = (const float*)d_in[i];
    a.out = (float*)d_out; a.ws = (unsigned char*)d_ws;
    if (MK_N_LAUNCHES == 1) {
        a.ph_lo = 0; a.ph_hi = NPHASE;
        hipLaunchKernelGGL(hymba_fwd, dim3(grid), dim3(NWAVES * 64), LDS_BYTES, stream, a);
    } else {
        for (int p = 0; p < NPHASE; ++p) { a.ph_lo = p; a.ph_hi = p + 1; hipLaunchKernelGGL(hymba_fwd, dim3(grid), dim3(NWAVES * 64), LDS_BYTES, stream, a); }
    }
}
```

```cpp
#include <hip/hip_runtime.h>
#include <cstdio>
#include <cstdint>

#define LAS __attribute__((address_space(3)))
#define GAS __attribute__((address_space(1)))
typedef unsigned short bf16_t;
typedef short bf16x8 __attribute__((ext_vector_type(8)));
typedef float f32x4 __attribute__((ext_vector_type(4)));
typedef float f32x16 __attribute__((ext_vector_type(16)));
typedef unsigned u32x4 __attribute__((ext_vector_type(4)));
typedef unsigned u32x2 __attribute__((ext_vector_type(2)));

#ifndef PROBE_PHASE
#define PROBE_PHASE -1
#endif
#ifndef MK_N_LAUNCHES
#define MK_N_LAUNCHES 1
#endif

constexpr int D = 2048, FF = 5632, DIN = 3072, DH = 1024;
constexpr int MP = 8192, MS = 128, M = MP + MS, MPAD = 8448;
constexpr int SEQ = 2048, NB = 4, NG = 64, NP = 64, GS = 16;
constexpr float EPS = 1e-6f;
constexpr int NPHASE = 10;
constexpr int NMP = MP / 256;
constexpr int NWAVES = 8;

constexpr size_t MiB = 1u << 20;
constexpr size_t WS_CTL = 0, CTL_ZERO_BYTES = 1 * MiB;
constexpr size_t WS_W13A = 1 * MiB, WS_W2A = 45 * MiB, WS_WIN = 67 * MiB, WS_WGLU = 79 * MiB, WS_WOUT = 81 * MiB, WS_W13B = 89 * MiB, WS_W2B = 133 * MiB;
constexpr size_t WS_S5M = 155 * MiB, WS_S5AUX = 171 * MiB;
constexpr size_t WS_XB = 172 * MiB;
constexpr size_t WS_X1 = 205 * MiB;
constexpr size_t WS_GS5 = WS_X1;
constexpr size_t WS_H = 271 * MiB;
constexpr size_t WS_U = 271 * MiB, WS_XLRU = WS_U + (size_t)MPAD * DH * 2, WS_GG = WS_XLRU + (size_t)MPAD * DH * 4, WS_MRG = WS_GG + (size_t)MPAD * DH * 2;
constexpr size_t WS_SLAB = 362 * MiB;
constexpr size_t WS_END = 373 * MiB;
static_assert(WS_MRG + (size_t)MPAD * D * 2 <= WS_END && WS_H + (size_t)MPAD * FF * 2 <= WS_SLAB && WS_SLAB + (size_t)11 * MS * D * 4 <= WS_END, "ws map");
constexpr int S5M_GROUP_BYTES = 256 * 1024;
constexpr int S5AUX_GROUP_FLOATS = 2304;
constexpr int CW_BAR = 4096;
constexpr int CW_CNT = 8192;
constexpr size_t CTL_SSQ_BYTE = 262144;

constexpr int RING_BYTES = 139264;
constexpr int LDSCTL_OFF = RING_BYTES, MISC_OFF = LDSCTL_OFF + 320;
constexpr int LDS_BYTES = 147456;

__device__ __forceinline__ unsigned cvt_pk_bf16(float lo, float hi) { unsigned r; asm volatile("v_cvt_pk_bf16_f32 %0, %1, %2" : "=v"(r) : "v"(lo), "v"(hi)); return r; }
__device__ __forceinline__ float bf_lo(unsigned w) { return __uint_as_float(w << 16); }
__device__ __forceinline__ float bf_hi(unsigned w) { return __uint_as_float(w & 0xffff0000u); }
__device__ __forceinline__ float fexp(float x) { return __builtin_amdgcn_exp2f(x * 1.44269504089f); }
__device__ __forceinline__ float fsigmoid(float x) { return __builtin_amdgcn_rcpf(1.0f + fexp(-x)); }
__device__ __forceinline__ float fsilu(float x) { return x * fsigmoid(x); }
__device__ __forceinline__ float fgelu(float x) { return x * fsigmoid(1.5957691216057308f * (x + 0.044715f * x * x * x)); }
__device__ __forceinline__ u32x4 pack8(const f32x4 a, const f32x4 b) { u32x4 w; w.x = cvt_pk_bf16(a[0], a[1]); w.y = cvt_pk_bf16(a[2], a[3]); w.z = cvt_pk_bf16(b[0], b[1]); w.w = cvt_pk_bf16(b[2], b[3]); return w; }
__device__ __forceinline__ float dot4(const f32x4 a) { return (a[0] * a[0] + a[1] * a[1]) + (a[2] * a[2] + a[3] * a[3]); }
__device__ __forceinline__ float wave_sum(float v) {
#pragma unroll
    for (int o = 1; o < 64; o <<= 1) v += __shfl_xor(v, o);
    return v;
}
__device__ __forceinline__ float neg_expm1(float x) {
    float p = 1.0f / 5040.0f; p = fmaf(p, x, 1.0f / 720.0f); p = fmaf(p, x, 1.0f / 120.0f); p = fmaf(p, x, 1.0f / 24.0f); p = fmaf(p, x, 1.0f / 6.0f); p = fmaf(p, x, 0.5f); p = fmaf(p, x, 1.0f);
    const float small = -(p * x), big = 1.0f - fexp(x);
    return x > -0.35f ? small : big;
}
#define LDS_WAIT() asm volatile("s_waitcnt lgkmcnt(0)" ::: "memory")
#define VM_WAIT() asm volatile("s_waitcnt vmcnt(0)" ::: "memory")

namespace pg8 {
constexpr int BM = 256, BK = 64, HALF = 128, HTB = HALF * BK * 2, STAGE_BYTES = 8 * HTB, NXCD = 8, WGM = 8;
__host__ __device__ __forceinline__ int lds_byte(int r, int c) { const int st = (r >> 4) * 2 + (c >> 5), rr = r & 15, cc = c & 31, ob = rr * 64 + cc * 2; return st * 1024 + (ob ^ (((ob >> 9) & 1) << 5)); }
__host__ __device__ __forceinline__ void stage_rc(int b, int& R, int& C) { const int st = b / 1024, sb = b % 1024, swz = sb ^ (((sb >> 9) & 1) << 5); R = (st >> 1) * 16 + swz / 64; C = (st & 1) * 32 + (swz % 64) / 2; }
__host__ __device__ __forceinline__ int perm32(int rho) { const int n = rho >> 4, i = rho & 15; return 8 * (i >> 2) + 4 * n + (i & 3); }

struct Unit { int pm, pn, kt0, nkt; };
struct Gemm { const bf16_t* A; const bf16_t* Bt; int lda, ldb; };

struct PanelOrder {
    int nN, nwgP, G, c, nktFull, sliceKt, nExtra;
    unsigned* ready; unsigned need;
    __device__ void init(int nN_, int nktFull_, int sliceKt_, int G_, int c_) { nN = nN_; nwgP = 32 * nN_; G = G_; c = c_; nktFull = nktFull_; sliceKt = sliceKt_; nExtra = nN_ * (nktFull_ / sliceKt_); ready = nullptr; need = 0u; }
    __device__ __forceinline__ void a_ready(const Unit& u) const {
        if (ready == nullptr || u.pm != 32) return;
        if (threadIdx.x < 64) {
            unsigned polls = 0;
            while ((unsigned)__builtin_amdgcn_readfirstlane(__hip_atomic_load(ready, __ATOMIC_RELAXED, __HIP_MEMORY_SCOPE_AGENT)) < need) { __builtin_amdgcn_s_sleep(2); if (++polls > (1u << 22)) break; }
            __builtin_amdgcn_fence(__ATOMIC_ACQUIRE, "agent");
            asm volatile("s_waitcnt vmcnt(0)" ::: "memory");
        }
        asm volatile("" ::: "memory"); __builtin_amdgcn_s_barrier(); asm volatile("" ::: "memory");
    }
    __device__ bool next(int i, Unit& u) const {
        const long L = (long)i * G + c;
        if (L < nwgP) {
            int wgid = (int)L; { const int q = nwgP / NXCD, r = nwgP % NXCD, xcd = wgid % NXCD, off = wgid / NXCD; wgid = (xcd < r ? xcd * (q + 1) : r * (q + 1) + (xcd - r) * q) + off; }
            const int nig = WGM * nN, gid = wgid / nig, fm = gid * WGM, gsz = (32 - fm) < WGM ? (32 - fm) : WGM;
            u.pm = fm + ((wgid % nig) % gsz); u.pn = (wgid % nig) / gsz; u.kt0 = 0; u.nkt = nktFull; return true;
        }
        const int e = (int)(L - nwgP); if (e >= nExtra) return false;
        u.pm = 32; u.pn = e % nN; u.kt0 = (e / nN) * sliceKt; u.nkt = sliceKt; return true;
    }
};

template <class Epi, class Sched>
__device__ __forceinline__ void gemm_phase(LAS unsigned char* lds, const Gemm g, const Sched& S, const Epi& E) {
    const int tid = threadIdx.x, wid = __builtin_amdgcn_readfirstlane(tid >> 6), lane = tid & 63, wr = wid >> 2, wc = wid & 3, fr = lane & 15, fq = lane >> 4;
    unsigned voffA[2], voffB[2];
#pragma unroll
    for (int i = 0; i < 2; ++i) { int R, C; stage_rc(tid * 16 + i * 8192, R, C); const int Rb = Epi::PERM ? ((R & ~31) + perm32(R & 31)) : R;
        voffA[i] = (unsigned)(R * g.lda + C) * 2u; voffB[i] = (unsigned)(Rb * g.ldb + C) * 2u; }
    const size_t kstep = (size_t)(BK * 2);
    const size_t hstepA = (size_t)HALF * g.lda * 2, hstepB = (size_t)HALF * g.ldb * 2;
    const size_t tstepA = 2 * hstepA, tstepB = 2 * hstepB;
    const unsigned ldsw = (unsigned)wid * 1024u;
    const int aoff = lds_byte(wr * 64 + fr, fq * 8), boff = lds_byte(wc * 32 + fr, fq * 8);
#define PG8_SA(b, h) (((b) * 2 + (h)) * HTB)
#define PG8_SB(b, h) ((4 + (b) * 2 + (h)) * HTB)
#define PG8_STAGE(bufoff, gbase, voff) do { _Pragma("unroll") for (int _i = 0; _i < 2; ++_i) \
        __builtin_amdgcn_global_load_lds((const unsigned*)((const char*)(gbase) + (voff)[_i]), (LAS unsigned*)(lds + (bufoff) + ldsw + _i * 8192), 16, 0, 0); } while (0)
#define PG8_LDA(dst, b, h) do { _Pragma("unroll") for (int m = 0; m < 4; ++m) _Pragma("unroll") for (int k = 0; k < 2; ++k) dst[m][k] = *(const LAS bf16x8*)(lds + PG8_SA(b, h) + aoff + m * 2048 + k * 1024); } while (0)
#define PG8_LDB(dst, b, h) do { _Pragma("unroll") for (int n = 0; n < 2; ++n) _Pragma("unroll") for (int k = 0; k < 2; ++k) dst[n][k] = *(const LAS bf16x8*)(lds + PG8_SB(b, h) + boff + n * 2048 + k * 1024); } while (0)
#define PG8_MMA(ai, bj, At, Bt) do { __builtin_amdgcn_s_setprio(1); _Pragma("unroll") for (int m = 0; m < 4; ++m) _Pragma("unroll") for (int n = 0; n < 2; ++n) _Pragma("unroll") for (int k = 0; k < 2; ++k) \
        acc[ai][bj][m][n] = __builtin_amdgcn_mfma_f32_16x16x32_bf16(Bt[n][k], At[m][k], acc[ai][bj][m][n], 0, 0, 0); __builtin_amdgcn_s_setprio(0); } while (0)
#define PG8_WAIT_V(n) asm volatile("s_waitcnt vmcnt(" #n ")" ::: "memory")
#define PG8_WAIT_L(n) asm volatile("s_waitcnt lgkmcnt(" #n ")" ::: "memory")
#define PG8_BAR __builtin_amdgcn_s_barrier()
#define PG8_SCHED __builtin_amdgcn_sched_barrier(0)
    Unit cur, nxt; int ui = 0;
    if (!S.next(0, cur)) return;
    f32x4 acc[2][2][4][2];
#pragma unroll
    for (int a = 0; a < 2; ++a)
#pragma unroll
        for (int b = 0; b < 2; ++b)
#pragma unroll
            for (int m = 0; m < 4; ++m)
#pragma unroll
                for (int n = 0; n < 2; ++n) acc[a][b][m][n] = (f32x4){0.f, 0.f, 0.f, 0.f};
    bf16x8 At[4][2], B0[2][2], B1[2][2];
    const char* cA = (const char*)g.A + (size_t)cur.pm * tstepA + (size_t)cur.kt0 * kstep;
    const char* cB = (const char*)g.Bt + (size_t)cur.pn * tstepB + (size_t)cur.kt0 * kstep;
    S.a_ready(cur);
    PG8_STAGE(PG8_SB(0, 0), cB, voffB); PG8_STAGE(PG8_SB(0, 1), cB + hstepB, voffB); PG8_STAGE(PG8_SA(0, 0), cA, voffA); PG8_STAGE(PG8_SA(0, 1), cA + hstepA, voffA);
    if (wr == 1) PG8_BAR;
    PG8_WAIT_V(2); PG8_BAR;
    PG8_STAGE(PG8_SB(1, 0), cB + kstep, voffB); PG8_STAGE(PG8_SA(1, 0), cA + kstep, voffA); PG8_STAGE(PG8_SB(1, 1), cB + hstepB + kstep, voffB);
    PG8_WAIT_V(6); PG8_BAR;
    for (;;) {
        const bool has_next = S.next(ui + 1, nxt);
        const char* nA = has_next ? (const char*)g.A + (size_t)nxt.pm * tstepA + (size_t)nxt.kt0 * kstep : cA;
        const char* nB = has_next ? (const char*)g.Bt + (size_t)nxt.pn * tstepB + (size_t)nxt.kt0 * kstep : cB;
        const int nt = cur.nkt;
        for (int t = 0; t < nt; t += 2) {
            const bool last = (t == nt - 2);
            if (last && has_next) S.a_ready(nxt);
            const char* a1 = cA + (size_t)(t + 1) * kstep;
            const char* a2 = last ? nA : cA + (size_t)(t + 2) * kstep; const char* b2 = last ? nB : cB + (size_t)(t + 2) * kstep;
            const char* a3 = a2 + kstep; const char* b3 = b2 + kstep;
            if constexpr (Epi::HAS_MID) { if (t == Epi::MID_T) E.mid(acc, cur, wr, wc, fr, fq); }
            PG8_LDB(B0, 0, 0); PG8_LDB(B1, 0, 1); PG8_SCHED; PG8_LDA(At, 0, 0); PG8_STAGE(PG8_SA(1, 1), a1 + hstepA, voffA);
            PG8_WAIT_V(8); PG8_WAIT_L(0); PG8_BAR; PG8_MMA(0, 0, At, B0); PG8_MMA(0, 1, At, B1); PG8_BAR; PG8_SCHED;
            PG8_LDA(At, 0, 1); PG8_STAGE(PG8_SB(0, 0), b2, voffB); PG8_STAGE(PG8_SB(0, 1), b2 + hstepB, voffB); PG8_STAGE(PG8_SA(0, 0), a2, voffA);
            PG8_WAIT_V(8); PG8_WAIT_L(0); PG8_BAR; PG8_MMA(1, 0, At, B0); PG8_MMA(1, 1, At, B1); PG8_BAR; PG8_SCHED;
            PG8_LDB(B0, 1, 0); PG8_LDB(B1, 1, 1); PG8_SCHED; PG8_LDA(At, 1, 0); PG8_STAGE(PG8_SA(0, 1), a2 + hstepA, voffA);
            PG8_WAIT_V(8); PG8_WAIT_L(0); PG8_BAR; PG8_MMA(0, 0, At, B0); PG8_MMA(0, 1, At, B1); PG8_BAR; PG8_SCHED;
            PG8_LDA(At, 1, 1); PG8_STAGE(PG8_SB(1, 0), b3, voffB); PG8_STAGE(PG8_SB(1, 1), b3 + hstepB, voffB); PG8_STAGE(PG8_SA(1, 0), a3, voffA);
            PG8_WAIT_V(8); PG8_WAIT_L(0); PG8_BAR; PG8_MMA(1, 0, At, B0); PG8_MMA(1, 1, At, B1); PG8_BAR; PG8_SCHED;
        }
        if (wr == 0) PG8_BAR;
        E(acc, cur, wr, wc, fr, fq);
        if (!has_next) break;
#pragma unroll
        for (int a = 0; a < 2; ++a)
#pragma unroll
            for (int b = 0; b < 2; ++b)
#pragma unroll
                for (int m = 0; m < 4; ++m)
#pragma unroll
                    for (int n = 0; n < 2; ++n) acc[a][b][m][n] = (f32x4){0.f, 0.f, 0.f, 0.f};
        cur = nxt; cA = nA; cB = nB; ++ui;
        if (wr == 1) PG8_BAR;
    }
    PG8_WAIT_V(0);
    PG8_BAR;
#undef PG8_SA
#undef PG8_SB
#undef PG8_STAGE
#undef PG8_LDA
#undef PG8_LDB
#undef PG8_MMA
#undef PG8_WAIT_V
#undef PG8_WAIT_L
#undef PG8_BAR
#undef PG8_SCHED
}


typedef f32x4 Acc[2][2][4][2];
__device__ __forceinline__ void slab_store(const Acc& acc, const Unit& u, float* slab, int wr, int wc, int fr, int fq) {
    int rowl = wr * 64 + fr, col0 = u.pn * BM + wc * 32 + 8 * fq; asm volatile("" : "+v"(rowl), "+v"(col0));
    float* base = slab + (size_t)(u.kt0 / u.nkt) * ((size_t)MS * D);
#pragma unroll
    for (int m = 0; m < 4; ++m)
#pragma unroll
        for (int bj = 0; bj < 2; ++bj) { float* p = base + (size_t)(rowl + m * 16) * D + col0 + bj * HALF; *(f32x4*)p = acc[0][bj][m][0]; *(f32x4*)(p + 4) = acc[0][bj][m][1]; }
}
struct EpiSwiGLU {
    static constexpr bool PERM = true, HAS_MID = false; static constexpr int MID_T = -1;
    bf16_t* O; const float* ssq;
    __device__ __forceinline__ void mid(Acc&, const Unit&, int, int, int, int) const {}
    __device__ __forceinline__ void operator()(const Acc& acc, const Unit& u, int wr, int wc, int fr, int fq) const {
        int row0 = u.pm * BM + wr * 64 + fr, colh = u.pn * 128 + wc * 32 + 8 * fq; asm volatile("" : "+v"(row0), "+v"(colh));
        float sq[2][4];
#pragma unroll
        for (int ai = 0; ai < 2; ++ai)
#pragma unroll
            for (int m = 0; m < 4; ++m) sq[ai][m] = ssq[row0 + ai * HALF + m * 16];
        asm volatile("" ::: "memory");
#pragma unroll
        for (int ai = 0; ai < 2; ++ai)
#pragma unroll
            for (int m = 0; m < 4; ++m) {
                const int row = row0 + ai * HALF + m * 16;
                const float r = rsqrtf(sq[ai][m] * (1.0f / D) + EPS);
                f32x4 h0, h1;
#pragma unroll
                for (int j = 0; j < 4; ++j) { h0[j] = fsilu(acc[ai][0][m][0][j] * r) * (acc[ai][1][m][0][j] * r); h1[j] = fsilu(acc[ai][0][m][1][j] * r) * (acc[ai][1][m][1][j] * r); }
                *(u32x4*)(O + (size_t)row * FF + colh) = pack8(h0, h1);
            }
    }
};
typedef u32x4 ResTile[2][4][2];
typedef u32x4 ResHalf[4][2];
__device__ __forceinline__ void res_load(ResTile& res, const bf16_t* XB, int row0, int col0) {
#pragma unroll
    for (int ai = 0; ai < 2; ++ai)
#pragma unroll
        for (int m = 0; m < 4; ++m)
#pragma unroll
            for (int bj = 0; bj < 2; ++bj) res[ai][m][bj] = *(const u32x4*)(XB + (size_t)(row0 + ai * HALF + m * 16) * D + col0 + bj * HALF);
    asm volatile("" ::: "memory");
}
__device__ __forceinline__ void res_load_half(ResHalf& res, const bf16_t* XB, int rowh, int col0) {
#pragma unroll
    for (int m = 0; m < 4; ++m)
#pragma unroll
        for (int bj = 0; bj < 2; ++bj) res[m][bj] = *(const u32x4*)(XB + (size_t)(rowh + m * 16) * D + col0 + bj * HALF);
    asm volatile("" ::: "memory");
}
__device__ __forceinline__ f32x4 res_lo(const u32x4 w) { return (f32x4){bf_lo(w.x), bf_hi(w.x), bf_lo(w.y), bf_hi(w.y)}; }
__device__ __forceinline__ f32x4 res_hi(const u32x4 w) { return (f32x4){bf_lo(w.z), bf_hi(w.z), bf_lo(w.w), bf_hi(w.w)}; }
struct EpiResid {
    static constexpr bool PERM = true, HAS_MID = false; static constexpr int MID_T = -1;
    float* slab; bf16_t* XB; float* ssq;
    __device__ __forceinline__ void mid(Acc&, const Unit&, int, int, int, int) const {}
    __device__ __forceinline__ void operator()(const Acc& acc, const Unit& u, int wr, int wc, int fr, int fq) const {
        if (u.pm == 32) { slab_store(acc, u, slab, wr, wc, fr, fq); return; }
        int row0 = u.pm * BM + wr * 64 + fr, col0 = u.pn * BM + wc * 32 + 8 * fq; asm volatile("" : "+v"(row0), "+v"(col0));
#pragma unroll
        for (int ai = 0; ai < 2; ++ai) {
            ResHalf res; res_load_half(res, XB, row0 + ai * HALF, col0);
#pragma unroll
            for (int m = 0; m < 4; ++m) {
                const int row = row0 + ai * HALF + m * 16;
                float s = 0.f;
#pragma unroll
                for (int bj = 0; bj < 2; ++bj) {
                    const f32x4 v0 = res_lo(res[m][bj]) + 0.5f * acc[ai][bj][m][0], v1 = res_hi(res[m][bj]) + 0.5f * acc[ai][bj][m][1];
                    *(u32x4*)(XB + (size_t)row * D + col0 + bj * HALF) = pack8(v0, v1);
                    s += dot4(v0) + dot4(v1);
                }
                s += __shfl_xor(s, 16); s += __shfl_xor(s, 32);
                if (fq == 0) atomicAdd(ssq + row, s);
            }
        }
    }
};
struct EpiProj {
    static constexpr bool PERM = true, HAS_MID = false; static constexpr int MID_T = -1;
    bf16_t* U; float* XL; bf16_t* GG; const float* ssq;
    __device__ __forceinline__ void mid(Acc&, const Unit&, int, int, int, int) const {}
    __device__ __forceinline__ void operator()(const Acc& acc, const Unit& u, int wr, int wc, int fr, int fq) const {
        int row0 = u.pm * BM + wr * 64 + fr, col0 = (u.pn & 3) * BM + wc * 32 + 8 * fq; const int seg = u.pn >> 2; asm volatile("" : "+v"(row0), "+v"(col0));
        float sq[2][4];
#pragma unroll
        for (int ai = 0; ai < 2; ++ai)
#pragma unroll
            for (int m = 0; m < 4; ++m) sq[ai][m] = ssq[row0 + ai * HALF + m * 16];
        asm volatile("" ::: "memory");
#pragma unroll
        for (int ai = 0; ai < 2; ++ai)
#pragma unroll
            for (int m = 0; m < 4; ++m) {
                const int row = row0 + ai * HALF + m * 16;
                const float r = rsqrtf(sq[ai][m] * (1.0f / D) + EPS);
#pragma unroll
                for (int bj = 0; bj < 2; ++bj) {
                    const size_t o = (size_t)row * DH + col0 + bj * HALF;
                    f32x4 v0 = acc[ai][bj][m][0] * r, v1 = acc[ai][bj][m][1] * r;
                    if (seg == 0) { *(u32x4*)(U + o) = pack8(v0, v1); }
                    else if (seg == 1) { *(f32x4*)(XL + o) = v0; *(f32x4*)(XL + o + 4) = v1; }
                    else {
#pragma unroll
                        for (int j = 0; j < 4; ++j) { v0[j] = fgelu(v0[j]); v1[j] = fgelu(v1[j]); }
                        *(u32x4*)(GG + o) = pack8(v0, v1);
                    }
                }
            }
    }
};
struct EpiGlu {
    static constexpr bool PERM = true, HAS_MID = false; static constexpr int MID_T = -1;
    const bf16_t* GS; const float* bias; bf16_t* MRG; float* ssq;
    __device__ __forceinline__ void mid(Acc&, const Unit&, int, int, int, int) const {}
    __device__ __forceinline__ void operator()(const Acc& acc, const Unit& u, int wr, int wc, int fr, int fq) const {
        int row0 = u.pm * BM + wr * 64 + fr, col0 = u.pn * BM + wc * 32 + 8 * fq; asm volatile("" : "+v"(row0), "+v"(col0));
        ResTile gt;
#pragma unroll
        for (int ai = 0; ai < 2; ++ai)
#pragma unroll
            for (int m = 0; m < 4; ++m)
#pragma unroll
                for (int bj = 0; bj < 2; ++bj) gt[ai][m][bj] = *(const u32x4*)(GS + (size_t)(row0 + ai * HALF + m * 16) * DH + col0 + bj * HALF);
        f32x4 bb[2][2];
#pragma unroll
        for (int bj = 0; bj < 2; ++bj) { bb[bj][0] = *(const f32x4*)(bias + col0 + bj * HALF); bb[bj][1] = *(const f32x4*)(bias + col0 + bj * HALF + 4); }
        asm volatile("" ::: "memory");
#pragma unroll
        for (int ai = 0; ai < 2; ++ai)
#pragma unroll
            for (int m = 0; m < 4; ++m) {
                const int row = row0 + ai * HALF + m * 16;
                float s = 0.f;
#pragma unroll
                for (int bj = 0; bj < 2; ++bj) {
                    const f32x4 g0 = res_lo(gt[ai][m][bj]), g1 = res_hi(gt[ai][m][bj]);
                    f32x4 v0, v1;
#pragma unroll
                    for (int j = 0; j < 4; ++j) { v0[j] = g0[j] * fsigmoid(acc[ai][bj][m][0][j] + bb[bj][0][j]); v1[j] = g1[j] * fsigmoid(acc[ai][bj][m][1][j] + bb[bj][1][j]); }
                    *(u32x4*)(MRG + (size_t)row * D + col0 + bj * HALF) = pack8(v0, v1);
                    s += dot4(v0) + dot4(v1);
                }
                s += __shfl_xor(s, 16); s += __shfl_xor(s, 32);
                if (fq == 0) atomicAdd(ssq + row, s);
            }
    }
};
struct EpiOut {
    static constexpr bool PERM = true, HAS_MID = true; static constexpr int MID_T = 16;
    const float* ssq_s5; const float* ssq_lru; bf16_t* XB; float* ssq; float* slab;
    __device__ __forceinline__ void mid(Acc& acc, const Unit& u, int wr, int wc, int fr, int fq) const {
        if (u.pm == 32 && slab) return;
        int row0 = u.pm * BM + wr * 64 + fr; asm volatile("" : "+v"(row0));
        float f[2][4];
#pragma unroll
        for (int ai = 0; ai < 2; ++ai)
#pragma unroll
            for (int m = 0; m < 4; ++m) { const int row = row0 + ai * HALF + m * 16; f[ai][m] = rsqrtf(ssq_s5[row] * (1.0f / DH) + EPS) * sqrtf(ssq_lru[row] * (1.0f / DH) + EPS); }
#pragma unroll
        for (int ai = 0; ai < 2; ++ai)
#pragma unroll
            for (int m = 0; m < 4; ++m)
#pragma unroll
                for (int bj = 0; bj < 2; ++bj)
#pragma unroll
                    for (int n = 0; n < 2; ++n) acc[ai][bj][m][n] = acc[ai][bj][m][n] * f[ai][m];
    }
    __device__ __forceinline__ void operator()(const Acc& acc, const Unit& u, int wr, int wc, int fr, int fq) const {
        if (u.pm == 32 && slab) { slab_store(acc, u, slab, wr, wc, fr, fq); return; }
        int row0 = u.pm * BM + wr * 64 + fr, col0 = u.pn * BM + wc * 32 + 8 * fq; asm volatile("" : "+v"(row0), "+v"(col0));
        float rl[2][4];
#pragma unroll
        for (int ai = 0; ai < 2; ++ai)
#pragma unroll
            for (int m = 0; m < 4; ++m) rl[ai][m] = ssq_lru[row0 + ai * HALF + m * 16];
#pragma unroll
        for (int ai = 0; ai < 2; ++ai) {
            ResHalf res; res_load_half(res, XB, row0 + ai * HALF, col0);
#pragma unroll
            for (int m = 0; m < 4; ++m) {
                const int row = row0 + ai * HALF + m * 16;
                const float r = rsqrtf(rl[ai][m] * (1.0f / DH) + EPS);
                float s = 0.f;
#pragma unroll
                for (int bj = 0; bj < 2; ++bj) {
                    const f32x4 v0 = res_lo(res[m][bj]) + r * acc[ai][bj][m][0], v1 = res_hi(res[m][bj]) + r * acc[ai][bj][m][1];
                    *(u32x4*)(XB + (size_t)row * D + col0 + bj * HALF) = pack8(v0, v1);
                    s += dot4(v0) + dot4(v1);
                }
                s += __shfl_xor(s, 16); s += __shfl_xor(s, 32);
                if (fq == 0) atomicAdd(ssq + row, s);
            }
        }
    }
};
struct EpiFinal {
    static constexpr bool PERM = true, HAS_MID = false; static constexpr int MID_T = -1;
    bf16_t* XB; float* ssq; float* slab;
    __device__ __forceinline__ void mid(Acc&, const Unit&, int, int, int, int) const {}
    __device__ __forceinline__ void operator()(const Acc& acc, const Unit& u, int wr, int wc, int fr, int fq) const {
        if (u.pm == 32) { slab_store(acc, u, slab, wr, wc, fr, fq); return; }
        int row0 = u.pm * BM + wr * 64 + fr, col0 = u.pn * BM + wc * 32 + 8 * fq; asm volatile("" : "+v"(row0), "+v"(col0));
#pragma unroll
        for (int ai = 0; ai < 2; ++ai) {
            ResHalf res; res_load_half(res, XB, row0 + ai * HALF, col0);
#pragma unroll
            for (int m = 0; m < 4; ++m) {
                const int row = row0 + ai * HALF + m * 16;
                float s = 0.f;
#pragma unroll
                for (int bj = 0; bj < 2; ++bj) {
                    const f32x4 v0 = res_lo(res[m][bj]) + 0.5f * acc[ai][bj][m][0], v1 = res_hi(res[m][bj]) + 0.5f * acc[ai][bj][m][1];
                    *(u32x4*)(XB + (size_t)row * D + col0 + bj * HALF) = pack8(v0, v1);
                    s += dot4(v0) + dot4(v1);
                }
                s += __shfl_xor(s, 16); s += __shfl_xor(s, 32);
                if (fq == 0) atomicAdd(ssq + row, s);
            }
        }
    }
};
}

#define XB_TMO      128
#define XB_XCNT(j)  (256  + 64 * (j))
#define XB_XSUB(j)  (1280 + 64 * (j))
#define XB_XGEN(j)  (2304 + 64 * (j))
#define XB_TOP      3328
#define XB_TOPGEN   3392
#define XCD_BAR_WORDS 3456
#define XB_SPIN_CAP (1u << 18)
__device__ __forceinline__ unsigned xb_ld(unsigned* p)              { return __hip_atomic_load(p, __ATOMIC_RELAXED, __HIP_MEMORY_SCOPE_AGENT); }
__device__ __forceinline__ unsigned xb_add(unsigned* p, unsigned v) { return __hip_atomic_fetch_add(p, v, __ATOMIC_RELAXED, __HIP_MEMORY_SCOPE_AGENT); }
__device__ __forceinline__ unsigned xb_xcc_id() { return (unsigned)__builtin_amdgcn_s_getreg((3 << 11) | 20) & 0xFu; }
#define XB_SPIN(cond, bar) do { unsigned _sp = 0; while (cond) { __builtin_amdgcn_s_sleep(1); \
    if ((++_sp & 255u) == 0u) { if (xb_ld(&(bar)[XB_TMO])) break; if (_sp > XB_SPIN_CAP) { atomicAdd(&(bar)[XB_TMO], 1u); break; } } } } while (0)
struct XcdBarrier { unsigned* bar; unsigned x; volatile LAS unsigned* st; };
__device__ __forceinline__ XcdBarrier xcd_barrier_post(unsigned* bar, volatile LAS unsigned* st) {
    XcdBarrier b; b.bar = bar; b.x = xb_xcc_id(); b.st = st;
    if (threadIdx.x == 0) (void)xb_add(&bar[XB_XCNT(b.x)], 1u);
    return b;
}
__device__ __forceinline__ void xcd_barrier_complete(unsigned* bar, unsigned x, unsigned& nloc, unsigned& nx) {
    const unsigned G = gridDim.x * gridDim.y * gridDim.z;
    unsigned sum, cnt, mine, sp = 0u;
    for (;;) {
        sum = 0u; cnt = 0u; mine = 0u;
#pragma unroll
        for (unsigned j = 0; j < 16; ++j) { const unsigned c = xb_ld(&bar[XB_XCNT(j)]); sum += c; cnt += (c > 0u) ? 1u : 0u; mine = (j == x) ? c : mine; }
        if (sum == G) break;
        __builtin_amdgcn_s_sleep(1);
        if ((++sp & 255u) == 0u) { if (xb_ld(&bar[XB_TMO])) break; if (sp > XB_SPIN_CAP) { atomicAdd(&bar[XB_TMO], 1u); break; } }
    }
    nloc = mine > 0u ? mine : 1u; nx = cnt > 0u ? cnt : 1u;
}
__device__ __forceinline__ void xcd_barrier(const XcdBarrier& b) {
    asm volatile("s_waitcnt vmcnt(0)" ::: "memory");
    __syncthreads();
    if (threadIdx.x == 0) {
        unsigned* bar = b.bar;
        __builtin_amdgcn_s_waitcnt(0);
        unsigned nloc = b.st[0], nx = b.st[1];
        if (nloc == 0u) { xcd_barrier_complete(bar, b.x, nloc, nx); b.st[0] = nloc; b.st[1] = nx; }
        const unsigned old = xb_add(&bar[XB_XSUB(b.x)], 1u);
        const unsigned gen = old / nloc;
        if (old + 1u == (gen + 1u) * nloc) {
            __builtin_amdgcn_fence(__ATOMIC_RELEASE, "agent");
            asm volatile("s_waitcnt vmcnt(0)" ::: "memory");
            const unsigned og = xb_add(&bar[XB_TOP], 1u);
            const unsigned tg = og / nx;
            __builtin_amdgcn_fence(__ATOMIC_ACQUIRE, "agent");
            if (og + 1u == (tg + 1u) * nx) xb_add(&bar[XB_TOPGEN], 1u);
            else XB_SPIN(xb_ld(&bar[XB_TOPGEN]) == tg, bar);
            asm volatile("s_waitcnt vmcnt(0)" ::: "memory");
        } else {
            __builtin_amdgcn_fence(__ATOMIC_ACQUIRE, "agent");
            XB_SPIN(xb_ld(&bar[XB_TOPGEN]) == gen, bar);
            asm volatile("s_waitcnt vmcnt(0)" ::: "memory");
        }
    }
    __syncthreads();
}

enum { I_XP = 0, I_XS, I_S5RE, I_S5IM, I_LRUH, I_LRUCONV, I_GFFN1, I_W1A, I_W3A, I_W2A, I_GMIX, I_WIN, I_LAMRE, I_LAMIM, I_LOGDT, I_BRE, I_BIM, I_CRE, I_CIM,
       I_DSKIP, I_WGLU, I_BGLU, I_CONVW, I_CONVB, I_WA, I_BA, I_WX, I_BX, I_LAML, I_GS5, I_GLRU, I_WOUT, I_GFFN2, I_W1B, I_W3B, I_W2B, I_GFINAL, N_IN };
struct Args { const float* in[N_IN]; float* out; unsigned char* ws; int ph_lo, ph_hi; };
constexpr size_t O_Y = 0, O_PS5RE = (size_t)M * D, O_PS5IM = O_PS5RE + NB * NG * NP, O_PLRUH = O_PS5IM + NB * NG * NP, O_PLRUC = O_PLRUH + NB * DH,
                 O_SS5RE = O_PLRUC + NB * 3 * DH, O_SS5IM = O_SS5RE + (size_t)MS * NG * NP, O_SLRUH = O_SS5IM + (size_t)MS * NG * NP, O_SLRUC = O_SLRUH + (size_t)MS * DH,
                 O_END = O_SLRUC + (size_t)MS * 3 * DH;
static_assert(O_END == 18661376, "output size");

typedef float f32x2 __attribute__((ext_vector_type(2)));
constexpr int STG_PITCH = 144, STG_BYTES = 64 * STG_PITCH;
__device__ __forceinline__ void p0_task(const float* W, int N, const float* gk, bf16_t* WT, int ldt, int k0, int n0, int nd0, LAS unsigned char* stg, int lane) {
    const float* src = W + (size_t)k0 * N + n0 + 2 * lane;
    f32x2 v[64];
#if PROBE_PHASE >= 0
    { const float* p = src; const size_t step = (size_t)N;
#pragma unroll
      for (int i = 0; i < 64; ++i) { v[i] = __builtin_nontemporal_load((const f32x2*)p); p += step; if ((i & 7) == 7) asm volatile("" : "+v"(p)); } }
#else
#pragma unroll
    for (int i = 0; i < 64; ++i) v[i] = __builtin_nontemporal_load((const f32x2*)(src + (size_t)i * N));
#endif
    if (gk) {
#pragma unroll
        for (int i = 0; i < 64; ++i) v[i] = v[i] * gk[k0 + i];
    }
#pragma unroll
    for (int j = 0; j < 2; ++j) {
#pragma unroll
        for (int kb = 0; kb < 8; ++kb) {
            u32x4 o; o.x = cvt_pk_bf16(v[8 * kb][j], v[8 * kb + 1][j]); o.y = cvt_pk_bf16(v[8 * kb + 2][j], v[8 * kb + 3][j]); o.z = cvt_pk_bf16(v[8 * kb + 4][j], v[8 * kb + 5][j]); o.w = cvt_pk_bf16(v[8 * kb + 6][j], v[8 * kb + 7][j]);
            *(LAS u32x4*)(stg + lane * STG_PITCH + kb * 16) = o;
        }
        LDS_WAIT(); asm volatile("" ::: "memory");
#pragma unroll
        for (int it = 0; it < 8; ++it) {
            const int rr = 8 * it + (lane >> 3), kb = lane & 7;
            const u32x4 o = *(const LAS u32x4*)(stg + rr * STG_PITCH + kb * 16);
            *(u32x4*)(WT + (size_t)(nd0 + 2 * rr + j) * ldt + k0 + 8 * kb) = o;
        }
        LDS_WAIT(); asm volatile("" ::: "memory");
    }
}
__device__ __forceinline__ void sincos_d(double x, double& s, double& c) {
    const double k = rint(x * 0.63661977236758134308);
    double r = fma(-k, 1.57079632679489655800, x); r = fma(-k, 6.12323399573676603587e-17, r);
    const double r2 = r * r;
    double sp = -7.6471637318198164759e-13; sp = fma(sp, r2, 1.6059043836821614599e-10); sp = fma(sp, r2, -2.5052108385441718775e-8); sp = fma(sp, r2, 2.7557319223985890653e-6);
    sp = fma(sp, r2, -1.9841269841269841270e-4); sp = fma(sp, r2, 8.3333333333333333333e-3); sp = fma(sp, r2, -1.6666666666666666667e-1);
    const double sr = fma(sp * r2, r, r);
    double cp = 4.7794773323873852974e-14; cp = fma(cp, r2, -1.1470745597729724714e-11); cp = fma(cp, r2, 2.0876756987868098979e-9); cp = fma(cp, r2, -2.7557319223985890653e-7);
    cp = fma(cp, r2, 2.4801587301587301587e-5); cp = fma(cp, r2, -1.3888888888888888889e-3); cp = fma(cp, r2, 4.1666666666666666667e-2); cp = fma(cp, r2, -0.5);
    const double cr = fma(cp, r2, 1.0);
    const int q = ((int)k) & 3;
    s = (q == 0) ? sr : (q == 1) ? cr : (q == 2) ? -sr : -cr;
    c = (q == 0) ? cr : (q == 1) ? -sr : (q == 2) ? -cr : sr;
}
__device__ __forceinline__ void p0_s5_group(const Args& a, LAS unsigned char* lds, int g, int tid) {
    LAS float* LPre = (LAS float*)lds;
    LAS float* LPim = LPre + 17 * 64;
    LAS float* BBre = LPim + 17 * 64;
    LAS float* BBim = BBre + 1024;
    LAS float* CRe = BBim + 1024;
    LAS float* CIm = CRe + 1024;
    LAS float* Kt = CIm + 1024;
    LAS float* Kt2 = Kt + 4096;
    LAS float* QQ = Kt2 + 4096;
    const float ldt = a.in[I_LOGDT][g];
    float lre_[3], lim_[3];
#pragma unroll
    for (int i = 0; i < 3; ++i) { const int idx = tid + 512 * i, p = idx & 63; lre_[i] = a.in[I_LAMRE][g * 64 + p]; lim_[i] = a.in[I_LAMIM][g * 64 + p]; }
    float cr_[2], ci_[2], br_[2], bi_[2];
#pragma unroll
    for (int i = 0; i < 2; ++i) { const int idx = tid + 512 * i; cr_[i] = a.in[I_CRE][(size_t)g * 1024 + idx]; ci_[i] = a.in[I_CIM][(size_t)g * 1024 + idx]; br_[i] = a.in[I_BRE][(size_t)g * 1024 + idx]; bi_[i] = a.in[I_BIM][(size_t)g * 1024 + idx]; }
    const float dsk = a.in[I_DSKIP][g * 16 + (tid & 15)];
    const double dt = exp((double)ldt);
#pragma unroll
    for (int i = 0; i < 3; ++i) {
        const int idx = tid + 512 * i;
        if (idx < 17 * 64) {
            const int k = idx >> 6, p = idx & 63;
            const double lre = (double)lre_[i], lim = (double)lim_[i];
            const double mag = exp(lre * dt * (double)k); double sn, cs; sincos_d(lim * dt * (double)k, sn, cs);
            LPre[idx] = (float)(mag * cs); LPim[idx] = (float)(mag * sn);
            if (k == 1) {
                const double nr = mag * cs - 1.0, ni = mag * sn, den = lre * lre + lim * lim;
                QQ[2 * p] = (float)((nr * lre + ni * lim) / den); QQ[2 * p + 1] = (float)((ni * lre - nr * lim) / den);
            }
        }
    }
#pragma unroll
    for (int i = 0; i < 2; ++i) { const int idx = tid + 512 * i; CRe[idx] = cr_[i]; CIm[idx] = ci_[i]; }
    __syncthreads();
#pragma unroll
    for (int i = 0; i < 2; ++i) { const int idx = tid + 512 * i, p = idx >> 4; const float qr = QQ[2 * p], qi = QQ[2 * p + 1];
        BBre[idx] = qr * br_[i] - qi * bi_[i]; BBim[idx] = qr * bi_[i] + qi * br_[i]; }
    __syncthreads();
    {
        const int c = (tid >> 4) & 15, cp = tid & 15, ph = tid >> 8;
        float acc[16];
#pragma unroll
        for (int k = 0; k < 16; ++k) acc[k] = 0.f;
        for (int pp = 0; pp < 32; ++pp) {
            const int p = 32 * ph + pp;
            const float cr = CRe[c * 64 + p], ci = CIm[c * 64 + p], br = BBre[p * 16 + cp], bi = BBim[p * 16 + cp];
            const float gr = cr * br - ci * bi, gi = cr * bi + ci * br;
#pragma unroll
            for (int k = 0; k < 16; ++k) acc[k] += gr * LPre[k * 64 + p] - gi * LPim[k * 64 + p];
        }
        if (ph == 0 && c == cp) acc[0] += dsk;
        LAS float* dst = ph ? Kt2 : Kt;
#pragma unroll
        for (int k = 0; k < 16; ++k) dst[(k * 16 + c) * 16 + cp] = acc[k];
    }
    __syncthreads();
    bf16_t* Win = (bf16_t*)(a.ws + WS_S5M + (size_t)g * S5M_GROUP_BYTES);
    bf16_t* MW = Win + 128 * 256;
    for (int idx = tid; idx < 256 * 48; idx += NWAVES * 64) {
        const int rr = idx / 48, cg = idx % 48, s = rr >> 4, c = rr & 15;
        float v[8];
        if (cg < 32) { const int sp = cg >> 1, c0 = (cg & 1) * 8;
#pragma unroll
            for (int i = 0; i < 8; ++i) { const int o = (((s - sp) & 15) * 16 + c) * 16 + c0 + i; v[i] = (sp <= s) ? Kt[o] + Kt2[o] : 0.f; }
        } else { const int im = cg >= 40, p0 = (cg - (im ? 40 : 32)) * 8;
#pragma unroll
            for (int i = 0; i < 8; ++i) { const int p = p0 + i; const float cr = CRe[c * 64 + p], ci = CIm[c * 64 + p], lr = LPre[(s + 1) * 64 + p], li = LPim[(s + 1) * 64 + p];
                v[i] = im ? -(cr * li + ci * lr) : (cr * lr - ci * li); }
        }
        u32x4 o; o.x = cvt_pk_bf16(v[0], v[1]); o.y = cvt_pk_bf16(v[2], v[3]); o.z = cvt_pk_bf16(v[4], v[5]); o.w = cvt_pk_bf16(v[6], v[7]);
        *(u32x4*)(MW + (size_t)rr * 384 + cg * 8) = o;
    }
    for (int idx = tid; idx < 128 * 32; idx += NWAVES * 64) {
        const int n = idx >> 5, cg = idx & 31, p = n & 63, im = n >> 6, sp = cg >> 1, c0 = (cg & 1) * 8;
        const float lr = LPre[(15 - sp) * 64 + p], li = LPim[(15 - sp) * 64 + p];
        float v[8];
#pragma unroll
        for (int i = 0; i < 8; ++i) { const float br = BBre[p * 16 + c0 + i], bi = BBim[p * 16 + c0 + i]; v[i] = im ? (lr * bi + li * br) : (lr * br - li * bi); }
        u32x4 o; o.x = cvt_pk_bf16(v[0], v[1]); o.y = cvt_pk_bf16(v[2], v[3]); o.z = cvt_pk_bf16(v[4], v[5]); o.w = cvt_pk_bf16(v[6], v[7]);
        *(u32x4*)(Win + (size_t)n * 256 + cg * 8) = o;
    }
    {
        float* aux = (float*)(a.ws + WS_S5AUX) + (size_t)g * S5AUX_GROUP_FLOATS;
        for (int idx = tid; idx < 64; idx += NWAVES * 64) { aux[idx] = LPre[64 + idx]; aux[64 + idx] = LPim[64 + idx]; aux[128 + idx] = LPre[16 * 64 + idx]; aux[192 + idx] = LPim[16 * 64 + idx]; }
        for (int idx = tid; idx < 1024; idx += NWAVES * 64) { aux[256 + idx] = BBre[idx]; aux[1280 + idx] = BBim[idx]; }
    }
    __syncthreads();
}
__device__ __forceinline__ void conv_tasks(const Args& a, LAS unsigned char* stg, int first, int last, int wv, int nwv, int lane) {
    constexpr int T_W1 = (D / 64) * (FF / 128), T_W2 = (FF / 64) * (D / 128), T_IN = (D / 64) * (DIN / 128), T_GLU = (DH / 64) * (DH / 128), T_OUT = (D / 64) * (D / 128);
    const int cnt[9] = {T_W1, T_W1, T_W2, T_IN, T_GLU, T_OUT, T_W1, T_W1, T_W2};
    int NT = 0;
#pragma unroll
    for (int m = 0; m < 9; ++m) if (m >= first && m <= last) NT += cnt[m];
    const int t_lo = (int)(((long)wv * NT) / nwv), t_hi = (int)(((long)(wv + 1) * NT) / nwv);
    unsigned char* ws = a.ws;
    for (int it = t_lo; it < t_hi; ++it) {
        int r = it, mat = first;
#pragma unroll
        for (int m = 0; m < 9; ++m) if (m >= first && m < last && mat == m && r >= cnt[m]) { r -= cnt[m]; mat = m + 1; }
        const float* W; const float* gk = nullptr; bf16_t* WT; int K, N, dual = 0, off = 0;
        switch (mat) {
            case 0: W = a.in[I_W1A]; gk = a.in[I_GFFN1]; WT = (bf16_t*)(ws + WS_W13A); K = D; N = FF; dual = 1; break;
            case 1: W = a.in[I_W3A]; gk = a.in[I_GFFN1]; WT = (bf16_t*)(ws + WS_W13A); K = D; N = FF; dual = 1; off = 128; break;
            case 2: W = a.in[I_W2A]; WT = (bf16_t*)(ws + WS_W2A); K = FF; N = D; break;
            case 3: W = a.in[I_WIN]; gk = a.in[I_GMIX]; WT = (bf16_t*)(ws + WS_WIN); K = D; N = DIN; break;
            case 4: W = a.in[I_WGLU]; WT = (bf16_t*)(ws + WS_WGLU); K = DH; N = DH; break;
            case 5: W = a.in[I_WOUT]; WT = (bf16_t*)(ws + WS_WOUT); K = D; N = D; dual = 2; break;
            case 6: W = a.in[I_W1B]; gk = a.in[I_GFFN2]; WT = (bf16_t*)(ws + WS_W13B); K = D; N = FF; dual = 1; break;
            case 7: W = a.in[I_W3B]; gk = a.in[I_GFFN2]; WT = (bf16_t*)(ws + WS_W13B); K = D; N = FF; dual = 1; off = 128; break;
            default: W = a.in[I_W2B]; WT = (bf16_t*)(ws + WS_W2B); K = FF; N = D; break;
        }
        const int nkb = K / 64, nb = r / nkb, kb = r % nkb, k0 = kb * 64, n0 = nb * 128;
        if (dual == 2) { gk = k0 < DH ? a.in[I_GS5] : a.in[I_GLRU] - DH; dual = 0; }
        p0_task(W, N, gk, WT, K, k0, n0, dual ? (nb * 256 + off) : n0, stg, lane);
    }
}
__device__ __forceinline__ void p0_prologue(const Args& a, LAS unsigned char* lds, int vcu, int G, int lane, int wave) {
    const int gw = vcu * NWAVES + wave, NGW = G * NWAVES;
    unsigned char* ws = a.ws;
    bf16_t* XB = (bf16_t*)(ws + WS_XB); float* ssq0 = (float*)(ws + WS_CTL + CTL_SSQ_BYTE);
    for (int grp = gw; grp < MPAD / 4; grp += NGW) {
        const int m0 = 4 * grp;
        u32x2* o = (u32x2*)(XB + (size_t)m0 * D) + lane;
        if (m0 < M) {
            const float* xr = m0 < MP ? a.in[I_XP] + (size_t)m0 * D : a.in[I_XS] + (size_t)(m0 - MP) * D;
            const f32x4* x4 = (const f32x4*)xr + lane; f32x4 v[4][8];
#pragma unroll
            for (int r = 0; r < 4; ++r)
#pragma unroll
                for (int j = 0; j < 8; ++j) v[r][j] = __builtin_nontemporal_load(x4 + r * (D / 4) + 64 * j);
#pragma unroll
            for (int r = 0; r < 4; ++r) {
                float s = 0.f;
#pragma unroll
                for (int j = 0; j < 8; ++j) s += dot4(v[r][j]);
                s = wave_sum(s);
#pragma unroll
                for (int j = 0; j < 8; ++j) { u32x2 w; w.x = cvt_pk_bf16(v[r][j][0], v[r][j][1]); w.y = cvt_pk_bf16(v[r][j][2], v[r][j][3]); o[r * (D / 4) + 64 * j] = w; }
                if (lane == 0) ssq0[m0 + r] = s;
            }
        } else {
#pragma unroll
            for (int r = 0; r < 4; ++r)
#pragma unroll
                for (int j = 0; j < 8; ++j) o[r * (D / 4) + 64 * j] = (u32x2){0u, 0u};
        }
    }
    conv_tasks(a, lds + wave * STG_BYTES, 0, 3, gw, NGW, lane);
}

#define MFMA32(a, b, c) __builtin_amdgcn_mfma_f32_32x32x16_bf16((a), (b), (c), 0, 0, 0)
constexpr int S5_PITCH = 528;
constexpr int S5_XC_OFF = 0, S5_Z_OFF = 128 * S5_PITCH;
static_assert(2 * 128 * S5_PITCH <= RING_BYTES, "S5 LDS map");
__device__ __forceinline__ void s5_prompt(const Args& a, LAS unsigned char* lds, int b, int g, int tid, int lane, int wave) {
    const bf16_t* U = (const bf16_t*)(a.ws + WS_U);
    const bf16_t* Win = (const bf16_t*)(a.ws + WS_S5M + (size_t)g * S5M_GROUP_BYTES);
    const bf16_t* MW = Win + 128 * 256;
    bf16_t* GS5 = (bf16_t*)(a.ws + WS_GS5);
    LAS unsigned char* XCs = lds + S5_XC_OFF;
    LAS unsigned char* ZS = lds + S5_Z_OFF;
    const int r32 = lane & 31, hh = lane >> 5;
    {
        u32x4 v[8];
#pragma unroll
        for (int i = 0; i < 8; ++i) { const int q = tid + 512 * i, t = q >> 1, half = q & 1; v[i] = *(const u32x4*)(U + (size_t)(b * SEQ + t) * DH + 16 * g + 8 * half); }
#pragma unroll
        for (int i = 0; i < 8; ++i) { const int q = tid + 512 * i, t = q >> 1, half = q & 1; *(LAS u32x4*)(XCs + (t >> 4) * S5_PITCH + (t & 15) * 32 + 16 * half) = v[i]; }
    }
    {
        const int mt = wave & 3, nt0 = (wave >> 2) * 2;
        const bf16_t* w0 = Win + (size_t)(32 * nt0 + r32) * 256 + 8 * hh;
        bf16x8 bw[2][8];
#pragma unroll
        for (int ks = 0; ks < 8; ++ks) { bw[0][ks] = *(const bf16x8*)(w0 + 16 * ks); bw[1][ks] = *(const bf16x8*)(w0 + 32 * 256 + 16 * ks); }
        __syncthreads();
        f32x16 acc0, acc1;
#pragma unroll
        for (int i = 0; i < 16; ++i) { acc0[i] = 0.f; acc1[i] = 0.f; }
        const LAS unsigned char* xa = XCs + (32 * mt + r32) * S5_PITCH + 16 * hh;
#pragma unroll 1
        for (int kh = 0; kh < 2; ++kh) {
#pragma unroll
            for (int ks = 0; ks < 8; ++ks) { const bf16x8 af = *(const LAS bf16x8*)(xa + 32 * (8 * kh + ks)); acc0 = MFMA32(af, bw[0][ks], acc0); acc1 = MFMA32(af, bw[1][ks], acc1); }
            if (kh == 0) {
#pragma unroll
                for (int ks = 0; ks < 8; ++ks) { bw[0][ks] = *(const bf16x8*)(w0 + 128 + 16 * ks); bw[1][ks] = *(const bf16x8*)(w0 + 32 * 256 + 128 + 16 * ks); }
            }
        }
        LAS float* Z = (LAS float*)ZS;
#pragma unroll
        for (int i = 0; i < 16; ++i) { const int j = 32 * mt + (i & 3) + 8 * (i >> 2) + 4 * hh;
            Z[j * (S5_PITCH / 4) + 32 * nt0 + r32] = acc0[i]; Z[j * (S5_PITCH / 4) + 32 * nt0 + 32 + r32] = acc1[i]; }
    }
    __syncthreads();
    if (wave == 0) {
        const float* aux = (const float*)(a.ws + WS_S5AUX) + (size_t)g * S5AUX_GROUP_FLOATS;
        const float l16r = aux[128 + lane], l16i = aux[192 + lane];
        const LAS float* Z = (const LAS float*)ZS;
        float sr = 0.f, si = 0.f;
        for (int jb = 0; jb < 16; ++jb) {
            float zr[8], zi[8];
#pragma unroll
            for (int i = 0; i < 8; ++i) { zr[i] = Z[(8 * jb + i) * (S5_PITCH / 4) + lane]; zi[i] = Z[(8 * jb + i) * (S5_PITCH / 4) + 64 + lane]; }
            LDS_WAIT();
#pragma unroll
            for (int i = 0; i < 8; ++i) {
                const unsigned w = cvt_pk_bf16(sr, si);
                *(LAS unsigned short*)(ZS + (8 * jb + i) * S5_PITCH + 2 * lane) = (unsigned short)(w & 0xffffu);
                *(LAS unsigned short*)(ZS + (8 * jb + i) * S5_PITCH + 128 + 2 * lane) = (unsigned short)(w >> 16);
                const float nr = l16r * sr - l16i * si + zr[i], ni = l16r * si + l16i * sr + zi[i];
                sr = nr; si = ni;
            }
        }
        a.out[O_PS5RE + (size_t)(b * NG + g) * NP + lane] = sr;
        a.out[O_PS5IM + (size_t)(b * NG + g) * NP + lane] = si;
    }
#pragma unroll 1
    for (int pass = 0; pass < 2; ++pass) {
        const int mt = pass ? 7 - wave : wave, n0 = 2 * pass;
        const int nks = 2 * mt + 2;
        const bf16_t* mw = MW + (size_t)(32 * mt + r32) * 384 + 8 * hh;
        bf16x8 am[24];
#pragma unroll
        for (int ks = 0; ks < 16; ++ks) if (ks < nks) am[ks] = *(const bf16x8*)(mw + 16 * ks);
#pragma unroll
        for (int kq = 0; kq < 8; ++kq) am[16 + kq] = *(const bf16x8*)(mw + 256 + 16 * kq);
        if (pass == 0) __syncthreads();
        f32x16 acc[2];
#pragma unroll
        for (int n = 0; n < 2; ++n)
#pragma unroll
            for (int i = 0; i < 16; ++i) acc[n][i] = 0.f;
#pragma unroll
        for (int ks = 0; ks < 16; ++ks) if (ks < nks) {
#pragma unroll
            for (int n = 0; n < 2; ++n) { const bf16x8 bf = *(const LAS bf16x8*)(XCs + (32 * (n0 + n) + r32) * S5_PITCH + 32 * ks + 16 * hh); acc[n] = MFMA32(am[ks], bf, acc[n]); }
        }
#pragma unroll
        for (int kq = 0; kq < 8; ++kq) {
#pragma unroll
            for (int n = 0; n < 2; ++n) { const bf16x8 bf = *(const LAS bf16x8*)(ZS + (32 * (n0 + n) + r32) * S5_PITCH + 32 * kq + 16 * hh); acc[n] = MFMA32(am[16 + kq], bf, acc[n]); }
        }
#pragma unroll
        for (int n = 0; n < 2; ++n)
#pragma unroll
            for (int q = 0; q < 4; ++q) {
                const int s = 2 * mt + (q >> 1), c0 = 8 * (q & 1) + 4 * hh, t = 16 * (32 * (n0 + n) + r32) + s;
                u32x2 w; w.x = cvt_pk_bf16(fgelu(acc[n][4 * q]), fgelu(acc[n][4 * q + 1])); w.y = cvt_pk_bf16(fgelu(acc[n][4 * q + 2]), fgelu(acc[n][4 * q + 3]));
                *(u32x2*)(GS5 + (size_t)(b * SEQ + t) * DH + 16 * g + c0) = w;
            }
    }
    __syncthreads();
}
__device__ __forceinline__ void s5_sample(const Args& a, LAS unsigned char* lds, int g, int bs0, int tid) {
    const bf16_t* U = (const bf16_t*)(a.ws + WS_U);
    bf16_t* GS5 = (bf16_t*)(a.ws + WS_GS5);
    const float* aux = (const float*)(a.ws + WS_S5AUX) + (size_t)g * S5AUX_GROUP_FLOATS;
    LAS float* HR = (LAS float*)lds;
    LAS float* HI = HR + 2048;
    LAS float* UU = HI + 2048;
    LAS float* CR = UU + 512;
    LAS float* CI = CR + 1024;
    LAS float* BR = CI + 1024;
    LAS float* BI = BR + 1024;
    const int bl0 = tid >> 4, c0 = tid & 15;
    const unsigned short uraw = U[(size_t)(MP + bs0 + bl0) * DH + 16 * g + c0];
    float cr_[2], ci_[2], br_[2], bi_[2], h0r[4], h0i[4];
#pragma unroll
    for (int i = 0; i < 2; ++i) { const int idx = tid + 512 * i; cr_[i] = a.in[I_CRE][(size_t)g * 1024 + idx]; ci_[i] = a.in[I_CIM][(size_t)g * 1024 + idx]; br_[i] = aux[256 + idx]; bi_[i] = aux[1280 + idx]; }
#pragma unroll
    for (int i = 0; i < 4; ++i) { const int idx = tid + 512 * i, bl = idx >> 6, p = idx & 63; const size_t so = (size_t)((bs0 + bl) * NG + g) * NP + p; h0r[i] = a.in[I_S5RE][so]; h0i[i] = a.in[I_S5IM][so]; }
    const float lr = aux[tid & 63], li = aux[64 + (tid & 63)];
    const float dsk = a.in[I_DSKIP][g * 16 + c0];
    UU[tid] = __uint_as_float((unsigned)uraw << 16);
#pragma unroll
    for (int i = 0; i < 2; ++i) { const int idx = tid + 512 * i; CR[idx] = cr_[i]; CI[idx] = ci_[i]; BR[idx] = br_[i]; BI[idx] = bi_[i]; }
    __syncthreads();
#pragma unroll
    for (int i = 0; i < 4; ++i) {
        const int idx = tid + 512 * i, bl = idx >> 6, p = idx & 63;
        float hr = lr * h0r[i] - li * h0i[i], hi = lr * h0i[i] + li * h0r[i];
#pragma unroll
        for (int q = 0; q < 4; ++q) { const f32x4 br = *(const LAS f32x4*)(BR + p * 16 + 4 * q), bi = *(const LAS f32x4*)(BI + p * 16 + 4 * q); const f32x4 u4 = *(const LAS f32x4*)(UU + bl * 16 + 4 * q);
#pragma unroll
            for (int j = 0; j < 4; ++j) { hr += br[j] * u4[j]; hi += bi[j] * u4[j]; } }
        const size_t so = (size_t)((bs0 + bl) * NG + g) * NP + p;
        a.out[O_SS5RE + so] = hr; a.out[O_SS5IM + so] = hi;
        HR[idx] = hr; HI[idx] = hi;
    }
    __syncthreads();
    {
        float y = 0.f;
#pragma unroll 16
        for (int p = 0; p < 64; ++p) y += CR[c0 * 64 + p] * HR[bl0 * 64 + p] - CI[c0 * 64 + p] * HI[bl0 * 64 + p];
        y += dsk * UU[tid];
        const float gv = fgelu(y); const unsigned w = cvt_pk_bf16(gv, gv);
        GS5[(size_t)(MP + bs0 + bl0) * DH + 16 * g + c0] = (bf16_t)(w & 0xffffu);
    }
    __syncthreads();
}

constexpr int XC_PITCH = 144;
__device__ __forceinline__ void lru_item(const Args& a, LAS unsigned char* lds, bool sample, int b, int head, int q, int tid, int lane, int wave) {
    const float* XL = (const float*)(a.ws + WS_XLRU);
    const bf16_t* GG = (const bf16_t*)(a.ws + WS_GG);
    bf16_t* MRG = (bf16_t*)(a.ws + WS_MRG);
    float* ssq_lru = (float*)(a.ws + WS_CTL + CTL_SSQ_BYTE) + 3 * MPAD;
    LAS unsigned char* XC = lds;
    LAS float* XCF = (LAS float*)(lds + 36864);
    LAS float* AA = XCF + 4096;
    LAS float* BX = AA + 4096;
    LAS float* SEGP = BX + 4096;
    LAS float* SEGH = SEGP + 512;
    LAS float* CAR = SEGH + 512;
    const int ch0 = 64 * head + 16 * q;
    const int fr = lane & 15, fq = lane >> 4;
    bf16x8 Bf[2][2];
#pragma unroll
    for (int mat = 0; mat < 2; ++mat)
#pragma unroll
        for (int ks = 0; ks < 2; ++ks) {
            const float* w = (mat ? a.in[I_WX] : a.in[I_WA]) + ((size_t)(head * 64 + 32 * ks + 8 * fq)) * 64 + 16 * q + fr;
            u32x4 p; p.x = cvt_pk_bf16(w[0], w[64]); p.y = cvt_pk_bf16(w[128], w[192]); p.z = cvt_pk_bf16(w[256], w[320]); p.w = cvt_pk_bf16(w[384], w[448]);
            Bf[mat][ks] = __builtin_bit_cast(bf16x8, p);
        }
    const int chn = ch0 + fr;
    const float ba = a.in[I_BA][chn], bx_ = a.in[I_BX][chn];
    const float spl = log1pf(expf(-a.in[I_LAML][chn]));
    const int cq = tid & 15, cch = 64 * head + 4 * cq, rg = tid >> 4;
    const f32x4 cw0 = *(const f32x4*)(a.in[I_CONVW] + cch), cw1 = *(const f32x4*)(a.in[I_CONVW] + DH + cch), cw2 = *(const f32x4*)(a.in[I_CONVW] + 2 * DH + cch),
                cw3 = *(const f32x4*)(a.in[I_CONVW] + 3 * DH + cch), cb = *(const f32x4*)(a.in[I_CONVB] + cch);
    const int er = tid >> 1, eh = tid & 1;
    if (!sample) {
        float hcar = 0.f;
        f32x4 xin[11]; u32x4 ggn;
        { const int R0 = b * SEQ, r0 = rg * 8;
#pragma unroll
          for (int i = 0; i < 11; ++i) { const int t = r0 + i - 3; xin[i] = (t >= 0) ? *(const f32x4*)(XL + (size_t)(R0 + t) * DH + cch) : (f32x4){0.f, 0.f, 0.f, 0.f}; }
          ggn = *(const u32x4*)(GG + (size_t)(R0 + er) * DH + ch0 + 8 * eh); }
        for (int chk = 0; chk < 8; ++chk) {
            const int R0 = b * SEQ + chk * 256, r0 = rg * 8;
#pragma unroll
            for (int rr = 0; rr < 8; ++rr) {
                const f32x4 xc = cb + cw0 * xin[rr] + cw1 * xin[rr + 1] + cw2 * xin[rr + 2] + cw3 * xin[rr + 3];
                u32x2 w; w.x = cvt_pk_bf16(xc[0], xc[1]); w.y = cvt_pk_bf16(xc[2], xc[3]);
                *(LAS u32x2*)(XC + (r0 + rr) * XC_PITCH + 8 * cq) = w;
                if ((cq >> 2) == q) *(LAS f32x4*)(XCF + (r0 + rr) * 16 + 4 * (cq & 3)) = xc;
            }
            const u32x4 gw = ggn;
            if (chk < 7) {
                const float* p = XL + (size_t)(R0 + 256 + r0 - 3) * DH + cch;
#pragma unroll
                for (int i = 0; i < 11; ++i) xin[i] = *(const f32x4*)(p + (size_t)i * DH);
                ggn = *(const u32x4*)(GG + (size_t)(R0 + 256 + er) * DH + ch0 + 8 * eh);
            }
            __syncthreads();
#pragma unroll
            for (int tt = 0; tt < 2; ++tt) {
                const int tile = 2 * wave + tt;
                f32x4 ar = (f32x4){0.f, 0.f, 0.f, 0.f}, ax = ar;
#pragma unroll
                for (int ks = 0; ks < 2; ++ks) {
                    const bf16x8 af = *(const LAS bf16x8*)(XC + (16 * tile + fr) * XC_PITCH + 64 * ks + 16 * fq);
                    ar = __builtin_amdgcn_mfma_f32_16x16x32_bf16(af, Bf[0][ks], ar, 0, 0, 0);
                    ax = __builtin_amdgcn_mfma_f32_16x16x32_bf16(af, Bf[1][ks], ax, 0, 0, 0);
                }
#pragma unroll
                for (int r4 = 0; r4 < 4; ++r4) {
                    const int rr = 16 * tile + 4 * fq + r4;
                    const float xcv = XCF[rr * 16 + fr];
                    const float rg_ = fsigmoid(ar[r4] + ba), ig = fsigmoid(ax[r4] + bx_);
                    const float la = -8.0f * rg_ * spl;
                    const float av = fexp(la); AA[rr * 16 + fr] = av; BX[rr * 16 + fr] = __builtin_amdgcn_sqrtf(fmaxf(fmaf(-av, av, 1.0f), 0.f)) * (ig * xcv);
                }
            }
            __syncthreads();
            const int sn = tid & 15, sg = tid >> 4;
            float av[8], bv[8];
            { float P = 1.f, h = 0.f;
#pragma unroll
              for (int i = 0; i < 8; ++i) { av[i] = AA[(8 * sg + i) * 16 + sn]; bv[i] = BX[(8 * sg + i) * 16 + sn]; }
#pragma unroll
              for (int i = 0; i < 8; ++i) { h = av[i] * h + bv[i]; P *= av[i]; }
              SEGP[tid] = P; SEGH[tid] = h; }
            __syncthreads();
            if (wave == 0 && lane < 16) {
                float run = hcar;
#pragma unroll 8
                for (int s2 = 0; s2 < 32; ++s2) { CAR[s2 * 16 + lane] = run; run = SEGP[s2 * 16 + lane] * run + SEGH[s2 * 16 + lane]; }
                hcar = run;
            }
            __syncthreads();
            { float h = CAR[tid];
#pragma unroll
              for (int i = 0; i < 8; ++i) { h = av[i] * h + bv[i]; BX[(8 * sg + i) * 16 + sn] = h; } }
            __syncthreads();
            {
                const size_t row = (size_t)R0 + er;
                const f32x4 h0 = *(const LAS f32x4*)(BX + er * 16 + 8 * eh), h1 = *(const LAS f32x4*)(BX + er * 16 + 8 * eh + 4);
                const f32x4 y0 = (f32x4){h0[0] * bf_lo(gw.x), h0[1] * bf_hi(gw.x), h0[2] * bf_lo(gw.y), h0[3] * bf_hi(gw.y)};
                const f32x4 y1 = (f32x4){h1[0] * bf_lo(gw.z), h1[1] * bf_hi(gw.z), h1[2] * bf_lo(gw.w), h1[3] * bf_hi(gw.w)};
                *(u32x4*)(MRG + row * D + DH + ch0 + 8 * eh) = pack8(y0, y1);
                float s = dot4(y0) + dot4(y1);
                s += __shfl_xor(s, 1);
                if (eh == 0) atomicAdd(ssq_lru + row, s);
            }
        }
        if (wave == 0 && lane < 16) a.out[O_PLRUH + (size_t)b * DH + ch0 + lane] = hcar;
        if (wave == 1 && lane < 48) { const int k = lane >> 4, n = lane & 15;
            a.out[O_PLRUC + ((size_t)b * 3 + k) * DH + ch0 + n] = XL[(size_t)(b * SEQ + SEQ - 3 + k) * DH + ch0 + n]; }
    } else {
        const int R0 = MP, bs0 = 32 * b;
        {
            const float* cbuf = a.in[I_LRUCONV];
            const int bs = bs0 + rg;
            const f32x4 x0 = *(const f32x4*)(XL + (size_t)(R0 + bs) * DH + cch);
            const f32x4 c0 = *(const f32x4*)(cbuf + ((size_t)bs * 3 + 0) * DH + cch), c1 = *(const f32x4*)(cbuf + ((size_t)bs * 3 + 1) * DH + cch), c2 = *(const f32x4*)(cbuf + ((size_t)bs * 3 + 2) * DH + cch);
            const f32x4 xc = cb + cw0 * c0 + cw1 * c1 + cw2 * c2 + cw3 * x0;
            u32x2 w; w.x = cvt_pk_bf16(xc[0], xc[1]); w.y = cvt_pk_bf16(xc[2], xc[3]);
            *(LAS u32x2*)(XC + rg * XC_PITCH + 8 * cq) = w;
            if ((cq >> 2) == q) {
                *(LAS f32x4*)(XCF + rg * 16 + 4 * (cq & 3)) = xc;
                float* oc = a.out + O_SLRUC + (size_t)bs * 3 * DH + cch;
                *(f32x4*)oc = c1; *(f32x4*)(oc + DH) = c2; *(f32x4*)(oc + 2 * DH) = x0;
            }
        }
        __syncthreads();
        if (wave < 2) {
            const int tile = wave;
            f32x4 ar = (f32x4){0.f, 0.f, 0.f, 0.f}, ax = ar;
#pragma unroll
            for (int ks = 0; ks < 2; ++ks) {
                const bf16x8 af = *(const LAS bf16x8*)(XC + (16 * tile + fr) * XC_PITCH + 64 * ks + 16 * fq);
                ar = __builtin_amdgcn_mfma_f32_16x16x32_bf16(af, Bf[0][ks], ar, 0, 0, 0);
                ax = __builtin_amdgcn_mfma_f32_16x16x32_bf16(af, Bf[1][ks], ax, 0, 0, 0);
            }
#pragma unroll
            for (int r4 = 0; r4 < 4; ++r4) {
                const int rl = 16 * tile + 4 * fq + r4, bs = bs0 + rl;
                const float xcv = XCF[rl * 16 + fr];
                const float rg_ = fsigmoid(ar[r4] + ba), ig = fsigmoid(ax[r4] + bx_);
                const float la = -8.0f * rg_ * spl;
                const float av = fexp(la); const float h = av * a.in[I_LRUH][(size_t)bs * DH + chn] + __builtin_amdgcn_sqrtf(fmaxf(fmaf(-av, av, 1.0f), 0.f)) * (ig * xcv);
                BX[rl * 16 + fr] = h; a.out[O_SLRUH + (size_t)bs * DH + chn] = h;
            }
        }
        __syncthreads();
        if (er < 32) {
            const size_t row = (size_t)R0 + bs0 + er;
            const u32x4 gw = *(const u32x4*)(GG + row * DH + ch0 + 8 * eh);
            const f32x4 h0 = *(const LAS f32x4*)(BX + er * 16 + 8 * eh), h1 = *(const LAS f32x4*)(BX + er * 16 + 8 * eh + 4);
            const f32x4 y0 = (f32x4){h0[0] * bf_lo(gw.x), h0[1] * bf_hi(gw.x), h0[2] * bf_lo(gw.y), h0[3] * bf_hi(gw.y)};
            const f32x4 y1 = (f32x4){h1[0] * bf_lo(gw.z), h1[1] * bf_hi(gw.z), h1[2] * bf_lo(gw.w), h1[3] * bf_hi(gw.w)};
            *(u32x4*)(MRG + row * D + DH + ch0 + 8 * eh) = pack8(y0, y1);
            float s = dot4(y0) + dot4(y1);
            s += __shfl_xor(s, 1);
            if (eh == 0) atomicAdd(ssq_lru + row, s);
        }
    }
    __syncthreads();
}

__global__ void __launch_bounds__(NWAVES * 64, 2) hymba_fwd(Args args) {
    extern __shared__ __attribute__((aligned(16))) unsigned char lds_raw[];
    LAS unsigned char* lds = (LAS unsigned char*)lds_raw;
    volatile LAS unsigned* MISC = (volatile LAS unsigned*)(lds + MISC_OFF);
    const int tid = threadIdx.x, lane = tid & 63, wave = __builtin_amdgcn_readfirstlane(tid >> 6);
    const int G = gridDim.x, bx = blockIdx.x;
    const int vcu = (G % 8 == 0) ? (bx % 8) * (G / 8) + bx / 8 : bx;
    unsigned char* ws = args.ws;
    unsigned* ctl = (unsigned*)(ws + WS_CTL);
    for (int u = tid; u < (LDS_BYTES - LDSCTL_OFF) / 4; u += NWAVES * 64) ((LAS unsigned*)(lds + LDSCTL_OFF))[u] = 0u;
    __syncthreads();
    XcdBarrier bar; bar.bar = ctl + CW_BAR; bar.x = 0; bar.st = nullptr;
    if (MK_N_LAUNCHES == 1) bar = xcd_barrier_post(ctl + CW_BAR, MISC + 8);
#define GRID_BAR() do { if (MK_N_LAUNCHES == 1) xcd_barrier(bar); } while (0)
#define STAMP(k) do { if (PROBE_PHASE >= 0 && bx == 0 && tid == 0) { const unsigned long long now_ = __builtin_amdgcn_s_memrealtime(); \
        const unsigned long long prev_ = ((unsigned long long)MISC[17] << 32) | MISC[16]; if ((k) == PROBE_PHASE) { const unsigned long long d_ = now_ - prev_; MISC[18] = (unsigned)d_; } \
        MISC[16] = (unsigned)now_; MISC[17] = (unsigned)(now_ >> 32); } } while (0)
    STAMP(-1);
    const int lo = args.ph_lo, hi = args.ph_hi;
#define IN(k) (lo <= (k) && (k) < hi)
#define BOTH(k) (IN(k) && IN((k) + 1))
    float* ssq = (float*)(ws + WS_CTL + CTL_SSQ_BYTE);
    float *ssq0 = ssq, *ssq1 = ssq + MPAD, *ssq_s5 = ssq + 2 * MPAD, *ssq_lru = ssq + 3 * MPAD, *ssq2 = ssq + 4 * MPAD, *ssq3 = ssq + 5 * MPAD;
    bf16_t* XB = (bf16_t*)(ws + WS_XB); float* X1 = (float*)(ws + WS_X1); bf16_t* HID = (bf16_t*)(ws + WS_H);
    bf16_t* U = (bf16_t*)(ws + WS_U); float* XL = (float*)(ws + WS_XLRU); bf16_t* GG = (bf16_t*)(ws + WS_GG); bf16_t* MRG = (bf16_t*)(ws + WS_MRG);
    float* SLAB = (float*)(ws + WS_SLAB); float* SLAB5 = (float*)(ws + WS_U);
    const int gws = wave * G + bx;

    unsigned* cnt_fin2 = ctl + CW_CNT; unsigned* cnt_fin5 = ctl + CW_CNT + 64;
#define PUBLISH(cnt) do { asm volatile("s_waitcnt vmcnt(0)" ::: "memory"); __builtin_amdgcn_fence(__ATOMIC_RELEASE, "agent"); asm volatile("s_waitcnt vmcnt(0)" ::: "memory"); \
        if (lane == 0) __hip_atomic_fetch_add((cnt), 1u, __ATOMIC_RELAXED, __HIP_MEMORY_SCOPE_AGENT); } while (0)

    if (IN(0)) { p0_prologue(args, lds, vcu, G, lane, wave); if (BOTH(0)) GRID_BAR(); STAMP(0); }
    if (IN(1)) {
        constexpr int GG1 = 242;
        if (bx < GG1) {
            pg8::Gemm g{XB, (const bf16_t*)(ws + WS_W13A), D, D}; pg8::PanelOrder S; S.init(2 * FF / 256, D / 64, D / 64, GG1, bx);
            pg8::EpiSwiGLU E{HID, ssq0};
            pg8::gemm_phase(lds, g, S, E);
        } else {
            for (int gj = bx - GG1; gj < NG; gj += G - GG1) p0_s5_group(args, lds, gj, tid);
        }
        if (BOTH(1)) GRID_BAR();
        STAMP(1);
    }
    if (IN(2)) {
        pg8::Gemm g{HID, (const bf16_t*)(ws + WS_W2A), FF, FF}; pg8::PanelOrder S; S.init(D / 256, FF / 64, 8, G, bx);
        pg8::EpiResid E{SLAB, XB, ssq1};
        pg8::gemm_phase(lds, g, S, E);
        if (bx >= 88) conv_tasks(args, lds + wave * STG_BYTES, 4, 5, (bx - 88) * NWAVES + wave, (G - 88) * NWAVES, lane);
        if (BOTH(2)) GRID_BAR();
        STAMP(2);
    }
    if (IN(3)) {
        constexpr int GG3 = 198;
        { const int r = (bx >= GG3 && wave < 3) ? (bx - GG3) + (G - GG3) * wave : MS;
          if (r < MS) {
            const int row = MP + r;
            const f32x4* xr = (const f32x4*)(args.in[I_XS] + (size_t)r * D) + lane; f32x4 v[8]; float sq = 0.f;
#pragma unroll
            for (int j = 0; j < 8; ++j) { f32x4 t = (f32x4){0.f, 0.f, 0.f, 0.f};
#pragma unroll
                for (int sl = 0; sl < 11; ++sl) t += ((const f32x4*)(SLAB + ((size_t)sl * MS + r) * D) + lane)[64 * j];
                v[j] = xr[64 * j] + 0.5f * t; sq += dot4(v[j]); }
            sq = wave_sum(sq);
#pragma unroll
            for (int j = 0; j < 8; ++j) { ((f32x4*)(X1 + (size_t)row * D) + lane)[64 * j] = v[j];
                u32x2 w; w.x = cvt_pk_bf16(v[j][0], v[j][1]); w.y = cvt_pk_bf16(v[j][2], v[j][3]); ((u32x2*)(XB + (size_t)row * D) + lane)[64 * j] = w; }
            if (lane == 0) ssq1[row] = sq;
            PUBLISH(cnt_fin2);
          } }
        if (bx < GG3) {
            pg8::Gemm g{XB, (const bf16_t*)(ws + WS_WIN), D, D}; pg8::PanelOrder S; S.init(DIN / 256, D / 64, D / 64, GG3, bx); S.ready = cnt_fin2; S.need = MS;
            pg8::EpiProj E{U, XL, GG, ssq1};
            pg8::gemm_phase(lds, g, S, E);
        } else conv_tasks(args, lds + wave * STG_BYTES, 6, 7, (bx - GG3) * NWAVES + wave, (G - GG3) * NWAVES, lane);
        if (BOTH(3)) GRID_BAR();
        STAMP(3);
    }
    if (IN(4)) {
        { bf16_t* GS5 = (bf16_t*)(ws + WS_GS5); const int gw = bx * NWAVES + wave, NGW = G * NWAVES;
          for (int m = M + gw; m < MPAD; m += NGW) {
              ((u32x4*)(GS5 + (size_t)m * DH))[lane] = (u32x4){0u, 0u, 0u, 0u}; ((u32x4*)(GS5 + (size_t)m * DH))[64 + lane] = (u32x4){0u, 0u, 0u, 0u};
              ((u32x4*)(MRG + (size_t)m * D + DH))[lane] = (u32x4){0u, 0u, 0u, 0u}; ((u32x4*)(MRG + (size_t)m * D + DH))[64 + lane] = (u32x4){0u, 0u, 0u, 0u}; } }
        for (int it = bx; it < NB * NG; it += G) { const int b = it >> 6, g = ((it & 7) << 3) | ((it >> 3) & 7); s5_prompt(args, lds, b, g, tid, lane, wave); }
        STAMP(20);
        for (int it = bx; it < 4 * NG; it += G) s5_sample(args, lds, it >> 2, 32 * (it & 3), tid);
        STAMP(21);
        for (int it = bx; it < NB * 64; it += G) lru_item(args, lds, false, it >> 6, ((it & 7) << 1) | ((it >> 5) & 1), (it >> 3) & 3, tid, lane, wave);
        STAMP(22);
        if (BOTH(4)) GRID_BAR();
        STAMP(4);
    }
    if (IN(5)) {
        pg8::Gemm g{(const bf16_t*)(ws + WS_GS5), (const bf16_t*)(ws + WS_WGLU), DH, DH}; pg8::PanelOrder S; S.init(DH / 256, DH / 64, DH / 64, G, bx);
        pg8::EpiGlu E{(const bf16_t*)(ws + WS_GS5), args.in[I_BGLU], MRG, ssq_s5};
        pg8::gemm_phase(lds, g, S, E);
        if (bx >= 132) for (int it = bx - 132; it < 256; it += G - 132) lru_item(args, lds, true, it & 3, it >> 4, (it >> 2) & 3, tid, lane, wave);
        if (BOTH(5)) GRID_BAR();
        STAMP(5);
    }
    if (IN(6)) {
        pg8::Gemm g{MRG, (const bf16_t*)(ws + WS_WOUT), D, D}; pg8::PanelOrder S; S.init(D / 256, D / 64, D / 64, G, bx); S.nExtra = 0;
        pg8::EpiOut E{ssq_s5, ssq_lru, XB, ssq2, nullptr};
        pg8::gemm_phase(lds, g, S, E);
        if (BOTH(6)) GRID_BAR();
        STAMP(6);
    }
    if (IN(7)) {
        constexpr int GG7 = 242;
        if (bx >= GG7) {
            pg8::Gemm g{MRG, (const bf16_t*)(ws + WS_WOUT), D, D}; pg8::PanelOrder S; S.init(D / 256, D / 64, D / 64, 8, bx - GG7); S.nwgP = 0;
            pg8::EpiOut E{ssq_s5, ssq_lru, XB, ssq2, nullptr};
            pg8::gemm_phase(lds, g, S, E);
            if (bx - GG7 < 8) { asm volatile("s_waitcnt vmcnt(0)" ::: "memory"); __syncthreads();
                if (tid == 0) { __builtin_amdgcn_fence(__ATOMIC_RELEASE, "agent"); asm volatile("s_waitcnt vmcnt(0)" ::: "memory"); __hip_atomic_fetch_add(cnt_fin5, 1u, __ATOMIC_RELAXED, __HIP_MEMORY_SCOPE_AGENT); } }
        }
        if (bx < GG7) {
            pg8::Gemm g{XB, (const bf16_t*)(ws + WS_W13B), D, D}; pg8::PanelOrder S; S.init(2 * FF / 256, D / 64, D / 64, GG7, bx); S.ready = cnt_fin5; S.need = 8;
            pg8::EpiSwiGLU E{HID, ssq2};
            pg8::gemm_phase(lds, g, S, E);
        } else conv_tasks(args, lds + wave * STG_BYTES, 8, 8, (bx - GG7) * NWAVES + wave, (G - GG7) * NWAVES, lane);
        if (BOTH(7)) GRID_BAR();
        STAMP(7);
    }
    if (IN(8)) {
        pg8::Gemm g{HID, (const bf16_t*)(ws + WS_W2B), FF, FF}; pg8::PanelOrder S; S.init(D / 256, FF / 64, 8, G, bx);
        pg8::EpiFinal E{XB, ssq3, SLAB};
        pg8::gemm_phase(lds, g, S, E);
        if (BOTH(8)) GRID_BAR();
        STAMP(8);
    }
    if (IN(9)) {
        const f32x4* gf = (const f32x4*)args.in[I_GFINAL] + lane;
        if (gws < MS) {
            const int row = MP + gws; f32x4 v[8]; float sq = 0.f;
#pragma unroll
            for (int j = 0; j < 8; ++j) { f32x4 t = (f32x4){0.f, 0.f, 0.f, 0.f};
#pragma unroll
                for (int sl = 0; sl < 11; ++sl) t += ((const f32x4*)(SLAB + ((size_t)sl * MS + gws) * D) + lane)[64 * j];
                const u32x2 xw = ((const u32x2*)(XB + (size_t)row * D) + lane)[64 * j];
                v[j] = (f32x4){bf_lo(xw.x), bf_hi(xw.x), bf_lo(xw.y), bf_hi(xw.y)} + 0.5f * t; sq += dot4(v[j]); }
            const float r = rsqrtf(wave_sum(sq) * (1.0f / D) + EPS);
#pragma unroll
            for (int j = 0; j < 8; ++j) ((f32x4*)(args.out + (size_t)row * D) + lane)[64 * j] = v[j] * gf[64 * j] * r;
        }
        const int gw = bx * NWAVES + wave, NGW = G * NWAVES;
        for (int m = gw; m < MP; m += NGW) {
            const float r = rsqrtf(ssq3[m] * (1.0f / D) + EPS);
            const u32x4* xb = (const u32x4*)(XB + (size_t)m * D) + lane;
            f32x4* o = (f32x4*)(args.out + (size_t)m * D) + 2 * lane;
            const f32x4* g2 = (const f32x4*)args.in[I_GFINAL] + 2 * lane;
            u32x4 w[4];
#pragma unroll
            for (int j = 0; j < 4; ++j) w[j] = xb[64 * j];
#pragma unroll
            for (int j = 0; j < 4; ++j) { o[128 * j] = pg8::res_lo(w[j]) * g2[128 * j] * r; o[128 * j + 1] = pg8::res_hi(w[j]) * g2[128 * j + 1] * r; }
        }
    }
    if (PROBE_PHASE >= 0 && bx == 0 && tid == 0) {
        STAMP(9);
        const unsigned long long t0_ = __builtin_amdgcn_s_memrealtime(), d_ = 4ull * MISC[18];
        while (__builtin_amdgcn_s_memrealtime() - t0_ < d_) __builtin_amdgcn_s_sleep(8);
    }
#undef IN
#undef BOTH
#undef GRID_BAR
}

extern "C" void kernel_launch(void* const* d_in, const int* in_sizes, int n_in, void* d_out, int out_size, void* d_ws, size_t ws_size, hipStream_t stream) {
    static int grid = 0;
    if (grid == 0) {
        if (n_in != N_IN || in_sizes[0] != MP * D || (size_t)out_size != O_END || ws_size < WS_END) {
            fprintf(stderr, "kernel_launch: unexpected problem: n_in %d in0 %d out %d ws %zu (need %zu)\n", n_in, n_in > 0 ? in_sizes[0] : -1, out_size, ws_size, (size_t)WS_END); grid = -1; return; }
        int dev = 0, cus = 0;
        if (hipGetDevice(&dev) != hipSuccess || hipDeviceGetAttribute(&cus, hipDeviceAttributeMultiprocessorCount, dev) != hipSuccess) { grid = -1; return; }
        if (hipFuncSetAttribute((const void*)hymba_fwd, hipFuncAttributeMaxDynamicSharedMemorySize, LDS_BYTES) != hipSuccess) { fprintf(stderr, "kernel_launch: hipFuncSetAttribute failed\n"); grid = -1; return; }
        int per_cu = 0;
        if (hipOccupancyMaxActiveBlocksPerMultiprocessor(&per_cu, (const void*)hymba_fwd, NWAVES * 64, LDS_BYTES) != hipSuccess || per_cu < 1)
            fprintf(stderr, "kernel_launch: note: occupancy query reports %d workgroups per CU\n", per_cu);
        (void)hipGetLastError();
        grid = cus;
    }
    if (grid < 0) return;
    if (hipMemsetAsync((char*)d_ws + WS_CTL, 0, CTL_ZERO_BYTES, stream) != hipSuccess) { fprintf(stderr, "kernel_launch: memset failed\n"); return; }
    Args a{};
    for (int i = 0; i < N_IN; ++i) a.in[i] = (const float*)d_in[i];
    a.out = (float*)d_out; a.ws = (unsigned char*)d_ws;
    if (MK_N_LAUNCHES == 1) {
        a.ph_lo = 0; a.ph_hi = NPHASE;
        hipLaunchKernelGGL(hymba_fwd, dim3(grid), dim3(NWAVES * 64), LDS_BYTES, stream, a);
    } else {
        for (int p = 0; p < NPHASE; ++p) { a.ph_lo = p; a.ph_hi = p + 1; hipLaunchKernelGGL(hymba_fwd, dim3(grid), dim3(NWAVES * 64), LDS_BYTES, stream, a); }
    }
}
```

```cpp
#include <hip/hip_runtime.h>
#include <cstdio>
#include <cstdint>

#define LAS __attribute__((address_space(3)))
#define GAS __attribute__((address_space(1)))
typedef unsigned short bf16_t;
typedef short bf16x8 __attribute__((ext_vector_type(8)));
typedef float f32x4 __attribute__((ext_vector_type(4)));
typedef float f32x16 __attribute__((ext_vector_type(16)));
typedef unsigned u32x4 __attribute__((ext_vector_type(4)));
typedef unsigned u32x2 __attribute__((ext_vector_type(2)));

#ifndef PROBE_PHASE
#define PROBE_PHASE -1
#endif
#ifndef MK_N_LAUNCHES
#define MK_N_LAUNCHES 1
#endif

constexpr int D = 2048, FF = 5632, DIN = 3072, DH = 1024;
constexpr int MP = 8192, MS = 128, M = MP + MS, MPAD = 8448;
constexpr int SEQ = 2048, NB = 4, NG = 64, NP = 64, GS = 16;
constexpr float EPS = 1e-6f;
constexpr int NPHASE = 10;
constexpr int NMP = MP / 256;
constexpr int NWAVES = 8;

constexpr size_t MiB = 1u << 20;
constexpr size_t WS_CTL = 0, CTL_ZERO_BYTES = 1 * MiB;
constexpr size_t WS_W13A = 1 * MiB, WS_W2A = 45 * MiB, WS_WIN = 67 * MiB, WS_WGLU = 79 * MiB, WS_WOUT = 81 * MiB, WS_W13B = 89 * MiB, WS_W2B = 133 * MiB;
constexpr size_t WS_S5M = 155 * MiB, WS_S5AUX = 171 * MiB;
constexpr size_t WS_XB = 172 * MiB;
constexpr size_t WS_X1 = 205 * MiB;
constexpr size_t WS_GS5 = WS_X1;
constexpr size_t WS_H = 271 * MiB;
constexpr size_t WS_U = 271 * MiB, WS_XLRU = WS_U + (size_t)MPAD * DH * 2, WS_GG = WS_XLRU + (size_t)MPAD * DH * 4, WS_MRG = WS_GG + (size_t)MPAD * DH * 2;
constexpr size_t WS_SLAB = 362 * MiB;
constexpr size_t WS_END = 373 * MiB;
static_assert(WS_MRG + (size_t)MPAD * D * 2 <= WS_END && WS_H + (size_t)MPAD * FF * 2 <= WS_SLAB && WS_SLAB + (size_t)11 * MS * D * 4 <= WS_END, "ws map");
constexpr int S5M_GROUP_BYTES = 256 * 1024;
constexpr int S5AUX_GROUP_FLOATS = 2304;
constexpr int CW_BAR = 4096;
constexpr int CW_CNT = 8192;
constexpr size_t CTL_SSQ_BYTE = 262144;

constexpr int RING_BYTES = 139264;
constexpr int LDSCTL_OFF = RING_BYTES, MISC_OFF = LDSCTL_OFF + 320;
constexpr int LDS_BYTES = 147456;

__device__ __forceinline__ unsigned cvt_pk_bf16(float lo, float hi) { unsigned r; asm volatile("v_cvt_pk_bf16_f32 %0, %1, %2" : "=v"(r) : "v"(lo), "v"(hi)); return r; }
__device__ __forceinline__ float bf_lo(unsigned w) { return __uint_as_float(w << 16); }
__device__ __forceinline__ float bf_hi(unsigned w) { return __uint_as_float(w & 0xffff0000u); }
__device__ __forceinline__ float fexp(float x) { return __builtin_amdgcn_exp2f(x * 1.44269504089f); }
__device__ __forceinline__ float fsigmoid(float x) { return __builtin_amdgcn_rcpf(1.0f + fexp(-x)); }
__device__ __forceinline__ float fsilu(float x) { return x * fsigmoid(x); }
__device__ __forceinline__ float fgelu(float x) { return x * fsigmoid(1.5957691216057308f * (x + 0.044715f * x * x * x)); }
__device__ __forceinline__ u32x4 pack8(const f32x4 a, const f32x4 b) { u32x4 w; w.x = cvt_pk_bf16(a[0], a[1]); w.y = cvt_pk_bf16(a[2], a[3]); w.z = cvt_pk_bf16(b[0], b[1]); w.w = cvt_pk_bf16(b[2], b[3]); return w; }
__device__ __forceinline__ float dot4(const f32x4 a) { return (a[0] * a[0] + a[1] * a[1]) + (a[2] * a[2] + a[3] * a[3]); }
__device__ __forceinline__ float wave_sum(float v) {
#pragma unroll
    for (int o = 1; o < 64; o <<= 1) v += __shfl_xor(v, o);
    return v;
}
__device__ __forceinline__ float neg_expm1(float x) {
    float p = 1.0f / 5040.0f; p = fmaf(p, x, 1.0f / 720.0f); p = fmaf(p, x, 1.0f / 120.0f); p = fmaf(p, x, 1.0f / 24.0f); p = fmaf(p, x, 1.0f / 6.0f); p = fmaf(p, x, 0.5f); p = fmaf(p, x, 1.0f);
    const float small = -(p * x), big = 1.0f - fexp(x);
    return x > -0.35f ? small : big;
}
#define LDS_WAIT() asm volatile("s_waitcnt lgkmcnt(0)" ::: "memory")
#define VM_WAIT() asm volatile("s_waitcnt vmcnt(0)" ::: "memory")

namespace pg8 {
constexpr int BM = 256, BK = 64, HALF = 128, HTB = HALF * BK * 2, STAGE_BYTES = 8 * HTB, NXCD = 8, WGM = 8;
__host__ __device__ __forceinline__ int lds_byte(int r, int c) { const int st = (r >> 4) * 2 + (c >> 5), rr = r & 15, cc = c & 31, ob = rr * 64 + cc * 2; return st * 1024 + (ob ^ (((ob >> 9) & 1) << 5)); }
__host__ __device__ __forceinline__ void stage_rc(int b, int& R, int& C) { const int st = b / 1024, sb = b % 1024, swz = sb ^ (((sb >> 9) & 1) << 5); R = (st >> 1) * 16 + swz / 64; C = (st & 1) * 32 + (swz % 64) / 2; }
__host__ __device__ __forceinline__ int perm32(int rho) { const int n = rho >> 4, i = rho & 15; return 8 * (i >> 2) + 4 * n + (i & 3); }

struct Unit { int pm, pn, kt0, nkt; };
struct Gemm { const bf16_t* A; const bf16_t* Bt; int lda, ldb; };

struct PanelOrder {
    int nN, nwgP, G, c, nktFull, sliceKt, nExtra;
    unsigned* ready; unsigned need;
    __device__ void init(int nN_, int nktFull_, int sliceKt_, int G_, int c_) { nN = nN_; nwgP = 32 * nN_; G = G_; c = c_; nktFull = nktFull_; sliceKt = sliceKt_; nExtra = nN_ * (nktFull_ / sliceKt_); ready = nullptr; need = 0u; }
    __device__ __forceinline__ void a_ready(const Unit& u) const {
        if (ready == nullptr || u.pm != 32) return;
        if (threadIdx.x < 64) {
            unsigned polls = 0;
            while ((unsigned)__builtin_amdgcn_readfirstlane(__hip_atomic_load(ready, __ATOMIC_RELAXED, __HIP_MEMORY_SCOPE_AGENT)) < need) { __builtin_amdgcn_s_sleep(2); if (++polls > (1u << 22)) break; }
            __builtin_amdgcn_fence(__ATOMIC_ACQUIRE, "agent");
            asm volatile("s_waitcnt vmcnt(0)" ::: "memory");
        }
        asm volatile("" ::: "memory"); __builtin_amdgcn_s_barrier(); asm volatile("" ::: "memory");
    }
    __device__ bool next(int i, Unit& u) const {
        const long L = (long)i * G + c;
        if (L < nwgP) {
            int wgid = (int)L; { const int q = nwgP / NXCD, r = nwgP % NXCD, xcd = wgid % NXCD, off = wgid / NXCD; wgid = (xcd < r ? xcd * (q + 1) : r * (q + 1) + (xcd - r) * q) + off; }
            const int nig = WGM * nN, gid = wgid / nig, fm = gid * WGM, gsz = (32 - fm) < WGM ? (32 - fm) : WGM;
            u.pm = fm + ((wgid % nig) % gsz); u.pn = (wgid % nig) / gsz; u.kt0 = 0; u.nkt = nktFull; return true;
        }
        const int e = (int)(L - nwgP); if (e >= nExtra) return false;
        u.pm = 32; u.pn = e % nN; u.kt0 = (e / nN) * sliceKt; u.nkt = sliceKt; return true;
    }
};

template <class Epi, class Sched>
__device__ __forceinline__ void gemm_phase(LAS unsigned char* lds, const Gemm g, const Sched& S, const Epi& E) {
    const int tid = threadIdx.x, wid = __builtin_amdgcn_readfirstlane(tid >> 6), lane = tid & 63, wr = wid >> 2, wc = wid & 3, fr = lane & 15, fq = lane >> 4;
    unsigned voffA[2], voffB[2];
#pragma unroll
    for (int i = 0; i < 2; ++i) { int R, C; stage_rc(tid * 16 + i * 8192, R, C); const int Rb = Epi::PERM ? ((R & ~31) + perm32(R & 31)) : R;
        voffA[i] = (unsigned)(R * g.lda + C) * 2u; voffB[i] = (unsigned)(Rb * g.ldb + C) * 2u; }
    const size_t kstep = (size_t)(BK * 2);
    const size_t hstepA = (size_t)HALF * g.lda * 2, hstepB = (size_t)HALF * g.ldb * 2;
    const size_t tstepA = 2 * hstepA, tstepB = 2 * hstepB;
    const unsigned ldsw = (unsigned)wid * 1024u;
    const int aoff = lds_byte(wr * 64 + fr, fq * 8), boff = lds_byte(wc * 32 + fr, fq * 8);
#define PG8_SA(b, h) (((b) * 2 + (h)) * HTB)
#define PG8_SB(b, h) ((4 + (b) * 2 + (h)) * HTB)
#define PG8_STAGE(bufoff, gbase, voff) do { _Pragma("unroll") for (int _i = 0; _i < 2; ++_i) \
        __builtin_amdgcn_global_load_lds((const unsigned*)((const char*)(gbase) + (voff)[_i]), (LAS unsigned*)(lds + (bufoff) + ldsw + _i * 8192), 16, 0, 0); } while (0)
#define PG8_LDA(dst, b, h) do { _Pragma("unroll") for (int m = 0; m < 4; ++m) _Pragma("unroll") for (int k = 0; k < 2; ++k) dst[m][k] = *(const LAS bf16x8*)(lds + PG8_SA(b, h) + aoff + m * 2048 + k * 1024); } while (0)
#define PG8_LDB(dst, b, h) do { _Pragma("unroll") for (int n = 0; n < 2; ++n) _Pragma("unroll") for (int k = 0; k < 2; ++k) dst[n][k] = *(const LAS bf16x8*)(lds + PG8_SB(b, h) + boff + n * 2048 + k * 1024); } while (0)
#define PG8_MMA(ai, bj, At, Bt) do { __builtin_amdgcn_s_setprio(1); _Pragma("unroll") for (int m = 0; m < 4; ++m) _Pragma("unroll") for (int n = 0; n < 2; ++n) _Pragma("unroll") for (int k = 0; k < 2; ++k) \
        acc[ai][bj][m][n] = __builtin_amdgcn_mfma_f32_16x16x32_bf16(Bt[n][k], At[m][k], acc[ai][bj][m][n], 0, 0, 0); __builtin_amdgcn_s_setprio(0); } while (0)
#define PG8_WAIT_V(n) asm volatile("s_waitcnt vmcnt(" #n ")" ::: "memory")
#define PG8_WAIT_L(n) asm volatile("s_waitcnt lgkmcnt(" #n ")" ::: "memory")
#define PG8_BAR __builtin_amdgcn_s_barrier()
#define PG8_SCHED __builtin_amdgcn_sched_barrier(0)
    Unit cur, nxt; int ui = 0;
    if (!S.next(0, cur)) return;
    f32x4 acc[2][2][4][2];
#pragma unroll
    for (int a = 0; a < 2; ++a)
#pragma unroll
        for (int b = 0; b < 2; ++b)
#pragma unroll
            for (int m = 0; m < 4; ++m)
#pragma unroll
                for (int n = 0; n < 2; ++n) acc[a][b][m][n] = (f32x4){0.f, 0.f, 0.f, 0.f};
    bf16x8 At[4][2], B0[2][2], B1[2][2];
    const char* cA = (const char*)g.A + (size_t)cur.pm * tstepA + (size_t)cur.kt0 * kstep;
    const char* cB = (const char*)g.Bt + (size_t)cur.pn * tstepB + (size_t)cur.kt0 * kstep;
    S.a_ready(cur);
    PG8_STAGE(PG8_SB(0, 0), cB, voffB); PG8_STAGE(PG8_SB(0, 1), cB + hstepB, voffB); PG8_STAGE(PG8_SA(0, 0), cA, voffA); PG8_STAGE(PG8_SA(0, 1), cA + hstepA, voffA);
    if (wr == 1) PG8_BAR;
    PG8_WAIT_V(2); PG8_BAR;
    PG8_STAGE(PG8_SB(1, 0), cB + kstep, voffB); PG8_STAGE(PG8_SA(1, 0), cA + kstep, voffA); PG8_STAGE(PG8_SB(1, 1), cB + hstepB + kstep, voffB);
    PG8_WAIT_V(6); PG8_BAR;
    for (;;) {
        const bool has_next = S.next(ui + 1, nxt);
        const char* nA = has_next ? (const char*)g.A + (size_t)nxt.pm * tstepA + (size_t)nxt.kt0 * kstep : cA;
        const char* nB = has_next ? (const char*)g.Bt + (size_t)nxt.pn * tstepB + (size_t)nxt.kt0 * kstep : cB;
        const int nt = cur.nkt;
        for (int t = 0; t < nt; t += 2) {
            const bool last = (t == nt - 2);
            if (last && has_next) S.a_ready(nxt);
            const char* a1 = cA + (size_t)(t + 1) * kstep;
            const char* a2 = last ? nA : cA + (size_t)(t + 2) * kstep; const char* b2 = last ? nB : cB + (size_t)(t + 2) * kstep;
            const char* a3 = a2 + kstep; const char* b3 = b2 + kstep;
            if constexpr (Epi::HAS_MID) { if (t == Epi::MID_T) E.mid(acc, cur, wr, wc, fr, fq); }
            PG8_LDB(B0, 0, 0); PG8_LDB(B1, 0, 1); PG8_SCHED; PG8_LDA(At, 0, 0); PG8_STAGE(PG8_SA(1, 1), a1 + hstepA, voffA);
            PG8_WAIT_V(8); PG8_WAIT_L(0); PG8_BAR; PG8_MMA(0, 0, At, B0); PG8_MMA(0, 1, At, B1); PG8_BAR; PG8_SCHED;
            PG8_LDA(At, 0, 1); PG8_STAGE(PG8_SB(0, 0), b2, voffB); PG8_STAGE(PG8_SB(0, 1), b2 + hstepB, voffB); PG8_STAGE(PG8_SA(0, 0), a2, voffA);
            PG8_WAIT_V(8); PG8_WAIT_L(0); PG8_BAR; PG8_MMA(1, 0, At, B0); PG8_MMA(1, 1, At, B1); PG8_BAR; PG8_SCHED;
            PG8_LDB(B0, 1, 0); PG8_LDB(B1, 1, 1); PG8_SCHED; PG8_LDA(At, 1, 0); PG8_STAGE(PG8_SA(0, 1), a2 + hstepA, voffA);
            PG8_WAIT_V(8); PG8_WAIT_L(0); PG8_BAR; PG8_MMA(0, 0, At, B0); PG8_MMA(0, 1, At, B1); PG8_BAR; PG8_SCHED;
            PG8_LDA(At, 1, 1); PG8_STAGE(PG8_SB(1, 0), b3, voffB); PG8_STAGE(PG8_SB(1, 1), b3 + hstepB, voffB); PG8_STAGE(PG8_SA(1, 0), a3, voffA);
            PG8_WAIT_V(8); PG8_WAIT_L(0); PG8_BAR; PG8_MMA(1, 0, At, B0); PG8_MMA(1, 1, At, B1); PG8_BAR; PG8_SCHED;
        }
        if (wr == 0) PG8_BAR;
        E(acc, cur, wr, wc, fr, fq);
        if (!has_next) break;
#pragma unroll
        for (int a = 0; a < 2; ++a)
#pragma unroll
            for (int b = 0; b < 2; ++b)
#pragma unroll
                for (int m = 0; m < 4; ++m)
#pragma unroll
                    for (int n = 0; n < 2; ++n) acc[a][b][m][n] = (f32x4){0.f, 0.f, 0.f, 0.f};
        cur = nxt; cA = nA; cB = nB; ++ui;
        if (wr == 1) PG8_BAR;
    }
    PG8_WAIT_V(0);
    PG8_BAR;
#undef PG8_SA
#undef PG8_SB
#undef PG8_STAGE
#undef PG8_LDA
#undef PG8_LDB
#undef PG8_MMA
#undef PG8_WAIT_V
#undef PG8_WAIT_L
#undef PG8_BAR
#undef PG8_SCHED
}


typedef f32x4 Acc[2][2][4][2];
__device__ __forceinline__ void slab_store(const Acc& acc, const Unit& u, float* slab, int wr, int wc, int fr, int fq) {
    int rowl = wr * 64 + fr, col0 = u.pn * BM + wc * 32 + 8 * fq; asm volatile("" : "+v"(rowl), "+v"(col0));
    float* base = slab + (size_t)(u.kt0 / u.nkt) * ((size_t)MS * D);
#pragma unroll
    for (int m = 0; m < 4; ++m)
#pragma unroll
        for (int bj = 0; bj < 2; ++bj) { float* p = base + (size_t)(rowl + m * 16) * D + col0 + bj * HALF; *(f32x4*)p = acc[0][bj][m][0]; *(f32x4*)(p + 4) = acc[0][bj][m][1]; }
}
struct EpiSwiGLU {
    static constexpr bool PERM = true, HAS_MID = false; static constexpr int MID_T = -1;
    bf16_t* O; const float* ssq;
    __device__ __forceinline__ void mid(Acc&, const Unit&, int, int, int, int) const {}
    __device__ __forceinline__ void operator()(const Acc& acc, const Unit& u, int wr, int wc, int fr, int fq) const {
        int row0 = u.pm * BM + wr * 64 + fr, colh = u.pn * 128 + wc * 32 + 8 * fq; asm volatile("" : "+v"(row0), "+v"(colh));
        float sq[2][4];
#pragma unroll
        for (int ai = 0; ai < 2; ++ai)
#pragma unroll
            for (int m = 0; m < 4; ++m) sq[ai][m] = ssq[row0 + ai * HALF + m * 16];
        asm volatile("" ::: "memory");
#pragma unroll
        for (int ai = 0; ai < 2; ++ai)
#pragma unroll
            for (int m = 0; m < 4; ++m) {
                const int row = row0 + ai * HALF + m * 16;
                const float r = rsqrtf(sq[ai][m] * (1.0f / D) + EPS);
                f32x4 h0, h1;
#pragma unroll
                for (int j = 0; j < 4; ++j) { h0[j] = fsilu(acc[ai][0][m][0][j] * r) * (acc[ai][1][m][0][j] * r); h1[j] = fsilu(acc[ai][0][m][1][j] * r) * (acc[ai][1][m][1][j] * r); }
                *(u32x4*)(O + (size_t)row * FF + colh) = pack8(h0, h1);
            }
    }
};
typedef u32x4 ResTile[2][4][2];
typedef u32x4 ResHalf[4][2];
__device__ __forceinline__ void res_load(ResTile& res, const bf16_t* XB, int row0, int col0) {
#pragma unroll
    for (int ai = 0; ai < 2; ++ai)
#pragma unroll
        for (int m = 0; m < 4; ++m)
#pragma unroll
            for (int bj = 0; bj < 2; ++bj) res[ai][m][bj] = *(const u32x4*)(XB + (size_t)(row0 + ai * HALF + m * 16) * D + col0 + bj * HALF);
    asm volatile("" ::: "memory");
}
__device__ __forceinline__ void res_load_half(ResHalf& res, const bf16_t* XB, int rowh, int col0) {
#pragma unroll
    for (int m = 0; m < 4; ++m)
#pragma unroll
        for (int bj = 0; bj < 2; ++bj) res[m][bj] = *(const u32x4*)(XB + (size_t)(rowh + m * 16) * D + col0 + bj * HALF);
    asm volatile("" ::: "memory");
}
__device__ __forceinline__ f32x4 res_lo(const u32x4 w) { return (f32x4){bf_lo(w.x), bf_hi(w.x), bf_lo(w.y), bf_hi(w.y)}; }
__device__ __forceinline__ f32x4 res_hi(const u32x4 w) { return (f32x4){bf_lo(w.z), bf_hi(w.z), bf_lo(w.w), bf_hi(w.w)}; }
struct EpiResid {
    static constexpr bool PERM = true, HAS_MID = false; static constexpr int MID_T = -1;
    float* slab; bf16_t* XB; float* ssq;
    __device__ __forceinline__ void mid(Acc&, const Unit&, int, int, int, int) const {}
    __device__ __forceinline__ void operator()(const Acc& acc, const Unit& u, int wr, int wc, int fr, int fq) const {
        if (u.pm == 32) { slab_store(acc, u, slab, wr, wc, fr, fq); return; }
        int row0 = u.pm * BM + wr * 64 + fr, col0 = u.pn * BM + wc * 32 + 8 * fq; asm volatile("" : "+v"(row0), "+v"(col0));
#pragma unroll
        for (int ai = 0; ai < 2; ++ai) {
            ResHalf res; res_load_half(res, XB, row0 + ai * HALF, col0);
#pragma unroll
            for (int m = 0; m < 4; ++m) {
                const int row = row0 + ai * HALF + m * 16;
                float s = 0.f;
#pragma unroll
                for (int bj = 0; bj < 2; ++bj) {
                    const f32x4 v0 = res_lo(res[m][bj]) + 0.5f * acc[ai][bj][m][0], v1 = res_hi(res[m][bj]) + 0.5f * acc[ai][bj][m][1];
                    *(u32x4*)(XB + (size_t)row * D + col0 + bj * HALF) = pack8(v0, v1);
                    s += dot4(v0) + dot4(v1);
                }
                s += __shfl_xor(s, 16); s += __shfl_xor(s, 32);
                if (fq == 0) atomicAdd(ssq + row, s);
            }
        }
    }
};
struct EpiProj {
    static constexpr bool PERM = true, HAS_MID = false; static constexpr int MID_T = -1;
    bf16_t* U; float* XL; bf16_t* GG; const float* ssq;
    __device__ __forceinline__ void mid(Acc&, const Unit&, int, int, int, int) const {}
    __device__ __forceinline__ void operator()(const Acc& acc, const Unit& u, int wr, int wc, int fr, int fq) const {
        int row0 = u.pm * BM + wr * 64 + fr, col0 = (u.pn & 3) * BM + wc * 32 + 8 * fq; const int seg = u.pn >> 2; asm volatile("" : "+v"(row0), "+v"(col0));
        float sq[2][4];
#pragma unroll
        for (int ai = 0; ai < 2; ++ai)
#pragma unroll
            for (int m = 0; m < 4; ++m) sq[ai][m] = ssq[row0 + ai * HALF + m * 16];
        asm volatile("" ::: "memory");
#pragma unroll
        for (int ai = 0; ai < 2; ++ai)
#pragma unroll
            for (int m = 0; m < 4; ++m) {
                const int row = row0 + ai * HALF + m * 16;
                const float r = rsqrtf(sq[ai][m] * (1.0f / D) + EPS);
#pragma unroll
                for (int bj = 0; bj < 2; ++bj) {
                    const size_t o = (size_t)row * DH + col0 + bj * HALF;
                    f32x4 v0 = acc[ai][bj][m][0] * r, v1 = acc[ai][bj][m][1] * r;
                    if (seg == 0) { *(u32x4*)(U + o) = pack8(v0, v1); }
                    else if (seg == 1) { *(f32x4*)(XL + o) = v0; *(f32x4*)(XL + o + 4) = v1; }
                    else {
#pragma unroll
                        for (int j = 0; j < 4; ++j) { v0[j] = fgelu(v0[j]); v1[j] = fgelu(v1[j]); }
                        *(u32x4*)(GG + o) = pack8(v0, v1);
                    }
                }
            }
    }
};
struct EpiGlu {
    static constexpr bool PERM = true, HAS_MID = false; static constexpr int MID_T = -1;
    const bf16_t* GS; const float* bias; bf16_t* MRG; float* ssq;
    __device__ __forceinline__ void mid(Acc&, const Unit&, int, int, int, int) const {}
    __device__ __forceinline__ void operator()(const Acc& acc, const Unit& u, int wr, int wc, int fr, int fq) const {
        int row0 = u.pm * BM + wr * 64 + fr, col0 = u.pn * BM + wc * 32 + 8 * fq; asm volatile("" : "+v"(row0), "+v"(col0));
        ResTile gt;
#pragma unroll
        for (int ai = 0; ai < 2; ++ai)
#pragma unroll
            for (int m = 0; m < 4; ++m)
#pragma unroll
                for (int bj = 0; bj < 2; ++bj) gt[ai][m][bj] = *(const u32x4*)(GS + (size_t)(row0 + ai * HALF + m * 16) * DH + col0 + bj * HALF);
        f32x4 bb[2][2];
#pragma unroll
        for (int bj = 0; bj < 2; ++bj) { bb[bj][0] = *(const f32x4*)(bias + col0 + bj * HALF); bb[bj][1] = *(const f32x4*)(bias + col0 + bj * HALF + 4); }
        asm volatile("" ::: "memory");
#pragma unroll
        for (int ai = 0; ai < 2; ++ai)
#pragma unroll
            for (int m = 0; m < 4; ++m) {
                const int row = row0 + ai * HALF + m * 16;
                float s = 0.f;
#pragma unroll
                for (int bj = 0; bj < 2; ++bj) {
                    const f32x4 g0 = res_lo(gt[ai][m][bj]), g1 = res_hi(gt[ai][m][bj]);
                    f32x4 v0, v1;
#pragma unroll
                    for (int j = 0; j < 4; ++j) { v0[j] = g0[j] * fsigmoid(acc[ai][bj][m][0][j] + bb[bj][0][j]); v1[j] = g1[j] * fsigmoid(acc[ai][bj][m][1][j] + bb[bj][1][j]); }
                    *(u32x4*)(MRG + (size_t)row * D + col0 + bj * HALF) = pack8(v0, v1);
                    s += dot4(v0) + dot4(v1);
                }
                s += __shfl_xor(s, 16); s += __shfl_xor(s, 32);
                if (fq == 0) atomicAdd(ssq + row, s);
            }
    }
};
struct EpiOut {
    static constexpr bool PERM = true, HAS_MID = true; static constexpr int MID_T = 16;
    const float* ssq_s5; const float* ssq_lru; bf16_t* XB; float* ssq; float* slab;
    __device__ __forceinline__ void mid(Acc& acc, const Unit& u, int wr, int wc, int fr, int fq) const {
        if (u.pm == 32 && slab) return;
        int row0 = u.pm * BM + wr * 64 + fr; asm volatile("" : "+v"(row0));
        float f[2][4];
#pragma unroll
        for (int ai = 0; ai < 2; ++ai)
#pragma unroll
            for (int m = 0; m < 4; ++m) { const int row = row0 + ai * HALF + m * 16; f[ai][m] = rsqrtf(ssq_s5[row] * (1.0f / DH) + EPS) * sqrtf(ssq_lru[row] * (1.0f / DH) + EPS); }
#pragma unroll
        for (int ai = 0; ai < 2; ++ai)
#pragma unroll
            for (int m = 0; m < 4; ++m)
#pragma unroll
                for (int bj = 0; bj < 2; ++bj)
#pragma unroll
                    for (int n = 0; n < 2; ++n) acc[ai][bj][m][n] = acc[ai][bj][m][n] * f[ai][m];
    }
    __device__ __forceinline__ void operator()(const Acc& acc, const Unit& u, int wr, int wc, int fr, int fq) const {
        if (u.pm == 32 && slab) { slab_store(acc, u, slab, wr, wc, fr, fq); return; }
        int row0 = u.pm * BM + wr * 64 + fr, col0 = u.pn * BM + wc * 32 + 8 * fq; asm volatile("" : "+v"(row0), "+v"(col0));
        float rl[2][4];
#pragma unroll
        for (int ai = 0; ai < 2; ++ai)
#pragma unroll
            for (int m = 0; m < 4; ++m) rl[ai][m] = ssq_lru[row0 + ai * HALF + m * 16];
#pragma unroll
        for (int ai = 0; ai < 2; ++ai) {
            ResHalf res; res_load_half(res, XB, row0 + ai * HALF, col0);
#pragma unroll
            for (int m = 0; m < 4; ++m) {
                const int row = row0 + ai * HALF + m * 16;
                const float r = rsqrtf(rl[ai][m] * (1.0f / DH) + EPS);
                float s = 0.f;
#pragma unroll
                for (int bj = 0; bj < 2; ++bj) {
                    const f32x4 v0 = res_lo(res[m][bj]) + r * acc[ai][bj][m][0], v1 = res_hi(res[m][bj]) + r * acc[ai][bj][m][1];
                    *(u32x4*)(XB + (size_t)row * D + col0 + bj * HALF) = pack8(v0, v1);
                    s += dot4(v0) + dot4(v1);
                }
                s += __shfl_xor(s, 16); s += __shfl_xor(s, 32);
                if (fq == 0) atomicAdd(ssq + row, s);
            }
        }
    }
};
struct EpiFinal {
    static constexpr bool PERM = true, HAS_MID = false; static constexpr int MID_T = -1;
    bf16_t* XB; float* ssq; float* slab;
    __device__ __forceinline__ void mid(Acc&, const Unit&, int, int, int, int) const {}
    __device__ __forceinline__ void operator()(const Acc& acc, const Unit& u, int wr, int wc, int fr, int fq) const {
        if (u.pm == 32) { slab_store(acc, u, slab, wr, wc, fr, fq); return; }
        int row0 = u.pm * BM + wr * 64 + fr, col0 = u.pn * BM + wc * 32 + 8 * fq; asm volatile("" : "+v"(row0), "+v"(col0));
#pragma unroll
        for (int ai = 0; ai < 2; ++ai) {
            ResHalf res; res_load_half(res, XB, row0 + ai * HALF, col0);
#pragma unroll
            for (int m = 0; m < 4; ++m) {
                const int row = row0 + ai * HALF + m * 16;
                float s = 0.f;
#pragma unroll
                for (int bj = 0; bj < 2; ++bj) {
                    const f32x4 v0 = res_lo(res[m][bj]) + 0.5f * acc[ai][bj][m][0], v1 = res_hi(res[m][bj]) + 0.5f * acc[ai][bj][m][1];
                    *(u32x4*)(XB + (size_t)row * D + col0 + bj * HALF) = pack8(v0, v1);
                    s += dot4(v0) + dot4(v1);
                }
                s += __shfl_xor(s, 16); s += __shfl_xor(s, 32);
                if (fq == 0) atomicAdd(ssq + row, s);
            }
        }
    }
};
}

#define XB_TMO      128
#define XB_XCNT(j)  (256  + 64 * (j))
#define XB_XSUB(j)  (1280 + 64 * (j))
#define XB_XGEN(j)  (2304 + 64 * (j))
#define XB_TOP      3328
#define XB_TOPGEN   3392
#define XCD_BAR_WORDS 3456
#define XB_SPIN_CAP (1u << 18)
__device__ __forceinline__ unsigned xb_ld(unsigned* p)              { return __hip_atomic_load(p, __ATOMIC_RELAXED, __HIP_MEMORY_SCOPE_AGENT); }
__device__ __forceinline__ unsigned xb_add(unsigned* p, unsigned v) { return __hip_atomic_fetch_add(p, v, __ATOMIC_RELAXED, __HIP_MEMORY_SCOPE_AGENT); }
__device__ __forceinline__ unsigned xb_xcc_id() { return (unsigned)__builtin_amdgcn_s_getreg((3 << 11) | 20) & 0xFu; }
#define XB_SPIN(cond, bar) do { unsigned _sp = 0; while (cond) { __builtin_amdgcn_s_sleep(1); \
    if ((++_sp & 255u) == 0u) { if (xb_ld(&(bar)[XB_TMO])) break; if (_sp > XB_SPIN_CAP) { atomicAdd(&(bar)[XB_TMO], 1u); break; } } } } while (0)
struct XcdBarrier { unsigned* bar; unsigned x; volatile LAS unsigned* st; };
__device__ __forceinline__ XcdBarrier xcd_barrier_post(unsigned* bar, volatile LAS unsigned* st) {
    XcdBarrier b; b.bar = bar; b.x = xb_xcc_id(); b.st = st;
    if (threadIdx.x == 0) (void)xb_add(&bar[XB_XCNT(b.x)], 1u);
    return b;
}
__device__ __forceinline__ void xcd_barrier_complete(unsigned* bar, unsigned x, unsigned& nloc, unsigned& nx) {
    const unsigned G = gridDim.x * gridDim.y * gridDim.z;
    unsigned sum, cnt, mine, sp = 0u;
    for (;;) {
        sum = 0u; cnt = 0u; mine = 0u;
#pragma unroll
        for (unsigned j = 0; j < 16; ++j) { const unsigned c = xb_ld(&bar[XB_XCNT(j)]); sum += c; cnt += (c > 0u) ? 1u : 0u; mine = (j == x) ? c : mine; }
        if (sum == G) break;
        __builtin_amdgcn_s_sleep(1);
        if ((++sp & 255u) == 0u) { if (xb_ld(&bar[XB_TMO])) break; if (sp > XB_SPIN_CAP) { atomicAdd(&bar[XB_TMO], 1u); break; } }
    }
    nloc = mine > 0u ? mine : 1u; nx = cnt > 0u ? cnt : 1u;
}
__device__ __forceinline__ void xcd_barrier(const XcdBarrier& b) {
    asm volatile("s_waitcnt vmcnt(0)" ::: "memory");
    __syncthreads();
    if (threadIdx.x == 0) {
        unsigned* bar = b.bar;
        __builtin_amdgcn_s_waitcnt(0);
        unsigned nloc = b.st[0], nx = b.st[1];
        if (nloc == 0u) { xcd_barrier_complete(bar, b.x, nloc, nx); b.st[0] = nloc; b.st[1] = nx; }
        const unsigned old = xb_add(&bar[XB_XSUB(b.x)], 1u);
        const unsigned gen = old / nloc;
        if (old + 1u == (gen + 1u) * nloc) {
            __builtin_amdgcn_fence(__ATOMIC_RELEASE, "agent");
            asm volatile("s_waitcnt vmcnt(0)" ::: "memory");
            (void)__hip_atomic_fetch_add(&bar[XB_TOP], 1u, __ATOMIC_RELAXED, __HIP_MEMORY_SCOPE_AGENT);
        }
        __builtin_amdgcn_fence(__ATOMIC_ACQUIRE, "agent");
        const unsigned target = (gen + 1u) * nx;
        XB_SPIN(xb_ld(&bar[XB_TOP]) < target, bar);
        asm volatile("s_waitcnt vmcnt(0)" ::: "memory");
    }
    __syncthreads();
}

enum { I_XP = 0, I_XS, I_S5RE, I_S5IM, I_LRUH, I_LRUCONV, I_GFFN1, I_W1A, I_W3A, I_W2A, I_GMIX, I_WIN, I_LAMRE, I_LAMIM, I_LOGDT, I_BRE, I_BIM, I_CRE, I_CIM,
       I_DSKIP, I_WGLU, I_BGLU, I_CONVW, I_CONVB, I_WA, I_BA, I_WX, I_BX, I_LAML, I_GS5, I_GLRU, I_WOUT, I_GFFN2, I_W1B, I_W3B, I_W2B, I_GFINAL, N_IN };
struct Args { const float* in[N_IN]; float* out; unsigned char* ws; int ph_lo, ph_hi; };
constexpr size_t O_Y = 0, O_PS5RE = (size_t)M * D, O_PS5IM = O_PS5RE + NB * NG * NP, O_PLRUH = O_PS5IM + NB * NG * NP, O_PLRUC = O_PLRUH + NB * DH,
                 O_SS5RE = O_PLRUC + NB * 3 * DH, O_SS5IM = O_SS5RE + (size_t)MS * NG * NP, O_SLRUH = O_SS5IM + (size_t)MS * NG * NP, O_SLRUC = O_SLRUH + (size_t)MS * DH,
                 O_END = O_SLRUC + (size_t)MS * 3 * DH;
static_assert(O_END == 18661376, "output size");

typedef float f32x2 __attribute__((ext_vector_type(2)));
constexpr int STG_PITCH = 144, STG_BYTES = 64 * STG_PITCH;
__device__ __forceinline__ void p0_task(const float* W, int N, const float* gk, bf16_t* WT, int ldt, int k0, int n0, int nd0, LAS unsigned char* stg, int lane) {
    const float* src = W + (size_t)k0 * N + n0 + 2 * lane;
    f32x2 v[64];
#if PROBE_PHASE >= 0
    { const float* p = src; const size_t step = (size_t)N;
#pragma unroll
      for (int i = 0; i < 64; ++i) { v[i] = __builtin_nontemporal_load((const f32x2*)p); p += step; if ((i & 7) == 7) asm volatile("" : "+v"(p)); } }
#else
#pragma unroll
    for (int i = 0; i < 64; ++i) v[i] = __builtin_nontemporal_load((const f32x2*)(src + (size_t)i * N));
#endif
    if (gk) {
#pragma unroll
        for (int i = 0; i < 64; ++i) v[i] = v[i] * gk[k0 + i];
    }
#pragma unroll
    for (int j = 0; j < 2; ++j) {
#pragma unroll
        for (int kb = 0; kb < 8; ++kb) {
            u32x4 o; o.x = cvt_pk_bf16(v[8 * kb][j], v[8 * kb + 1][j]); o.y = cvt_pk_bf16(v[8 * kb + 2][j], v[8 * kb + 3][j]); o.z = cvt_pk_bf16(v[8 * kb + 4][j], v[8 * kb + 5][j]); o.w = cvt_pk_bf16(v[8 * kb + 6][j], v[8 * kb + 7][j]);
            *(LAS u32x4*)(stg + lane * STG_PITCH + kb * 16) = o;
        }
        LDS_WAIT(); asm volatile("" ::: "memory");
#pragma unroll
        for (int it = 0; it < 8; ++it) {
            const int rr = 8 * it + (lane >> 3), kb = lane & 7;
            const u32x4 o = *(const LAS u32x4*)(stg + rr * STG_PITCH + kb * 16);
            *(u32x4*)(WT + (size_t)(nd0 + 2 * rr + j) * ldt + k0 + 8 * kb) = o;
        }
        LDS_WAIT(); asm volatile("" ::: "memory");
    }
}
__device__ __forceinline__ void sincos_d(double x, double& s, double& c) {
    const double k = rint(x * 0.63661977236758134308);
    double r = fma(-k, 1.57079632679489655800, x); r = fma(-k, 6.12323399573676603587e-17, r);
    const double r2 = r * r;
    double sp = -7.6471637318198164759e-13; sp = fma(sp, r2, 1.6059043836821614599e-10); sp = fma(sp, r2, -2.5052108385441718775e-8); sp = fma(sp, r2, 2.7557319223985890653e-6);
    sp = fma(sp, r2, -1.9841269841269841270e-4); sp = fma(sp, r2, 8.3333333333333333333e-3); sp = fma(sp, r2, -1.6666666666666666667e-1);
    const double sr = fma(sp * r2, r, r);
    double cp = 4.7794773323873852974e-14; cp = fma(cp, r2, -1.1470745597729724714e-11); cp = fma(cp, r2, 2.0876756987868098979e-9); cp = fma(cp, r2, -2.7557319223985890653e-7);
    cp = fma(cp, r2, 2.4801587301587301587e-5); cp = fma(cp, r2, -1.3888888888888888889e-3); cp = fma(cp, r2, 4.1666666666666666667e-2); cp = fma(cp, r2, -0.5);
    const double cr = fma(cp, r2, 1.0);
    const int q = ((int)k) & 3;
    s = (q == 0) ? sr : (q == 1) ? cr : (q == 2) ? -sr : -cr;
    c = (q == 0) ? cr : (q == 1) ? -sr : (q == 2) ? -cr : sr;
}
__device__ __forceinline__ void p0_s5_group(const Args& a, LAS unsigned char* lds, int g, int tid) {
    LAS float* LPre = (LAS float*)lds;
    LAS float* LPim = LPre + 17 * 64;
    LAS float* BBre = LPim + 17 * 64;
    LAS float* BBim = BBre + 1024;
    LAS float* CRe = BBim + 1024;
    LAS float* CIm = CRe + 1024;
    LAS float* Kt = CIm + 1024;
    LAS float* Kt2 = Kt + 4096;
    LAS float* QQ = Kt2 + 4096;
    const float ldt = a.in[I_LOGDT][g];
    float lre_[3], lim_[3];
#pragma unroll
    for (int i = 0; i < 3; ++i) { const int idx = tid + 512 * i, p = idx & 63; lre_[i] = a.in[I_LAMRE][g * 64 + p]; lim_[i] = a.in[I_LAMIM][g * 64 + p]; }
    float cr_[2], ci_[2], br_[2], bi_[2];
#pragma unroll
    for (int i = 0; i < 2; ++i) { const int idx = tid + 512 * i; cr_[i] = a.in[I_CRE][(size_t)g * 1024 + idx]; ci_[i] = a.in[I_CIM][(size_t)g * 1024 + idx]; br_[i] = a.in[I_BRE][(size_t)g * 1024 + idx]; bi_[i] = a.in[I_BIM][(size_t)g * 1024 + idx]; }
    const float dsk = a.in[I_DSKIP][g * 16 + (tid & 15)];
    const double dt = exp((double)ldt);
#pragma unroll
    for (int i = 0; i < 3; ++i) {
        const int idx = tid + 512 * i;
        if (idx < 17 * 64) {
            const int k = idx >> 6, p = idx & 63;
            const double lre = (double)lre_[i], lim = (double)lim_[i];
            const double mag = exp(lre * dt * (double)k); double sn, cs; sincos_d(lim * dt * (double)k, sn, cs);
            LPre[idx] = (float)(mag * cs); LPim[idx] = (float)(mag * sn);
            if (k == 1) {
                const double nr = mag * cs - 1.0, ni = mag * sn, den = lre * lre + lim * lim;
                QQ[2 * p] = (float)((nr * lre + ni * lim) / den); QQ[2 * p + 1] = (float)((ni * lre - nr * lim) / den);
            }
        }
    }
#pragma unroll
    for (int i = 0; i < 2; ++i) { const int idx = tid + 512 * i; CRe[idx] = cr_[i]; CIm[idx] = ci_[i]; }
    __syncthreads();
#pragma unroll
    for (int i = 0; i < 2; ++i) { const int idx = tid + 512 * i, p = idx >> 4; const float qr = QQ[2 * p], qi = QQ[2 * p + 1];
        BBre[idx] = qr * br_[i] - qi * bi_[i]; BBim[idx] = qr * bi_[i] + qi * br_[i]; }
    __syncthreads();
    {
        const int c = (tid >> 4) & 15, cp = tid & 15, ph = tid >> 8;
        float acc[16];
#pragma unroll
        for (int k = 0; k < 16; ++k) acc[k] = 0.f;
        for (int pp = 0; pp < 32; ++pp) {
            const int p = 32 * ph + pp;
            const float cr = CRe[c * 64 + p], ci = CIm[c * 64 + p], br = BBre[p * 16 + cp], bi = BBim[p * 16 + cp];
            const float gr = cr * br - ci * bi, gi = cr * bi + ci * br;
#pragma unroll
            for (int k = 0; k < 16; ++k) acc[k] += gr * LPre[k * 64 + p] - gi * LPim[k * 64 + p];
        }
        if (ph == 0 && c == cp) acc[0] += dsk;
        LAS float* dst = ph ? Kt2 : Kt;
#pragma unroll
        for (int k = 0; k < 16; ++k) dst[(k * 16 + c) * 16 + cp] = acc[k];
    }
    __syncthreads();
    bf16_t* Win = (bf16_t*)(a.ws + WS_S5M + (size_t)g * S5M_GROUP_BYTES);
    bf16_t* MW = Win + 128 * 256;
    for (int idx = tid; idx < 256 * 48; idx += NWAVES * 64) {
        const int rr = idx / 48, cg = idx % 48, s = rr >> 4, c = rr & 15;
        float v[8];
        if (cg < 32) { const int sp = cg >> 1, c0 = (cg & 1) * 8;
#pragma unroll
            for (int i = 0; i < 8; ++i) { const int o = (((s - sp) & 15) * 16 + c) * 16 + c0 + i; v[i] = (sp <= s) ? Kt[o] + Kt2[o] : 0.f; }
        } else { const int im = cg >= 40, p0 = (cg - (im ? 40 : 32)) * 8;
#pragma unroll
            for (int i = 0; i < 8; ++i) { const int p = p0 + i; const float cr = CRe[c * 64 + p], ci = CIm[c * 64 + p], lr = LPre[(s + 1) * 64 + p], li = LPim[(s + 1) * 64 + p];
                v[i] = im ? -(cr * li + ci * lr) : (cr * lr - ci * li); }
        }
        u32x4 o; o.x = cvt_pk_bf16(v[0], v[1]); o.y = cvt_pk_bf16(v[2], v[3]); o.z = cvt_pk_bf16(v[4], v[5]); o.w = cvt_pk_bf16(v[6], v[7]);
        *(u32x4*)(MW + (size_t)rr * 384 + cg * 8) = o;
    }
    for (int idx = tid; idx < 128 * 32; idx += NWAVES * 64) {
        const int n = idx >> 5, cg = idx & 31, p = n & 63, im = n >> 6, sp = cg >> 1, c0 = (cg & 1) * 8;
        const float lr = LPre[(15 - sp) * 64 + p], li = LPim[(15 - sp) * 64 + p];
        float v[8];
#pragma unroll
        for (int i = 0; i < 8; ++i) { const float br = BBre[p * 16 + c0 + i], bi = BBim[p * 16 + c0 + i]; v[i] = im ? (lr * bi + li * br) : (lr * br - li * bi); }
        u32x4 o; o.x = cvt_pk_bf16(v[0], v[1]); o.y = cvt_pk_bf16(v[2], v[3]); o.z = cvt_pk_bf16(v[4], v[5]); o.w = cvt_pk_bf16(v[6], v[7]);
        *(u32x4*)(Win + (size_t)n * 256 + cg * 8) = o;
    }
    {
        float* aux = (float*)(a.ws + WS_S5AUX) + (size_t)g * S5AUX_GROUP_FLOATS;
        for (int idx = tid; idx < 64; idx += NWAVES * 64) { aux[idx] = LPre[64 + idx]; aux[64 + idx] = LPim[64 + idx]; aux[128 + idx] = LPre[16 * 64 + idx]; aux[192 + idx] = LPim[16 * 64 + idx]; }
        for (int idx = tid; idx < 1024; idx += NWAVES * 64) { aux[256 + idx] = BBre[idx]; aux[1280 + idx] = BBim[idx]; }
    }
    __syncthreads();
}
__device__ __forceinline__ void conv_tasks(const Args& a, LAS unsigned char* stg, int first, int last, int wv, int nwv, int lane) {
    constexpr int T_W1 = (D / 64) * (FF / 128), T_W2 = (FF / 64) * (D / 128), T_IN = (D / 64) * (DIN / 128), T_GLU = (DH / 64) * (DH / 128), T_OUT = (D / 64) * (D / 128);
    const int cnt[9] = {T_W1, T_W1, T_W2, T_IN, T_GLU, T_OUT, T_W1, T_W1, T_W2};
    int NT = 0;
#pragma unroll
    for (int m = 0; m < 9; ++m) if (m >= first && m <= last) NT += cnt[m];
    const int t_lo = (int)(((long)wv * NT) / nwv), t_hi = (int)(((long)(wv + 1) * NT) / nwv);
    unsigned char* ws = a.ws;
    for (int it = t_lo; it < t_hi; ++it) {
        int r = it, mat = first;
#pragma unroll
        for (int m = 0; m < 9; ++m) if (m >= first && m < last && mat == m && r >= cnt[m]) { r -= cnt[m]; mat = m + 1; }
        const float* W; const float* gk = nullptr; bf16_t* WT; int K, N, dual = 0, off = 0;
        switch (mat) {
            case 0: W = a.in[I_W1A]; gk = a.in[I_GFFN1]; WT = (bf16_t*)(ws + WS_W13A); K = D; N = FF; dual = 1; break;
            case 1: W = a.in[I_W3A]; gk = a.in[I_GFFN1]; WT = (bf16_t*)(ws + WS_W13A); K = D; N = FF; dual = 1; off = 128; break;
            case 2: W = a.in[I_W2A]; WT = (bf16_t*)(ws + WS_W2A); K = FF; N = D; break;
            case 3: W = a.in[I_WIN]; gk = a.in[I_GMIX]; WT = (bf16_t*)(ws + WS_WIN); K = D; N = DIN; break;
            case 4: W = a.in[I_WGLU]; WT = (bf16_t*)(ws + WS_WGLU); K = DH; N = DH; break;
            case 5: W = a.in[I_WOUT]; WT = (bf16_t*)(ws + WS_WOUT); K = D; N = D; dual = 2; break;
            case 6: W = a.in[I_W1B]; gk = a.in[I_GFFN2]; WT = (bf16_t*)(ws + WS_W13B); K = D; N = FF; dual = 1; break;
            case 7: W = a.in[I_W3B]; gk = a.in[I_GFFN2]; WT = (bf16_t*)(ws + WS_W13B); K = D; N = FF; dual = 1; off = 128; break;
            default: W = a.in[I_W2B]; WT = (bf16_t*)(ws + WS_W2B); K = FF; N = D; break;
        }
        const int nkb = K / 64, nb = r / nkb, kb = r % nkb, k0 = kb * 64, n0 = nb * 128;
        if (dual == 2) { gk = k0 < DH ? a.in[I_GS5] : a.in[I_GLRU] - DH; dual = 0; }
        p0_task(W, N, gk, WT, K, k0, n0, dual ? (nb * 256 + off) : n0, stg, lane);
    }
}
__device__ __forceinline__ void p0_prologue(const Args& a, LAS unsigned char* lds, int vcu, int G, int lane, int wave) {
    const int gw = vcu * NWAVES + wave, NGW = G * NWAVES;
    unsigned char* ws = a.ws;
    bf16_t* XB = (bf16_t*)(ws + WS_XB); float* ssq0 = (float*)(ws + WS_CTL + CTL_SSQ_BYTE);
    for (int grp = gw; grp < MPAD / 4; grp += NGW) {
        const int m0 = 4 * grp;
        u32x2* o = (u32x2*)(XB + (size_t)m0 * D) + lane;
        if (m0 < M) {
            const float* xr = m0 < MP ? a.in[I_XP] + (size_t)m0 * D : a.in[I_XS] + (size_t)(m0 - MP) * D;
            const f32x4* x4 = (const f32x4*)xr + lane; f32x4 v[4][8];
#pragma unroll
            for (int r = 0; r < 4; ++r)
#pragma unroll
                for (int j = 0; j < 8; ++j) v[r][j] = __builtin_nontemporal_load(x4 + r * (D / 4) + 64 * j);
#pragma unroll
            for (int r = 0; r < 4; ++r) {
                float s = 0.f;
#pragma unroll
                for (int j = 0; j < 8; ++j) s += dot4(v[r][j]);
                s = wave_sum(s);
#pragma unroll
                for (int j = 0; j < 8; ++j) { u32x2 w; w.x = cvt_pk_bf16(v[r][j][0], v[r][j][1]); w.y = cvt_pk_bf16(v[r][j][2], v[r][j][3]); o[r * (D / 4) + 64 * j] = w; }
                if (lane == 0) ssq0[m0 + r] = s;
            }
        } else {
#pragma unroll
            for (int r = 0; r < 4; ++r)
#pragma unroll
                for (int j = 0; j < 8; ++j) o[r * (D / 4) + 64 * j] = (u32x2){0u, 0u};
        }
    }
    conv_tasks(a, lds + wave * STG_BYTES, 0, 3, gw, NGW, lane);
}

#define MFMA32(a, b, c) __builtin_amdgcn_mfma_f32_32x32x16_bf16((a), (b), (c), 0, 0, 0)
constexpr int S5_PITCH = 528;
constexpr int S5_XC_OFF = 0, S5_Z_OFF = 128 * S5_PITCH;
static_assert(2 * 128 * S5_PITCH <= RING_BYTES, "S5 LDS map");
__device__ __forceinline__ void s5_prompt(const Args& a, LAS unsigned char* lds, int b, int g, int tid, int lane, int wave) {
    const bf16_t* U = (const bf16_t*)(a.ws + WS_U);
    const bf16_t* Win = (const bf16_t*)(a.ws + WS_S5M + (size_t)g * S5M_GROUP_BYTES);
    const bf16_t* MW = Win + 128 * 256;
    bf16_t* GS5 = (bf16_t*)(a.ws + WS_GS5);
    LAS unsigned char* XCs = lds + S5_XC_OFF;
    LAS unsigned char* ZS = lds + S5_Z_OFF;
    const int r32 = lane & 31, hh = lane >> 5;
    {
        u32x4 v[8];
#pragma unroll
        for (int i = 0; i < 8; ++i) { const int q = tid + 512 * i, t = q >> 1, half = q & 1; v[i] = *(const u32x4*)(U + (size_t)(b * SEQ + t) * DH + 16 * g + 8 * half); }
#pragma unroll
        for (int i = 0; i < 8; ++i) { const int q = tid + 512 * i, t = q >> 1, half = q & 1; *(LAS u32x4*)(XCs + (t >> 4) * S5_PITCH + (t & 15) * 32 + 16 * half) = v[i]; }
    }
    {
        const int mt = wave & 3, nt0 = (wave >> 2) * 2;
        const bf16_t* w0 = Win + (size_t)(32 * nt0 + r32) * 256 + 8 * hh;
        bf16x8 bw[2][8];
#pragma unroll
        for (int ks = 0; ks < 8; ++ks) { bw[0][ks] = *(const bf16x8*)(w0 + 16 * ks); bw[1][ks] = *(const bf16x8*)(w0 + 32 * 256 + 16 * ks); }
        __syncthreads();
        f32x16 acc0, acc1;
#pragma unroll
        for (int i = 0; i < 16; ++i) { acc0[i] = 0.f; acc1[i] = 0.f; }
        const LAS unsigned char* xa = XCs + (32 * mt + r32) * S5_PITCH + 16 * hh;
#pragma unroll 1
        for (int kh = 0; kh < 2; ++kh) {
#pragma unroll
            for (int ks = 0; ks < 8; ++ks) { const bf16x8 af = *(const LAS bf16x8*)(xa + 32 * (8 * kh + ks)); acc0 = MFMA32(af, bw[0][ks], acc0); acc1 = MFMA32(af, bw[1][ks], acc1); }
            if (kh == 0) {
#pragma unroll
                for (int ks = 0; ks < 8; ++ks) { bw[0][ks] = *(const bf16x8*)(w0 + 128 + 16 * ks); bw[1][ks] = *(const bf16x8*)(w0 + 32 * 256 + 128 + 16 * ks); }
            }
        }
        LAS float* Z = (LAS float*)ZS;
#pragma unroll
        for (int i = 0; i < 16; ++i) { const int j = 32 * mt + (i & 3) + 8 * (i >> 2) + 4 * hh;
            Z[j * (S5_PITCH / 4) + 32 * nt0 + r32] = acc0[i]; Z[j * (S5_PITCH / 4) + 32 * nt0 + 32 + r32] = acc1[i]; }
    }
    __syncthreads();
    if (wave == 0) {
        const float* aux = (const float*)(a.ws + WS_S5AUX) + (size_t)g * S5AUX_GROUP_FLOATS;
        const float l16r = aux[128 + lane], l16i = aux[192 + lane];
        const LAS float* Z = (const LAS float*)ZS;
        float sr = 0.f, si = 0.f;
        for (int jb = 0; jb < 16; ++jb) {
            float zr[8], zi[8];
#pragma unroll
            for (int i = 0; i < 8; ++i) { zr[i] = Z[(8 * jb + i) * (S5_PITCH / 4) + lane]; zi[i] = Z[(8 * jb + i) * (S5_PITCH / 4) + 64 + lane]; }
            LDS_WAIT();
#pragma unroll
            for (int i = 0; i < 8; ++i) {
                const unsigned w = cvt_pk_bf16(sr, si);
                *(LAS unsigned short*)(ZS + (8 * jb + i) * S5_PITCH + 2 * lane) = (unsigned short)(w & 0xffffu);
                *(LAS unsigned short*)(ZS + (8 * jb + i) * S5_PITCH + 128 + 2 * lane) = (unsigned short)(w >> 16);
                const float nr = l16r * sr - l16i * si + zr[i], ni = l16r * si + l16i * sr + zi[i];
                sr = nr; si = ni;
            }
        }
        a.out[O_PS5RE + (size_t)(b * NG + g) * NP + lane] = sr;
        a.out[O_PS5IM + (size_t)(b * NG + g) * NP + lane] = si;
    }
#pragma unroll 1
    for (int pass = 0; pass < 2; ++pass) {
        const int mt = pass ? 7 - wave : wave, n0 = 2 * pass;
        const int nks = 2 * mt + 2;
        const bf16_t* mw = MW + (size_t)(32 * mt + r32) * 384 + 8 * hh;
        bf16x8 am[24];
#pragma unroll
        for (int ks = 0; ks < 16; ++ks) if (ks < nks) am[ks] = *(const bf16x8*)(mw + 16 * ks);
#pragma unroll
        for (int kq = 0; kq < 8; ++kq) am[16 + kq] = *(const bf16x8*)(mw + 256 + 16 * kq);
        if (pass == 0) __syncthreads();
        f32x16 acc[2];
#pragma unroll
        for (int n = 0; n < 2; ++n)
#pragma unroll
            for (int i = 0; i < 16; ++i) acc[n][i] = 0.f;
#pragma unroll
        for (int ks = 0; ks < 16; ++ks) if (ks < nks) {
#pragma unroll
            for (int n = 0; n < 2; ++n) { const bf16x8 bf = *(const LAS bf16x8*)(XCs + (32 * (n0 + n) + r32) * S5_PITCH + 32 * ks + 16 * hh); acc[n] = MFMA32(am[ks], bf, acc[n]); }
        }
#pragma unroll
        for (int kq = 0; kq < 8; ++kq) {
#pragma unroll
            for (int n = 0; n < 2; ++n) { const bf16x8 bf = *(const LAS bf16x8*)(ZS + (32 * (n0 + n) + r32) * S5_PITCH + 32 * kq + 16 * hh); acc[n] = MFMA32(am[16 + kq], bf, acc[n]); }
        }
#pragma unroll
        for (int n = 0; n < 2; ++n)
#pragma unroll
            for (int q = 0; q < 4; ++q) {
                const int s = 2 * mt + (q >> 1), c0 = 8 * (q & 1) + 4 * hh, t = 16 * (32 * (n0 + n) + r32) + s;
                u32x2 w; w.x = cvt_pk_bf16(fgelu(acc[n][4 * q]), fgelu(acc[n][4 * q + 1])); w.y = cvt_pk_bf16(fgelu(acc[n][4 * q + 2]), fgelu(acc[n][4 * q + 3]));
                *(u32x2*)(GS5 + (size_t)(b * SEQ + t) * DH + 16 * g + c0) = w;
            }
    }
    __syncthreads();
}
__device__ __forceinline__ void s5_sample(const Args& a, LAS unsigned char* lds, int g, int bs0, int tid) {
    const bf16_t* U = (const bf16_t*)(a.ws + WS_U);
    bf16_t* GS5 = (bf16_t*)(a.ws + WS_GS5);
    const float* aux = (const float*)(a.ws + WS_S5AUX) + (size_t)g * S5AUX_GROUP_FLOATS;
    LAS float* HR = (LAS float*)lds;
    LAS float* HI = HR + 2048;
    LAS float* UU = HI + 2048;
    LAS float* CR = UU + 512;
    LAS float* CI = CR + 1024;
    LAS float* BR = CI + 1024;
    LAS float* BI = BR + 1024;
    const int bl0 = tid >> 4, c0 = tid & 15;
    const unsigned short uraw = U[(size_t)(MP + bs0 + bl0) * DH + 16 * g + c0];
    float cr_[2], ci_[2], br_[2], bi_[2], h0r[4], h0i[4];
#pragma unroll
    for (int i = 0; i < 2; ++i) { const int idx = tid + 512 * i; cr_[i] = a.in[I_CRE][(size_t)g * 1024 + idx]; ci_[i] = a.in[I_CIM][(size_t)g * 1024 + idx]; br_[i] = aux[256 + idx]; bi_[i] = aux[1280 + idx]; }
#pragma unroll
    for (int i = 0; i < 4; ++i) { const int idx = tid + 512 * i, bl = idx >> 6, p = idx & 63; const size_t so = (size_t)((bs0 + bl) * NG + g) * NP + p; h0r[i] = a.in[I_S5RE][so]; h0i[i] = a.in[I_S5IM][so]; }
    const float lr = aux[tid & 63], li = aux[64 + (tid & 63)];
    const float dsk = a.in[I_DSKIP][g * 16 + c0];
    UU[tid] = __uint_as_float((unsigned)uraw << 16);
#pragma unroll
    for (int i = 0; i < 2; ++i) { const int idx = tid + 512 * i; CR[idx] = cr_[i]; CI[idx] = ci_[i]; BR[idx] = br_[i]; BI[idx] = bi_[i]; }
    __syncthreads();
#pragma unroll
    for (int i = 0; i < 4; ++i) {
        const int idx = tid + 512 * i, bl = idx >> 6, p = idx & 63;
        float hr = lr * h0r[i] - li * h0i[i], hi = lr * h0i[i] + li * h0r[i];
#pragma unroll
        for (int q = 0; q < 4; ++q) { const f32x4 br = *(const LAS f32x4*)(BR + p * 16 + 4 * q), bi = *(const LAS f32x4*)(BI + p * 16 + 4 * q); const f32x4 u4 = *(const LAS f32x4*)(UU + bl * 16 + 4 * q);
#pragma unroll
            for (int j = 0; j < 4; ++j) { hr += br[j] * u4[j]; hi += bi[j] * u4[j]; } }
        const size_t so = (size_t)((bs0 + bl) * NG + g) * NP + p;
        a.out[O_SS5RE + so] = hr; a.out[O_SS5IM + so] = hi;
        HR[idx] = hr; HI[idx] = hi;
    }
    __syncthreads();
    {
        float y = 0.f;
#pragma unroll 16
        for (int p = 0; p < 64; ++p) y += CR[c0 * 64 + p] * HR[bl0 * 64 + p] - CI[c0 * 64 + p] * HI[bl0 * 64 + p];
        y += dsk * UU[tid];
        const float gv = fgelu(y); const unsigned w = cvt_pk_bf16(gv, gv);
        GS5[(size_t)(MP + bs0 + bl0) * DH + 16 * g + c0] = (bf16_t)(w & 0xffffu);
    }
    __syncthreads();
}

constexpr int XC_PITCH = 144;
__device__ __forceinline__ void lru_item(const Args& a, LAS unsigned char* lds, bool sample, int b, int head, int q, int tid, int lane, int wave) {
    const float* XL = (const float*)(a.ws + WS_XLRU);
    const bf16_t* GG = (const bf16_t*)(a.ws + WS_GG);
    bf16_t* MRG = (bf16_t*)(a.ws + WS_MRG);
    float* ssq_lru = (float*)(a.ws + WS_CTL + CTL_SSQ_BYTE) + 3 * MPAD;
    LAS unsigned char* XC = lds;
    LAS float* XCF = (LAS float*)(lds + 36864);
    LAS float* AA = XCF + 4096;
    LAS float* BX = AA + 4096;
    LAS float* SEGP = BX + 4096;
    LAS float* SEGH = SEGP + 512;
    LAS float* CAR = SEGH + 512;
    const int ch0 = 64 * head + 16 * q;
    const int fr = lane & 15, fq = lane >> 4;
    bf16x8 Bf[2][2];
#pragma unroll
    for (int mat = 0; mat < 2; ++mat)
#pragma unroll
        for (int ks = 0; ks < 2; ++ks) {
            const float* w = (mat ? a.in[I_WX] : a.in[I_WA]) + ((size_t)(head * 64 + 32 * ks + 8 * fq)) * 64 + 16 * q + fr;
            u32x4 p; p.x = cvt_pk_bf16(w[0], w[64]); p.y = cvt_pk_bf16(w[128], w[192]); p.z = cvt_pk_bf16(w[256], w[320]); p.w = cvt_pk_bf16(w[384], w[448]);
            Bf[mat][ks] = __builtin_bit_cast(bf16x8, p);
        }
    const int chn = ch0 + fr;
    const float ba = a.in[I_BA][chn], bx_ = a.in[I_BX][chn];
    const float spl = log1pf(expf(-a.in[I_LAML][chn]));
    const int cq = tid & 15, cch = 64 * head + 4 * cq, rg = tid >> 4;
    const f32x4 cw0 = *(const f32x4*)(a.in[I_CONVW] + cch), cw1 = *(const f32x4*)(a.in[I_CONVW] + DH + cch), cw2 = *(const f32x4*)(a.in[I_CONVW] + 2 * DH + cch),
                cw3 = *(const f32x4*)(a.in[I_CONVW] + 3 * DH + cch), cb = *(const f32x4*)(a.in[I_CONVB] + cch);
    const int er = tid >> 1, eh = tid & 1;
    if (!sample) {
        float hcar = 0.f;
        f32x4 xin[11]; u32x4 ggn;
        { const int R0 = b * SEQ, r0 = rg * 8;
#pragma unroll
          for (int i = 0; i < 11; ++i) { const int t = r0 + i - 3; xin[i] = (t >= 0) ? *(const f32x4*)(XL + (size_t)(R0 + t) * DH + cch) : (f32x4){0.f, 0.f, 0.f, 0.f}; }
          ggn = *(const u32x4*)(GG + (size_t)(R0 + er) * DH + ch0 + 8 * eh); }
        for (int chk = 0; chk < 8; ++chk) {
            const int R0 = b * SEQ + chk * 256, r0 = rg * 8;
#pragma unroll
            for (int rr = 0; rr < 8; ++rr) {
                const f32x4 xc = cb + cw0 * xin[rr] + cw1 * xin[rr + 1] + cw2 * xin[rr + 2] + cw3 * xin[rr + 3];
                u32x2 w; w.x = cvt_pk_bf16(xc[0], xc[1]); w.y = cvt_pk_bf16(xc[2], xc[3]);
                *(LAS u32x2*)(XC + (r0 + rr) * XC_PITCH + 8 * cq) = w;
                if ((cq >> 2) == q) *(LAS f32x4*)(XCF + (r0 + rr) * 16 + 4 * (cq & 3)) = xc;
            }
            const u32x4 gw = ggn;
            if (chk < 7) {
                const float* p = XL + (size_t)(R0 + 256 + r0 - 3) * DH + cch;
#pragma unroll
                for (int i = 0; i < 11; ++i) xin[i] = *(const f32x4*)(p + (size_t)i * DH);
                ggn = *(const u32x4*)(GG + (size_t)(R0 + 256 + er) * DH + ch0 + 8 * eh);
            }
            __syncthreads();
#pragma unroll
            for (int tt = 0; tt < 2; ++tt) {
                const int tile = 2 * wave + tt;
                f32x4 ar = (f32x4){0.f, 0.f, 0.f, 0.f}, ax = ar;
#pragma unroll
                for (int ks = 0; ks < 2; ++ks) {
                    const bf16x8 af = *(const LAS bf16x8*)(XC + (16 * tile + fr) * XC_PITCH + 64 * ks + 16 * fq);
                    ar = __builtin_amdgcn_mfma_f32_16x16x32_bf16(af, Bf[0][ks], ar, 0, 0, 0);
                    ax = __builtin_amdgcn_mfma_f32_16x16x32_bf16(af, Bf[1][ks], ax, 0, 0, 0);
                }
#pragma unroll
                for (int r4 = 0; r4 < 4; ++r4) {
                    const int rr = 16 * tile + 4 * fq + r4;
                    const float xcv = XCF[rr * 16 + fr];
                    const float rg_ = fsigmoid(ar[r4] + ba), ig = fsigmoid(ax[r4] + bx_);
                    const float la = -8.0f * rg_ * spl;
                    const float av = fexp(la); AA[rr * 16 + fr] = av; BX[rr * 16 + fr] = __builtin_amdgcn_sqrtf(fmaxf(fmaf(-av, av, 1.0f), 0.f)) * (ig * xcv);
                }
            }
            __syncthreads();
            const int sn = tid & 15, sg = tid >> 4;
            float av[8], bv[8];
            { float P = 1.f, h = 0.f;
#pragma unroll
              for (int i = 0; i < 8; ++i) { av[i] = AA[(8 * sg + i) * 16 + sn]; bv[i] = BX[(8 * sg + i) * 16 + sn]; }
#pragma unroll
              for (int i = 0; i < 8; ++i) { h = av[i] * h + bv[i]; P *= av[i]; }
              SEGP[tid] = P; SEGH[tid] = h; }
            __syncthreads();
            if (wave == 0 && lane < 16) {
                float run = hcar;
#pragma unroll 8
                for (int s2 = 0; s2 < 32; ++s2) { CAR[s2 * 16 + lane] = run; run = SEGP[s2 * 16 + lane] * run + SEGH[s2 * 16 + lane]; }
                hcar = run;
            }
            __syncthreads();
            { float h = CAR[tid];
#pragma unroll
              for (int i = 0; i < 8; ++i) { h = av[i] * h + bv[i]; BX[(8 * sg + i) * 16 + sn] = h; } }
            __syncthreads();
            {
                const size_t row = (size_t)R0 + er;
                const f32x4 h0 = *(const LAS f32x4*)(BX + er * 16 + 8 * eh), h1 = *(const LAS f32x4*)(BX + er * 16 + 8 * eh + 4);
                const f32x4 y0 = (f32x4){h0[0] * bf_lo(gw.x), h0[1] * bf_hi(gw.x), h0[2] * bf_lo(gw.y), h0[3] * bf_hi(gw.y)};
                const f32x4 y1 = (f32x4){h1[0] * bf_lo(gw.z), h1[1] * bf_hi(gw.z), h1[2] * bf_lo(gw.w), h1[3] * bf_hi(gw.w)};
                *(u32x4*)(MRG + row * D + DH + ch0 + 8 * eh) = pack8(y0, y1);
                float s = dot4(y0) + dot4(y1);
                s += __shfl_xor(s, 1);
                if (eh == 0) atomicAdd(ssq_lru + row, s);
            }
        }
        if (wave == 0 && lane < 16) a.out[O_PLRUH + (size_t)b * DH + ch0 + lane] = hcar;
        if (wave == 1 && lane < 48) { const int k = lane >> 4, n = lane & 15;
            a.out[O_PLRUC + ((size_t)b * 3 + k) * DH + ch0 + n] = XL[(size_t)(b * SEQ + SEQ - 3 + k) * DH + ch0 + n]; }
    } else {
        const int R0 = MP, bs0 = 32 * b;
        {
            const float* cbuf = a.in[I_LRUCONV];
            const int bs = bs0 + rg;
            const f32x4 x0 = *(const f32x4*)(XL + (size_t)(R0 + bs) * DH + cch);
            const f32x4 c0 = *(const f32x4*)(cbuf + ((size_t)bs * 3 + 0) * DH + cch), c1 = *(const f32x4*)(cbuf + ((size_t)bs * 3 + 1) * DH + cch), c2 = *(const f32x4*)(cbuf + ((size_t)bs * 3 + 2) * DH + cch);
            const f32x4 xc = cb + cw0 * c0 + cw1 * c1 + cw2 * c2 + cw3 * x0;
            u32x2 w; w.x = cvt_pk_bf16(xc[0], xc[1]); w.y = cvt_pk_bf16(xc[2], xc[3]);
            *(LAS u32x2*)(XC + rg * XC_PITCH + 8 * cq) = w;
            if ((cq >> 2) == q) {
                *(LAS f32x4*)(XCF + rg * 16 + 4 * (cq & 3)) = xc;
                float* oc = a.out + O_SLRUC + (size_t)bs * 3 * DH + cch;
                *(f32x4*)oc = c1; *(f32x4*)(oc + DH) = c2; *(f32x4*)(oc + 2 * DH) = x0;
            }
        }
        __syncthreads();
        if (wave < 2) {
            const int tile = wave;
            f32x4 ar = (f32x4){0.f, 0.f, 0.f, 0.f}, ax = ar;
#pragma unroll
            for (int ks = 0; ks < 2; ++ks) {
                const bf16x8 af = *(const LAS bf16x8*)(XC + (16 * tile + fr) * XC_PITCH + 64 * ks + 16 * fq);
                ar = __builtin_amdgcn_mfma_f32_16x16x32_bf16(af, Bf[0][ks], ar, 0, 0, 0);
                ax = __builtin_amdgcn_mfma_f32_16x16x32_bf16(af, Bf[1][ks], ax, 0, 0, 0);
            }
#pragma unroll
            for (int r4 = 0; r4 < 4; ++r4) {
                const int rl = 16 * tile + 4 * fq + r4, bs = bs0 + rl;
                const float xcv = XCF[rl * 16 + fr];
                const float rg_ = fsigmoid(ar[r4] + ba), ig = fsigmoid(ax[r4] + bx_);
                const float la = -8.0f * rg_ * spl;
                const float av = fexp(la); const float h = av * a.in[I_LRUH][(size_t)bs * DH + chn] + __builtin_amdgcn_sqrtf(fmaxf(fmaf(-av, av, 1.0f), 0.f)) * (ig * xcv);
                BX[rl * 16 + fr] = h; a.out[O_SLRUH + (size_t)bs * DH + chn] = h;
            }
        }
        __syncthreads();
        if (er < 32) {
            const size_t row = (size_t)R0 + bs0 + er;
            const u32x4 gw = *(const u32x4*)(GG + row * DH + ch0 + 8 * eh);
            const f32x4 h0 = *(const LAS f32x4*)(BX + er * 16 + 8 * eh), h1 = *(const LAS f32x4*)(BX + er * 16 + 8 * eh + 4);
            const f32x4 y0 = (f32x4){h0[0] * bf_lo(gw.x), h0[1] * bf_hi(gw.x), h0[2] * bf_lo(gw.y), h0[3] * bf_hi(gw.y)};
            const f32x4 y1 = (f32x4){h1[0] * bf_lo(gw.z), h1[1] * bf_hi(gw.z), h1[2] * bf_lo(gw.w), h1[3] * bf_hi(gw.w)};
            *(u32x4*)(MRG + row * D + DH + ch0 + 8 * eh) = pack8(y0, y1);
            float s = dot4(y0) + dot4(y1);
            s += __shfl_xor(s, 1);
            if (eh == 0) atomicAdd(ssq_lru + row, s);
        }
    }
    __syncthreads();
}

__global__ void __launch_bounds__(NWAVES * 64, 2) hymba_fwd(Args args) {
    extern __shared__ __attribute__((aligned(16))) unsigned char lds_raw[];
    LAS unsigned char* lds = (LAS unsigned char*)lds_raw;
    volatile LAS unsigned* MISC = (volatile LAS unsigned*)(lds + MISC_OFF);
    const int tid = threadIdx.x, lane = tid & 63, wave = __builtin_amdgcn_readfirstlane(tid >> 6);
    const int G = gridDim.x, bx = blockIdx.x;
    const int vcu = (G % 8 == 0) ? (bx % 8) * (G / 8) + bx / 8 : bx;
    unsigned char* ws = args.ws;
    unsigned* ctl = (unsigned*)(ws + WS_CTL);
    for (int u = tid; u < (LDS_BYTES - LDSCTL_OFF) / 4; u += NWAVES * 64) ((LAS unsigned*)(lds + LDSCTL_OFF))[u] = 0u;
    __syncthreads();
    XcdBarrier bar; bar.bar = ctl + CW_BAR; bar.x = 0; bar.st = nullptr;
    if (MK_N_LAUNCHES == 1) bar = xcd_barrier_post(ctl + CW_BAR, MISC + 8);
#define GRID_BAR() do { if (MK_N_LAUNCHES == 1) xcd_barrier(bar); } while (0)
#define STAMP(k) do { if (PROBE_PHASE >= 0 && bx == 0 && tid == 0) { const unsigned long long now_ = __builtin_amdgcn_s_memrealtime(); \
        const unsigned long long prev_ = ((unsigned long long)MISC[17] << 32) | MISC[16]; if ((k) == PROBE_PHASE) { const unsigned long long d_ = now_ - prev_; MISC[18] = (unsigned)d_; } \
        MISC[16] = (unsigned)now_; MISC[17] = (unsigned)(now_ >> 32); } } while (0)
    STAMP(-1);
    const int lo = args.ph_lo, hi = args.ph_hi;
#define IN(k) (lo <= (k) && (k) < hi)
#define BOTH(k) (IN(k) && IN((k) + 1))
    float* ssq = (float*)(ws + WS_CTL + CTL_SSQ_BYTE);
    float *ssq0 = ssq, *ssq1 = ssq + MPAD, *ssq_s5 = ssq + 2 * MPAD, *ssq_lru = ssq + 3 * MPAD, *ssq2 = ssq + 4 * MPAD, *ssq3 = ssq + 5 * MPAD;
    bf16_t* XB = (bf16_t*)(ws + WS_XB); float* X1 = (float*)(ws + WS_X1); bf16_t* HID = (bf16_t*)(ws + WS_H);
    bf16_t* U = (bf16_t*)(ws + WS_U); float* XL = (float*)(ws + WS_XLRU); bf16_t* GG = (bf16_t*)(ws + WS_GG); bf16_t* MRG = (bf16_t*)(ws + WS_MRG);
    float* SLAB = (float*)(ws + WS_SLAB); float* SLAB5 = (float*)(ws + WS_U);
    const int gws = wave * G + bx;

    unsigned* cnt_fin2 = ctl + CW_CNT; unsigned* cnt_fin5 = ctl + CW_CNT + 64;
#define PUBLISH(cnt) do { asm volatile("s_waitcnt vmcnt(0)" ::: "memory"); __builtin_amdgcn_fence(__ATOMIC_RELEASE, "agent"); asm volatile("s_waitcnt vmcnt(0)" ::: "memory"); \
        if (lane == 0) __hip_atomic_fetch_add((cnt), 1u, __ATOMIC_RELAXED, __HIP_MEMORY_SCOPE_AGENT); } while (0)

    if (IN(0)) { p0_prologue(args, lds, vcu, G, lane, wave); if (BOTH(0)) GRID_BAR(); STAMP(0); }
    if (IN(1)) {
        constexpr int GG1 = 242;
        if (bx < GG1) {
            pg8::Gemm g{XB, (const bf16_t*)(ws + WS_W13A), D, D}; pg8::PanelOrder S; S.init(2 * FF / 256, D / 64, D / 64, GG1, bx);
            pg8::EpiSwiGLU E{HID, ssq0};
            pg8::gemm_phase(lds, g, S, E);
        } else {
            for (int gj = bx - GG1; gj < NG; gj += G - GG1) p0_s5_group(args, lds, gj, tid);
        }
        if (BOTH(1)) GRID_BAR();
        STAMP(1);
    }
    if (IN(2)) {
        pg8::Gemm g{HID, (const bf16_t*)(ws + WS_W2A), FF, FF}; pg8::PanelOrder S; S.init(D / 256, FF / 64, 8, G, bx);
        pg8::EpiResid E{SLAB, XB, ssq1};
        pg8::gemm_phase(lds, g, S, E);
        if (bx >= 88) conv_tasks(args, lds + wave * STG_BYTES, 4, 5, (bx - 88) * NWAVES + wave, (G - 88) * NWAVES, lane);
        if (BOTH(2)) GRID_BAR();
        STAMP(2);
    }
    if (IN(3)) {
        constexpr int GG3 = 198;
        { const int r = (bx >= GG3 && wave < 3) ? (bx - GG3) + (G - GG3) * wave : MS;
          if (r < MS) {
            const int row = MP + r;
            const f32x4* xr = (const f32x4*)(args.in[I_XS] + (size_t)r * D) + lane; f32x4 v[8]; float sq = 0.f;
#pragma unroll
            for (int j = 0; j < 8; ++j) { f32x4 t = (f32x4){0.f, 0.f, 0.f, 0.f};
#pragma unroll
                for (int sl = 0; sl < 11; ++sl) t += ((const f32x4*)(SLAB + ((size_t)sl * MS + r) * D) + lane)[64 * j];
                v[j] = xr[64 * j] + 0.5f * t; sq += dot4(v[j]); }
            sq = wave_sum(sq);
#pragma unroll
            for (int j = 0; j < 8; ++j) { ((f32x4*)(X1 + (size_t)row * D) + lane)[64 * j] = v[j];
                u32x2 w; w.x = cvt_pk_bf16(v[j][0], v[j][1]); w.y = cvt_pk_bf16(v[j][2], v[j][3]); ((u32x2*)(XB + (size_t)row * D) + lane)[64 * j] = w; }
            if (lane == 0) ssq1[row] = sq;
            PUBLISH(cnt_fin2);
          } }
        if (bx < GG3) {
            pg8::Gemm g{XB, (const bf16_t*)(ws + WS_WIN), D, D}; pg8::PanelOrder S; S.init(DIN / 256, D / 64, D / 64, GG3, bx); S.ready = cnt_fin2; S.need = MS;
            pg8::EpiProj E{U, XL, GG, ssq1};
            pg8::gemm_phase(lds, g, S, E);
        } else conv_tasks(args, lds + wave * STG_BYTES, 6, 7, (bx - GG3) * NWAVES + wave, (G - GG3) * NWAVES, lane);
        if (BOTH(3)) GRID_BAR();
        STAMP(3);
    }
    if (IN(4)) {
        { bf16_t* GS5 = (bf16_t*)(ws + WS_GS5); const int gw = bx * NWAVES + wave, NGW = G * NWAVES;
          for (int m = M + gw; m < MPAD; m += NGW) {
              ((u32x4*)(GS5 + (size_t)m * DH))[lane] = (u32x4){0u, 0u, 0u, 0u}; ((u32x4*)(GS5 + (size_t)m * DH))[64 + lane] = (u32x4){0u, 0u, 0u, 0u};
              ((u32x4*)(MRG + (size_t)m * D + DH))[lane] = (u32x4){0u, 0u, 0u, 0u}; ((u32x4*)(MRG + (size_t)m * D + DH))[64 + lane] = (u32x4){0u, 0u, 0u, 0u}; } }
        for (int it = bx; it < NB * NG; it += G) { const int b = it >> 6, g = ((it & 7) << 3) | ((it >> 3) & 7); s5_prompt(args, lds, b, g, tid, lane, wave); }
        STAMP(20);
        for (int it = bx; it < 4 * NG; it += G) s5_sample(args, lds, it >> 2, 32 * (it & 3), tid);
        STAMP(21);
        for (int it = bx; it < NB * 64; it += G) lru_item(args, lds, false, it >> 6, ((it & 7) << 1) | ((it >> 5) & 1), (it >> 3) & 3, tid, lane, wave);
        STAMP(22);
        if (BOTH(4)) GRID_BAR();
        STAMP(4);
    }
    if (IN(5)) {
        pg8::Gemm g{(const bf16_t*)(ws + WS_GS5), (const bf16_t*)(ws + WS_WGLU), DH, DH}; pg8::PanelOrder S; S.init(DH / 256, DH / 64, DH / 64, G, bx);
        pg8::EpiGlu E{(const bf16_t*)(ws + WS_GS5), args.in[I_BGLU], MRG, ssq_s5};
        pg8::gemm_phase(lds, g, S, E);
        if (bx >= 132) for (int it = bx - 132; it < 256; it += G - 132) lru_item(args, lds, true, it & 3, it >> 4, (it >> 2) & 3, tid, lane, wave);
        if (BOTH(5)) GRID_BAR();
        STAMP(5);
    }
    if (IN(6)) {
        pg8::Gemm g{MRG, (const bf16_t*)(ws + WS_WOUT), D, D}; pg8::PanelOrder S; S.init(D / 256, D / 64, D / 64, G, bx); S.nExtra = 0;
        pg8::EpiOut E{ssq_s5, ssq_lru, XB, ssq2, nullptr};
        pg8::gemm_phase(lds, g, S, E);
        if (BOTH(6)) GRID_BAR();
        STAMP(6);
    }
    if (IN(7)) {
        constexpr int GG7 = 242;
        if (bx >= GG7) {
            pg8::Gemm g{MRG, (const bf16_t*)(ws + WS_WOUT), D, D}; pg8::PanelOrder S; S.init(D / 256, D / 64, D / 64, 8, bx - GG7); S.nwgP = 0;
            pg8::EpiOut E{ssq_s5, ssq_lru, XB, ssq2, nullptr};
            pg8::gemm_phase(lds, g, S, E);
            if (bx - GG7 < 8) { asm volatile("s_waitcnt vmcnt(0)" ::: "memory"); __syncthreads();
                if (tid == 0) { __builtin_amdgcn_fence(__ATOMIC_RELEASE, "agent"); asm volatile("s_waitcnt vmcnt(0)" ::: "memory"); __hip_atomic_fetch_add(cnt_fin5, 1u, __ATOMIC_RELAXED, __HIP_MEMORY_SCOPE_AGENT); } }
        }
        if (bx < GG7) {
            pg8::Gemm g{XB, (const bf16_t*)(ws + WS_W13B), D, D}; pg8::PanelOrder S; S.init(2 * FF / 256, D / 64, D / 64, GG7, bx); S.ready = cnt_fin5; S.need = 8;
            pg8::EpiSwiGLU E{HID, ssq2};
            pg8::gemm_phase(lds, g, S, E);
        } else conv_tasks(args, lds + wave * STG_BYTES, 8, 8, (bx - GG7) * NWAVES + wave, (G - GG7) * NWAVES, lane);
        if (BOTH(7)) GRID_BAR();
        STAMP(7);
    }
    if (IN(8)) {
        pg8::Gemm g{HID, (const bf16_t*)(ws + WS_W2B), FF, FF}; pg8::PanelOrder S; S.init(D / 256, FF / 64, 8, G, bx);
        pg8::EpiFinal E{XB, ssq3, SLAB};
        pg8::gemm_phase(lds, g, S, E);
        if (BOTH(8)) GRID_BAR();
        STAMP(8);
    }
    if (IN(9)) {
        const f32x4* gf = (const f32x4*)args.in[I_GFINAL] + lane;
        if (gws < MS) {
            const int row = MP + gws; f32x4 v[8]; float sq = 0.f;
#pragma unroll
            for (int j = 0; j < 8; ++j) { f32x4 t = (f32x4){0.f, 0.f, 0.f, 0.f};
#pragma unroll
                for (int sl = 0; sl < 11; ++sl) t += ((const f32x4*)(SLAB + ((size_t)sl * MS + gws) * D) + lane)[64 * j];
                const u32x2 xw = ((const u32x2*)(XB + (size_t)row * D) + lane)[64 * j];
                v[j] = (f32x4){bf_lo(xw.x), bf_hi(xw.x), bf_lo(xw.y), bf_hi(xw.y)} + 0.5f * t; sq += dot4(v[j]); }
            const float r = rsqrtf(wave_sum(sq) * (1.0f / D) + EPS);
#pragma unroll
            for (int j = 0; j < 8; ++j) ((f32x4*)(args.out + (size_t)row * D) + lane)[64 * j] = v[j] * gf[64 * j] * r;
        }
        const int gw = bx * NWAVES + wave, NGW = G * NWAVES;
        for (int m = gw; m < MP; m += NGW) {
            const float r = rsqrtf(ssq3[m] * (1.0f / D) + EPS);
            const u32x4* xb = (const u32x4*)(XB + (size_t)m * D) + lane;
            f32x4* o = (f32x4*)(args.out + (size_t)m * D) + 2 * lane;
            const f32x4* g2 = (const f32x4*)args.in[I_GFINAL] + 2 * lane;
            u32x4 w[4];
#pragma unroll
            for (int j = 0; j < 4; ++j) w[j] = xb[64 * j];
#pragma unroll
            for (int j = 0; j < 4; ++j) { o[128 * j] = pg8::res_lo(w[j]) * g2[128 * j] * r; o[128 * j + 1] = pg8::res_hi(w[j]) * g2[128 * j + 1] * r; }
        }
    }
    if (PROBE_PHASE >= 0 && bx == 0 && tid == 0) {
        STAMP(9);
        const unsigned long long t0_ = __builtin_amdgcn_s_memrealtime(), d_ = 4ull * MISC[18];
        while (__builtin_amdgcn_s_memrealtime() - t0_ < d_) __builtin_amdgcn_s_sleep(8);
    }
#undef IN
#undef BOTH
#undef GRID_BAR
}

extern "C" void kernel_launch(void* const* d_in, const int* in_sizes, int n_in, void* d_out, int out_size, void* d_ws, size_t ws_size, hipStream_t stream) {
    static int grid = 0;
    if (grid == 0) {
        if (n_in != N_IN || in_sizes[0] != MP * D || (size_t)out_size != O_END || ws_size < WS_END) {
            fprintf(stderr, "kernel_launch: unexpected problem: n_in %d in0 %d out %d ws %zu (need %zu)\n", n_in, n_in > 0 ? in_sizes[0] : -1, out_size, ws_size, (size_t)WS_END); grid = -1; return; }
        int dev = 0, cus = 0;
        if (hipGetDevice(&dev) != hipSuccess || hipDeviceGetAttribute(&cus, hipDeviceAttributeMultiprocessorCount, dev) != hipSuccess) { grid = -1; return; }
        if (hipFuncSetAttribute((const void*)hymba_fwd, hipFuncAttributeMaxDynamicSharedMemorySize, LDS_BYTES) != hipSuccess) { fprintf(stderr, "kernel_launch: hipFuncSetAttribute failed\n"); grid = -1; return; }
        int per_cu = 0;
        if (hipOccupancyMaxActiveBlocksPerMultiprocessor(&per_cu, (const void*)hymba_fwd, NWAVES * 64, LDS_BYTES) != hipSuccess || per_cu < 1)
            fprintf(stderr, "kernel_launch: note: occupancy query reports %d workgroups per CU\n", per_cu);
        (void)hipGetLastError();
        grid = cus;
    }
    if (grid < 0) return;
    if (hipMemsetAsync((char*)d_ws + WS_CTL, 0, CTL_ZERO_BYTES, stream) != hipSuccess) { fprintf(stderr, "kernel_launch: memset failed\n"); return; }
    Args a{};
    for (int i = 0; i < N_IN; ++i) a.in[i] = (const float*)d_in[i];
    a.out = (float*)d_out; a.ws = (unsigned char*)d_ws;
    if (MK_N_LAUNCHES == 1) {
        a.ph_lo = 0; a.ph_hi = NPHASE;
        hipLaunchKernelGGL(hymba_fwd, dim3(grid), dim3(NWAVES * 64), LDS_BYTES, stream, a);
    } else {
        for (int p = 0; p < NPHASE; ++p) { a.ph_lo = p; a.ph_hi = p + 1; hipLaunchKernelGGL(hymba_fwd, dim3(grid), dim3(NWAVES * 64), LDS_BYTES, stream, a); }
    }
}
```

```cpp
#include <hip/hip_runtime.h>
#include <cstdio>
#include <cstdint>

#define LAS __attribute__((address_space(3)))
#define GAS __attribute__((address_space(1)))
typedef unsigned short bf16_t;
typedef short bf16x8 __attribute__((ext_vector_type(8)));
typedef float f32x4 __attribute__((ext_vector_type(4)));
typedef float f32x16 __attribute__((ext_vector_type(16)));
typedef unsigned u32x4 __attribute__((ext_vector_type(4)));
typedef unsigned u32x2 __attribute__((ext_vector_type(2)));

#ifndef PROBE_PHASE
#define PROBE_PHASE -1
#endif
#ifndef MK_N_LAUNCHES
#define MK_N_LAUNCHES 1
#endif

constexpr int D = 2048, FF = 5632, DIN = 3072, DH = 1024;
constexpr int MP = 8192, MS = 128, M = MP + MS, MPAD = 8448;
constexpr int SEQ = 2048, NB = 4, NG = 64, NP = 64, GS = 16;
constexpr float EPS = 1e-6f;
constexpr int NPHASE = 10;
constexpr int NMP = MP / 256;
constexpr int NWAVES = 8;

constexpr size_t MiB = 1u << 20;
constexpr size_t WS_CTL = 0, CTL_ZERO_BYTES = 1 * MiB;
constexpr size_t WS_W13A = 1 * MiB, WS_W2A = 45 * MiB, WS_WIN = 67 * MiB, WS_WGLU = 79 * MiB, WS_WOUT = 81 * MiB, WS_W13B = 89 * MiB, WS_W2B = 133 * MiB;
constexpr size_t WS_S5M = 155 * MiB, WS_S5AUX = 171 * MiB;
constexpr size_t WS_XB = 172 * MiB;
constexpr size_t WS_X1 = 205 * MiB;
constexpr size_t WS_GS5 = WS_X1;
constexpr size_t WS_H = 271 * MiB;
constexpr size_t WS_U = 271 * MiB, WS_XLRU = WS_U + (size_t)MPAD * DH * 2, WS_GG = WS_XLRU + (size_t)MPAD * DH * 4, WS_MRG = WS_GG + (size_t)MPAD * DH * 2;
constexpr size_t WS_SLAB = 362 * MiB;
constexpr size_t WS_END = 373 * MiB;
static_assert(WS_MRG + (size_t)MPAD * D * 2 <= WS_END && WS_H + (size_t)MPAD * FF * 2 <= WS_SLAB && WS_SLAB + (size_t)11 * MS * D * 4 <= WS_END, "ws map");
constexpr int S5M_GROUP_BYTES = 256 * 1024;
constexpr int S5AUX_GROUP_FLOATS = 2304;
constexpr int CW_BAR = 4096;
constexpr int CW_CNT = 8192;
constexpr size_t CTL_SSQ_BYTE = 262144;

constexpr int RING_BYTES = 139264;
constexpr int LDSCTL_OFF = RING_BYTES, MISC_OFF = LDSCTL_OFF + 320;
constexpr int LDS_BYTES = 147456;

__device__ __forceinline__ unsigned cvt_pk_bf16(float lo, float hi) { unsigned r; asm volatile("v_cvt_pk_bf16_f32 %0, %1, %2" : "=v"(r) : "v"(lo), "v"(hi)); return r; }
__device__ __forceinline__ float bf_lo(unsigned w) { return __uint_as_float(w << 16); }
__device__ __forceinline__ float bf_hi(unsigned w) { return __uint_as_float(w & 0xffff0000u); }
__device__ __forceinline__ float fexp(float x) { return __builtin_amdgcn_exp2f(x * 1.44269504089f); }
__device__ __forceinline__ float fsigmoid(float x) { return __builtin_amdgcn_rcpf(1.0f + fexp(-x)); }
__device__ __forceinline__ float fsilu(float x) { return x * fsigmoid(x); }
__device__ __forceinline__ float fgelu(float x) { return x * fsigmoid(1.5957691216057308f * (x + 0.044715f * x * x * x)); }
__device__ __forceinline__ u32x4 pack8(const f32x4 a, const f32x4 b) { u32x4 w; w.x = cvt_pk_bf16(a[0], a[1]); w.y = cvt_pk_bf16(a[2], a[3]); w.z = cvt_pk_bf16(b[0], b[1]); w.w = cvt_pk_bf16(b[2], b[3]); return w; }
__device__ __forceinline__ float dot4(const f32x4 a) { return (a[0] * a[0] + a[1] * a[1]) + (a[2] * a[2] + a[3] * a[3]); }
__device__ __forceinline__ float wave_sum(float v) {
#pragma unroll
    for (int o = 1; o < 64; o <<= 1) v += __shfl_xor(v, o);
    return v;
}
__device__ __forceinline__ float neg_expm1(float x) {
    float p = 1.0f / 5040.0f; p = fmaf(p, x, 1.0f / 720.0f); p = fmaf(p, x, 1.0f / 120.0f); p = fmaf(p, x, 1.0f / 24.0f); p = fmaf(p, x, 1.0f / 6.0f); p = fmaf(p, x, 0.5f); p = fmaf(p, x, 1.0f);
    const float small = -(p * x), big = 1.0f - fexp(x);
    return x > -0.35f ? small : big;
}
#define LDS_WAIT() asm volatile("s_waitcnt lgkmcnt(0)" ::: "memory")
#define VM_WAIT() asm volatile("s_waitcnt vmcnt(0)" ::: "memory")

namespace pg8 {
constexpr int BM = 256, BK = 64, HALF = 128, HTB = HALF * BK * 2, STAGE_BYTES = 8 * HTB, NXCD = 8, WGM = 8;
__host__ __device__ __forceinline__ int lds_byte(int r, int c) { const int st = (r >> 4) * 2 + (c >> 5), rr = r & 15, cc = c & 31, ob = rr * 64 + cc * 2; return st * 1024 + (ob ^ (((ob >> 9) & 1) << 5)); }
__host__ __device__ __forceinline__ void stage_rc(int b, int& R, int& C) { const int st = b / 1024, sb = b % 1024, swz = sb ^ (((sb >> 9) & 1) << 5); R = (st >> 1) * 16 + swz / 64; C = (st & 1) * 32 + (swz % 64) / 2; }
__host__ __device__ __forceinline__ int perm32(int rho) { const int n = rho >> 4, i = rho & 15; return 8 * (i >> 2) + 4 * n + (i & 3); }

struct Unit { int pm, pn, kt0, nkt; };
struct Gemm { const bf16_t* A; const bf16_t* Bt; int lda, ldb; };

struct PanelOrder {
    int nN, nwgP, G, c, nktFull, sliceKt, nExtra;
    unsigned* ready; unsigned need;
    __device__ void init(int nN_, int nktFull_, int sliceKt_, int G_, int c_) { nN = nN_; nwgP = 32 * nN_; G = G_; c = c_; nktFull = nktFull_; sliceKt = sliceKt_; nExtra = nN_ * (nktFull_ / sliceKt_); ready = nullptr; need = 0u; }
    __device__ __forceinline__ void a_ready(const Unit& u) const {
        if (ready == nullptr || u.pm != 32) return;
        if (threadIdx.x < 64) {
            unsigned polls = 0;
            while ((unsigned)__builtin_amdgcn_readfirstlane(__hip_atomic_load(ready, __ATOMIC_RELAXED, __HIP_MEMORY_SCOPE_AGENT)) < need) { __builtin_amdgcn_s_sleep(2); if (++polls > (1u << 22)) break; }
            __builtin_amdgcn_fence(__ATOMIC_ACQUIRE, "agent");
            asm volatile("s_waitcnt vmcnt(0)" ::: "memory");
        }
        asm volatile("" ::: "memory"); __builtin_amdgcn_s_barrier(); asm volatile("" ::: "memory");
    }
    __device__ bool next(int i, Unit& u) const {
        const long L = (long)i * G + c;
        if (L < nwgP) {
            int wgid = (int)L; { const int q = nwgP / NXCD, r = nwgP % NXCD, xcd = wgid % NXCD, off = wgid / NXCD; wgid = (xcd < r ? xcd * (q + 1) : r * (q + 1) + (xcd - r) * q) + off; }
            const int nig = WGM * nN, gid = wgid / nig, fm = gid * WGM, gsz = (32 - fm) < WGM ? (32 - fm) : WGM;
            u.pm = fm + ((wgid % nig) % gsz); u.pn = (wgid % nig) / gsz; u.kt0 = 0; u.nkt = nktFull; return true;
        }
        const int e = (int)(L - nwgP); if (e >= nExtra) return false;
        u.pm = 32; u.pn = e % nN; u.kt0 = (e / nN) * sliceKt; u.nkt = sliceKt; return true;
    }
};

template <class Epi, class Sched>
__device__ __forceinline__ void gemm_phase(LAS unsigned char* lds, const Gemm g, const Sched& S, const Epi& E) {
    const int tid = threadIdx.x, wid = __builtin_amdgcn_readfirstlane(tid >> 6), lane = tid & 63, wr = wid >> 2, wc = wid & 3, fr = lane & 15, fq = lane >> 4;
    unsigned voffA[2], voffB[2];
#pragma unroll
    for (int i = 0; i < 2; ++i) { int R, C; stage_rc(tid * 16 + i * 8192, R, C); const int Rb = Epi::PERM ? ((R & ~31) + perm32(R & 31)) : R;
        voffA[i] = (unsigned)(R * g.lda + C) * 2u; voffB[i] = (unsigned)(Rb * g.ldb + C) * 2u; }
    const size_t kstep = (size_t)(BK * 2);
    const size_t hstepA = (size_t)HALF * g.lda * 2, hstepB = (size_t)HALF * g.ldb * 2;
    const size_t tstepA = 2 * hstepA, tstepB = 2 * hstepB;
    const unsigned ldsw = (unsigned)wid * 1024u;
    const int aoff = lds_byte(wr * 64 + fr, fq * 8), boff = lds_byte(wc * 32 + fr, fq * 8);
#define PG8_SA(b, h) (((b) * 2 + (h)) * HTB)
#define PG8_SB(b, h) ((4 + (b) * 2 + (h)) * HTB)
#define PG8_STAGE(bufoff, gbase, voff) do { _Pragma("unroll") for (int _i = 0; _i < 2; ++_i) \
        __builtin_amdgcn_global_load_lds((const unsigned*)((const char*)(gbase) + (voff)[_i]), (LAS unsigned*)(lds + (bufoff) + ldsw + _i * 8192), 16, 0, 0); } while (0)
#define PG8_LDA(dst, b, h) do { _Pragma("unroll") for (int m = 0; m < 4; ++m) _Pragma("unroll") for (int k = 0; k < 2; ++k) dst[m][k] = *(const LAS bf16x8*)(lds + PG8_SA(b, h) + aoff + m * 2048 + k * 1024); } while (0)
#define PG8_LDB(dst, b, h) do { _Pragma("unroll") for (int n = 0; n < 2; ++n) _Pragma("unroll") for (int k = 0; k < 2; ++k) dst[n][k] = *(const LAS bf16x8*)(lds + PG8_SB(b, h) + boff + n * 2048 + k * 1024); } while (0)
#define PG8_MMA(ai, bj, At, Bt) do { __builtin_amdgcn_s_setprio(1); _Pragma("unroll") for (int m = 0; m < 4; ++m) _Pragma("unroll") for (int n = 0; n < 2; ++n) _Pragma("unroll") for (int k = 0; k < 2; ++k) \
        acc[ai][bj][m][n] = __builtin_amdgcn_mfma_f32_16x16x32_bf16(Bt[n][k], At[m][k], acc[ai][bj][m][n], 0, 0, 0); __builtin_amdgcn_s_setprio(0); } while (0)
#define PG8_WAIT_V(n) asm volatile("s_waitcnt vmcnt(" #n ")" ::: "memory")
#define PG8_WAIT_L(n) asm volatile("s_waitcnt lgkmcnt(" #n ")" ::: "memory")
#define PG8_BAR __builtin_amdgcn_s_barrier()
#define PG8_SCHED __builtin_amdgcn_sched_barrier(0)
    Unit cur, nxt; int ui = 0;
    if (!S.next(0, cur)) return;
    f32x4 acc[2][2][4][2];
#pragma unroll
    for (int a = 0; a < 2; ++a)
#pragma unroll
        for (int b = 0; b < 2; ++b)
#pragma unroll
            for (int m = 0; m < 4; ++m)
#pragma unroll
                for (int n = 0; n < 2; ++n) acc[a][b][m][n] = (f32x4){0.f, 0.f, 0.f, 0.f};
    bf16x8 At[4][2], B0[2][2], B1[2][2];
    const char* cA = (const char*)g.A + (size_t)cur.pm * tstepA + (size_t)cur.kt0 * kstep;
    const char* cB = (const char*)g.Bt + (size_t)cur.pn * tstepB + (size_t)cur.kt0 * kstep;
    S.a_ready(cur);
    PG8_STAGE(PG8_SB(0, 0), cB, voffB); PG8_STAGE(PG8_SB(0, 1), cB + hstepB, voffB); PG8_STAGE(PG8_SA(0, 0), cA, voffA); PG8_STAGE(PG8_SA(0, 1), cA + hstepA, voffA);
    if (wr == 1) PG8_BAR;
    PG8_WAIT_V(2); PG8_BAR;
    PG8_STAGE(PG8_SB(1, 0), cB + kstep, voffB); PG8_STAGE(PG8_SA(1, 0), cA + kstep, voffA); PG8_STAGE(PG8_SB(1, 1), cB + hstepB + kstep, voffB);
    PG8_WAIT_V(6); PG8_BAR;
    for (;;) {
        const bool has_next = S.next(ui + 1, nxt);
        const char* nA = has_next ? (const char*)g.A + (size_t)nxt.pm * tstepA + (size_t)nxt.kt0 * kstep : cA;
        const char* nB = has_next ? (const char*)g.Bt + (size_t)nxt.pn * tstepB + (size_t)nxt.kt0 * kstep : cB;
        const int nt = cur.nkt;
        if (cur.pm != 32) {
        for (int t = 0; t < nt; t += 2) {
            const bool last = (t == nt - 2);
            if (last && has_next) S.a_ready(nxt);
            const char* a1 = cA + (size_t)(t + 1) * kstep;
            const char* a2 = last ? nA : cA + (size_t)(t + 2) * kstep; const char* b2 = last ? nB : cB + (size_t)(t + 2) * kstep;
            const char* a3 = a2 + kstep; const char* b3 = b2 + kstep;
            if constexpr (Epi::HAS_MID) { if (t == Epi::MID_T) E.mid(acc, cur, wr, wc, fr, fq); }
            PG8_LDB(B0, 0, 0); PG8_LDB(B1, 0, 1); PG8_SCHED; PG8_LDA(At, 0, 0); PG8_STAGE(PG8_SA(1, 1), a1 + hstepA, voffA);
            PG8_WAIT_V(8); PG8_WAIT_L(0); PG8_BAR; PG8_MMA(0, 0, At, B0); PG8_MMA(0, 1, At, B1); PG8_BAR; PG8_SCHED;
            PG8_LDA(At, 0, 1); PG8_STAGE(PG8_SB(0, 0), b2, voffB); PG8_STAGE(PG8_SB(0, 1), b2 + hstepB, voffB); PG8_STAGE(PG8_SA(0, 0), a2, voffA);
            PG8_WAIT_V(8); PG8_WAIT_L(0); PG8_BAR; PG8_MMA(1, 0, At, B0); PG8_MMA(1, 1, At, B1); PG8_BAR; PG8_SCHED;
            PG8_LDB(B0, 1, 0); PG8_LDB(B1, 1, 1); PG8_SCHED; PG8_LDA(At, 1, 0); PG8_STAGE(PG8_SA(0, 1), a2 + hstepA, voffA);
            PG8_WAIT_V(8); PG8_WAIT_L(0); PG8_BAR; PG8_MMA(0, 0, At, B0); PG8_MMA(0, 1, At, B1); PG8_BAR; PG8_SCHED;
            PG8_LDA(At, 1, 1); PG8_STAGE(PG8_SB(1, 0), b3, voffB); PG8_STAGE(PG8_SB(1, 1), b3 + hstepB, voffB); PG8_STAGE(PG8_SA(1, 0), a3, voffA);
            PG8_WAIT_V(8); PG8_WAIT_L(0); PG8_BAR; PG8_MMA(1, 0, At, B0); PG8_MMA(1, 1, At, B1); PG8_BAR; PG8_SCHED;
        }
        } else {
        for (int t = 0; t < nt; t += 2) {
            const bool last = (t == nt - 2);
            if (last && has_next) S.a_ready(nxt);
            const char* a1 = cA + (size_t)(t + 1) * kstep;
            const char* a2 = last ? nA : cA + (size_t)(t + 2) * kstep; const char* b2 = last ? nB : cB + (size_t)(t + 2) * kstep;
            const char* a3 = a2 + kstep; const char* b3 = b2 + kstep;
            if constexpr (Epi::HAS_MID) { if (t == Epi::MID_T) E.mid(acc, cur, wr, wc, fr, fq); }
            PG8_LDB(B0, 0, 0); PG8_LDB(B1, 0, 1); PG8_SCHED; PG8_LDA(At, 0, 0); PG8_STAGE(PG8_SA(1, 1), a1 + hstepA, voffA);
            PG8_WAIT_V(8); PG8_WAIT_L(0); PG8_BAR; PG8_MMA(0, 0, At, B0); PG8_MMA(0, 1, At, B1); PG8_BAR; PG8_SCHED;
            PG8_LDA(At, 0, 1); PG8_STAGE(PG8_SB(0, 0), b2, voffB); PG8_STAGE(PG8_SB(0, 1), b2 + hstepB, voffB); PG8_STAGE(PG8_SA(0, 0), a2, voffA);
            PG8_WAIT_V(8); PG8_WAIT_L(0); PG8_BAR; PG8_BAR; PG8_SCHED;
            PG8_LDB(B0, 1, 0); PG8_LDB(B1, 1, 1); PG8_SCHED; PG8_LDA(At, 1, 0); PG8_STAGE(PG8_SA(0, 1), a2 + hstepA, voffA);
            PG8_WAIT_V(8); PG8_WAIT_L(0); PG8_BAR; PG8_MMA(0, 0, At, B0); PG8_MMA(0, 1, At, B1); PG8_BAR; PG8_SCHED;
            PG8_LDA(At, 1, 1); PG8_STAGE(PG8_SB(1, 0), b3, voffB); PG8_STAGE(PG8_SB(1, 1), b3 + hstepB, voffB); PG8_STAGE(PG8_SA(1, 0), a3, voffA);
            PG8_WAIT_V(8); PG8_WAIT_L(0); PG8_BAR; PG8_BAR; PG8_SCHED;
        }
        }
        if (wr == 0) PG8_BAR;
        E(acc, cur, wr, wc, fr, fq);
        if (!has_next) break;
#pragma unroll
        for (int a = 0; a < 2; ++a)
#pragma unroll
            for (int b = 0; b < 2; ++b)
#pragma unroll
                for (int m = 0; m < 4; ++m)
#pragma unroll
                    for (int n = 0; n < 2; ++n) acc[a][b][m][n] = (f32x4){0.f, 0.f, 0.f, 0.f};
        cur = nxt; cA = nA; cB = nB; ++ui;
        if (wr == 1) PG8_BAR;
    }
    PG8_WAIT_V(0);
    PG8_BAR;
#undef PG8_SA
#undef PG8_SB
#undef PG8_STAGE
#undef PG8_LDA
#undef PG8_LDB
#undef PG8_MMA
#undef PG8_WAIT_V
#undef PG8_WAIT_L
#undef PG8_BAR
#undef PG8_SCHED
}


typedef f32x4 Acc[2][2][4][2];
__device__ __forceinline__ void slab_store(const Acc& acc, const Unit& u, float* slab, int wr, int wc, int fr, int fq) {
    int rowl = wr * 64 + fr, col0 = u.pn * BM + wc * 32 + 8 * fq; asm volatile("" : "+v"(rowl), "+v"(col0));
    float* base = slab + (size_t)(u.kt0 / u.nkt) * ((size_t)MS * D);
#pragma unroll
    for (int m = 0; m < 4; ++m)
#pragma unroll
        for (int bj = 0; bj < 2; ++bj) { float* p = base + (size_t)(rowl + m * 16) * D + col0 + bj * HALF; *(f32x4*)p = acc[0][bj][m][0]; *(f32x4*)(p + 4) = acc[0][bj][m][1]; }
}
struct EpiSwiGLU {
    static constexpr bool PERM = true, HAS_MID = false; static constexpr int MID_T = -1;
    bf16_t* O; const float* ssq;
    __device__ __forceinline__ void mid(Acc&, const Unit&, int, int, int, int) const {}
    __device__ __forceinline__ void operator()(const Acc& acc, const Unit& u, int wr, int wc, int fr, int fq) const {
        int row0 = u.pm * BM + wr * 64 + fr, colh = u.pn * 128 + wc * 32 + 8 * fq; asm volatile("" : "+v"(row0), "+v"(colh));
        float sq[2][4];
#pragma unroll
        for (int ai = 0; ai < 2; ++ai)
#pragma unroll
            for (int m = 0; m < 4; ++m) sq[ai][m] = ssq[row0 + ai * HALF + m * 16];
        asm volatile("" ::: "memory");
#pragma unroll
        for (int ai = 0; ai < 2; ++ai)
#pragma unroll
            for (int m = 0; m < 4; ++m) {
                const int row = row0 + ai * HALF + m * 16;
                const float r = rsqrtf(sq[ai][m] * (1.0f / D) + EPS);
                f32x4 h0, h1;
#pragma unroll
                for (int j = 0; j < 4; ++j) { h0[j] = fsilu(acc[ai][0][m][0][j] * r) * (acc[ai][1][m][0][j] * r); h1[j] = fsilu(acc[ai][0][m][1][j] * r) * (acc[ai][1][m][1][j] * r); }
                *(u32x4*)(O + (size_t)row * FF + colh) = pack8(h0, h1);
            }
    }
};
typedef u32x4 ResTile[2][4][2];
typedef u32x4 ResHalf[4][2];
__device__ __forceinline__ void res_load(ResTile& res, const bf16_t* XB, int row0, int col0) {
#pragma unroll
    for (int ai = 0; ai < 2; ++ai)
#pragma unroll
        for (int m = 0; m < 4; ++m)
#pragma unroll
            for (int bj = 0; bj < 2; ++bj) res[ai][m][bj] = *(const u32x4*)(XB + (size_t)(row0 + ai * HALF + m * 16) * D + col0 + bj * HALF);
    asm volatile("" ::: "memory");
}
__device__ __forceinline__ void res_load_half(ResHalf& res, const bf16_t* XB, int rowh, int col0) {
#pragma unroll
    for (int m = 0; m < 4; ++m)
#pragma unroll
        for (int bj = 0; bj < 2; ++bj) res[m][bj] = *(const u32x4*)(XB + (size_t)(rowh + m * 16) * D + col0 + bj * HALF);
    asm volatile("" ::: "memory");
}
__device__ __forceinline__ f32x4 res_lo(const u32x4 w) { return (f32x4){bf_lo(w.x), bf_hi(w.x), bf_lo(w.y), bf_hi(w.y)}; }
__device__ __forceinline__ f32x4 res_hi(const u32x4 w) { return (f32x4){bf_lo(w.z), bf_hi(w.z), bf_lo(w.w), bf_hi(w.w)}; }
struct EpiResid {
    static constexpr bool PERM = true, HAS_MID = false; static constexpr int MID_T = -1;
    float* slab; bf16_t* XB; float* ssq;
    __device__ __forceinline__ void mid(Acc&, const Unit&, int, int, int, int) const {}
    __device__ __forceinline__ void operator()(const Acc& acc, const Unit& u, int wr, int wc, int fr, int fq) const {
        if (u.pm == 32) { slab_store(acc, u, slab, wr, wc, fr, fq); return; }
        int row0 = u.pm * BM + wr * 64 + fr, col0 = u.pn * BM + wc * 32 + 8 * fq; asm volatile("" : "+v"(row0), "+v"(col0));
#pragma unroll
        for (int ai = 0; ai < 2; ++ai) {
            ResHalf res; res_load_half(res, XB, row0 + ai * HALF, col0);
#pragma unroll
            for (int m = 0; m < 4; ++m) {
                const int row = row0 + ai * HALF + m * 16;
                float s = 0.f;
#pragma unroll
                for (int bj = 0; bj < 2; ++bj) {
                    const f32x4 v0 = res_lo(res[m][bj]) + 0.5f * acc[ai][bj][m][0], v1 = res_hi(res[m][bj]) + 0.5f * acc[ai][bj][m][1];
                    *(u32x4*)(XB + (size_t)row * D + col0 + bj * HALF) = pack8(v0, v1);
                    s += dot4(v0) + dot4(v1);
                }
                s += __shfl_xor(s, 16); s += __shfl_xor(s, 32);
                if (fq == 0) atomicAdd(ssq + row, s);
            }
        }
    }
};
struct EpiProj {
    static constexpr bool PERM = true, HAS_MID = false; static constexpr int MID_T = -1;
    bf16_t* U; float* XL; bf16_t* GG; const float* ssq;
    __device__ __forceinline__ void mid(Acc&, const Unit&, int, int, int, int) const {}
    __device__ __forceinline__ void operator()(const Acc& acc, const Unit& u, int wr, int wc, int fr, int fq) const {
        int row0 = u.pm * BM + wr * 64 + fr, col0 = (u.pn & 3) * BM + wc * 32 + 8 * fq; const int seg = u.pn >> 2; asm volatile("" : "+v"(row0), "+v"(col0));
        float sq[2][4];
#pragma unroll
        for (int ai = 0; ai < 2; ++ai)
#pragma unroll
            for (int m = 0; m < 4; ++m) sq[ai][m] = ssq[row0 + ai * HALF + m * 16];
        asm volatile("" ::: "memory");
#pragma unroll
        for (int ai = 0; ai < 2; ++ai)
#pragma unroll
            for (int m = 0; m < 4; ++m) {
                const int row = row0 + ai * HALF + m * 16;
                const float r = rsqrtf(sq[ai][m] * (1.0f / D) + EPS);
#pragma unroll
                for (int bj = 0; bj < 2; ++bj) {
                    const size_t o = (size_t)row * DH + col0 + bj * HALF;
                    f32x4 v0 = acc[ai][bj][m][0] * r, v1 = acc[ai][bj][m][1] * r;
                    if (seg == 0) { *(u32x4*)(U + o) = pack8(v0, v1); }
                    else if (seg == 1) { *(f32x4*)(XL + o) = v0; *(f32x4*)(XL + o + 4) = v1; }
                    else {
#pragma unroll
                        for (int j = 0; j < 4; ++j) { v0[j] = fgelu(v0[j]); v1[j] = fgelu(v1[j]); }
                        *(u32x4*)(GG + o) = pack8(v0, v1);
                    }
                }
            }
    }
};
struct EpiGlu {
    static constexpr bool PERM = true, HAS_MID = false; static constexpr int MID_T = -1;
    const bf16_t* GS; const float* bias; bf16_t* MRG; float* ssq;
    __device__ __forceinline__ void mid(Acc&, const Unit&, int, int, int, int) const {}
    __device__ __forceinline__ void operator()(const Acc& acc, const Unit& u, int wr, int wc, int fr, int fq) const {
        int row0 = u.pm * BM + wr * 64 + fr, col0 = u.pn * BM + wc * 32 + 8 * fq; asm volatile("" : "+v"(row0), "+v"(col0));
        ResTile gt;
#pragma unroll
        for (int ai = 0; ai < 2; ++ai)
#pragma unroll
            for (int m = 0; m < 4; ++m)
#pragma unroll
                for (int bj = 0; bj < 2; ++bj) gt[ai][m][bj] = *(const u32x4*)(GS + (size_t)(row0 + ai * HALF + m * 16) * DH + col0 + bj * HALF);
        f32x4 bb[2][2];
#pragma unroll
        for (int bj = 0; bj < 2; ++bj) { bb[bj][0] = *(const f32x4*)(bias + col0 + bj * HALF); bb[bj][1] = *(const f32x4*)(bias + col0 + bj * HALF + 4); }
        asm volatile("" ::: "memory");
#pragma unroll
        for (int ai = 0; ai < 2; ++ai)
#pragma unroll
            for (int m = 0; m < 4; ++m) {
                const int row = row0 + ai * HALF + m * 16;
                float s = 0.f;
#pragma unroll
                for (int bj = 0; bj < 2; ++bj) {
                    const f32x4 g0 = res_lo(gt[ai][m][bj]), g1 = res_hi(gt[ai][m][bj]);
                    f32x4 v0, v1;
#pragma unroll
                    for (int j = 0; j < 4; ++j) { v0[j] = g0[j] * fsigmoid(acc[ai][bj][m][0][j] + bb[bj][0][j]); v1[j] = g1[j] * fsigmoid(acc[ai][bj][m][1][j] + bb[bj][1][j]); }
                    *(u32x4*)(MRG + (size_t)row * D + col0 + bj * HALF) = pack8(v0, v1);
                    s += dot4(v0) + dot4(v1);
                }
                s += __shfl_xor(s, 16); s += __shfl_xor(s, 32);
                if (fq == 0) atomicAdd(ssq + row, s);
            }
    }
};
struct EpiOut {
    static constexpr bool PERM = true, HAS_MID = true; static constexpr int MID_T = 16;
    const float* ssq_s5; const float* ssq_lru; bf16_t* XB; float* ssq; float* slab;
    __device__ __forceinline__ void mid(Acc& acc, const Unit& u, int wr, int wc, int fr, int fq) const {
        if (u.pm == 32 && slab) return;
        int row0 = u.pm * BM + wr * 64 + fr; asm volatile("" : "+v"(row0));
        float f[2][4];
#pragma unroll
        for (int ai = 0; ai < 2; ++ai)
#pragma unroll
            for (int m = 0; m < 4; ++m) { const int row = row0 + ai * HALF + m * 16; f[ai][m] = rsqrtf(ssq_s5[row] * (1.0f / DH) + EPS) * sqrtf(ssq_lru[row] * (1.0f / DH) + EPS); }
#pragma unroll
        for (int ai = 0; ai < 2; ++ai)
#pragma unroll
            for (int m = 0; m < 4; ++m)
#pragma unroll
                for (int bj = 0; bj < 2; ++bj)
#pragma unroll
                    for (int n = 0; n < 2; ++n) acc[ai][bj][m][n] = acc[ai][bj][m][n] * f[ai][m];
    }
    __device__ __forceinline__ void operator()(const Acc& acc, const Unit& u, int wr, int wc, int fr, int fq) const {
        if (u.pm == 32 && slab) { slab_store(acc, u, slab, wr, wc, fr, fq); return; }
        int row0 = u.pm * BM + wr * 64 + fr, col0 = u.pn * BM + wc * 32 + 8 * fq; asm volatile("" : "+v"(row0), "+v"(col0));
        float rl[2][4];
#pragma unroll
        for (int ai = 0; ai < 2; ++ai)
#pragma unroll
            for (int m = 0; m < 4; ++m) rl[ai][m] = ssq_lru[row0 + ai * HALF + m * 16];
#pragma unroll
        for (int ai = 0; ai < 2; ++ai) {
            ResHalf res; res_load_half(res, XB, row0 + ai * HALF, col0);
#pragma unroll
            for (int m = 0; m < 4; ++m) {
                const int row = row0 + ai * HALF + m * 16;
                const float r = rsqrtf(rl[ai][m] * (1.0f / DH) + EPS);
                float s = 0.f;
#pragma unroll
                for (int bj = 0; bj < 2; ++bj) {
                    const f32x4 v0 = res_lo(res[m][bj]) + r * acc[ai][bj][m][0], v1 = res_hi(res[m][bj]) + r * acc[ai][bj][m][1];
                    *(u32x4*)(XB + (size_t)row * D + col0 + bj * HALF) = pack8(v0, v1);
                    s += dot4(v0) + dot4(v1);
                }
                s += __shfl_xor(s, 16); s += __shfl_xor(s, 32);
                if (fq == 0) atomicAdd(ssq + row, s);
            }
        }
    }
};
struct EpiFinal {
    static constexpr bool PERM = true, HAS_MID = false; static constexpr int MID_T = -1;
    bf16_t* XB; float* ssq; float* slab;
    __device__ __forceinline__ void mid(Acc&, const Unit&, int, int, int, int) const {}
    __device__ __forceinline__ void operator()(const Acc& acc, const Unit& u, int wr, int wc, int fr, int fq) const {
        if (u.pm == 32) { slab_store(acc, u, slab, wr, wc, fr, fq); return; }
        int row0 = u.pm * BM + wr * 64 + fr, col0 = u.pn * BM + wc * 32 + 8 * fq; asm volatile("" : "+v"(row0), "+v"(col0));
#pragma unroll
        for (int ai = 0; ai < 2; ++ai) {
            ResHalf res; res_load_half(res, XB, row0 + ai * HALF, col0);
#pragma unroll
            for (int m = 0; m < 4; ++m) {
                const int row = row0 + ai * HALF + m * 16;
                float s = 0.f;
#pragma unroll
                for (int bj = 0; bj < 2; ++bj) {
                    const f32x4 v0 = res_lo(res[m][bj]) + 0.5f * acc[ai][bj][m][0], v1 = res_hi(res[m][bj]) + 0.5f * acc[ai][bj][m][1];
                    *(u32x4*)(XB + (size_t)row * D + col0 + bj * HALF) = pack8(v0, v1);
                    s += dot4(v0) + dot4(v1);
                }
                s += __shfl_xor(s, 16); s += __shfl_xor(s, 32);
                if (fq == 0) atomicAdd(ssq + row, s);
            }
        }
    }
};
}

#define XB_TMO      128
#define XB_XCNT(j)  (256  + 64 * (j))
#define XB_XSUB(j)  (1280 + 64 * (j))
#define XB_XGEN(j)  (2304 + 64 * (j))
#define XB_TOP      3328
#define XB_TOPGEN   3392
#define XCD_BAR_WORDS 3456
#define XB_SPIN_CAP (1u << 18)
__device__ __forceinline__ unsigned xb_ld(unsigned* p)              { return __hip_atomic_load(p, __ATOMIC_RELAXED, __HIP_MEMORY_SCOPE_AGENT); }
__device__ __forceinline__ unsigned xb_add(unsigned* p, unsigned v) { return __hip_atomic_fetch_add(p, v, __ATOMIC_RELAXED, __HIP_MEMORY_SCOPE_AGENT); }
__device__ __forceinline__ unsigned xb_xcc_id() { return (unsigned)__builtin_amdgcn_s_getreg((3 << 11) | 20) & 0xFu; }
#define XB_SPIN(cond, bar) do { unsigned _sp = 0; while (cond) { __builtin_amdgcn_s_sleep(1); \
    if ((++_sp & 255u) == 0u) { if (xb_ld(&(bar)[XB_TMO])) break; if (_sp > XB_SPIN_CAP) { atomicAdd(&(bar)[XB_TMO], 1u); break; } } } } while (0)
struct XcdBarrier { unsigned* bar; unsigned x; volatile LAS unsigned* st; };
__device__ __forceinline__ XcdBarrier xcd_barrier_post(unsigned* bar, volatile LAS unsigned* st) {
    XcdBarrier b; b.bar = bar; b.x = xb_xcc_id(); b.st = st;
    if (threadIdx.x == 0) (void)xb_add(&bar[XB_XCNT(b.x)], 1u);
    return b;
}
__device__ __forceinline__ void xcd_barrier_complete(unsigned* bar, unsigned x, unsigned& nloc, unsigned& nx) {
    const unsigned G = gridDim.x * gridDim.y * gridDim.z;
    unsigned sum, cnt, mine, sp = 0u;
    for (;;) {
        sum = 0u; cnt = 0u; mine = 0u;
#pragma unroll
        for (unsigned j = 0; j < 16; ++j) { const unsigned c = xb_ld(&bar[XB_XCNT(j)]); sum += c; cnt += (c > 0u) ? 1u : 0u; mine = (j == x) ? c : mine; }
        if (sum == G) break;
        __builtin_amdgcn_s_sleep(1);
        if ((++sp & 255u) == 0u) { if (xb_ld(&bar[XB_TMO])) break; if (sp > XB_SPIN_CAP) { atomicAdd(&bar[XB_TMO], 1u); break; } }
    }
    nloc = mine > 0u ? mine : 1u; nx = cnt > 0u ? cnt : 1u;
}
__device__ __forceinline__ void xcd_barrier(const XcdBarrier& b) {
    asm volatile("s_waitcnt vmcnt(0)" ::: "memory");
    __syncthreads();
    if (threadIdx.x == 0) {
        unsigned* bar = b.bar;
        __builtin_amdgcn_s_waitcnt(0);
        unsigned nloc = b.st[0], nx = b.st[1];
        if (nloc == 0u) { xcd_barrier_complete(bar, b.x, nloc, nx); b.st[0] = nloc; b.st[1] = nx; }
        const unsigned old = xb_add(&bar[XB_XSUB(b.x)], 1u);
        const unsigned gen = old / nloc;
        if (old + 1u == (gen + 1u) * nloc) {
            __builtin_amdgcn_fence(__ATOMIC_RELEASE, "agent");
            asm volatile("s_waitcnt vmcnt(0)" ::: "memory");
            (void)__hip_atomic_fetch_add(&bar[XB_TOP], 1u, __ATOMIC_RELAXED, __HIP_MEMORY_SCOPE_AGENT);
        }
        __builtin_amdgcn_fence(__ATOMIC_ACQUIRE, "agent");
        const unsigned target = (gen + 1u) * nx;
        XB_SPIN(xb_ld(&bar[XB_TOP]) < target, bar);
        asm volatile("s_waitcnt vmcnt(0)" ::: "memory");
    }
    __syncthreads();
}

enum { I_XP = 0, I_XS, I_S5RE, I_S5IM, I_LRUH, I_LRUCONV, I_GFFN1, I_W1A, I_W3A, I_W2A, I_GMIX, I_WIN, I_LAMRE, I_LAMIM, I_LOGDT, I_BRE, I_BIM, I_CRE, I_CIM,
       I_DSKIP, I_WGLU, I_BGLU, I_CONVW, I_CONVB, I_WA, I_BA, I_WX, I_BX, I_LAML, I_GS5, I_GLRU, I_WOUT, I_GFFN2, I_W1B, I_W3B, I_W2B, I_GFINAL, N_IN };
struct Args { const float* in[N_IN]; float* out; unsigned char* ws; int ph_lo, ph_hi; };
constexpr size_t O_Y = 0, O_PS5RE = (size_t)M * D, O_PS5IM = O_PS5RE + NB * NG * NP, O_PLRUH = O_PS5IM + NB * NG * NP, O_PLRUC = O_PLRUH + NB * DH,
                 O_SS5RE = O_PLRUC + NB * 3 * DH, O_SS5IM = O_SS5RE + (size_t)MS * NG * NP, O_SLRUH = O_SS5IM + (size_t)MS * NG * NP, O_SLRUC = O_SLRUH + (size_t)MS * DH,
                 O_END = O_SLRUC + (size_t)MS * 3 * DH;
static_assert(O_END == 18661376, "output size");

typedef float f32x2 __attribute__((ext_vector_type(2)));
constexpr int STG_PITCH = 144, STG_BYTES = 64 * STG_PITCH;
__device__ __forceinline__ void p0_task(const float* W, int N, const float* gk, bf16_t* WT, int ldt, int k0, int n0, int nd0, LAS unsigned char* stg, int lane) {
    const float* src = W + (size_t)k0 * N + n0 + 2 * lane;
    f32x2 v[64];
#if PROBE_PHASE >= 0
    { const float* p = src; const size_t step = (size_t)N;
#pragma unroll
      for (int i = 0; i < 64; ++i) { v[i] = __builtin_nontemporal_load((const f32x2*)p); p += step; if ((i & 7) == 7) asm volatile("" : "+v"(p)); } }
#else
#pragma unroll
    for (int i = 0; i < 64; ++i) v[i] = __builtin_nontemporal_load((const f32x2*)(src + (size_t)i * N));
#endif
    if (gk) {
#pragma unroll
        for (int i = 0; i < 64; ++i) v[i] = v[i] * gk[k0 + i];
    }
#pragma unroll
    for (int j = 0; j < 2; ++j) {
#pragma unroll
        for (int kb = 0; kb < 8; ++kb) {
            u32x4 o; o.x = cvt_pk_bf16(v[8 * kb][j], v[8 * kb + 1][j]); o.y = cvt_pk_bf16(v[8 * kb + 2][j], v[8 * kb + 3][j]); o.z = cvt_pk_bf16(v[8 * kb + 4][j], v[8 * kb + 5][j]); o.w = cvt_pk_bf16(v[8 * kb + 6][j], v[8 * kb + 7][j]);
            *(LAS u32x4*)(stg + lane * STG_PITCH + kb * 16) = o;
        }
        LDS_WAIT(); asm volatile("" ::: "memory");
#pragma unroll
        for (int it = 0; it < 8; ++it) {
            const int rr = 8 * it + (lane >> 3), kb = lane & 7;
            const u32x4 o = *(const LAS u32x4*)(stg + rr * STG_PITCH + kb * 16);
            *(u32x4*)(WT + (size_t)(nd0 + 2 * rr + j) * ldt + k0 + 8 * kb) = o;
        }
        LDS_WAIT(); asm volatile("" ::: "memory");
    }
}
__device__ __forceinline__ void sincos_d(double x, double& s, double& c) {
    const double k = rint(x * 0.63661977236758134308);
    double r = fma(-k, 1.57079632679489655800, x); r = fma(-k, 6.12323399573676603587e-17, r);
    const double r2 = r * r;
    double sp = -7.6471637318198164759e-13; sp = fma(sp, r2, 1.6059043836821614599e-10); sp = fma(sp, r2, -2.5052108385441718775e-8); sp = fma(sp, r2, 2.7557319223985890653e-6);
    sp = fma(sp, r2, -1.9841269841269841270e-4); sp = fma(sp, r2, 8.3333333333333333333e-3); sp = fma(sp, r2, -1.6666666666666666667e-1);
    const double sr = fma(sp * r2, r, r);
    double cp = 4.7794773323873852974e-14; cp = fma(cp, r2, -1.1470745597729724714e-11); cp = fma(cp, r2, 2.0876756987868098979e-9); cp = fma(cp, r2, -2.7557319223985890653e-7);
    cp = fma(cp, r2, 2.4801587301587301587e-5); cp = fma(cp, r2, -1.3888888888888888889e-3); cp = fma(cp, r2, 4.1666666666666666667e-2); cp = fma(cp, r2, -0.5);
    const double cr = fma(cp, r2, 1.0);
    const int q = ((int)k) & 3;
    s = (q == 0) ? sr : (q == 1) ? cr : (q == 2) ? -sr : -cr;
    c = (q == 0) ? cr : (q == 1) ? -sr : (q == 2) ? -cr : sr;
}
__device__ __forceinline__ void p0_s5_group(const Args& a, LAS unsigned char* lds, int g, int tid) {
    LAS float* LPre = (LAS float*)lds;
    LAS float* LPim = LPre + 17 * 64;
    LAS float* BBre = LPim + 17 * 64;
    LAS float* BBim = BBre + 1024;
    LAS float* CRe = BBim + 1024;
    LAS float* CIm = CRe + 1024;
    LAS float* Kt = CIm + 1024;
    LAS float* Kt2 = Kt + 4096;
    LAS float* QQ = Kt2 + 4096;
    const float ldt = a.in[I_LOGDT][g];
    float lre_[3], lim_[3];
#pragma unroll
    for (int i = 0; i < 3; ++i) { const int idx = tid + 512 * i, p = idx & 63; lre_[i] = a.in[I_LAMRE][g * 64 + p]; lim_[i] = a.in[I_LAMIM][g * 64 + p]; }
    float cr_[2], ci_[2], br_[2], bi_[2];
#pragma unroll
    for (int i = 0; i < 2; ++i) { const int idx = tid + 512 * i; cr_[i] = a.in[I_CRE][(size_t)g * 1024 + idx]; ci_[i] = a.in[I_CIM][(size_t)g * 1024 + idx]; br_[i] = a.in[I_BRE][(size_t)g * 1024 + idx]; bi_[i] = a.in[I_BIM][(size_t)g * 1024 + idx]; }
    const float dsk = a.in[I_DSKIP][g * 16 + (tid & 15)];
    const double dt = exp((double)ldt);
#pragma unroll
    for (int i = 0; i < 3; ++i) {
        const int idx = tid + 512 * i;
        if (idx < 17 * 64) {
            const int k = idx >> 6, p = idx & 63;
            const double lre = (double)lre_[i], lim = (double)lim_[i];
            const double mag = exp(lre * dt * (double)k); double sn, cs; sincos_d(lim * dt * (double)k, sn, cs);
            LPre[idx] = (float)(mag * cs); LPim[idx] = (float)(mag * sn);
            if (k == 1) {
                const double nr = mag * cs - 1.0, ni = mag * sn, den = lre * lre + lim * lim;
                QQ[2 * p] = (float)((nr * lre + ni * lim) / den); QQ[2 * p + 1] = (float)((ni * lre - nr * lim) / den);
            }
        }
    }
#pragma unroll
    for (int i = 0; i < 2; ++i) { const int idx = tid + 512 * i; CRe[idx] = cr_[i]; CIm[idx] = ci_[i]; }
    __syncthreads();
#pragma unroll
    for (int i = 0; i < 2; ++i) { const int idx = tid + 512 * i, p = idx >> 4; const float qr = QQ[2 * p], qi = QQ[2 * p + 1];
        BBre[idx] = qr * br_[i] - qi * bi_[i]; BBim[idx] = qr * bi_[i] + qi * br_[i]; }
    __syncthreads();
    {
        const int c = (tid >> 4) & 15, cp = tid & 15, ph = tid >> 8;
        float acc[16];
#pragma unroll
        for (int k = 0; k < 16; ++k) acc[k] = 0.f;
        for (int pp = 0; pp < 32; ++pp) {
            const int p = 32 * ph + pp;
            const float cr = CRe[c * 64 + p], ci = CIm[c * 64 + p], br = BBre[p * 16 + cp], bi = BBim[p * 16 + cp];
            const float gr = cr * br - ci * bi, gi = cr * bi + ci * br;
#pragma unroll
            for (int k = 0; k < 16; ++k) acc[k] += gr * LPre[k * 64 + p] - gi * LPim[k * 64 + p];
        }
        if (ph == 0 && c == cp) acc[0] += dsk;
        LAS float* dst = ph ? Kt2 : Kt;
#pragma unroll
        for (int k = 0; k < 16; ++k) dst[(k * 16 + c) * 16 + cp] = acc[k];
    }
    __syncthreads();
    bf16_t* Win = (bf16_t*)(a.ws + WS_S5M + (size_t)g * S5M_GROUP_BYTES);
    bf16_t* MW = Win + 128 * 256;
    for (int idx = tid; idx < 256 * 48; idx += NWAVES * 64) {
        const int rr = idx / 48, cg = idx % 48, s = rr >> 4, c = rr & 15;
        float v[8];
        if (cg < 32) { const int sp = cg >> 1, c0 = (cg & 1) * 8;
#pragma unroll
            for (int i = 0; i < 8; ++i) { const int o = (((s - sp) & 15) * 16 + c) * 16 + c0 + i; v[i] = (sp <= s) ? Kt[o] + Kt2[o] : 0.f; }
        } else { const int im = cg >= 40, p0 = (cg - (im ? 40 : 32)) * 8;
#pragma unroll
            for (int i = 0; i < 8; ++i) { const int p = p0 + i; const float cr = CRe[c * 64 + p], ci = CIm[c * 64 + p], lr = LPre[(s + 1) * 64 + p], li = LPim[(s + 1) * 64 + p];
                v[i] = im ? -(cr * li + ci * lr) : (cr * lr - ci * li); }
        }
        u32x4 o; o.x = cvt_pk_bf16(v[0], v[1]); o.y = cvt_pk_bf16(v[2], v[3]); o.z = cvt_pk_bf16(v[4], v[5]); o.w = cvt_pk_bf16(v[6], v[7]);
        *(u32x4*)(MW + (size_t)rr * 384 + cg * 8) = o;
    }
    for (int idx = tid; idx < 128 * 32; idx += NWAVES * 64) {
        const int n = idx >> 5, cg = idx & 31, p = n & 63, im = n >> 6, sp = cg >> 1, c0 = (cg & 1) * 8;
        const float lr = LPre[(15 - sp) * 64 + p], li = LPim[(15 - sp) * 64 + p];
        float v[8];
#pragma unroll
        for (int i = 0; i < 8; ++i) { const float br = BBre[p * 16 + c0 + i], bi = BBim[p * 16 + c0 + i]; v[i] = im ? (lr * bi + li * br) : (lr * br - li * bi); }
        u32x4 o; o.x = cvt_pk_bf16(v[0], v[1]); o.y = cvt_pk_bf16(v[2], v[3]); o.z = cvt_pk_bf16(v[4], v[5]); o.w = cvt_pk_bf16(v[6], v[7]);
        *(u32x4*)(Win + (size_t)n * 256 + cg * 8) = o;
    }
    {
        float* aux = (float*)(a.ws + WS_S5AUX) + (size_t)g * S5AUX_GROUP_FLOATS;
        for (int idx = tid; idx < 64; idx += NWAVES * 64) { aux[idx] = LPre[64 + idx]; aux[64 + idx] = LPim[64 + idx]; aux[128 + idx] = LPre[16 * 64 + idx]; aux[192 + idx] = LPim[16 * 64 + idx]; }
        for (int idx = tid; idx < 1024; idx += NWAVES * 64) { aux[256 + idx] = BBre[idx]; aux[1280 + idx] = BBim[idx]; }
    }
    __syncthreads();
}
__device__ __forceinline__ void conv_tasks(const Args& a, LAS unsigned char* stg, int first, int last, int wv, int nwv, int lane) {
    constexpr int T_W1 = (D / 64) * (FF / 128), T_W2 = (FF / 64) * (D / 128), T_IN = (D / 64) * (DIN / 128), T_GLU = (DH / 64) * (DH / 128), T_OUT = (D / 64) * (D / 128);
    const int cnt[9] = {T_W1, T_W1, T_W2, T_IN, T_GLU, T_OUT, T_W1, T_W1, T_W2};
    int NT = 0;
#pragma unroll
    for (int m = 0; m < 9; ++m) if (m >= first && m <= last) NT += cnt[m];
    const int t_lo = (int)(((long)wv * NT) / nwv), t_hi = (int)(((long)(wv + 1) * NT) / nwv);
    unsigned char* ws = a.ws;
    for (int it = t_lo; it < t_hi; ++it) {
        int r = it, mat = first;
#pragma unroll
        for (int m = 0; m < 9; ++m) if (m >= first && m < last && mat == m && r >= cnt[m]) { r -= cnt[m]; mat = m + 1; }
        const float* W; const float* gk = nullptr; bf16_t* WT; int K, N, dual = 0, off = 0;
        switch (mat) {
            case 0: W = a.in[I_W1A]; gk = a.in[I_GFFN1]; WT = (bf16_t*)(ws + WS_W13A); K = D; N = FF; dual = 1; break;
            case 1: W = a.in[I_W3A]; gk = a.in[I_GFFN1]; WT = (bf16_t*)(ws + WS_W13A); K = D; N = FF; dual = 1; off = 128; break;
            case 2: W = a.in[I_W2A]; WT = (bf16_t*)(ws + WS_W2A); K = FF; N = D; break;
            case 3: W = a.in[I_WIN]; gk = a.in[I_GMIX]; WT = (bf16_t*)(ws + WS_WIN); K = D; N = DIN; break;
            case 4: W = a.in[I_WGLU]; WT = (bf16_t*)(ws + WS_WGLU); K = DH; N = DH; break;
            case 5: W = a.in[I_WOUT]; WT = (bf16_t*)(ws + WS_WOUT); K = D; N = D; dual = 2; break;
            case 6: W = a.in[I_W1B]; gk = a.in[I_GFFN2]; WT = (bf16_t*)(ws + WS_W13B); K = D; N = FF; dual = 1; break;
            case 7: W = a.in[I_W3B]; gk = a.in[I_GFFN2]; WT = (bf16_t*)(ws + WS_W13B); K = D; N = FF; dual = 1; off = 128; break;
            default: W = a.in[I_W2B]; WT = (bf16_t*)(ws + WS_W2B); K = FF; N = D; break;
        }
        const int nkb = K / 64, nb = r / nkb, kb = r % nkb, k0 = kb * 64, n0 = nb * 128;
        if (dual == 2) { gk = k0 < DH ? a.in[I_GS5] : a.in[I_GLRU] - DH; dual = 0; }
        p0_task(W, N, gk, WT, K, k0, n0, dual ? (nb * 256 + off) : n0, stg, lane);
    }
}
__device__ __forceinline__ void p0_prologue(const Args& a, LAS unsigned char* lds, int vcu, int G, int lane, int wave) {
    const int gw = vcu * NWAVES + wave, NGW = G * NWAVES;
    unsigned char* ws = a.ws;
    bf16_t* XB = (bf16_t*)(ws + WS_XB); float* ssq0 = (float*)(ws + WS_CTL + CTL_SSQ_BYTE);
    for (int grp = gw; grp < MPAD / 4; grp += NGW) {
        const int m0 = 4 * grp;
        u32x2* o = (u32x2*)(XB + (size_t)m0 * D) + lane;
        if (m0 < M) {
            const float* xr = m0 < MP ? a.in[I_XP] + (size_t)m0 * D : a.in[I_XS] + (size_t)(m0 - MP) * D;
            const f32x4* x4 = (const f32x4*)xr + lane; f32x4 v[4][8];
#pragma unroll
            for (int r = 0; r < 4; ++r)
#pragma unroll
                for (int j = 0; j < 8; ++j) v[r][j] = __builtin_nontemporal_load(x4 + r * (D / 4) + 64 * j);
#pragma unroll
            for (int r = 0; r < 4; ++r) {
                float s = 0.f;
#pragma unroll
                for (int j = 0; j < 8; ++j) s += dot4(v[r][j]);
                s = wave_sum(s);
#pragma unroll
                for (int j = 0; j < 8; ++j) { u32x2 w; w.x = cvt_pk_bf16(v[r][j][0], v[r][j][1]); w.y = cvt_pk_bf16(v[r][j][2], v[r][j][3]); o[r * (D / 4) + 64 * j] = w; }
                if (lane == 0) ssq0[m0 + r] = s;
            }
        } else {
#pragma unroll
            for (int r = 0; r < 4; ++r)
#pragma unroll
                for (int j = 0; j < 8; ++j) o[r * (D / 4) + 64 * j] = (u32x2){0u, 0u};
        }
    }
    conv_tasks(a, lds + wave * STG_BYTES, 0, 3, gw, NGW, lane);
}

#define MFMA32(a, b, c) __builtin_amdgcn_mfma_f32_32x32x16_bf16((a), (b), (c), 0, 0, 0)
constexpr int S5_PITCH = 528;
constexpr int S5_XC_OFF = 0, S5_Z_OFF = 128 * S5_PITCH;
static_assert(2 * 128 * S5_PITCH <= RING_BYTES, "S5 LDS map");
__device__ __forceinline__ void s5_prompt(const Args& a, LAS unsigned char* lds, int b, int g, int tid, int lane, int wave) {
    const bf16_t* U = (const bf16_t*)(a.ws + WS_U);
    const bf16_t* Win = (const bf16_t*)(a.ws + WS_S5M + (size_t)g * S5M_GROUP_BYTES);
    const bf16_t* MW = Win + 128 * 256;
    bf16_t* GS5 = (bf16_t*)(a.ws + WS_GS5);
    LAS unsigned char* XCs = lds + S5_XC_OFF;
    LAS unsigned char* ZS = lds + S5_Z_OFF;
    const int r32 = lane & 31, hh = lane >> 5;
    {
        u32x4 v[8];
#pragma unroll
        for (int i = 0; i < 8; ++i) { const int q = tid + 512 * i, t = q >> 1, half = q & 1; v[i] = *(const u32x4*)(U + (size_t)(b * SEQ + t) * DH + 16 * g + 8 * half); }
#pragma unroll
        for (int i = 0; i < 8; ++i) { const int q = tid + 512 * i, t = q >> 1, half = q & 1; *(LAS u32x4*)(XCs + (t >> 4) * S5_PITCH + (t & 15) * 32 + 16 * half) = v[i]; }
    }
    {
        const int mt = wave & 3, nt0 = (wave >> 2) * 2;
        const bf16_t* w0 = Win + (size_t)(32 * nt0 + r32) * 256 + 8 * hh;
        bf16x8 bw[2][8];
#pragma unroll
        for (int ks = 0; ks < 8; ++ks) { bw[0][ks] = *(const bf16x8*)(w0 + 16 * ks); bw[1][ks] = *(const bf16x8*)(w0 + 32 * 256 + 16 * ks); }
        __syncthreads();
        f32x16 acc0, acc1;
#pragma unroll
        for (int i = 0; i < 16; ++i) { acc0[i] = 0.f; acc1[i] = 0.f; }
        const LAS unsigned char* xa = XCs + (32 * mt + r32) * S5_PITCH + 16 * hh;
#pragma unroll 1
        for (int kh = 0; kh < 2; ++kh) {
#pragma unroll
            for (int ks = 0; ks < 8; ++ks) { const bf16x8 af = *(const LAS bf16x8*)(xa + 32 * (8 * kh + ks)); acc0 = MFMA32(af, bw[0][ks], acc0); acc1 = MFMA32(af, bw[1][ks], acc1); }
            if (kh == 0) {
#pragma unroll
                for (int ks = 0; ks < 8; ++ks) { bw[0][ks] = *(const bf16x8*)(w0 + 128 + 16 * ks); bw[1][ks] = *(const bf16x8*)(w0 + 32 * 256 + 128 + 16 * ks); }
            }
        }
        LAS float* Z = (LAS float*)ZS;
#pragma unroll
        for (int i = 0; i < 16; ++i) { const int j = 32 * mt + (i & 3) + 8 * (i >> 2) + 4 * hh;
            Z[j * (S5_PITCH / 4) + 32 * nt0 + r32] = acc0[i]; Z[j * (S5_PITCH / 4) + 32 * nt0 + 32 + r32] = acc1[i]; }
    }
    __syncthreads();
    if (wave == 0) {
        const float* aux = (const float*)(a.ws + WS_S5AUX) + (size_t)g * S5AUX_GROUP_FLOATS;
        const float l16r = aux[128 + lane], l16i = aux[192 + lane];
        const LAS float* Z = (const LAS float*)ZS;
        float sr = 0.f, si = 0.f;
        for (int jb = 0; jb < 16; ++jb) {
            float zr[8], zi[8];
#pragma unroll
            for (int i = 0; i < 8; ++i) { zr[i] = Z[(8 * jb + i) * (S5_PITCH / 4) + lane]; zi[i] = Z[(8 * jb + i) * (S5_PITCH / 4) + 64 + lane]; }
            LDS_WAIT();
#pragma unroll
            for (int i = 0; i < 8; ++i) {
                const unsigned w = cvt_pk_bf16(sr, si);
                *(LAS unsigned short*)(ZS + (8 * jb + i) * S5_PITCH + 2 * lane) = (unsigned short)(w & 0xffffu);
                *(LAS unsigned short*)(ZS + (8 * jb + i) * S5_PITCH + 128 + 2 * lane) = (unsigned short)(w >> 16);
                const float nr = l16r * sr - l16i * si + zr[i], ni = l16r * si + l16i * sr + zi[i];
                sr = nr; si = ni;
            }
        }
        a.out[O_PS5RE + (size_t)(b * NG + g) * NP + lane] = sr;
        a.out[O_PS5IM + (size_t)(b * NG + g) * NP + lane] = si;
    }
#pragma unroll 1
    for (int pass = 0; pass < 2; ++pass) {
        const int mt = pass ? 7 - wave : wave, n0 = 2 * pass;
        const int nks = 2 * mt + 2;
        const bf16_t* mw = MW + (size_t)(32 * mt + r32) * 384 + 8 * hh;
        bf16x8 am[24];
#pragma unroll
        for (int ks = 0; ks < 16; ++ks) if (ks < nks) am[ks] = *(const bf16x8*)(mw + 16 * ks);
#pragma unroll
        for (int kq = 0; kq < 8; ++kq) am[16 + kq] = *(const bf16x8*)(mw + 256 + 16 * kq);
        if (pass == 0) __syncthreads();
        f32x16 acc[2];
#pragma unroll
        for (int n = 0; n < 2; ++n)
#pragma unroll
            for (int i = 0; i < 16; ++i) acc[n][i] = 0.f;
#pragma unroll
        for (int ks = 0; ks < 16; ++ks) if (ks < nks) {
#pragma unroll
            for (int n = 0; n < 2; ++n) { const bf16x8 bf = *(const LAS bf16x8*)(XCs + (32 * (n0 + n) + r32) * S5_PITCH + 32 * ks + 16 * hh); acc[n] = MFMA32(am[ks], bf, acc[n]); }
        }
#pragma unroll
        for (int kq = 0; kq < 8; ++kq) {
#pragma unroll
            for (int n = 0; n < 2; ++n) { const bf16x8 bf = *(const LAS bf16x8*)(ZS + (32 * (n0 + n) + r32) * S5_PITCH + 32 * kq + 16 * hh); acc[n] = MFMA32(am[16 + kq], bf, acc[n]); }
        }
#pragma unroll
        for (int n = 0; n < 2; ++n)
#pragma unroll
            for (int q = 0; q < 4; ++q) {
                const int s = 2 * mt + (q >> 1), c0 = 8 * (q & 1) + 4 * hh, t = 16 * (32 * (n0 + n) + r32) + s;
                u32x2 w; w.x = cvt_pk_bf16(fgelu(acc[n][4 * q]), fgelu(acc[n][4 * q + 1])); w.y = cvt_pk_bf16(fgelu(acc[n][4 * q + 2]), fgelu(acc[n][4 * q + 3]));
                *(u32x2*)(GS5 + (size_t)(b * SEQ + t) * DH + 16 * g + c0) = w;
            }
    }
    __syncthreads();
}
__device__ __forceinline__ void s5_sample(const Args& a, LAS unsigned char* lds, int g, int bs0, int tid) {
    const bf16_t* U = (const bf16_t*)(a.ws + WS_U);
    bf16_t* GS5 = (bf16_t*)(a.ws + WS_GS5);
    const float* aux = (const float*)(a.ws + WS_S5AUX) + (size_t)g * S5AUX_GROUP_FLOATS;
    LAS float* HR = (LAS float*)lds;
    LAS float* HI = HR + 2048;
    LAS float* UU = HI + 2048;
    LAS float* CR = UU + 512;
    LAS float* CI = CR + 1024;
    LAS float* BR = CI + 1024;
    LAS float* BI = BR + 1024;
    const int bl0 = tid >> 4, c0 = tid & 15;
    const unsigned short uraw = U[(size_t)(MP + bs0 + bl0) * DH + 16 * g + c0];
    float cr_[2], ci_[2], br_[2], bi_[2], h0r[4], h0i[4];
#pragma unroll
    for (int i = 0; i < 2; ++i) { const int idx = tid + 512 * i; cr_[i] = a.in[I_CRE][(size_t)g * 1024 + idx]; ci_[i] = a.in[I_CIM][(size_t)g * 1024 + idx]; br_[i] = aux[256 + idx]; bi_[i] = aux[1280 + idx]; }
#pragma unroll
    for (int i = 0; i < 4; ++i) { const int idx = tid + 512 * i, bl = idx >> 6, p = idx & 63; const size_t so = (size_t)((bs0 + bl) * NG + g) * NP + p; h0r[i] = a.in[I_S5RE][so]; h0i[i] = a.in[I_S5IM][so]; }
    const float lr = aux[tid & 63], li = aux[64 + (tid & 63)];
    const float dsk = a.in[I_DSKIP][g * 16 + c0];
    UU[tid] = __uint_as_float((unsigned)uraw << 16);
#pragma unroll
    for (int i = 0; i < 2; ++i) { const int idx = tid + 512 * i; CR[idx] = cr_[i]; CI[idx] = ci_[i]; BR[idx] = br_[i]; BI[idx] = bi_[i]; }
    __syncthreads();
#pragma unroll
    for (int i = 0; i < 4; ++i) {
        const int idx = tid + 512 * i, bl = idx >> 6, p = idx & 63;
        float hr = lr * h0r[i] - li * h0i[i], hi = lr * h0i[i] + li * h0r[i];
#pragma unroll
        for (int q = 0; q < 4; ++q) { const f32x4 br = *(const LAS f32x4*)(BR + p * 16 + 4 * q), bi = *(const LAS f32x4*)(BI + p * 16 + 4 * q); const f32x4 u4 = *(const LAS f32x4*)(UU + bl * 16 + 4 * q);
#pragma unroll
            for (int j = 0; j < 4; ++j) { hr += br[j] * u4[j]; hi += bi[j] * u4[j]; } }
        const size_t so = (size_t)((bs0 + bl) * NG + g) * NP + p;
        a.out[O_SS5RE + so] = hr; a.out[O_SS5IM + so] = hi;
        HR[idx] = hr; HI[idx] = hi;
    }
    __syncthreads();
    {
        float y = 0.f;
#pragma unroll 16
        for (int p = 0; p < 64; ++p) y += CR[c0 * 64 + p] * HR[bl0 * 64 + p] - CI[c0 * 64 + p] * HI[bl0 * 64 + p];
        y += dsk * UU[tid];
        const float gv = fgelu(y); const unsigned w = cvt_pk_bf16(gv, gv);
        GS5[(size_t)(MP + bs0 + bl0) * DH + 16 * g + c0] = (bf16_t)(w & 0xffffu);
    }
    __syncthreads();
}

constexpr int XC_PITCH = 144;
__device__ __forceinline__ void lru_item(const Args& a, LAS unsigned char* lds, bool sample, int b, int head, int q, int tid, int lane, int wave) {
    const float* XL = (const float*)(a.ws + WS_XLRU);
    const bf16_t* GG = (const bf16_t*)(a.ws + WS_GG);
    bf16_t* MRG = (bf16_t*)(a.ws + WS_MRG);
    float* ssq_lru = (float*)(a.ws + WS_CTL + CTL_SSQ_BYTE) + 3 * MPAD;
    LAS unsigned char* XC = lds;
    LAS float* XCF = (LAS float*)(lds + 36864);
    LAS float* AA = XCF + 4096;
    LAS float* BX = AA + 4096;
    LAS float* SEGP = BX + 4096;
    LAS float* SEGH = SEGP + 512;
    LAS float* CAR = SEGH + 512;
    const int ch0 = 64 * head + 16 * q;
    const int fr = lane & 15, fq = lane >> 4;
    bf16x8 Bf[2][2];
#pragma unroll
    for (int mat = 0; mat < 2; ++mat)
#pragma unroll
        for (int ks = 0; ks < 2; ++ks) {
            const float* w = (mat ? a.in[I_WX] : a.in[I_WA]) + ((size_t)(head * 64 + 32 * ks + 8 * fq)) * 64 + 16 * q + fr;
            u32x4 p; p.x = cvt_pk_bf16(w[0], w[64]); p.y = cvt_pk_bf16(w[128], w[192]); p.z = cvt_pk_bf16(w[256], w[320]); p.w = cvt_pk_bf16(w[384], w[448]);
            Bf[mat][ks] = __builtin_bit_cast(bf16x8, p);
        }
    const int chn = ch0 + fr;
    const float ba = a.in[I_BA][chn], bx_ = a.in[I_BX][chn];
    const float spl = log1pf(expf(-a.in[I_LAML][chn]));
    const int cq = tid & 15, cch = 64 * head + 4 * cq, rg = tid >> 4;
    const f32x4 cw0 = *(const f32x4*)(a.in[I_CONVW] + cch), cw1 = *(const f32x4*)(a.in[I_CONVW] + DH + cch), cw2 = *(const f32x4*)(a.in[I_CONVW] + 2 * DH + cch),
                cw3 = *(const f32x4*)(a.in[I_CONVW] + 3 * DH + cch), cb = *(const f32x4*)(a.in[I_CONVB] + cch);
    const int er = tid >> 1, eh = tid & 1;
    if (!sample) {
        float hcar = 0.f;
        f32x4 xin[11]; u32x4 ggn;
        { const int R0 = b * SEQ, r0 = rg * 8;
#pragma unroll
          for (int i = 0; i < 11; ++i) { const int t = r0 + i - 3; xin[i] = (t >= 0) ? *(const f32x4*)(XL + (size_t)(R0 + t) * DH + cch) : (f32x4){0.f, 0.f, 0.f, 0.f}; }
          ggn = *(const u32x4*)(GG + (size_t)(R0 + er) * DH + ch0 + 8 * eh); }
        for (int chk = 0; chk < 8; ++chk) {
            const int R0 = b * SEQ + chk * 256, r0 = rg * 8;
#pragma unroll
            for (int rr = 0; rr < 8; ++rr) {
                const f32x4 xc = cb + cw0 * xin[rr] + cw1 * xin[rr + 1] + cw2 * xin[rr + 2] + cw3 * xin[rr + 3];
                u32x2 w; w.x = cvt_pk_bf16(xc[0], xc[1]); w.y = cvt_pk_bf16(xc[2], xc[3]);
                *(LAS u32x2*)(XC + (r0 + rr) * XC_PITCH + 8 * cq) = w;
                if ((cq >> 2) == q) *(LAS f32x4*)(XCF + (r0 + rr) * 16 + 4 * (cq & 3)) = xc;
            }
            const u32x4 gw = ggn;
            if (chk < 7) {
                const float* p = XL + (size_t)(R0 + 256 + r0 - 3) * DH + cch;
#pragma unroll
                for (int i = 0; i < 11; ++i) xin[i] = *(const f32x4*)(p + (size_t)i * DH);
                ggn = *(const u32x4*)(GG + (size_t)(R0 + 256 + er) * DH + ch0 + 8 * eh);
            }
            __syncthreads();
#pragma unroll
            for (int tt = 0; tt < 2; ++tt) {
                const int tile = 2 * wave + tt;
                f32x4 ar = (f32x4){0.f, 0.f, 0.f, 0.f}, ax = ar;
#pragma unroll
                for (int ks = 0; ks < 2; ++ks) {
                    const bf16x8 af = *(const LAS bf16x8*)(XC + (16 * tile + fr) * XC_PITCH + 64 * ks + 16 * fq);
                    ar = __builtin_amdgcn_mfma_f32_16x16x32_bf16(af, Bf[0][ks], ar, 0, 0, 0);
                    ax = __builtin_amdgcn_mfma_f32_16x16x32_bf16(af, Bf[1][ks], ax, 0, 0, 0);
                }
#pragma unroll
                for (int r4 = 0; r4 < 4; ++r4) {
                    const int rr = 16 * tile + 4 * fq + r4;
                    const float xcv = XCF[rr * 16 + fr];
                    const float rg_ = fsigmoid(ar[r4] + ba), ig = fsigmoid(ax[r4] + bx_);
                    const float la = -8.0f * rg_ * spl;
                    const float av = fexp(la); AA[rr * 16 + fr] = av; BX[rr * 16 + fr] = __builtin_amdgcn_sqrtf(fmaxf(fmaf(-av, av, 1.0f), 0.f)) * (ig * xcv);
                }
            }
            __syncthreads();
            const int sn = tid & 15, sg = tid >> 4;
            float av[8], bv[8];
            { float P = 1.f, h = 0.f;
#pragma unroll
              for (int i = 0; i < 8; ++i) { av[i] = AA[(8 * sg + i) * 16 + sn]; bv[i] = BX[(8 * sg + i) * 16 + sn]; }
#pragma unroll
              for (int i = 0; i < 8; ++i) { h = av[i] * h + bv[i]; P *= av[i]; }
              SEGP[tid] = P; SEGH[tid] = h; }
            __syncthreads();
            if (wave == 0 && lane < 16) {
                float run = hcar;
#pragma unroll 8
                for (int s2 = 0; s2 < 32; ++s2) { CAR[s2 * 16 + lane] = run; run = SEGP[s2 * 16 + lane] * run + SEGH[s2 * 16 + lane]; }
                hcar = run;
            }
            __syncthreads();
            { float h = CAR[tid];
#pragma unroll
              for (int i = 0; i < 8; ++i) { h = av[i] * h + bv[i]; BX[(8 * sg + i) * 16 + sn] = h; } }
            __syncthreads();
            {
                const size_t row = (size_t)R0 + er;
                const f32x4 h0 = *(const LAS f32x4*)(BX + er * 16 + 8 * eh), h1 = *(const LAS f32x4*)(BX + er * 16 + 8 * eh + 4);
                const f32x4 y0 = (f32x4){h0[0] * bf_lo(gw.x), h0[1] * bf_hi(gw.x), h0[2] * bf_lo(gw.y), h0[3] * bf_hi(gw.y)};
                const f32x4 y1 = (f32x4){h1[0] * bf_lo(gw.z), h1[1] * bf_hi(gw.z), h1[2] * bf_lo(gw.w), h1[3] * bf_hi(gw.w)};
                *(u32x4*)(MRG + row * D + DH + ch0 + 8 * eh) = pack8(y0, y1);
                float s = dot4(y0) + dot4(y1);
                s += __shfl_xor(s, 1);
                if (eh == 0) atomicAdd(ssq_lru + row, s);
            }
        }
        if (wave == 0 && lane < 16) a.out[O_PLRUH + (size_t)b * DH + ch0 + lane] = hcar;
        if (wave == 1 && lane < 48) { const int k = lane >> 4, n = lane & 15;
            a.out[O_PLRUC + ((size_t)b * 3 + k) * DH + ch0 + n] = XL[(size_t)(b * SEQ + SEQ - 3 + k) * DH + ch0 + n]; }
    } else {
        const int R0 = MP, bs0 = 32 * b;
        {
            const float* cbuf = a.in[I_LRUCONV];
            const int bs = bs0 + rg;
            const f32x4 x0 = *(const f32x4*)(XL + (size_t)(R0 + bs) * DH + cch);
            const f32x4 c0 = *(const f32x4*)(cbuf + ((size_t)bs * 3 + 0) * DH + cch), c1 = *(const f32x4*)(cbuf + ((size_t)bs * 3 + 1) * DH + cch), c2 = *(const f32x4*)(cbuf + ((size_t)bs * 3 + 2) * DH + cch);
            const f32x4 xc = cb + cw0 * c0 + cw1 * c1 + cw2 * c2 + cw3 * x0;
            u32x2 w; w.x = cvt_pk_bf16(xc[0], xc[1]); w.y = cvt_pk_bf16(xc[2], xc[3]);
            *(LAS u32x2*)(XC + rg * XC_PITCH + 8 * cq) = w;
            if ((cq >> 2) == q) {
                *(LAS f32x4*)(XCF + rg * 16 + 4 * (cq & 3)) = xc;
                float* oc = a.out + O_SLRUC + (size_t)bs * 3 * DH + cch;
                *(f32x4*)oc = c1; *(f32x4*)(oc + DH) = c2; *(f32x4*)(oc + 2 * DH) = x0;
            }
        }
        __syncthreads();
        if (wave < 2) {
            const int tile = wave;
            f32x4 ar = (f32x4){0.f, 0.f, 0.f, 0.f}, ax = ar;
#pragma unroll
            for (int ks = 0; ks < 2; ++ks) {
                const bf16x8 af = *(const LAS bf16x8*)(XC + (16 * tile + fr) * XC_PITCH + 64 * ks + 16 * fq);
                ar = __builtin_amdgcn_mfma_f32_16x16x32_bf16(af, Bf[0][ks], ar, 0, 0, 0);
                ax = __builtin_amdgcn_mfma_f32_16x16x32_bf16(af, Bf[1][ks], ax, 0, 0, 0);
            }
#pragma unroll
            for (int r4 = 0; r4 < 4; ++r4) {
                const int rl = 16 * tile + 4 * fq + r4, bs = bs0 + rl;
                const float xcv = XCF[rl * 16 + fr];
                const float rg_ = fsigmoid(ar[r4] + ba), ig = fsigmoid(ax[r4] + bx_);
                const float la = -8.0f * rg_ * spl;
                const float av = fexp(la); const float h = av * a.in[I_LRUH][(size_t)bs * DH + chn] + __builtin_amdgcn_sqrtf(fmaxf(fmaf(-av, av, 1.0f), 0.f)) * (ig * xcv);
                BX[rl * 16 + fr] = h; a.out[O_SLRUH + (size_t)bs * DH + chn] = h;
            }
        }
        __syncthreads();
        if (er < 32) {
            const size_t row = (size_t)R0 + bs0 + er;
            const u32x4 gw = *(const u32x4*)(GG + row * DH + ch0 + 8 * eh);
            const f32x4 h0 = *(const LAS f32x4*)(BX + er * 16 + 8 * eh), h1 = *(const LAS f32x4*)(BX + er * 16 + 8 * eh + 4);
            const f32x4 y0 = (f32x4){h0[0] * bf_lo(gw.x), h0[1] * bf_hi(gw.x), h0[2] * bf_lo(gw.y), h0[3] * bf_hi(gw.y)};
            const f32x4 y1 = (f32x4){h1[0] * bf_lo(gw.z), h1[1] * bf_hi(gw.z), h1[2] * bf_lo(gw.w), h1[3] * bf_hi(gw.w)};
            *(u32x4*)(MRG + row * D + DH + ch0 + 8 * eh) = pack8(y0, y1);
            float s = dot4(y0) + dot4(y1);
            s += __shfl_xor(s, 1);
            if (eh == 0) atomicAdd(ssq_lru + row, s);
        }
    }
    __syncthreads();
}

__global__ void __launch_bounds__(NWAVES * 64, 2) hymba_fwd(Args args) {
    extern __shared__ __attribute__((aligned(16))) unsigned char lds_raw[];
    LAS unsigned char* lds = (LAS unsigned char*)lds_raw;
    volatile LAS unsigned* MISC = (volatile LAS unsigned*)(lds + MISC_OFF);
    const int tid = threadIdx.x, lane = tid & 63, wave = __builtin_amdgcn_readfirstlane(tid >> 6);
    const int G = gridDim.x, bx = blockIdx.x;
    const int vcu = (G % 8 == 0) ? (bx % 8) * (G / 8) + bx / 8 : bx;
    unsigned char* ws = args.ws;
    unsigned* ctl = (unsigned*)(ws + WS_CTL);
    for (int u = tid; u < (LDS_BYTES - LDSCTL_OFF) / 4; u += NWAVES * 64) ((LAS unsigned*)(lds + LDSCTL_OFF))[u] = 0u;
    __syncthreads();
    XcdBarrier bar; bar.bar = ctl + CW_BAR; bar.x = 0; bar.st = nullptr;
    if (MK_N_LAUNCHES == 1) bar = xcd_barrier_post(ctl + CW_BAR, MISC + 8);
#define GRID_BAR() do { if (MK_N_LAUNCHES == 1) xcd_barrier(bar); } while (0)
#define STAMP(k) do { if (PROBE_PHASE >= 0 && bx == 0 && tid == 0) { const unsigned long long now_ = __builtin_amdgcn_s_memrealtime(); \
        const unsigned long long prev_ = ((unsigned long long)MISC[17] << 32) | MISC[16]; if ((k) == PROBE_PHASE) { const unsigned long long d_ = now_ - prev_; MISC[18] = (unsigned)d_; } \
        MISC[16] = (unsigned)now_; MISC[17] = (unsigned)(now_ >> 32); } } while (0)
    STAMP(-1);
    const int lo = args.ph_lo, hi = args.ph_hi;
#define IN(k) (lo <= (k) && (k) < hi)
#define BOTH(k) (IN(k) && IN((k) + 1))
    float* ssq = (float*)(ws + WS_CTL + CTL_SSQ_BYTE);
    float *ssq0 = ssq, *ssq1 = ssq + MPAD, *ssq_s5 = ssq + 2 * MPAD, *ssq_lru = ssq + 3 * MPAD, *ssq2 = ssq + 4 * MPAD, *ssq3 = ssq + 5 * MPAD;
    bf16_t* XB = (bf16_t*)(ws + WS_XB); float* X1 = (float*)(ws + WS_X1); bf16_t* HID = (bf16_t*)(ws + WS_H);
    bf16_t* U = (bf16_t*)(ws + WS_U); float* XL = (float*)(ws + WS_XLRU); bf16_t* GG = (bf16_t*)(ws + WS_GG); bf16_t* MRG = (bf16_t*)(ws + WS_MRG);
    float* SLAB = (float*)(ws + WS_SLAB); float* SLAB5 = (float*)(ws + WS_U);
    const int gws = wave * G + bx;

    unsigned* cnt_fin2 = ctl + CW_CNT; unsigned* cnt_fin5 = ctl + CW_CNT + 64;
#define PUBLISH(cnt) do { asm volatile("s_waitcnt vmcnt(0)" ::: "memory"); __builtin_amdgcn_fence(__ATOMIC_RELEASE, "agent"); asm volatile("s_waitcnt vmcnt(0)" ::: "memory"); \
        if (lane == 0) __hip_atomic_fetch_add((cnt), 1u, __ATOMIC_RELAXED, __HIP_MEMORY_SCOPE_AGENT); } while (0)

    if (IN(0)) { p0_prologue(args, lds, vcu, G, lane, wave); if (BOTH(0)) GRID_BAR(); STAMP(0); }
    if (IN(1)) {
        constexpr int GG1 = 242;
        if (bx < GG1) {
            pg8::Gemm g{XB, (const bf16_t*)(ws + WS_W13A), D, D}; pg8::PanelOrder S; S.init(2 * FF / 256, D / 64, D / 64, GG1, bx);
            pg8::EpiSwiGLU E{HID, ssq0};
            pg8::gemm_phase(lds, g, S, E);
        } else {
            for (int gj = bx - GG1; gj < NG; gj += G - GG1) p0_s5_group(args, lds, gj, tid);
            __syncthreads();
            conv_tasks(args, lds + wave * STG_BYTES, 4, 4, (bx - GG1) * NWAVES + wave, (G - GG1) * NWAVES, lane);
        }
        if (BOTH(1)) GRID_BAR();
        STAMP(1);
    }
    if (IN(2)) {
        pg8::Gemm g{HID, (const bf16_t*)(ws + WS_W2A), FF, FF}; pg8::PanelOrder S; S.init(D / 256, FF / 64, 8, G, bx);
        pg8::EpiResid E{SLAB, XB, ssq1};
        pg8::gemm_phase(lds, g, S, E);
        if (BOTH(2)) GRID_BAR();
        STAMP(2);
    }
    if (IN(3)) {
        constexpr int GG3 = 198;
        { const int r = (bx >= GG3 && wave < 3) ? (bx - GG3) + (G - GG3) * wave : MS;
          if (r < MS) {
            const int row = MP + r;
            const f32x4* xr = (const f32x4*)(args.in[I_XS] + (size_t)r * D) + lane; f32x4 v[8]; float sq = 0.f;
#pragma unroll
            for (int j = 0; j < 8; ++j) { f32x4 t = (f32x4){0.f, 0.f, 0.f, 0.f};
#pragma unroll
                for (int sl = 0; sl < 11; ++sl) t += ((const f32x4*)(SLAB + ((size_t)sl * MS + r) * D) + lane)[64 * j];
                v[j] = xr[64 * j] + 0.5f * t; sq += dot4(v[j]); }
            sq = wave_sum(sq);
#pragma unroll
            for (int j = 0; j < 8; ++j) { ((f32x4*)(X1 + (size_t)row * D) + lane)[64 * j] = v[j];
                u32x2 w; w.x = cvt_pk_bf16(v[j][0], v[j][1]); w.y = cvt_pk_bf16(v[j][2], v[j][3]); ((u32x2*)(XB + (size_t)row * D) + lane)[64 * j] = w; }
            if (lane == 0) ssq1[row] = sq;
            PUBLISH(cnt_fin2);
          } }
        if (bx < GG3) {
            pg8::Gemm g{XB, (const bf16_t*)(ws + WS_WIN), D, D}; pg8::PanelOrder S; S.init(DIN / 256, D / 64, D / 64, GG3, bx); S.ready = cnt_fin2; S.need = MS;
            pg8::EpiProj E{U, XL, GG, ssq1};
            pg8::gemm_phase(lds, g, S, E);
        } else conv_tasks(args, lds + wave * STG_BYTES, 6, 7, (bx - GG3) * NWAVES + wave, (G - GG3) * NWAVES, lane);
        if (BOTH(3)) GRID_BAR();
        STAMP(3);
    }
    if (IN(4)) {
        { bf16_t* GS5 = (bf16_t*)(ws + WS_GS5); const int gw = bx * NWAVES + wave, NGW = G * NWAVES;
          for (int m = M + gw; m < MPAD; m += NGW) {
              ((u32x4*)(GS5 + (size_t)m * DH))[lane] = (u32x4){0u, 0u, 0u, 0u}; ((u32x4*)(GS5 + (size_t)m * DH))[64 + lane] = (u32x4){0u, 0u, 0u, 0u};
              ((u32x4*)(MRG + (size_t)m * D + DH))[lane] = (u32x4){0u, 0u, 0u, 0u}; ((u32x4*)(MRG + (size_t)m * D + DH))[64 + lane] = (u32x4){0u, 0u, 0u, 0u}; } }
        for (int it = bx; it < NB * NG; it += G) { const int b = it >> 6, g = ((it & 7) << 3) | ((it >> 3) & 7); s5_prompt(args, lds, b, g, tid, lane, wave); }
        STAMP(20);
        for (int it = bx; it < 4 * NG; it += G) s5_sample(args, lds, it >> 2, 32 * (it & 3), tid);
        STAMP(21);
        for (int it = bx; it < NB * 64; it += G) lru_item(args, lds, false, it >> 6, ((it & 7) << 1) | ((it >> 5) & 1), (it >> 3) & 3, tid, lane, wave);
        STAMP(22);
        if (BOTH(4)) GRID_BAR();
        STAMP(4);
    }
    if (IN(5)) {
        pg8::Gemm g{(const bf16_t*)(ws + WS_GS5), (const bf16_t*)(ws + WS_WGLU), DH, DH}; pg8::PanelOrder S; S.init(DH / 256, DH / 64, DH / 64, G, bx);
        pg8::EpiGlu E{(const bf16_t*)(ws + WS_GS5), args.in[I_BGLU], MRG, ssq_s5};
        pg8::gemm_phase(lds, g, S, E);
        if (bx >= 132) {
            conv_tasks(args, lds + wave * STG_BYTES, 5, 5, (bx - 132) * NWAVES + wave, (G - 132) * NWAVES, lane);
            __syncthreads();
            for (int it = bx - 132; it < 256; it += G - 132) lru_item(args, lds, true, it & 3, it >> 4, (it >> 2) & 3, tid, lane, wave);
        }
        if (BOTH(5)) GRID_BAR();
        STAMP(5);
    }
    if (IN(6)) {
        pg8::Gemm g{MRG, (const bf16_t*)(ws + WS_WOUT), D, D}; pg8::PanelOrder S; S.init(D / 256, D / 64, D / 64, G, bx); S.nExtra = 0;
        pg8::EpiOut E{ssq_s5, ssq_lru, XB, ssq2, nullptr};
        pg8::gemm_phase(lds, g, S, E);
        if (BOTH(6)) GRID_BAR();
        STAMP(6);
    }
    if (IN(7)) {
        constexpr int GG7 = 242;
        if (bx >= GG7) {
            pg8::Gemm g{MRG, (const bf16_t*)(ws + WS_WOUT), D, D}; pg8::PanelOrder S; S.init(D / 256, D / 64, D / 64, 8, bx - GG7); S.nwgP = 0;
            pg8::EpiOut E{ssq_s5, ssq_lru, XB, ssq2, nullptr};
            pg8::gemm_phase(lds, g, S, E);
            if (bx - GG7 < 8) { asm volatile("s_waitcnt vmcnt(0)" ::: "memory"); __syncthreads();
                if (tid == 0) { __builtin_amdgcn_fence(__ATOMIC_RELEASE, "agent"); asm volatile("s_waitcnt vmcnt(0)" ::: "memory"); __hip_atomic_fetch_add(cnt_fin5, 1u, __ATOMIC_RELAXED, __HIP_MEMORY_SCOPE_AGENT); } }
        }
        if (bx < GG7) {
            pg8::Gemm g{XB, (const bf16_t*)(ws + WS_W13B), D, D}; pg8::PanelOrder S; S.init(2 * FF / 256, D / 64, D / 64, GG7, bx); S.ready = cnt_fin5; S.need = 8;
            pg8::EpiSwiGLU E{HID, ssq2};
            pg8::gemm_phase(lds, g, S, E);
        } else conv_tasks(args, lds + wave * STG_BYTES, 8, 8, (bx - GG7) * NWAVES + wave, (G - GG7) * NWAVES, lane);
        if (BOTH(7)) GRID_BAR();
        STAMP(7);
    }
    if (IN(8)) {
        pg8::Gemm g{HID, (const bf16_t*)(ws + WS_W2B), FF, FF}; pg8::PanelOrder S; S.init(D / 256, FF / 64, 8, G, bx);
        pg8::EpiFinal E{XB, ssq3, SLAB};
        pg8::gemm_phase(lds, g, S, E);
        if (BOTH(8)) GRID_BAR();
        STAMP(8);
    }
    if (IN(9)) {
        const f32x4* gf = (const f32x4*)args.in[I_GFINAL] + lane;
        if (gws < MS) {
            const int row = MP + gws; f32x4 v[8]; float sq = 0.f;
#pragma unroll
            for (int j = 0; j < 8; ++j) { f32x4 t = (f32x4){0.f, 0.f, 0.f, 0.f};
#pragma unroll
                for (int sl = 0; sl < 11; ++sl) t += ((const f32x4*)(SLAB + ((size_t)sl * MS + gws) * D) + lane)[64 * j];
                const u32x2 xw = ((const u32x2*)(XB + (size_t)row * D) + lane)[64 * j];
                v[j] = (f32x4){bf_lo(xw.x), bf_hi(xw.x), bf_lo(xw.y), bf_hi(xw.y)} + 0.5f * t; sq += dot4(v[j]); }
            const float r = rsqrtf(wave_sum(sq) * (1.0f / D) + EPS);
#pragma unroll
            for (int j = 0; j < 8; ++j) ((f32x4*)(args.out + (size_t)row * D) + lane)[64 * j] = v[j] * gf[64 * j] * r;
        }
        const int gw = bx * NWAVES + wave, NGW = G * NWAVES;
        for (int m = gw; m < MP; m += NGW) {
            const float r = rsqrtf(ssq3[m] * (1.0f / D) + EPS);
            const u32x4* xb = (const u32x4*)(XB + (size_t)m * D) + lane;
            f32x4* o = (f32x4*)(args.out + (size_t)m * D) + 2 * lane;
            const f32x4* g2 = (const f32x4*)args.in[I_GFINAL] + 2 * lane;
            u32x4 w[4];
#pragma unroll
            for (int j = 0; j < 4; ++j) w[j] = xb[64 * j];
#pragma unroll
            for (int j = 0; j < 4; ++j) { o[128 * j] = pg8::res_lo(w[j]) * g2[128 * j] * r; o[128 * j + 1] = pg8::res_hi(w[j]) * g2[128 * j + 1] * r; }
        }
    }
    if (PROBE_PHASE >= 0 && bx == 0 && tid == 0) {
        STAMP(9);
        const unsigned long long t0_ = __builtin_amdgcn_s_memrealtime(), d_ = 4ull * MISC[18];
        while (__builtin_amdgcn_s_memrealtime() - t0_ < d_) __builtin_amdgcn_s_sleep(8);
    }
#undef IN
#undef BOTH
#undef GRID_BAR
}

extern "C" void kernel_launch(void* const* d_in, const int* in_sizes, int n_in, void* d_out, int out_size, void* d_ws, size_t ws_size, hipStream_t stream) {
    static int grid = 0;
    if (grid == 0) {
        if (n_in != N_IN || in_sizes[0] != MP * D || (size_t)out_size != O_END || ws_size < WS_END) {
            fprintf(stderr, "kernel_launch: unexpected problem: n_in %d in0 %d out %d ws %zu (need %zu)\n", n_in, n_in > 0 ? in_sizes[0] : -1, out_size, ws_size, (size_t)WS_END); grid = -1; return; }
        int dev = 0, cus = 0;
        if (hipGetDevice(&dev) != hipSuccess || hipDeviceGetAttribute(&cus, hipDeviceAttributeMultiprocessorCount, dev) != hipSuccess) { grid = -1; return; }
        if (hipFuncSetAttribute((const void*)hymba_fwd, hipFuncAttributeMaxDynamicSharedMemorySize, LDS_BYTES) != hipSuccess) { fprintf(stderr, "kernel_launch: hipFuncSetAttribute failed\n"); grid = -1; return; }
        int per_cu = 0;
        if (hipOccupancyMaxActiveBlocksPerMultiprocessor(&per_cu, (const void*)hymba_fwd, NWAVES * 64, LDS_BYTES) != hipSuccess || per_cu < 1)
            fprintf(stderr, "kernel_launch: note: occupancy query reports %d workgroups per CU\n", per_cu);
        (void)hipGetLastError();
        grid = cus;
    }
    if (grid < 0) return;
    if (hipMemsetAsync((char*)d_ws + WS_CTL, 0, CTL_ZERO_BYTES, stream) != hipSuccess) { fprintf(stderr, "kernel_launch: memset failed\n"); return; }
    Args a{};
    for (int i = 0; i < N_IN; ++i) a.in[i] = (const float*)d_in[i];
    a.out = (float*)d_out; a.ws = (unsigned char*)d_ws;
    if (MK_N_LAUNCHES == 1) {
        a.ph_lo = 0; a.ph_hi = NPHASE;
        hipLaunchKernelGGL(hymba_fwd, dim3(grid), dim3(NWAVES * 64), LDS_BYTES, stream, a);
    } else {
        for (int p = 0; p < NPHASE; ++p) { a.ph_lo = p; a.ph_hi = p + 1; hipLaunchKernelGGL(hymba_fwd, dim3(grid), dim3(NWAVES * 64), LDS_BYTES, stream, a); }
    }
}
```

```cpp
#include <hip/hip_runtime.h>
#include <cstdio>
#include <cstdint>

#define LAS __attribute__((address_space(3)))
#define GAS __attribute__((address_space(1)))
typedef unsigned short bf16_t;
typedef short bf16x8 __attribute__((ext_vector_type(8)));
typedef float f32x4 __attribute__((ext_vector_type(4)));
typedef float f32x16 __attribute__((ext_vector_type(16)));
typedef unsigned u32x4 __attribute__((ext_vector_type(4)));
typedef unsigned u32x2 __attribute__((ext_vector_type(2)));

#ifndef PROBE_PHASE
#define PROBE_PHASE -1
#endif
#ifndef MK_N_LAUNCHES
#define MK_N_LAUNCHES 1
#endif

constexpr int D = 2048, FF = 5632, DIN = 3072, DH = 1024;
constexpr int MP = 8192, MS = 128, M = MP + MS, MPAD = 8448;
constexpr int SEQ = 2048, NB = 4, NG = 64, NP = 64, GS = 16;
constexpr float EPS = 1e-6f;
constexpr int NPHASE = 10;
constexpr int NMP = MP / 256;
constexpr int NWAVES = 8;

constexpr size_t MiB = 1u << 20;
constexpr size_t WS_CTL = 0, CTL_ZERO_BYTES = 1 * MiB;
constexpr size_t WS_W13A = 1 * MiB, WS_W2A = 45 * MiB, WS_WIN = 67 * MiB, WS_WGLU = 79 * MiB, WS_WOUT = 81 * MiB, WS_W13B = 89 * MiB, WS_W2B = 133 * MiB;
constexpr size_t WS_S5M = 155 * MiB, WS_S5AUX = 171 * MiB;
constexpr size_t WS_XB = 172 * MiB;
constexpr size_t WS_X1 = 205 * MiB;
constexpr size_t WS_GS5 = WS_X1;
constexpr size_t WS_H = 271 * MiB;
constexpr size_t WS_U = 271 * MiB, WS_XLRU = WS_U + (size_t)MPAD * DH * 2, WS_GG = WS_XLRU + (size_t)MPAD * DH * 4, WS_MRG = WS_GG + (size_t)MPAD * DH * 2;
constexpr size_t WS_SLAB = 362 * MiB;
constexpr size_t WS_END = 373 * MiB;
static_assert(WS_MRG + (size_t)MPAD * D * 2 <= WS_END && WS_H + (size_t)MPAD * FF * 2 <= WS_SLAB && WS_SLAB + (size_t)11 * MS * D * 4 <= WS_END, "ws map");
constexpr int S5M_GROUP_BYTES = 256 * 1024;
constexpr int S5AUX_GROUP_FLOATS = 2304;
constexpr int CW_BAR = 4096;
constexpr int CW_CNT = 8192;
constexpr size_t CTL_SSQ_BYTE = 262144;

constexpr int RING_BYTES = 139264;
constexpr int LDSCTL_OFF = RING_BYTES, MISC_OFF = LDSCTL_OFF + 320;
constexpr int LDS_BYTES = 147456;

__device__ __forceinline__ unsigned cvt_pk_bf16(float lo, float hi) { unsigned r; asm volatile("v_cvt_pk_bf16_f32 %0, %1, %2" : "=v"(r) : "v"(lo), "v"(hi)); return r; }
__device__ __forceinline__ float bf_lo(unsigned w) { return __uint_as_float(w << 16); }
__device__ __forceinline__ float bf_hi(unsigned w) { return __uint_as_float(w & 0xffff0000u); }
__device__ __forceinline__ float fexp(float x) { return __builtin_amdgcn_exp2f(x * 1.44269504089f); }
__device__ __forceinline__ float fsigmoid(float x) { return __builtin_amdgcn_rcpf(1.0f + fexp(-x)); }
__device__ __forceinline__ float fsilu(float x) { return x * fsigmoid(x); }
__device__ __forceinline__ float fgelu(float x) { return x * fsigmoid(1.5957691216057308f * (x + 0.044715f * x * x * x)); }
__device__ __forceinline__ u32x4 pack8(const f32x4 a, const f32x4 b) { u32x4 w; w.x = cvt_pk_bf16(a[0], a[1]); w.y = cvt_pk_bf16(a[2], a[3]); w.z = cvt_pk_bf16(b[0], b[1]); w.w = cvt_pk_bf16(b[2], b[3]); return w; }
__device__ __forceinline__ float dot4(const f32x4 a) { return (a[0] * a[0] + a[1] * a[1]) + (a[2] * a[2] + a[3] * a[3]); }
__device__ __forceinline__ float wave_sum(float v) {
#pragma unroll
    for (int o = 1; o < 64; o <<= 1) v += __shfl_xor(v, o);
    return v;
}
__device__ __forceinline__ float neg_expm1(float x) {
    float p = 1.0f / 5040.0f; p = fmaf(p, x, 1.0f / 720.0f); p = fmaf(p, x, 1.0f / 120.0f); p = fmaf(p, x, 1.0f / 24.0f); p = fmaf(p, x, 1.0f / 6.0f); p = fmaf(p, x, 0.5f); p = fmaf(p, x, 1.0f);
    const float small = -(p * x), big = 1.0f - fexp(x);
    return x > -0.35f ? small : big;
}
#define LDS_WAIT() asm volatile("s_waitcnt lgkmcnt(0)" ::: "memory")
#define VM_WAIT() asm volatile("s_waitcnt vmcnt(0)" ::: "memory")

namespace pg8 {
constexpr int BM = 256, BK = 64, HALF = 128, HTB = HALF * BK * 2, STAGE_BYTES = 8 * HTB, NXCD = 8, WGM = 8;
__host__ __device__ __forceinline__ int lds_byte(int r, int c) { const int st = (r >> 4) * 2 + (c >> 5), rr = r & 15, cc = c & 31, ob = rr * 64 + cc * 2; return st * 1024 + (ob ^ (((ob >> 9) & 1) << 5)); }
__host__ __device__ __forceinline__ void stage_rc(int b, int& R, int& C) { const int st = b / 1024, sb = b % 1024, swz = sb ^ (((sb >> 9) & 1) << 5); R = (st >> 1) * 16 + swz / 64; C = (st & 1) * 32 + (swz % 64) / 2; }
__host__ __device__ __forceinline__ int perm32(int rho) { const int n = rho >> 4, i = rho & 15; return 8 * (i >> 2) + 4 * n + (i & 3); }

struct Unit { int pm, pn, kt0, nkt; };
struct Gemm { const bf16_t* A; const bf16_t* Bt; int lda, ldb; };

struct PanelOrder {
    int nN, nwgP, G, c, nktFull, sliceKt, nExtra; bool extraFirst;
    unsigned* ready; unsigned need;
    __device__ void init(int nN_, int nktFull_, int sliceKt_, int G_, int c_) { nN = nN_; nwgP = 32 * nN_; G = G_; c = c_; nktFull = nktFull_; sliceKt = sliceKt_; nExtra = nN_ * (nktFull_ / sliceKt_); ready = nullptr; need = 0u; extraFirst = false; }
    __device__ __forceinline__ void a_ready(const Unit& u) const {
        if (ready == nullptr || u.pm != 32) return;
        if (threadIdx.x < 64) {
            unsigned polls = 0;
            while ((unsigned)__builtin_amdgcn_readfirstlane(__hip_atomic_load(ready, __ATOMIC_RELAXED, __HIP_MEMORY_SCOPE_AGENT)) < need) { __builtin_amdgcn_s_sleep(2); if (++polls > (1u << 22)) break; }
            __builtin_amdgcn_fence(__ATOMIC_ACQUIRE, "agent");
            asm volatile("s_waitcnt vmcnt(0)" ::: "memory");
        }
        asm volatile("" ::: "memory"); __builtin_amdgcn_s_barrier(); asm volatile("" ::: "memory");
    }
    __device__ bool next(int i, Unit& u) const {
        if (extraFirst) {
            const int ne = c < nExtra ? 1 : 0;
            if (i < ne) { u.pm = 32; u.pn = c % nN; u.kt0 = (c / nN) * sliceKt; u.nkt = sliceKt; return true; }
            i -= ne;
            if ((long)i * G + c >= nwgP) return false;
        }
        const long L = (long)i * G + c;
        if (L < nwgP) {
            int wgid = (int)L; { const int q = nwgP / NXCD, r = nwgP % NXCD, xcd = wgid % NXCD, off = wgid / NXCD; wgid = (xcd < r ? xcd * (q + 1) : r * (q + 1) + (xcd - r) * q) + off; }
            const int nig = WGM * nN, gid = wgid / nig, fm = gid * WGM, gsz = (32 - fm) < WGM ? (32 - fm) : WGM;
            u.pm = fm + ((wgid % nig) % gsz); u.pn = (wgid % nig) / gsz; u.kt0 = 0; u.nkt = nktFull; return true;
        }
        const int e = (int)(L - nwgP); if (e >= nExtra) return false;
        u.pm = 32; u.pn = e % nN; u.kt0 = (e / nN) * sliceKt; u.nkt = sliceKt; return true;
    }
};

template <class Epi, class Sched>
__device__ __forceinline__ void gemm_phase(LAS unsigned char* lds, const Gemm g, const Sched& S, const Epi& E) {
    const int tid = threadIdx.x, wid = __builtin_amdgcn_readfirstlane(tid >> 6), lane = tid & 63, wr = wid >> 2, wc = wid & 3, fr = lane & 15, fq = lane >> 4;
    unsigned voffA[2], voffB[2];
#pragma unroll
    for (int i = 0; i < 2; ++i) { int R, C; stage_rc(tid * 16 + i * 8192, R, C); const int Rb = Epi::PERM ? ((R & ~31) + perm32(R & 31)) : R;
        voffA[i] = (unsigned)(R * g.lda + C) * 2u; voffB[i] = (unsigned)(Rb * g.ldb + C) * 2u; }
    const size_t kstep = (size_t)(BK * 2);
    const size_t hstepA = (size_t)HALF * g.lda * 2, hstepB = (size_t)HALF * g.ldb * 2;
    const size_t tstepA = 2 * hstepA, tstepB = 2 * hstepB;
    const unsigned ldsw = (unsigned)wid * 1024u;
    const int aoff = lds_byte(wr * 64 + fr, fq * 8), boff = lds_byte(wc * 32 + fr, fq * 8);
#define PG8_SA(b, h) (((b) * 2 + (h)) * HTB)
#define PG8_SB(b, h) ((4 + (b) * 2 + (h)) * HTB)
#define PG8_STAGE(bufoff, gbase, voff) do { _Pragma("unroll") for (int _i = 0; _i < 2; ++_i) \
        __builtin_amdgcn_global_load_lds((const unsigned*)((const char*)(gbase) + (voff)[_i]), (LAS unsigned*)(lds + (bufoff) + ldsw + _i * 8192), 16, 0, 0); } while (0)
#define PG8_LDA(dst, b, h) do { _Pragma("unroll") for (int m = 0; m < 4; ++m) _Pragma("unroll") for (int k = 0; k < 2; ++k) dst[m][k] = *(const LAS bf16x8*)(lds + PG8_SA(b, h) + aoff + m * 2048 + k * 1024); } while (0)
#define PG8_LDB(dst, b, h) do { _Pragma("unroll") for (int n = 0; n < 2; ++n) _Pragma("unroll") for (int k = 0; k < 2; ++k) dst[n][k] = *(const LAS bf16x8*)(lds + PG8_SB(b, h) + boff + n * 2048 + k * 1024); } while (0)
#define PG8_MMA(ai, bj, At, Bt) do { __builtin_amdgcn_s_setprio(1); _Pragma("unroll") for (int m = 0; m < 4; ++m) _Pragma("unroll") for (int n = 0; n < 2; ++n) _Pragma("unroll") for (int k = 0; k < 2; ++k) \
        acc[ai][bj][m][n] = __builtin_amdgcn_mfma_f32_16x16x32_bf16(Bt[n][k], At[m][k], acc[ai][bj][m][n], 0, 0, 0); __builtin_amdgcn_s_setprio(0); } while (0)
#define PG8_WAIT_V(n) asm volatile("s_waitcnt vmcnt(" #n ")" ::: "memory")
#define PG8_WAIT_L(n) asm volatile("s_waitcnt lgkmcnt(" #n ")" ::: "memory")
#define PG8_BAR __builtin_amdgcn_s_barrier()
#define PG8_SCHED __builtin_amdgcn_sched_barrier(0)
    Unit cur, nxt; int ui = 0;
    if (!S.next(0, cur)) return;
    f32x4 acc[2][2][4][2];
#pragma unroll
    for (int a = 0; a < 2; ++a)
#pragma unroll
        for (int b = 0; b < 2; ++b)
#pragma unroll
            for (int m = 0; m < 4; ++m)
#pragma unroll
                for (int n = 0; n < 2; ++n) acc[a][b][m][n] = (f32x4){0.f, 0.f, 0.f, 0.f};
    bf16x8 At[4][2], B0[2][2], B1[2][2];
    const char* cA = (const char*)g.A + (size_t)cur.pm * tstepA + (size_t)cur.kt0 * kstep;
    const char* cB = (const char*)g.Bt + (size_t)cur.pn * tstepB + (size_t)cur.kt0 * kstep;
    S.a_ready(cur);
    PG8_STAGE(PG8_SB(0, 0), cB, voffB); PG8_STAGE(PG8_SB(0, 1), cB + hstepB, voffB); PG8_STAGE(PG8_SA(0, 0), cA, voffA); PG8_STAGE(PG8_SA(0, 1), cA + hstepA, voffA);
    if (wr == 1) PG8_BAR;
    PG8_WAIT_V(2); PG8_BAR;
    PG8_STAGE(PG8_SB(1, 0), cB + kstep, voffB); PG8_STAGE(PG8_SA(1, 0), cA + kstep, voffA); PG8_STAGE(PG8_SB(1, 1), cB + hstepB + kstep, voffB);
    PG8_WAIT_V(6); PG8_BAR;
    for (;;) {
        const bool has_next = S.next(ui + 1, nxt);
        const char* nA = has_next ? (const char*)g.A + (size_t)nxt.pm * tstepA + (size_t)nxt.kt0 * kstep : cA;
        const char* nB = has_next ? (const char*)g.Bt + (size_t)nxt.pn * tstepB + (size_t)nxt.kt0 * kstep : cB;
        const int nt = cur.nkt;
        if (cur.pm != 32) {
        for (int t = 0; t < nt; t += 2) {
            const bool last = (t == nt - 2);
            if (last && has_next) S.a_ready(nxt);
            const char* a1 = cA + (size_t)(t + 1) * kstep;
            const char* a2 = last ? nA : cA + (size_t)(t + 2) * kstep; const char* b2 = last ? nB : cB + (size_t)(t + 2) * kstep;
            const char* a3 = a2 + kstep; const char* b3 = b2 + kstep;
            if constexpr (Epi::HAS_MID) { if (t == Epi::MID_T) E.mid(acc, cur, wr, wc, fr, fq); }
            PG8_LDB(B0, 0, 0); PG8_LDB(B1, 0, 1); PG8_SCHED; PG8_LDA(At, 0, 0); PG8_STAGE(PG8_SA(1, 1), a1 + hstepA, voffA);
            PG8_WAIT_V(8); PG8_WAIT_L(0); PG8_BAR; PG8_MMA(0, 0, At, B0); PG8_MMA(0, 1, At, B1); PG8_BAR; PG8_SCHED;
            PG8_LDA(At, 0, 1); PG8_STAGE(PG8_SB(0, 0), b2, voffB); PG8_STAGE(PG8_SB(0, 1), b2 + hstepB, voffB); PG8_STAGE(PG8_SA(0, 0), a2, voffA);
            PG8_WAIT_V(8); PG8_WAIT_L(0); PG8_BAR; PG8_MMA(1, 0, At, B0); PG8_MMA(1, 1, At, B1); PG8_BAR; PG8_SCHED;
            PG8_LDB(B0, 1, 0); PG8_LDB(B1, 1, 1); PG8_SCHED; PG8_LDA(At, 1, 0); PG8_STAGE(PG8_SA(0, 1), a2 + hstepA, voffA);
            PG8_WAIT_V(8); PG8_WAIT_L(0); PG8_BAR; PG8_MMA(0, 0, At, B0); PG8_MMA(0, 1, At, B1); PG8_BAR; PG8_SCHED;
            PG8_LDA(At, 1, 1); PG8_STAGE(PG8_SB(1, 0), b3, voffB); PG8_STAGE(PG8_SB(1, 1), b3 + hstepB, voffB); PG8_STAGE(PG8_SA(1, 0), a3, voffA);
            PG8_WAIT_V(8); PG8_WAIT_L(0); PG8_BAR; PG8_MMA(1, 0, At, B0); PG8_MMA(1, 1, At, B1); PG8_BAR; PG8_SCHED;
        }
        } else {
        for (int t = 0; t < nt; t += 2) {
            const bool last = (t == nt - 2);
            if (last && has_next) S.a_ready(nxt);
            const char* a1 = cA + (size_t)(t + 1) * kstep;
            const char* a2 = last ? nA : cA + (size_t)(t + 2) * kstep; const char* b2 = last ? nB : cB + (size_t)(t + 2) * kstep;
            const char* a3 = a2 + kstep; const char* b3 = b2 + kstep;
            if constexpr (Epi::HAS_MID) { if (t == Epi::MID_T) E.mid(acc, cur, wr, wc, fr, fq); }
            PG8_LDB(B0, 0, 0); PG8_LDB(B1, 0, 1); PG8_SCHED; PG8_LDA(At, 0, 0); PG8_STAGE(PG8_SA(1, 1), a1 + hstepA, voffA);
            PG8_WAIT_V(8); PG8_WAIT_L(0); PG8_BAR; PG8_MMA(0, 0, At, B0); PG8_MMA(0, 1, At, B1); PG8_BAR; PG8_SCHED;
            PG8_LDA(At, 0, 1); PG8_STAGE(PG8_SB(0, 0), b2, voffB); PG8_STAGE(PG8_SB(0, 1), b2 + hstepB, voffB); PG8_STAGE(PG8_SA(0, 0), a2, voffA);
            PG8_WAIT_V(8); PG8_WAIT_L(0); PG8_BAR; PG8_BAR; PG8_SCHED;
            PG8_LDB(B0, 1, 0); PG8_LDB(B1, 1, 1); PG8_SCHED; PG8_LDA(At, 1, 0); PG8_STAGE(PG8_SA(0, 1), a2 + hstepA, voffA);
            PG8_WAIT_V(8); PG8_WAIT_L(0); PG8_BAR; PG8_MMA(0, 0, At, B0); PG8_MMA(0, 1, At, B1); PG8_BAR; PG8_SCHED;
            PG8_LDA(At, 1, 1); PG8_STAGE(PG8_SB(1, 0), b3, voffB); PG8_STAGE(PG8_SB(1, 1), b3 + hstepB, voffB); PG8_STAGE(PG8_SA(1, 0), a3, voffA);
            PG8_WAIT_V(8); PG8_WAIT_L(0); PG8_BAR; PG8_BAR; PG8_SCHED;
        }
        }
        if (wr == 0) PG8_BAR;
        E(acc, cur, wr, wc, fr, fq);
        if (!has_next) break;
#pragma unroll
        for (int a = 0; a < 2; ++a)
#pragma unroll
            for (int b = 0; b < 2; ++b)
#pragma unroll
                for (int m = 0; m < 4; ++m)
#pragma unroll
                    for (int n = 0; n < 2; ++n) acc[a][b][m][n] = (f32x4){0.f, 0.f, 0.f, 0.f};
        cur = nxt; cA = nA; cB = nB; ++ui;
        if (wr == 1) PG8_BAR;
    }
    PG8_WAIT_V(0);
    PG8_BAR;
    if constexpr (Epi::HAS_FIN) E.fin(acc, cur, wr, wc, fr, fq);
#undef PG8_SA
#undef PG8_SB
#undef PG8_STAGE
#undef PG8_LDA
#undef PG8_LDB
#undef PG8_MMA
#undef PG8_WAIT_V
#undef PG8_WAIT_L
#undef PG8_BAR
#undef PG8_SCHED
}


typedef f32x4 Acc[2][2][4][2];
__device__ __forceinline__ void slab_store(const Acc& acc, const Unit& u, float* slab, int wr, int wc, int fr, int fq) {
    int rowl = wr * 64 + fr, col0 = u.pn * BM + wc * 32 + 8 * fq; asm volatile("" : "+v"(rowl), "+v"(col0));
    float* base = slab + (size_t)(u.kt0 / u.nkt) * ((size_t)MS * D);
#pragma unroll
    for (int m = 0; m < 4; ++m)
#pragma unroll
        for (int bj = 0; bj < 2; ++bj) { float* p = base + (size_t)(rowl + m * 16) * D + col0 + bj * HALF; *(f32x4*)p = acc[0][bj][m][0]; *(f32x4*)(p + 4) = acc[0][bj][m][1]; }
}
struct EpiSwiGLU {
    static constexpr bool PERM = true, HAS_MID = false, HAS_FIN = false; static constexpr int MID_T = -1;
    bf16_t* O; const float* ssq;
    __device__ __forceinline__ void mid(Acc&, const Unit&, int, int, int, int) const {}
    __device__ __forceinline__ void operator()(const Acc& acc, const Unit& u, int wr, int wc, int fr, int fq) const {
        int row0 = u.pm * BM + wr * 64 + fr, colh = u.pn * 128 + wc * 32 + 8 * fq; asm volatile("" : "+v"(row0), "+v"(colh));
        float sq[2][4];
#pragma unroll
        for (int ai = 0; ai < 2; ++ai)
#pragma unroll
            for (int m = 0; m < 4; ++m) sq[ai][m] = ssq[row0 + ai * HALF + m * 16];
        asm volatile("" ::: "memory");
#pragma unroll
        for (int ai = 0; ai < 2; ++ai)
#pragma unroll
            for (int m = 0; m < 4; ++m) {
                const int row = row0 + ai * HALF + m * 16;
                const float r = rsqrtf(sq[ai][m] * (1.0f / D) + EPS);
                f32x4 h0, h1;
#pragma unroll
                for (int j = 0; j < 4; ++j) { h0[j] = fsilu(acc[ai][0][m][0][j] * r) * (acc[ai][1][m][0][j] * r); h1[j] = fsilu(acc[ai][0][m][1][j] * r) * (acc[ai][1][m][1][j] * r); }
                *(u32x4*)(O + (size_t)row * FF + colh) = pack8(h0, h1);
            }
    }
};
typedef u32x4 ResTile[2][4][2];
typedef u32x4 ResHalf[4][2];
__device__ __forceinline__ void res_load(ResTile& res, const bf16_t* XB, int row0, int col0) {
#pragma unroll
    for (int ai = 0; ai < 2; ++ai)
#pragma unroll
        for (int m = 0; m < 4; ++m)
#pragma unroll
            for (int bj = 0; bj < 2; ++bj) res[ai][m][bj] = *(const u32x4*)(XB + (size_t)(row0 + ai * HALF + m * 16) * D + col0 + bj * HALF);
    asm volatile("" ::: "memory");
}
__device__ __forceinline__ void res_load_half(ResHalf& res, const bf16_t* XB, int rowh, int col0) {
#pragma unroll
    for (int m = 0; m < 4; ++m)
#pragma unroll
        for (int bj = 0; bj < 2; ++bj) res[m][bj] = *(const u32x4*)(XB + (size_t)(rowh + m * 16) * D + col0 + bj * HALF);
    asm volatile("" ::: "memory");
}
__device__ __forceinline__ f32x4 res_lo(const u32x4 w) { return (f32x4){bf_lo(w.x), bf_hi(w.x), bf_lo(w.y), bf_hi(w.y)}; }
__device__ __forceinline__ f32x4 res_hi(const u32x4 w) { return (f32x4){bf_lo(w.z), bf_hi(w.z), bf_lo(w.w), bf_hi(w.w)}; }
struct EpiResid {
    static constexpr bool PERM = true, HAS_MID = false, HAS_FIN = false; static constexpr int MID_T = -1;
    float* slab; bf16_t* XB; float* ssq;
    __device__ __forceinline__ void mid(Acc&, const Unit&, int, int, int, int) const {}
    __device__ __forceinline__ void operator()(const Acc& acc, const Unit& u, int wr, int wc, int fr, int fq) const {
        if (u.pm == 32) { slab_store(acc, u, slab, wr, wc, fr, fq); return; }
        int row0 = u.pm * BM + wr * 64 + fr, col0 = u.pn * BM + wc * 32 + 8 * fq; asm volatile("" : "+v"(row0), "+v"(col0));
#pragma unroll
        for (int ai = 0; ai < 2; ++ai) {
            ResHalf res; res_load_half(res, XB, row0 + ai * HALF, col0);
#pragma unroll
            for (int m = 0; m < 4; ++m) {
                const int row = row0 + ai * HALF + m * 16;
                float s = 0.f;
#pragma unroll
                for (int bj = 0; bj < 2; ++bj) {
                    const f32x4 v0 = res_lo(res[m][bj]) + 0.5f * acc[ai][bj][m][0], v1 = res_hi(res[m][bj]) + 0.5f * acc[ai][bj][m][1];
                    *(u32x4*)(XB + (size_t)row * D + col0 + bj * HALF) = pack8(v0, v1);
                    s += dot4(v0) + dot4(v1);
                }
                s += __shfl_xor(s, 16); s += __shfl_xor(s, 32);
                if (fq == 0) atomicAdd(ssq + row, s);
            }
        }
    }
};
struct EpiProj {
    static constexpr bool PERM = true, HAS_MID = false, HAS_FIN = false; static constexpr int MID_T = -1;
    bf16_t* U; float* XL; bf16_t* GG; const float* ssq;
    __device__ __forceinline__ void mid(Acc&, const Unit&, int, int, int, int) const {}
    __device__ __forceinline__ void operator()(const Acc& acc, const Unit& u, int wr, int wc, int fr, int fq) const {
        int row0 = u.pm * BM + wr * 64 + fr, col0 = (u.pn & 3) * BM + wc * 32 + 8 * fq; const int seg = u.pn >> 2; asm volatile("" : "+v"(row0), "+v"(col0));
        float sq[2][4];
#pragma unroll
        for (int ai = 0; ai < 2; ++ai)
#pragma unroll
            for (int m = 0; m < 4; ++m) sq[ai][m] = ssq[row0 + ai * HALF + m * 16];
        asm volatile("" ::: "memory");
#pragma unroll
        for (int ai = 0; ai < 2; ++ai)
#pragma unroll
            for (int m = 0; m < 4; ++m) {
                const int row = row0 + ai * HALF + m * 16;
                const float r = rsqrtf(sq[ai][m] * (1.0f / D) + EPS);
#pragma unroll
                for (int bj = 0; bj < 2; ++bj) {
                    const size_t o = (size_t)row * DH + col0 + bj * HALF;
                    f32x4 v0 = acc[ai][bj][m][0] * r, v1 = acc[ai][bj][m][1] * r;
                    if (seg == 0) { *(u32x4*)(U + o) = pack8(v0, v1); }
                    else if (seg == 1) { *(f32x4*)(XL + o) = v0; *(f32x4*)(XL + o + 4) = v1; }
                    else {
#pragma unroll
                        for (int j = 0; j < 4; ++j) { v0[j] = fgelu(v0[j]); v1[j] = fgelu(v1[j]); }
                        *(u32x4*)(GG + o) = pack8(v0, v1);
                    }
                }
            }
    }
};
struct EpiGlu {
    static constexpr bool PERM = true, HAS_MID = false, HAS_FIN = false; static constexpr int MID_T = -1;
    const bf16_t* GS; const float* bias; bf16_t* MRG; float* ssq;
    __device__ __forceinline__ void mid(Acc&, const Unit&, int, int, int, int) const {}
    __device__ __forceinline__ void operator()(const Acc& acc, const Unit& u, int wr, int wc, int fr, int fq) const {
        int row0 = u.pm * BM + wr * 64 + fr, col0 = u.pn * BM + wc * 32 + 8 * fq; asm volatile("" : "+v"(row0), "+v"(col0));
        ResTile gt;
#pragma unroll
        for (int ai = 0; ai < 2; ++ai)
#pragma unroll
            for (int m = 0; m < 4; ++m)
#pragma unroll
                for (int bj = 0; bj < 2; ++bj) gt[ai][m][bj] = *(const u32x4*)(GS + (size_t)(row0 + ai * HALF + m * 16) * DH + col0 + bj * HALF);
        f32x4 bb[2][2];
#pragma unroll
        for (int bj = 0; bj < 2; ++bj) { bb[bj][0] = *(const f32x4*)(bias + col0 + bj * HALF); bb[bj][1] = *(const f32x4*)(bias + col0 + bj * HALF + 4); }
        asm volatile("" ::: "memory");
#pragma unroll
        for (int ai = 0; ai < 2; ++ai)
#pragma unroll
            for (int m = 0; m < 4; ++m) {
                const int row = row0 + ai * HALF + m * 16;
                float s = 0.f;
#pragma unroll
                for (int bj = 0; bj < 2; ++bj) {
                    const f32x4 g0 = res_lo(gt[ai][m][bj]), g1 = res_hi(gt[ai][m][bj]);
                    f32x4 v0, v1;
#pragma unroll
                    for (int j = 0; j < 4; ++j) { v0[j] = g0[j] * fsigmoid(acc[ai][bj][m][0][j] + bb[bj][0][j]); v1[j] = g1[j] * fsigmoid(acc[ai][bj][m][1][j] + bb[bj][1][j]); }
                    *(u32x4*)(MRG + (size_t)row * D + col0 + bj * HALF) = pack8(v0, v1);
                    s += dot4(v0) + dot4(v1);
                }
                s += __shfl_xor(s, 16); s += __shfl_xor(s, 32);
                if (fq == 0) atomicAdd(ssq + row, s);
            }
    }
};
struct EpiOut {
    static constexpr bool PERM = true, HAS_MID = true, HAS_FIN = false; static constexpr int MID_T = 16;
    const float* ssq_s5; const float* ssq_lru; bf16_t* XB; float* ssq; float* slab;
    __device__ __forceinline__ void mid(Acc& acc, const Unit& u, int wr, int wc, int fr, int fq) const {
        if (u.pm == 32 && slab) return;
        int row0 = u.pm * BM + wr * 64 + fr; asm volatile("" : "+v"(row0));
        float f[2][4];
#pragma unroll
        for (int ai = 0; ai < 2; ++ai)
#pragma unroll
            for (int m = 0; m < 4; ++m) { const int row = row0 + ai * HALF + m * 16; f[ai][m] = rsqrtf(ssq_s5[row] * (1.0f / DH) + EPS) * sqrtf(ssq_lru[row] * (1.0f / DH) + EPS); }
#pragma unroll
        for (int ai = 0; ai < 2; ++ai)
#pragma unroll
            for (int m = 0; m < 4; ++m)
#pragma unroll
                for (int bj = 0; bj < 2; ++bj)
#pragma unroll
                    for (int n = 0; n < 2; ++n) acc[ai][bj][m][n] = acc[ai][bj][m][n] * f[ai][m];
    }
    __device__ __forceinline__ void operator()(const Acc& acc, const Unit& u, int wr, int wc, int fr, int fq) const {
        if (u.pm == 32 && slab) { slab_store(acc, u, slab, wr, wc, fr, fq); return; }
        int row0 = u.pm * BM + wr * 64 + fr, col0 = u.pn * BM + wc * 32 + 8 * fq; asm volatile("" : "+v"(row0), "+v"(col0));
        float rl[2][4];
#pragma unroll
        for (int ai = 0; ai < 2; ++ai)
#pragma unroll
            for (int m = 0; m < 4; ++m) rl[ai][m] = ssq_lru[row0 + ai * HALF + m * 16];
#pragma unroll
        for (int ai = 0; ai < 2; ++ai) {
            ResHalf res; res_load_half(res, XB, row0 + ai * HALF, col0);
#pragma unroll
            for (int m = 0; m < 4; ++m) {
                const int row = row0 + ai * HALF + m * 16;
                const float r = rsqrtf(rl[ai][m] * (1.0f / DH) + EPS);
                float s = 0.f;
#pragma unroll
                for (int bj = 0; bj < 2; ++bj) {
                    const f32x4 v0 = res_lo(res[m][bj]) + r * acc[ai][bj][m][0], v1 = res_hi(res[m][bj]) + r * acc[ai][bj][m][1];
                    *(u32x4*)(XB + (size_t)row * D + col0 + bj * HALF) = pack8(v0, v1);
                    s += dot4(v0) + dot4(v1);
                }
                s += __shfl_xor(s, 16); s += __shfl_xor(s, 32);
                if (fq == 0) atomicAdd(ssq + row, s);
            }
        }
    }
};
struct EpiFinal {
    static constexpr bool PERM = true, HAS_MID = false, HAS_FIN = false; static constexpr int MID_T = -1;
    bf16_t* XB; float* ssq; float* slab;
    __device__ __forceinline__ void mid(Acc&, const Unit&, int, int, int, int) const {}
    __device__ __forceinline__ void operator()(const Acc& acc, const Unit& u, int wr, int wc, int fr, int fq) const {
        if (u.pm == 32) { slab_store(acc, u, slab, wr, wc, fr, fq); return; }
        int row0 = u.pm * BM + wr * 64 + fr, col0 = u.pn * BM + wc * 32 + 8 * fq; asm volatile("" : "+v"(row0), "+v"(col0));
#pragma unroll
        for (int ai = 0; ai < 2; ++ai) {
            ResHalf res; res_load_half(res, XB, row0 + ai * HALF, col0);
#pragma unroll
            for (int m = 0; m < 4; ++m) {
                const int row = row0 + ai * HALF + m * 16;
                float s = 0.f;
#pragma unroll
                for (int bj = 0; bj < 2; ++bj) {
                    const f32x4 v0 = res_lo(res[m][bj]) + 0.5f * acc[ai][bj][m][0], v1 = res_hi(res[m][bj]) + 0.5f * acc[ai][bj][m][1];
                    *(u32x4*)(XB + (size_t)row * D + col0 + bj * HALF) = pack8(v0, v1);
                    s += dot4(v0) + dot4(v1);
                }
                s += __shfl_xor(s, 16); s += __shfl_xor(s, 32);
                if (fq == 0) atomicAdd(ssq + row, s);
            }
        }
    }
};
struct EpiFinalFused {
    static constexpr bool PERM = true, HAS_MID = false, HAS_FIN = false;
    const bf16_t* XB; float* ssq; float* slab; unsigned* cnt_pan; unsigned* cnt_slc; const float* gfin; float* out;
    __device__ __forceinline__ void mid(Acc&, const Unit&, int, int, int, int) const {}
    __device__ __forceinline__ void operator()(const Acc& acc, const Unit& u, int wr, int wc, int fr, int fq) const {
        if (u.pm == 32) {
            slab_store(acc, u, slab, wr, wc, fr, fq);
            asm volatile("s_waitcnt vmcnt(0)" ::: "memory"); __syncthreads();
            if (threadIdx.x == 0) { __builtin_amdgcn_fence(__ATOMIC_RELEASE, "agent"); asm volatile("s_waitcnt vmcnt(0)" ::: "memory"); __hip_atomic_fetch_add(cnt_slc, 1u, __ATOMIC_RELAXED, __HIP_MEMORY_SCOPE_AGENT); }
            return;
        }
        int row0 = u.pm * BM + wr * 64 + fr, col0 = u.pn * BM + wc * 32 + 8 * fq; asm volatile("" : "+v"(row0), "+v"(col0));
        u32x4 xw[2][4][2];
#pragma unroll
        for (int ai = 0; ai < 2; ++ai) {
            ResHalf res; res_load_half(res, XB, row0 + ai * HALF, col0);
#pragma unroll
            for (int m = 0; m < 4; ++m) {
                const int row = row0 + ai * HALF + m * 16;
                float s = 0.f;
#pragma unroll
                for (int bj = 0; bj < 2; ++bj) {
                    const f32x4 v0 = res_lo(res[m][bj]) + 0.5f * acc[ai][bj][m][0], v1 = res_hi(res[m][bj]) + 0.5f * acc[ai][bj][m][1];
                    xw[ai][m][bj] = pack8(v0, v1);
                    s += dot4(v0) + dot4(v1);
                }
                s += __shfl_xor(s, 16); s += __shfl_xor(s, 32);
                if (fq == 0) atomicAdd(ssq + row, s);
            }
        }
        asm volatile("s_waitcnt vmcnt(0)" ::: "memory"); __syncthreads();
        if (threadIdx.x < 64) {
            unsigned* cnt = cnt_pan + 64 * u.pm;
            if (threadIdx.x == 0) { __builtin_amdgcn_fence(__ATOMIC_RELEASE, "agent"); asm volatile("s_waitcnt vmcnt(0)" ::: "memory"); __hip_atomic_fetch_add(cnt, 1u, __ATOMIC_RELAXED, __HIP_MEMORY_SCOPE_AGENT); }
            unsigned polls = 0;
            while ((unsigned)__builtin_amdgcn_readfirstlane(__hip_atomic_load(cnt, __ATOMIC_RELAXED, __HIP_MEMORY_SCOPE_AGENT)) < 8u) { __builtin_amdgcn_s_sleep(2); if (++polls > (1u << 22)) break; }
            __builtin_amdgcn_fence(__ATOMIC_ACQUIRE, "agent");
            asm volatile("s_waitcnt vmcnt(0)" ::: "memory");
        }
        __syncthreads();
        float rs[2][4];
#pragma unroll
        for (int ai = 0; ai < 2; ++ai)
#pragma unroll
            for (int m = 0; m < 4; ++m) rs[ai][m] = __hip_atomic_load(ssq + row0 + ai * HALF + m * 16, __ATOMIC_RELAXED, __HIP_MEMORY_SCOPE_AGENT);
#pragma unroll
        for (int ai = 0; ai < 2; ++ai)
#pragma unroll
            for (int m = 0; m < 4; ++m) rs[ai][m] = rsqrtf(rs[ai][m] * (1.0f / D) + EPS);
#pragma unroll
        for (int bj = 0; bj < 2; ++bj) {
            const f32x4 g0 = *(const f32x4*)(gfin + col0 + bj * HALF), g1 = *(const f32x4*)(gfin + col0 + bj * HALF + 4);
#pragma unroll
            for (int ai = 0; ai < 2; ++ai)
#pragma unroll
                for (int m = 0; m < 4; ++m) {
                    float* p = out + (size_t)(row0 + ai * HALF + m * 16) * D + col0 + bj * HALF;
                    *(f32x4*)p = res_lo(xw[ai][m][bj]) * g0 * rs[ai][m]; *(f32x4*)(p + 4) = res_hi(xw[ai][m][bj]) * g1 * rs[ai][m];
                }
            asm volatile("" ::: "memory");
        }
    }
};
}

#define XB_TMO      128
#define XB_XCNT(j)  (256  + 64 * (j))
#define XB_XSUB(j)  (1280 + 64 * (j))
#define XB_XGEN(j)  (2304 + 64 * (j))
#define XB_TOP      3328
#define XB_TOPGEN   3392
#define XCD_BAR_WORDS 3456
#define XB_SPIN_CAP (1u << 18)
__device__ __forceinline__ unsigned xb_ld(unsigned* p)              { return __hip_atomic_load(p, __ATOMIC_RELAXED, __HIP_MEMORY_SCOPE_AGENT); }
__device__ __forceinline__ unsigned xb_add(unsigned* p, unsigned v) { return __hip_atomic_fetch_add(p, v, __ATOMIC_RELAXED, __HIP_MEMORY_SCOPE_AGENT); }
__device__ __forceinline__ unsigned xb_xcc_id() { return (unsigned)__builtin_amdgcn_s_getreg((3 << 11) | 20) & 0xFu; }
#define XB_SPIN(cond, bar) do { unsigned _sp = 0; while (cond) { __builtin_amdgcn_s_sleep(1); \
    if ((++_sp & 255u) == 0u) { if (xb_ld(&(bar)[XB_TMO])) break; if (_sp > XB_SPIN_CAP) { atomicAdd(&(bar)[XB_TMO], 1u); break; } } } } while (0)
struct XcdBarrier { unsigned* bar; unsigned x; volatile LAS unsigned* st; };
__device__ __forceinline__ XcdBarrier xcd_barrier_post(unsigned* bar, volatile LAS unsigned* st) {
    XcdBarrier b; b.bar = bar; b.x = xb_xcc_id(); b.st = st;
    if (threadIdx.x == 0) (void)xb_add(&bar[XB_XCNT(b.x)], 1u);
    return b;
}
__device__ __forceinline__ void xcd_barrier_complete(unsigned* bar, unsigned x, unsigned& nloc, unsigned& nx) {
    const unsigned G = gridDim.x * gridDim.y * gridDim.z;
    unsigned sum, cnt, mine, sp = 0u;
    for (;;) {
        sum = 0u; cnt = 0u; mine = 0u;
#pragma unroll
        for (unsigned j = 0; j < 16; ++j) { const unsigned c = xb_ld(&bar[XB_XCNT(j)]); sum += c; cnt += (c > 0u) ? 1u : 0u; mine = (j == x) ? c : mine; }
        if (sum == G) break;
        __builtin_amdgcn_s_sleep(1);
        if ((++sp & 255u) == 0u) { if (xb_ld(&bar[XB_TMO])) break; if (sp > XB_SPIN_CAP) { atomicAdd(&bar[XB_TMO], 1u); break; } }
    }
    nloc = mine > 0u ? mine : 1u; nx = cnt > 0u ? cnt : 1u;
}
__device__ __forceinline__ void xcd_barrier(const XcdBarrier& b) {
    asm volatile("s_waitcnt vmcnt(0)" ::: "memory");
    __syncthreads();
    if (threadIdx.x == 0) {
        unsigned* bar = b.bar;
        __builtin_amdgcn_s_waitcnt(0);
        unsigned nloc = b.st[0], nx = b.st[1];
        if (nloc == 0u) { xcd_barrier_complete(bar, b.x, nloc, nx); b.st[0] = nloc; b.st[1] = nx; }
        const unsigned old = xb_add(&bar[XB_XSUB(b.x)], 1u);
        const unsigned gen = old / nloc;
        if (old + 1u == (gen + 1u) * nloc) {
            __builtin_amdgcn_fence(__ATOMIC_RELEASE, "agent");
            asm volatile("s_waitcnt vmcnt(0)" ::: "memory");
            (void)__hip_atomic_fetch_add(&bar[XB_TOP], 1u, __ATOMIC_RELAXED, __HIP_MEMORY_SCOPE_AGENT);
        }
        __builtin_amdgcn_fence(__ATOMIC_ACQUIRE, "agent");
        const unsigned target = (gen + 1u) * nx;
        XB_SPIN(xb_ld(&bar[XB_TOP]) < target, bar);
        asm volatile("s_waitcnt vmcnt(0)" ::: "memory");
    }
    __syncthreads();
}

enum { I_XP = 0, I_XS, I_S5RE, I_S5IM, I_LRUH, I_LRUCONV, I_GFFN1, I_W1A, I_W3A, I_W2A, I_GMIX, I_WIN, I_LAMRE, I_LAMIM, I_LOGDT, I_BRE, I_BIM, I_CRE, I_CIM,
       I_DSKIP, I_WGLU, I_BGLU, I_CONVW, I_CONVB, I_WA, I_BA, I_WX, I_BX, I_LAML, I_GS5, I_GLRU, I_WOUT, I_GFFN2, I_W1B, I_W3B, I_W2B, I_GFINAL, N_IN };
struct Args { const float* in[N_IN]; float* out; unsigned char* ws; int ph_lo, ph_hi; };
constexpr size_t O_Y = 0, O_PS5RE = (size_t)M * D, O_PS5IM = O_PS5RE + NB * NG * NP, O_PLRUH = O_PS5IM + NB * NG * NP, O_PLRUC = O_PLRUH + NB * DH,
                 O_SS5RE = O_PLRUC + NB * 3 * DH, O_SS5IM = O_SS5RE + (size_t)MS * NG * NP, O_SLRUH = O_SS5IM + (size_t)MS * NG * NP, O_SLRUC = O_SLRUH + (size_t)MS * DH,
                 O_END = O_SLRUC + (size_t)MS * 3 * DH;
static_assert(O_END == 18661376, "output size");

typedef float f32x2 __attribute__((ext_vector_type(2)));
constexpr int STG_PITCH = 144, STG_BYTES = 64 * STG_PITCH;
__device__ __forceinline__ void p0_task(const float* W, int N, const float* gk, bf16_t* WT, int ldt, int k0, int n0, int nd0, LAS unsigned char* stg, int lane) {
    const float* src = W + (size_t)k0 * N + n0 + 2 * lane;
    f32x2 v[64];
#if PROBE_PHASE >= 0
    { const float* p = src; const size_t step = (size_t)N;
#pragma unroll
      for (int i = 0; i < 64; ++i) { v[i] = __builtin_nontemporal_load((const f32x2*)p); p += step; if ((i & 7) == 7) asm volatile("" : "+v"(p)); } }
#else
#pragma unroll
    for (int i = 0; i < 64; ++i) v[i] = __builtin_nontemporal_load((const f32x2*)(src + (size_t)i * N));
#endif
    if (gk) {
#pragma unroll
        for (int i = 0; i < 64; ++i) v[i] = v[i] * gk[k0 + i];
    }
#pragma unroll
    for (int j = 0; j < 2; ++j) {
#pragma unroll
        for (int kb = 0; kb < 8; ++kb) {
            u32x4 o; o.x = cvt_pk_bf16(v[8 * kb][j], v[8 * kb + 1][j]); o.y = cvt_pk_bf16(v[8 * kb + 2][j], v[8 * kb + 3][j]); o.z = cvt_pk_bf16(v[8 * kb + 4][j], v[8 * kb + 5][j]); o.w = cvt_pk_bf16(v[8 * kb + 6][j], v[8 * kb + 7][j]);
            *(LAS u32x4*)(stg + lane * STG_PITCH + kb * 16) = o;
        }
        LDS_WAIT(); asm volatile("" ::: "memory");
#pragma unroll
        for (int it = 0; it < 8; ++it) {
            const int rr = 8 * it + (lane >> 3), kb = lane & 7;
            const u32x4 o = *(const LAS u32x4*)(stg + rr * STG_PITCH + kb * 16);
            *(u32x4*)(WT + (size_t)(nd0 + 2 * rr + j) * ldt + k0 + 8 * kb) = o;
        }
        LDS_WAIT(); asm volatile("" ::: "memory");
    }
}
__device__ __forceinline__ void sincos_d(double x, double& s, double& c) {
    const double k = rint(x * 0.63661977236758134308);
    double r = fma(-k, 1.57079632679489655800, x); r = fma(-k, 6.12323399573676603587e-17, r);
    const double r2 = r * r;
    double sp = -7.6471637318198164759e-13; sp = fma(sp, r2, 1.6059043836821614599e-10); sp = fma(sp, r2, -2.5052108385441718775e-8); sp = fma(sp, r2, 2.7557319223985890653e-6);
    sp = fma(sp, r2, -1.9841269841269841270e-4); sp = fma(sp, r2, 8.3333333333333333333e-3); sp = fma(sp, r2, -1.6666666666666666667e-1);
    const double sr = fma(sp * r2, r, r);
    double cp = 4.7794773323873852974e-14; cp = fma(cp, r2, -1.1470745597729724714e-11); cp = fma(cp, r2, 2.0876756987868098979e-9); cp = fma(cp, r2, -2.7557319223985890653e-7);
    cp = fma(cp, r2, 2.4801587301587301587e-5); cp = fma(cp, r2, -1.3888888888888888889e-3); cp = fma(cp, r2, 4.1666666666666666667e-2); cp = fma(cp, r2, -0.5);
    const double cr = fma(cp, r2, 1.0);
    const int q = ((int)k) & 3;
    s = (q == 0) ? sr : (q == 1) ? cr : (q == 2) ? -sr : -cr;
    c = (q == 0) ? cr : (q == 1) ? -sr : (q == 2) ? -cr : sr;
}
__device__ __forceinline__ void p0_s5_group(const Args& a, LAS unsigned char* lds, int g, int tid) {
    LAS float* LPre = (LAS float*)lds;
    LAS float* LPim = LPre + 17 * 64;
    LAS float* BBre = LPim + 17 * 64;
    LAS float* BBim = BBre + 1024;
    LAS float* CRe = BBim + 1024;
    LAS float* CIm = CRe + 1024;
    LAS float* Kt = CIm + 1024;
    LAS float* Kt2 = Kt + 4096;
    LAS float* QQ = Kt2 + 4096;
    const float ldt = a.in[I_LOGDT][g];
    float lre_[3], lim_[3];
#pragma unroll
    for (int i = 0; i < 3; ++i) { const int idx = tid + 512 * i, p = idx & 63; lre_[i] = a.in[I_LAMRE][g * 64 + p]; lim_[i] = a.in[I_LAMIM][g * 64 + p]; }
    float cr_[2], ci_[2], br_[2], bi_[2];
#pragma unroll
    for (int i = 0; i < 2; ++i) { const int idx = tid + 512 * i; cr_[i] = a.in[I_CRE][(size_t)g * 1024 + idx]; ci_[i] = a.in[I_CIM][(size_t)g * 1024 + idx]; br_[i] = a.in[I_BRE][(size_t)g * 1024 + idx]; bi_[i] = a.in[I_BIM][(size_t)g * 1024 + idx]; }
    const float dsk = a.in[I_DSKIP][g * 16 + (tid & 15)];
    const double dt = exp((double)ldt);
#pragma unroll
    for (int i = 0; i < 3; ++i) {
        const int idx = tid + 512 * i;
        if (idx < 17 * 64) {
            const int k = idx >> 6, p = idx & 63;
            const double lre = (double)lre_[i], lim = (double)lim_[i];
            const double mag = exp(lre * dt * (double)k); double sn, cs; sincos_d(lim * dt * (double)k, sn, cs);
            LPre[idx] = (float)(mag * cs); LPim[idx] = (float)(mag * sn);
            if (k == 1) {
                const double nr = mag * cs - 1.0, ni = mag * sn, den = lre * lre + lim * lim;
                QQ[2 * p] = (float)((nr * lre + ni * lim) / den); QQ[2 * p + 1] = (float)((ni * lre - nr * lim) / den);
            }
        }
    }
#pragma unroll
    for (int i = 0; i < 2; ++i) { const int idx = tid + 512 * i; CRe[idx] = cr_[i]; CIm[idx] = ci_[i]; }
    __syncthreads();
#pragma unroll
    for (int i = 0; i < 2; ++i) { const int idx = tid + 512 * i, p = idx >> 4; const float qr = QQ[2 * p], qi = QQ[2 * p + 1];
        BBre[idx] = qr * br_[i] - qi * bi_[i]; BBim[idx] = qr * bi_[i] + qi * br_[i]; }
    __syncthreads();
    {
        const int c = (tid >> 4) & 15, cp = tid & 15, ph = tid >> 8;
        float acc[16];
#pragma unroll
        for (int k = 0; k < 16; ++k) acc[k] = 0.f;
        for (int pp = 0; pp < 32; ++pp) {
            const int p = 32 * ph + pp;
            const float cr = CRe[c * 64 + p], ci = CIm[c * 64 + p], br = BBre[p * 16 + cp], bi = BBim[p * 16 + cp];
            const float gr = cr * br - ci * bi, gi = cr * bi + ci * br;
#pragma unroll
            for (int k = 0; k < 16; ++k) acc[k] += gr * LPre[k * 64 + p] - gi * LPim[k * 64 + p];
        }
        if (ph == 0 && c == cp) acc[0] += dsk;
        LAS float* dst = ph ? Kt2 : Kt;
#pragma unroll
        for (int k = 0; k < 16; ++k) dst[(k * 16 + c) * 16 + cp] = acc[k];
    }
    __syncthreads();
    bf16_t* Win = (bf16_t*)(a.ws + WS_S5M + (size_t)g * S5M_GROUP_BYTES);
    bf16_t* MW = Win + 128 * 256;
    for (int idx = tid; idx < 256 * 48; idx += NWAVES * 64) {
        const int rr = idx / 48, cg = idx % 48, s = rr >> 4, c = rr & 15;
        float v[8];
        if (cg < 32) { const int sp = cg >> 1, c0 = (cg & 1) * 8;
#pragma unroll
            for (int i = 0; i < 8; ++i) { const int o = (((s - sp) & 15) * 16 + c) * 16 + c0 + i; v[i] = (sp <= s) ? Kt[o] + Kt2[o] : 0.f; }
        } else { const int im = cg >= 40, p0 = (cg - (im ? 40 : 32)) * 8;
#pragma unroll
            for (int i = 0; i < 8; ++i) { const int p = p0 + i; const float cr = CRe[c * 64 + p], ci = CIm[c * 64 + p], lr = LPre[(s + 1) * 64 + p], li = LPim[(s + 1) * 64 + p];
                v[i] = im ? -(cr * li + ci * lr) : (cr * lr - ci * li); }
        }
        u32x4 o; o.x = cvt_pk_bf16(v[0], v[1]); o.y = cvt_pk_bf16(v[2], v[3]); o.z = cvt_pk_bf16(v[4], v[5]); o.w = cvt_pk_bf16(v[6], v[7]);
        *(u32x4*)(MW + (size_t)rr * 384 + cg * 8) = o;
    }
    for (int idx = tid; idx < 128 * 32; idx += NWAVES * 64) {
        const int n = idx >> 5, cg = idx & 31, p = n & 63, im = n >> 6, sp = cg >> 1, c0 = (cg & 1) * 8;
        const float lr = LPre[(15 - sp) * 64 + p], li = LPim[(15 - sp) * 64 + p];
        float v[8];
#pragma unroll
        for (int i = 0; i < 8; ++i) { const float br = BBre[p * 16 + c0 + i], bi = BBim[p * 16 + c0 + i]; v[i] = im ? (lr * bi + li * br) : (lr * br - li * bi); }
        u32x4 o; o.x = cvt_pk_bf16(v[0], v[1]); o.y = cvt_pk_bf16(v[2], v[3]); o.z = cvt_pk_bf16(v[4], v[5]); o.w = cvt_pk_bf16(v[6], v[7]);
        *(u32x4*)(Win + (size_t)n * 256 + cg * 8) = o;
    }
    {
        float* aux = (float*)(a.ws + WS_S5AUX) + (size_t)g * S5AUX_GROUP_FLOATS;
        for (int idx = tid; idx < 64; idx += NWAVES * 64) { aux[idx] = LPre[64 + idx]; aux[64 + idx] = LPim[64 + idx]; aux[128 + idx] = LPre[16 * 64 + idx]; aux[192 + idx] = LPim[16 * 64 + idx]; }
        for (int idx = tid; idx < 1024; idx += NWAVES * 64) { aux[256 + idx] = BBre[idx]; aux[1280 + idx] = BBim[idx]; }
    }
    __syncthreads();
}
__device__ __forceinline__ void conv_tasks(const Args& a, LAS unsigned char* stg, int first, int last, int wv, int nwv, int lane) {
    constexpr int T_W1 = (D / 64) * (FF / 128), T_W2 = (FF / 64) * (D / 128), T_IN = (D / 64) * (DIN / 128), T_GLU = (DH / 64) * (DH / 128), T_OUT = (D / 64) * (D / 128);
    const int cnt[9] = {T_W1, T_W1, T_W2, T_IN, T_GLU, T_OUT, T_W1, T_W1, T_W2};
    int NT = 0;
#pragma unroll
    for (int m = 0; m < 9; ++m) if (m >= first && m <= last) NT += cnt[m];
    const int t_lo = (int)(((long)wv * NT) / nwv), t_hi = (int)(((long)(wv + 1) * NT) / nwv);
    unsigned char* ws = a.ws;
    for (int it = t_lo; it < t_hi; ++it) {
        int r = it, mat = first;
#pragma unroll
        for (int m = 0; m < 9; ++m) if (m >= first && m < last && mat == m && r >= cnt[m]) { r -= cnt[m]; mat = m + 1; }
        const float* W; const float* gk = nullptr; bf16_t* WT; int K, N, dual = 0, off = 0;
        switch (mat) {
            case 0: W = a.in[I_W1A]; gk = a.in[I_GFFN1]; WT = (bf16_t*)(ws + WS_W13A); K = D; N = FF; dual = 1; break;
            case 1: W = a.in[I_W3A]; gk = a.in[I_GFFN1]; WT = (bf16_t*)(ws + WS_W13A); K = D; N = FF; dual = 1; off = 128; break;
            case 2: W = a.in[I_W2A]; WT = (bf16_t*)(ws + WS_W2A); K = FF; N = D; break;
            case 3: W = a.in[I_WIN]; gk = a.in[I_GMIX]; WT = (bf16_t*)(ws + WS_WIN); K = D; N = DIN; break;
            case 4: W = a.in[I_WGLU]; WT = (bf16_t*)(ws + WS_WGLU); K = DH; N = DH; break;
            case 5: W = a.in[I_WOUT]; WT = (bf16_t*)(ws + WS_WOUT); K = D; N = D; dual = 2; break;
            case 6: W = a.in[I_W1B]; gk = a.in[I_GFFN2]; WT = (bf16_t*)(ws + WS_W13B); K = D; N = FF; dual = 1; break;
            case 7: W = a.in[I_W3B]; gk = a.in[I_GFFN2]; WT = (bf16_t*)(ws + WS_W13B); K = D; N = FF; dual = 1; off = 128; break;
            default: W = a.in[I_W2B]; WT = (bf16_t*)(ws + WS_W2B); K = FF; N = D; break;
        }
        const int nkb = K / 64, nb = r / nkb, kb = r % nkb, k0 = kb * 64, n0 = nb * 128;
        if (dual == 2) { gk = k0 < DH ? a.in[I_GS5] : a.in[I_GLRU] - DH; dual = 0; }
        p0_task(W, N, gk, WT, K, k0, n0, dual ? (nb * 256 + off) : n0, stg, lane);
    }
}
__device__ __forceinline__ void p0_prologue(const Args& a, LAS unsigned char* lds, int vcu, int G, int lane, int wave) {
    const int gw = vcu * NWAVES + wave, NGW = G * NWAVES;
    unsigned char* ws = a.ws;
    bf16_t* XB = (bf16_t*)(ws + WS_XB); float* ssq0 = (float*)(ws + WS_CTL + CTL_SSQ_BYTE);
    for (int grp = gw; grp < MPAD / 4; grp += NGW) {
        const int m0 = 4 * grp;
        u32x2* o = (u32x2*)(XB + (size_t)m0 * D) + lane;
        if (m0 < M) {
            const float* xr = m0 < MP ? a.in[I_XP] + (size_t)m0 * D : a.in[I_XS] + (size_t)(m0 - MP) * D;
            const f32x4* x4 = (const f32x4*)xr + lane; f32x4 v[4][8];
#pragma unroll
            for (int r = 0; r < 4; ++r)
#pragma unroll
                for (int j = 0; j < 8; ++j) v[r][j] = __builtin_nontemporal_load(x4 + r * (D / 4) + 64 * j);
#pragma unroll
            for (int r = 0; r < 4; ++r) {
                float s = 0.f;
#pragma unroll
                for (int j = 0; j < 8; ++j) s += dot4(v[r][j]);
                s = wave_sum(s);
#pragma unroll
                for (int j = 0; j < 8; ++j) { u32x2 w; w.x = cvt_pk_bf16(v[r][j][0], v[r][j][1]); w.y = cvt_pk_bf16(v[r][j][2], v[r][j][3]); o[r * (D / 4) + 64 * j] = w; }
                if (lane == 0) ssq0[m0 + r] = s;
            }
        } else {
#pragma unroll
            for (int r = 0; r < 4; ++r)
#pragma unroll
                for (int j = 0; j < 8; ++j) o[r * (D / 4) + 64 * j] = (u32x2){0u, 0u};
        }
    }
    conv_tasks(a, lds + wave * STG_BYTES, 0, 3, gw, NGW, lane);
}

#define MFMA32(a, b, c) __builtin_amdgcn_mfma_f32_32x32x16_bf16((a), (b), (c), 0, 0, 0)
constexpr int S5_PITCH = 528;
constexpr int S5_XC_OFF = 0, S5_Z_OFF = 128 * S5_PITCH;
static_assert(2 * 128 * S5_PITCH <= RING_BYTES, "S5 LDS map");
__device__ __forceinline__ void s5_prompt(const Args& a, LAS unsigned char* lds, int b, int g, int tid, int lane, int wave) {
    const bf16_t* U = (const bf16_t*)(a.ws + WS_U);
    const bf16_t* Win = (const bf16_t*)(a.ws + WS_S5M + (size_t)g * S5M_GROUP_BYTES);
    const bf16_t* MW = Win + 128 * 256;
    bf16_t* GS5 = (bf16_t*)(a.ws + WS_GS5);
    LAS unsigned char* XCs = lds + S5_XC_OFF;
    LAS unsigned char* ZS = lds + S5_Z_OFF;
    const int r32 = lane & 31, hh = lane >> 5;
    {
        u32x4 v[8];
#pragma unroll
        for (int i = 0; i < 8; ++i) { const int q = tid + 512 * i, t = q >> 1, half = q & 1; v[i] = *(const u32x4*)(U + (size_t)(b * SEQ + t) * DH + 16 * g + 8 * half); }
#pragma unroll
        for (int i = 0; i < 8; ++i) { const int q = tid + 512 * i, t = q >> 1, half = q & 1; *(LAS u32x4*)(XCs + (t >> 4) * S5_PITCH + (t & 15) * 32 + 16 * half) = v[i]; }
    }
    {
        const int mt = wave & 3, nt0 = (wave >> 2) * 2;
        const bf16_t* w0 = Win + (size_t)(32 * nt0 + r32) * 256 + 8 * hh;
        bf16x8 bw[2][8];
#pragma unroll
        for (int ks = 0; ks < 8; ++ks) { bw[0][ks] = *(const bf16x8*)(w0 + 16 * ks); bw[1][ks] = *(const bf16x8*)(w0 + 32 * 256 + 16 * ks); }
        __syncthreads();
        f32x16 acc0, acc1;
#pragma unroll
        for (int i = 0; i < 16; ++i) { acc0[i] = 0.f; acc1[i] = 0.f; }
        const LAS unsigned char* xa = XCs + (32 * mt + r32) * S5_PITCH + 16 * hh;
#pragma unroll 1
        for (int kh = 0; kh < 2; ++kh) {
#pragma unroll
            for (int ks = 0; ks < 8; ++ks) { const bf16x8 af = *(const LAS bf16x8*)(xa + 32 * (8 * kh + ks)); acc0 = MFMA32(af, bw[0][ks], acc0); acc1 = MFMA32(af, bw[1][ks], acc1); }
            if (kh == 0) {
#pragma unroll
                for (int ks = 0; ks < 8; ++ks) { bw[0][ks] = *(const bf16x8*)(w0 + 128 + 16 * ks); bw[1][ks] = *(const bf16x8*)(w0 + 32 * 256 + 128 + 16 * ks); }
            }
        }
        LAS float* Z = (LAS float*)ZS;
#pragma unroll
        for (int i = 0; i < 16; ++i) { const int j = 32 * mt + (i & 3) + 8 * (i >> 2) + 4 * hh;
            Z[j * (S5_PITCH / 4) + 32 * nt0 + r32] = acc0[i]; Z[j * (S5_PITCH / 4) + 32 * nt0 + 32 + r32] = acc1[i]; }
    }
    __syncthreads();
    if (wave == 0) {
        const float* aux = (const float*)(a.ws + WS_S5AUX) + (size_t)g * S5AUX_GROUP_FLOATS;
        const float l16r = aux[128 + lane], l16i = aux[192 + lane];
        const LAS float* Z = (const LAS float*)ZS;
        float sr = 0.f, si = 0.f;
        for (int jb = 0; jb < 16; ++jb) {
            float zr[8], zi[8];
#pragma unroll
            for (int i = 0; i < 8; ++i) { zr[i] = Z[(8 * jb + i) * (S5_PITCH / 4) + lane]; zi[i] = Z[(8 * jb + i) * (S5_PITCH / 4) + 64 + lane]; }
            LDS_WAIT();
#pragma unroll
            for (int i = 0; i < 8; ++i) {
                const unsigned w = cvt_pk_bf16(sr, si);
                *(LAS unsigned short*)(ZS + (8 * jb + i) * S5_PITCH + 2 * lane) = (unsigned short)(w & 0xffffu);
                *(LAS unsigned short*)(ZS + (8 * jb + i) * S5_PITCH + 128 + 2 * lane) = (unsigned short)(w >> 16);
                const float nr = l16r * sr - l16i * si + zr[i], ni = l16r * si + l16i * sr + zi[i];
                sr = nr; si = ni;
            }
        }
        a.out[O_PS5RE + (size_t)(b * NG + g) * NP + lane] = sr;
        a.out[O_PS5IM + (size_t)(b * NG + g) * NP + lane] = si;
    }
#pragma unroll 1
    for (int pass = 0; pass < 2; ++pass) {
        const int mt = pass ? 7 - wave : wave, n0 = 2 * pass;
        const int nks = 2 * mt + 2;
        const bf16_t* mw = MW + (size_t)(32 * mt + r32) * 384 + 8 * hh;
        bf16x8 am[24];
#pragma unroll
        for (int ks = 0; ks < 16; ++ks) if (ks < nks) am[ks] = *(const bf16x8*)(mw + 16 * ks);
#pragma unroll
        for (int kq = 0; kq < 8; ++kq) am[16 + kq] = *(const bf16x8*)(mw + 256 + 16 * kq);
        if (pass == 0) __syncthreads();
        f32x16 acc[2];
#pragma unroll
        for (int n = 0; n < 2; ++n)
#pragma unroll
            for (int i = 0; i < 16; ++i) acc[n][i] = 0.f;
#pragma unroll
        for (int ks = 0; ks < 16; ++ks) if (ks < nks) {
#pragma unroll
            for (int n = 0; n < 2; ++n) { const bf16x8 bf = *(const LAS bf16x8*)(XCs + (32 * (n0 + n) + r32) * S5_PITCH + 32 * ks + 16 * hh); acc[n] = MFMA32(am[ks], bf, acc[n]); }
        }
#pragma unroll
        for (int kq = 0; kq < 8; ++kq) {
#pragma unroll
            for (int n = 0; n < 2; ++n) { const bf16x8 bf = *(const LAS bf16x8*)(ZS + (32 * (n0 + n) + r32) * S5_PITCH + 32 * kq + 16 * hh); acc[n] = MFMA32(am[16 + kq], bf, acc[n]); }
        }
#pragma unroll
        for (int n = 0; n < 2; ++n)
#pragma unroll
            for (int q = 0; q < 4; ++q) {
                const int s = 2 * mt + (q >> 1), c0 = 8 * (q & 1) + 4 * hh, t = 16 * (32 * (n0 + n) + r32) + s;
                u32x2 w; w.x = cvt_pk_bf16(fgelu(acc[n][4 * q]), fgelu(acc[n][4 * q + 1])); w.y = cvt_pk_bf16(fgelu(acc[n][4 * q + 2]), fgelu(acc[n][4 * q + 3]));
                *(u32x2*)(GS5 + (size_t)(b * SEQ + t) * DH + 16 * g + c0) = w;
            }
    }
    __syncthreads();
}
__device__ __forceinline__ void s5_sample(const Args& a, LAS unsigned char* lds, int g, int bs0, int tid) {
    const bf16_t* U = (const bf16_t*)(a.ws + WS_U);
    bf16_t* GS5 = (bf16_t*)(a.ws + WS_GS5);
    const float* aux = (const float*)(a.ws + WS_S5AUX) + (size_t)g * S5AUX_GROUP_FLOATS;
    LAS float* HR = (LAS float*)lds;
    LAS float* HI = HR + 2048;
    LAS float* UU = HI + 2048;
    LAS float* CR = UU + 512;
    LAS float* CI = CR + 1024;
    LAS float* BR = CI + 1024;
    LAS float* BI = BR + 1024;
    const int bl0 = tid >> 4, c0 = tid & 15;
    const unsigned short uraw = U[(size_t)(MP + bs0 + bl0) * DH + 16 * g + c0];
    float cr_[2], ci_[2], br_[2], bi_[2], h0r[4], h0i[4];
#pragma unroll
    for (int i = 0; i < 2; ++i) { const int idx = tid + 512 * i; cr_[i] = a.in[I_CRE][(size_t)g * 1024 + idx]; ci_[i] = a.in[I_CIM][(size_t)g * 1024 + idx]; br_[i] = aux[256 + idx]; bi_[i] = aux[1280 + idx]; }
#pragma unroll
    for (int i = 0; i < 4; ++i) { const int idx = tid + 512 * i, bl = idx >> 6, p = idx & 63; const size_t so = (size_t)((bs0 + bl) * NG + g) * NP + p; h0r[i] = a.in[I_S5RE][so]; h0i[i] = a.in[I_S5IM][so]; }
    const float lr = aux[tid & 63], li = aux[64 + (tid & 63)];
    const float dsk = a.in[I_DSKIP][g * 16 + c0];
    UU[tid] = __uint_as_float((unsigned)uraw << 16);
#pragma unroll
    for (int i = 0; i < 2; ++i) { const int idx = tid + 512 * i; CR[idx] = cr_[i]; CI[idx] = ci_[i]; BR[idx] = br_[i]; BI[idx] = bi_[i]; }
    __syncthreads();
#pragma unroll
    for (int i = 0; i < 4; ++i) {
        const int idx = tid + 512 * i, bl = idx >> 6, p = idx & 63;
        float hr = lr * h0r[i] - li * h0i[i], hi = lr * h0i[i] + li * h0r[i];
#pragma unroll
        for (int q = 0; q < 4; ++q) { const f32x4 br = *(const LAS f32x4*)(BR + p * 16 + 4 * q), bi = *(const LAS f32x4*)(BI + p * 16 + 4 * q); const f32x4 u4 = *(const LAS f32x4*)(UU + bl * 16 + 4 * q);
#pragma unroll
            for (int j = 0; j < 4; ++j) { hr += br[j] * u4[j]; hi += bi[j] * u4[j]; } }
        const size_t so = (size_t)((bs0 + bl) * NG + g) * NP + p;
        a.out[O_SS5RE + so] = hr; a.out[O_SS5IM + so] = hi;
        HR[idx] = hr; HI[idx] = hi;
    }
    __syncthreads();
    {
        float y = 0.f;
#pragma unroll 16
        for (int p = 0; p < 64; ++p) y += CR[c0 * 64 + p] * HR[bl0 * 64 + p] - CI[c0 * 64 + p] * HI[bl0 * 64 + p];
        y += dsk * UU[tid];
        const float gv = fgelu(y); const unsigned w = cvt_pk_bf16(gv, gv);
        GS5[(size_t)(MP + bs0 + bl0) * DH + 16 * g + c0] = (bf16_t)(w & 0xffffu);
    }
    __syncthreads();
}

constexpr int XC_PITCH = 144;
__device__ __forceinline__ void lru_item(const Args& a, LAS unsigned char* lds, bool sample, int b, int head, int q, int tid, int lane, int wave) {
    const float* XL = (const float*)(a.ws + WS_XLRU);
    const bf16_t* GG = (const bf16_t*)(a.ws + WS_GG);
    bf16_t* MRG = (bf16_t*)(a.ws + WS_MRG);
    float* ssq_lru = (float*)(a.ws + WS_CTL + CTL_SSQ_BYTE) + 3 * MPAD;
    LAS unsigned char* XC = lds;
    LAS float* XCF = (LAS float*)(lds + 36864);
    LAS float* AA = XCF + 4096;
    LAS float* BX = AA + 4096;
    LAS float* SEGP = BX + 4096;
    LAS float* SEGH = SEGP + 512;
    LAS float* CAR = SEGH + 512;
    const int ch0 = 64 * head + 16 * q;
    const int fr = lane & 15, fq = lane >> 4;
    bf16x8 Bf[2][2];
#pragma unroll
    for (int mat = 0; mat < 2; ++mat)
#pragma unroll
        for (int ks = 0; ks < 2; ++ks) {
            const float* w = (mat ? a.in[I_WX] : a.in[I_WA]) + ((size_t)(head * 64 + 32 * ks + 8 * fq)) * 64 + 16 * q + fr;
            u32x4 p; p.x = cvt_pk_bf16(w[0], w[64]); p.y = cvt_pk_bf16(w[128], w[192]); p.z = cvt_pk_bf16(w[256], w[320]); p.w = cvt_pk_bf16(w[384], w[448]);
            Bf[mat][ks] = __builtin_bit_cast(bf16x8, p);
        }
    const int chn = ch0 + fr;
    const float ba = a.in[I_BA][chn], bx_ = a.in[I_BX][chn];
    const float spl = log1pf(expf(-a.in[I_LAML][chn]));
    const int cq = tid & 15, cch = 64 * head + 4 * cq, rg = tid >> 4;
    const f32x4 cw0 = *(const f32x4*)(a.in[I_CONVW] + cch), cw1 = *(const f32x4*)(a.in[I_CONVW] + DH + cch), cw2 = *(const f32x4*)(a.in[I_CONVW] + 2 * DH + cch),
                cw3 = *(const f32x4*)(a.in[I_CONVW] + 3 * DH + cch), cb = *(const f32x4*)(a.in[I_CONVB] + cch);
    const int er = tid >> 1, eh = tid & 1;
    if (!sample) {
        float hcar = 0.f;
        f32x4 xin[11]; u32x4 ggn;
        { const int R0 = b * SEQ, r0 = rg * 8;
#pragma unroll
          for (int i = 0; i < 11; ++i) { const int t = r0 + i - 3; xin[i] = (t >= 0) ? *(const f32x4*)(XL + (size_t)(R0 + t) * DH + cch) : (f32x4){0.f, 0.f, 0.f, 0.f}; }
          ggn = *(const u32x4*)(GG + (size_t)(R0 + er) * DH + ch0 + 8 * eh); }
        for (int chk = 0; chk < 8; ++chk) {
            const int R0 = b * SEQ + chk * 256, r0 = rg * 8;
#pragma unroll
            for (int rr = 0; rr < 8; ++rr) {
                const f32x4 xc = cb + cw0 * xin[rr] + cw1 * xin[rr + 1] + cw2 * xin[rr + 2] + cw3 * xin[rr + 3];
                u32x2 w; w.x = cvt_pk_bf16(xc[0], xc[1]); w.y = cvt_pk_bf16(xc[2], xc[3]);
                *(LAS u32x2*)(XC + (r0 + rr) * XC_PITCH + 8 * cq) = w;
                if ((cq >> 2) == q) *(LAS f32x4*)(XCF + (r0 + rr) * 16 + 4 * (cq & 3)) = xc;
            }
            const u32x4 gw = ggn;
            if (chk < 7) {
                const float* p = XL + (size_t)(R0 + 256 + r0 - 3) * DH + cch;
#pragma unroll
                for (int i = 0; i < 11; ++i) xin[i] = *(const f32x4*)(p + (size_t)i * DH);
                ggn = *(const u32x4*)(GG + (size_t)(R0 + 256 + er) * DH + ch0 + 8 * eh);
            }
            __syncthreads();
#pragma unroll
            for (int tt = 0; tt < 2; ++tt) {
                const int tile = 2 * wave + tt;
                f32x4 ar = (f32x4){0.f, 0.f, 0.f, 0.f}, ax = ar;
#pragma unroll
                for (int ks = 0; ks < 2; ++ks) {
                    const bf16x8 af = *(const LAS bf16x8*)(XC + (16 * tile + fr) * XC_PITCH + 64 * ks + 16 * fq);
                    ar = __builtin_amdgcn_mfma_f32_16x16x32_bf16(af, Bf[0][ks], ar, 0, 0, 0);
                    ax = __builtin_amdgcn_mfma_f32_16x16x32_bf16(af, Bf[1][ks], ax, 0, 0, 0);
                }
#pragma unroll
                for (int r4 = 0; r4 < 4; ++r4) {
                    const int rr = 16 * tile + 4 * fq + r4;
                    const float xcv = XCF[rr * 16 + fr];
                    const float rg_ = fsigmoid(ar[r4] + ba), ig = fsigmoid(ax[r4] + bx_);
                    const float la = -8.0f * rg_ * spl;
                    const float av = fexp(la); AA[rr * 16 + fr] = av; BX[rr * 16 + fr] = __builtin_amdgcn_sqrtf(fmaxf(fmaf(-av, av, 1.0f), 0.f)) * (ig * xcv);
                }
            }
            __syncthreads();
            const int sn = tid & 15, sg = tid >> 4;
            float av[8], bv[8];
            { float P = 1.f, h = 0.f;
#pragma unroll
              for (int i = 0; i < 8; ++i) { av[i] = AA[(8 * sg + i) * 16 + sn]; bv[i] = BX[(8 * sg + i) * 16 + sn]; }
#pragma unroll
              for (int i = 0; i < 8; ++i) { h = av[i] * h + bv[i]; P *= av[i]; }
              SEGP[tid] = P; SEGH[tid] = h; }
            __syncthreads();
            if (wave == 0 && lane < 16) {
                float run = hcar;
#pragma unroll 8
                for (int s2 = 0; s2 < 32; ++s2) { CAR[s2 * 16 + lane] = run; run = SEGP[s2 * 16 + lane] * run + SEGH[s2 * 16 + lane]; }
                hcar = run;
            }
            __syncthreads();
            { float h = CAR[tid];
#pragma unroll
              for (int i = 0; i < 8; ++i) { h = av[i] * h + bv[i]; BX[(8 * sg + i) * 16 + sn] = h; } }
            __syncthreads();
            {
                const size_t row = (size_t)R0 + er;
                const f32x4 h0 = *(const LAS f32x4*)(BX + er * 16 + 8 * eh), h1 = *(const LAS f32x4*)(BX + er * 16 + 8 * eh + 4);
                const f32x4 y0 = (f32x4){h0[0] * bf_lo(gw.x), h0[1] * bf_hi(gw.x), h0[2] * bf_lo(gw.y), h0[3] * bf_hi(gw.y)};
                const f32x4 y1 = (f32x4){h1[0] * bf_lo(gw.z), h1[1] * bf_hi(gw.z), h1[2] * bf_lo(gw.w), h1[3] * bf_hi(gw.w)};
                *(u32x4*)(MRG + row * D + DH + ch0 + 8 * eh) = pack8(y0, y1);
                float s = dot4(y0) + dot4(y1);
                s += __shfl_xor(s, 1);
                if (eh == 0) atomicAdd(ssq_lru + row, s);
            }
        }
        if (wave == 0 && lane < 16) a.out[O_PLRUH + (size_t)b * DH + ch0 + lane] = hcar;
        if (wave == 1 && lane < 48) { const int k = lane >> 4, n = lane & 15;
            a.out[O_PLRUC + ((size_t)b * 3 + k) * DH + ch0 + n] = XL[(size_t)(b * SEQ + SEQ - 3 + k) * DH + ch0 + n]; }
    } else {
        const int R0 = MP, bs0 = 32 * b;
        {
            const float* cbuf = a.in[I_LRUCONV];
            const int bs = bs0 + rg;
            const f32x4 x0 = *(const f32x4*)(XL + (size_t)(R0 + bs) * DH + cch);
            const f32x4 c0 = *(const f32x4*)(cbuf + ((size_t)bs * 3 + 0) * DH + cch), c1 = *(const f32x4*)(cbuf + ((size_t)bs * 3 + 1) * DH + cch), c2 = *(const f32x4*)(cbuf + ((size_t)bs * 3 + 2) * DH + cch);
            const f32x4 xc = cb + cw0 * c0 + cw1 * c1 + cw2 * c2 + cw3 * x0;
            u32x2 w; w.x = cvt_pk_bf16(xc[0], xc[1]); w.y = cvt_pk_bf16(xc[2], xc[3]);
            *(LAS u32x2*)(XC + rg * XC_PITCH + 8 * cq) = w;
            if ((cq >> 2) == q) {
                *(LAS f32x4*)(XCF + rg * 16 + 4 * (cq & 3)) = xc;
                float* oc = a.out + O_SLRUC + (size_t)bs * 3 * DH + cch;
                *(f32x4*)oc = c1; *(f32x4*)(oc + DH) = c2; *(f32x4*)(oc + 2 * DH) = x0;
            }
        }
        __syncthreads();
        if (wave < 2) {
            const int tile = wave;
            f32x4 ar = (f32x4){0.f, 0.f, 0.f, 0.f}, ax = ar;
#pragma unroll
            for (int ks = 0; ks < 2; ++ks) {
                const bf16x8 af = *(const LAS bf16x8*)(XC + (16 * tile + fr) * XC_PITCH + 64 * ks + 16 * fq);
                ar = __builtin_amdgcn_mfma_f32_16x16x32_bf16(af, Bf[0][ks], ar, 0, 0, 0);
                ax = __builtin_amdgcn_mfma_f32_16x16x32_bf16(af, Bf[1][ks], ax, 0, 0, 0);
            }
#pragma unroll
            for (int r4 = 0; r4 < 4; ++r4) {
                const int rl = 16 * tile + 4 * fq + r4, bs = bs0 + rl;
                const float xcv = XCF[rl * 16 + fr];
                const float rg_ = fsigmoid(ar[r4] + ba), ig = fsigmoid(ax[r4] + bx_);
                const float la = -8.0f * rg_ * spl;
                const float av = fexp(la); const float h = av * a.in[I_LRUH][(size_t)bs * DH + chn] + __builtin_amdgcn_sqrtf(fmaxf(fmaf(-av, av, 1.0f), 0.f)) * (ig * xcv);
                BX[rl * 16 + fr] = h; a.out[O_SLRUH + (size_t)bs * DH + chn] = h;
            }
        }
        __syncthreads();
        if (er < 32) {
            const size_t row = (size_t)R0 + bs0 + er;
            const u32x4 gw = *(const u32x4*)(GG + row * DH + ch0 + 8 * eh);
            const f32x4 h0 = *(const LAS f32x4*)(BX + er * 16 + 8 * eh), h1 = *(const LAS f32x4*)(BX + er * 16 + 8 * eh + 4);
            const f32x4 y0 = (f32x4){h0[0] * bf_lo(gw.x), h0[1] * bf_hi(gw.x), h0[2] * bf_lo(gw.y), h0[3] * bf_hi(gw.y)};
            const f32x4 y1 = (f32x4){h1[0] * bf_lo(gw.z), h1[1] * bf_hi(gw.z), h1[2] * bf_lo(gw.w), h1[3] * bf_hi(gw.w)};
            *(u32x4*)(MRG + row * D + DH + ch0 + 8 * eh) = pack8(y0, y1);
            float s = dot4(y0) + dot4(y1);
            s += __shfl_xor(s, 1);
            if (eh == 0) atomicAdd(ssq_lru + row, s);
        }
    }
    __syncthreads();
}

__global__ void __launch_bounds__(NWAVES * 64, 2) hymba_fwd(Args args) {
    extern __shared__ __attribute__((aligned(16))) unsigned char lds_raw[];
    LAS unsigned char* lds = (LAS unsigned char*)lds_raw;
    volatile LAS unsigned* MISC = (volatile LAS unsigned*)(lds + MISC_OFF);
    const int tid = threadIdx.x, lane = tid & 63, wave = __builtin_amdgcn_readfirstlane(tid >> 6);
    const int G = gridDim.x, bx = blockIdx.x;
    const int vcu = (G % 8 == 0) ? (bx % 8) * (G / 8) + bx / 8 : bx;
    unsigned char* ws = args.ws;
    unsigned* ctl = (unsigned*)(ws + WS_CTL);
    for (int u = tid; u < (LDS_BYTES - LDSCTL_OFF) / 4; u += NWAVES * 64) ((LAS unsigned*)(lds + LDSCTL_OFF))[u] = 0u;
    __syncthreads();
    XcdBarrier bar; bar.bar = ctl + CW_BAR; bar.x = 0; bar.st = nullptr;
    if (MK_N_LAUNCHES == 1) bar = xcd_barrier_post(ctl + CW_BAR, MISC + 8);
#define GRID_BAR() do { if (MK_N_LAUNCHES == 1) xcd_barrier(bar); } while (0)
#define STAMP(k) do { if (PROBE_PHASE >= 0 && bx == 0 && tid == 0) { const unsigned long long now_ = __builtin_amdgcn_s_memrealtime(); \
        const unsigned long long prev_ = ((unsigned long long)MISC[17] << 32) | MISC[16]; if ((k) == PROBE_PHASE) { const unsigned long long d_ = now_ - prev_; MISC[18] = (unsigned)d_; } \
        MISC[16] = (unsigned)now_; MISC[17] = (unsigned)(now_ >> 32); } } while (0)
    STAMP(-1);
    const int lo = args.ph_lo, hi = args.ph_hi;
#define IN(k) (lo <= (k) && (k) < hi)
#define BOTH(k) (IN(k) && IN((k) + 1))
    float* ssq = (float*)(ws + WS_CTL + CTL_SSQ_BYTE);
    float *ssq0 = ssq, *ssq1 = ssq + MPAD, *ssq_s5 = ssq + 2 * MPAD, *ssq_lru = ssq + 3 * MPAD, *ssq2 = ssq + 4 * MPAD, *ssq3 = ssq + 5 * MPAD;
    bf16_t* XB = (bf16_t*)(ws + WS_XB); float* X1 = (float*)(ws + WS_X1); bf16_t* HID = (bf16_t*)(ws + WS_H);
    bf16_t* U = (bf16_t*)(ws + WS_U); float* XL = (float*)(ws + WS_XLRU); bf16_t* GG = (bf16_t*)(ws + WS_GG); bf16_t* MRG = (bf16_t*)(ws + WS_MRG);
    float* SLAB = (float*)(ws + WS_SLAB); float* SLAB5 = (float*)(ws + WS_U);
    const int gws = wave * G + bx;

    unsigned* cnt_fin2 = ctl + CW_CNT; unsigned* cnt_fin5 = ctl + CW_CNT + 64;
#define PUBLISH(cnt) do { asm volatile("s_waitcnt vmcnt(0)" ::: "memory"); __builtin_amdgcn_fence(__ATOMIC_RELEASE, "agent"); asm volatile("s_waitcnt vmcnt(0)" ::: "memory"); \
        if (lane == 0) __hip_atomic_fetch_add((cnt), 1u, __ATOMIC_RELAXED, __HIP_MEMORY_SCOPE_AGENT); } while (0)

    if (IN(0)) { p0_prologue(args, lds, vcu, G, lane, wave); if (BOTH(0)) GRID_BAR(); STAMP(0); }
    if (IN(1)) {
        constexpr int GG1 = 242;
        if (bx < GG1) {
            pg8::Gemm g{XB, (const bf16_t*)(ws + WS_W13A), D, D}; pg8::PanelOrder S; S.init(2 * FF / 256, D / 64, D / 64, GG1, bx);
            pg8::EpiSwiGLU E{HID, ssq0};
            pg8::gemm_phase(lds, g, S, E);
        } else {
            for (int gj = bx - GG1; gj < NG; gj += G - GG1) p0_s5_group(args, lds, gj, tid);
            __syncthreads();
            conv_tasks(args, lds + wave * STG_BYTES, 4, 4, (bx - GG1) * NWAVES + wave, (G - GG1) * NWAVES, lane);
        }
        if (BOTH(1)) GRID_BAR();
        STAMP(1);
    }
    if (IN(2)) {
        pg8::Gemm g{HID, (const bf16_t*)(ws + WS_W2A), FF, FF}; pg8::PanelOrder S; S.init(D / 256, FF / 64, 8, G, bx);
        pg8::EpiResid E{SLAB, XB, ssq1};
        pg8::gemm_phase(lds, g, S, E);
        if (BOTH(2)) GRID_BAR();
        STAMP(2);
    }
    if (IN(3)) {
        constexpr int GG3 = 198;
        { const int r = (bx >= GG3 && wave < 3) ? (bx - GG3) + (G - GG3) * wave : MS;
          if (r < MS) {
            const int row = MP + r;
            const f32x4* xr = (const f32x4*)(args.in[I_XS] + (size_t)r * D) + lane; f32x4 v[8]; float sq = 0.f;
#pragma unroll
            for (int j = 0; j < 8; ++j) { f32x4 t = (f32x4){0.f, 0.f, 0.f, 0.f};
#pragma unroll
                for (int sl = 0; sl < 11; ++sl) t += ((const f32x4*)(SLAB + ((size_t)sl * MS + r) * D) + lane)[64 * j];
                v[j] = xr[64 * j] + 0.5f * t; sq += dot4(v[j]); }
            sq = wave_sum(sq);
#pragma unroll
            for (int j = 0; j < 8; ++j) { ((f32x4*)(X1 + (size_t)row * D) + lane)[64 * j] = v[j];
                u32x2 w; w.x = cvt_pk_bf16(v[j][0], v[j][1]); w.y = cvt_pk_bf16(v[j][2], v[j][3]); ((u32x2*)(XB + (size_t)row * D) + lane)[64 * j] = w; }
            if (lane == 0) ssq1[row] = sq;
            PUBLISH(cnt_fin2);
          } }
        if (bx < GG3) {
            pg8::Gemm g{XB, (const bf16_t*)(ws + WS_WIN), D, D}; pg8::PanelOrder S; S.init(DIN / 256, D / 64, D / 64, GG3, bx); S.ready = cnt_fin2; S.need = MS;
            pg8::EpiProj E{U, XL, GG, ssq1};
            pg8::gemm_phase(lds, g, S, E);
        } else conv_tasks(args, lds + wave * STG_BYTES, 6, 7, (bx - GG3) * NWAVES + wave, (G - GG3) * NWAVES, lane);
        if (BOTH(3)) GRID_BAR();
        STAMP(3);
    }
    if (IN(4)) {
        { bf16_t* GS5 = (bf16_t*)(ws + WS_GS5); const int gw = bx * NWAVES + wave, NGW = G * NWAVES;
          for (int m = M + gw; m < MPAD; m += NGW) {
              ((u32x4*)(GS5 + (size_t)m * DH))[lane] = (u32x4){0u, 0u, 0u, 0u}; ((u32x4*)(GS5 + (size_t)m * DH))[64 + lane] = (u32x4){0u, 0u, 0u, 0u};
              ((u32x4*)(MRG + (size_t)m * D + DH))[lane] = (u32x4){0u, 0u, 0u, 0u}; ((u32x4*)(MRG + (size_t)m * D + DH))[64 + lane] = (u32x4){0u, 0u, 0u, 0u}; } }
        for (int it = bx; it < NB * NG; it += G) { const int b = it >> 6, g = ((it & 7) << 3) | ((it >> 3) & 7); s5_prompt(args, lds, b, g, tid, lane, wave); }
        STAMP(20);
        for (int it = bx; it < 4 * NG; it += G) s5_sample(args, lds, it >> 2, 32 * (it & 3), tid);
        STAMP(21);
        for (int it = bx; it < NB * 64; it += G) lru_item(args, lds, false, it >> 6, ((it & 7) << 1) | ((it >> 5) & 1), (it >> 3) & 3, tid, lane, wave);
        STAMP(22);
        if (BOTH(4)) GRID_BAR();
        STAMP(4);
    }
    if (IN(5)) {
        pg8::Gemm g{(const bf16_t*)(ws + WS_GS5), (const bf16_t*)(ws + WS_WGLU), DH, DH}; pg8::PanelOrder S; S.init(DH / 256, DH / 64, DH / 64, G, bx);
        pg8::EpiGlu E{(const bf16_t*)(ws + WS_GS5), args.in[I_BGLU], MRG, ssq_s5};
        pg8::gemm_phase(lds, g, S, E);
        if (bx >= 132) {
            conv_tasks(args, lds + wave * STG_BYTES, 5, 5, (bx - 132) * NWAVES + wave, (G - 132) * NWAVES, lane);
            __syncthreads();
            for (int it = bx - 132; it < 256; it += G - 132) lru_item(args, lds, true, it & 3, it >> 4, (it >> 2) & 3, tid, lane, wave);
        }
        if (BOTH(5)) GRID_BAR();
        STAMP(5);
    }
    if (IN(6)) {
        pg8::Gemm g{MRG, (const bf16_t*)(ws + WS_WOUT), D, D}; pg8::PanelOrder S; S.init(D / 256, D / 64, D / 64, G, bx); S.nExtra = 0;
        pg8::EpiOut E{ssq_s5, ssq_lru, XB, ssq2, nullptr};
        pg8::gemm_phase(lds, g, S, E);
        if (BOTH(6)) GRID_BAR();
        STAMP(6);
    }
    if (IN(7)) {
        constexpr int GG7 = 242;
        if (bx >= GG7) {
            pg8::Gemm g{MRG, (const bf16_t*)(ws + WS_WOUT), D, D}; pg8::PanelOrder S; S.init(D / 256, D / 64, D / 64, 8, bx - GG7); S.nwgP = 0;
            pg8::EpiOut E{ssq_s5, ssq_lru, XB, ssq2, nullptr};
            pg8::gemm_phase(lds, g, S, E);
            if (bx - GG7 < 8) { asm volatile("s_waitcnt vmcnt(0)" ::: "memory"); __syncthreads();
                if (tid == 0) { __builtin_amdgcn_fence(__ATOMIC_RELEASE, "agent"); asm volatile("s_waitcnt vmcnt(0)" ::: "memory"); __hip_atomic_fetch_add(cnt_fin5, 1u, __ATOMIC_RELAXED, __HIP_MEMORY_SCOPE_AGENT); } }
        }
        if (bx < GG7) {
            pg8::Gemm g{XB, (const bf16_t*)(ws + WS_W13B), D, D}; pg8::PanelOrder S; S.init(2 * FF / 256, D / 64, D / 64, GG7, bx); S.ready = cnt_fin5; S.need = 8;
            pg8::EpiSwiGLU E{HID, ssq2};
            pg8::gemm_phase(lds, g, S, E);
        } else conv_tasks(args, lds + wave * STG_BYTES, 8, 8, (bx - GG7) * NWAVES + wave, (G - GG7) * NWAVES, lane);
        if (BOTH(7)) GRID_BAR();
        STAMP(7);
    }
    if (IN(8)) {
        unsigned* cnt_pan = ctl + CW_CNT + 128; unsigned* cnt_slc = ctl + CW_CNT + 128 + 64 * 33;
        pg8::Gemm g{HID, (const bf16_t*)(ws + WS_W2B), FF, FF}; pg8::PanelOrder S; S.init(D / 256, FF / 64, 8, G, bx); S.extraFirst = true;
        pg8::EpiFinalFused E{XB, ssq3, SLAB, cnt_pan, cnt_slc, args.in[I_GFINAL], args.out};
        pg8::gemm_phase(lds, g, S, E);
        for (int rs = bx; rs < MS; rs += G) {
            if (tid < 64) {
                unsigned polls = 0;
                while ((unsigned)__builtin_amdgcn_readfirstlane(__hip_atomic_load(cnt_slc, __ATOMIC_RELAXED, __HIP_MEMORY_SCOPE_AGENT)) < 88u) { __builtin_amdgcn_s_sleep(2); if (++polls > (1u << 22)) break; }
                __builtin_amdgcn_fence(__ATOMIC_ACQUIRE, "agent");
                asm volatile("s_waitcnt vmcnt(0)" ::: "memory");
            }
            __syncthreads();
            LAS float* red = (LAS float*)lds;
            const int row = MP + rs, c4 = 64 * wave + lane;
            f32x4 t = (f32x4){0.f, 0.f, 0.f, 0.f};
#pragma unroll
            for (int sl = 0; sl < 11; ++sl) t += ((const f32x4*)(SLAB + ((size_t)sl * MS + rs) * D))[c4];
            const u32x2 xw = ((const u32x2*)(XB + (size_t)row * D))[c4];
            const f32x4 v = (f32x4){bf_lo(xw.x), bf_hi(xw.x), bf_lo(xw.y), bf_hi(xw.y)} + 0.5f * t;
            const float sq = wave_sum(dot4(v));
            if (lane == 0) red[wave] = sq;
            __syncthreads();
            float tot = 0.f;
#pragma unroll
            for (int k = 0; k < NWAVES; ++k) tot += red[k];
            const float r = rsqrtf(tot * (1.0f / D) + EPS);
            ((f32x4*)(args.out + (size_t)row * D))[c4] = v * ((const f32x4*)args.in[I_GFINAL])[c4] * r;
            __syncthreads();
        }
        STAMP(8);
    }
    if (PROBE_PHASE >= 0 && bx == 0 && tid == 0) {
        STAMP(9);
        const unsigned long long t0_ = __builtin_amdgcn_s_memrealtime(), d_ = 4ull * MISC[18];
        while (__builtin_amdgcn_s_memrealtime() - t0_ < d_) __builtin_amdgcn_s_sleep(8);
    }
#undef IN
#undef BOTH
#undef GRID_BAR
}

extern "C" void kernel_launch(void* const* d_in, const int* in_sizes, int n_in, void* d_out, int out_size, void* d_ws, size_t ws_size, hipStream_t stream) {
    static int grid = 0;
    if (grid == 0) {
        if (n_in != N_IN || in_sizes[0] != MP * D || (size_t)out_size != O_END || ws_size < WS_END) {
            fprintf(stderr, "kernel_launch: unexpected problem: n_in %d in0 %d out %d ws %zu (need %zu)\n", n_in, n_in > 0 ? in_sizes[0] : -1, out_size, ws_size, (size_t)WS_END); grid = -1; return; }
        int dev = 0, cus = 0;
        if (hipGetDevice(&dev) != hipSuccess || hipDeviceGetAttribute(&cus, hipDeviceAttributeMultiprocessorCount, dev) != hipSuccess) { grid = -1; return; }
        if (hipFuncSetAttribute((const void*)hymba_fwd, hipFuncAttributeMaxDynamicSharedMemorySize, LDS_BYTES) != hipSuccess) { fprintf(stderr, "kernel_launch: hipFuncSetAttribute failed\n"); grid = -1; return; }
        int per_cu = 0;
        if (hipOccupancyMaxActiveBlocksPerMultiprocessor(&per_cu, (const void*)hymba_fwd, NWAVES * 64, LDS_BYTES) != hipSuccess || per_cu < 1)
            fprintf(stderr, "kernel_launch: note: occupancy query reports %d workgroups per CU\n", per_cu);
        (void)hipGetLastError();
        grid = cus;
    }
    if (grid < 0) return;
    if (hipMemsetAsync((char*)d_ws + WS_CTL, 0, CTL_ZERO_BYTES, stream) != hipSuccess) { fprintf(stderr, "kernel_launch: memset failed\n"); return; }
    Args a{};
    for (int i = 0; i < N_IN; ++i) a.in[i] = (const float*)d_in[i];
    a.out = (float*)d_out; a.ws = (unsigned char*)d_ws;
    if (MK_N_LAUNCHES == 1) {
        a.ph_lo = 0; a.ph_hi = NPHASE;
        hipLaunchKernelGGL(hymba_fwd, dim3(grid), dim3(NWAVES * 64), LDS_BYTES, stream, a);
    } else {
        for (int p = 0; p < NPHASE; ++p) { a.ph_lo = p; a.ph_hi = p + 1; hipLaunchKernelGGL(hymba_fwd, dim3(grid), dim3(NWAVES * 64), LDS_BYTES, stream, a); }
    }
}
```
